# Optimizing an MI355X kernel written in HIP

```python
import jax, jax.numpy as jnp
from jax import lax
import numpy as np

D_MODEL = 2048
BATCH = 4
SEQ = 4096
DEPTH = 1

MEM_LEN = 256
ATTN_HEADS = 8
HEAD_DIM = 128
ATTN_WIDTH = ATTN_HEADS * HEAD_DIM
CONV_WIDTH = D_MODEL // 2
MIX_WIDTH = ATTN_WIDTH + CONV_WIDTH
IN_WIDTH = 3 * ATTN_WIDTH + 3 * CONV_WIDTH
CONV_K = 3
MOBA_BLOCK = 256
MOBA_TOPK = 3
Q_CHUNK = 16
XATTN_HEADS = 4
XATTN_HEAD_DIM = 128
XATTN_WIDTH = XATTN_HEADS * XATTN_HEAD_DIM
D_FF = ((int(8 * D_MODEL / 3) + 255) // 256) * 256
RMS_EPS = 1e-6
NEG = -1e30

kernel_name = "hymba_moba_shortconv_macaron"


def rmsnorm(x, g):
    xf = x.astype(jnp.float32)
    y = xf * lax.rsqrt(jnp.mean(xf * xf, axis=-1, keepdims=True) + RMS_EPS)
    return (y * g.astype(jnp.float32)).astype(x.dtype)


def swiglu(x, w_gate, w_up, w_down):
    return (jax.nn.silu(x @ w_gate) * (x @ w_up)) @ w_down


def moba_attention(q, k, v):
    b, s, h, dh = q.shape
    n_blk = -(-s // MOBA_BLOCK)
    s_pad = n_blk * MOBA_BLOCK
    pad = ((0, 0), (0, s_pad - s), (0, 0), (0, 0))
    q, k, v = [jnp.pad(t, pad).transpose(0, 2, 1, 3) for t in (q, k, v)]
    scale = dh ** -0.5
    kb = k.reshape(b, h, n_blk, MOBA_BLOCK, dh)
    vb = v.reshape(b, h, n_blk, MOBA_BLOCK, dh)
    topk = min(MOBA_TOPK, n_blk - 1)
    n_chunk = s_pad // Q_CHUNK
    qc = q.reshape(b, h, n_chunk, Q_CHUNK, dh).transpose(2, 0, 1, 3, 4)
    xs = (jnp.arange(n_chunk, dtype=jnp.int32), qc)
    if topk > 0:
        k_mean = jnp.mean(kb.astype(jnp.float32), axis=3)
        gate = jnp.einsum('bhsd,bhnd->bhsn', q.astype(jnp.float32), k_mean)
        q_blk = jnp.arange(s_pad, dtype=jnp.int32) // MOBA_BLOCK
        past = jnp.arange(n_blk, dtype=jnp.int32)[None, :] < q_blk[:, None]
        gate = jnp.where(past, gate, NEG)
        _, idx = lax.top_k(gate, topk)
        valid = idx < q_blk[:, None]
        idx_c = idx.reshape(b, h, n_chunk, Q_CHUNK, topk).transpose(2, 0, 1, 3, 4)
        valid_c = valid.reshape(b, h, n_chunk, Q_CHUNK, topk).transpose(2, 0, 1, 3, 4)
        xs = xs + (idx_c, valid_c)
    bi = jnp.arange(b)[:, None, None, None]
    hi = jnp.arange(h)[None, :, None, None]

    def chunk_attend(xs_i):
        c, q_i = xs_i[0], xs_i[1]
        t = c * Q_CHUNK + jnp.arange(Q_CHUNK, dtype=jnp.int32)
        blk = (c * Q_CHUNK) // MOBA_BLOCK
        k_own = lax.dynamic_index_in_dim(kb, blk, axis=2, keepdims=False)
        v_own = lax.dynamic_index_in_dim(vb, blk, axis=2, keepdims=False)
        qf = q_i.astype(jnp.float32) * scale
        s_own = jnp.einsum('bhqd,bhpd->bhqp', qf, k_own.astype(jnp.float32))
        kpos = blk * MOBA_BLOCK + jnp.arange(MOBA_BLOCK, dtype=jnp.int32)
        s_own = jnp.where(kpos[None, :] <= t[:, None], s_own, NEG)
        if topk > 0:
            idx_i, valid_i = xs_i[2], xs_i[3]
            k_sel = kb[bi, hi, idx_i]
            v_sel = vb[bi, hi, idx_i]
            s_sel = jnp.einsum('bhqd,bhqkpd->bhqkp', qf, k_sel.astype(jnp.float32))
            s_sel = jnp.where(valid_i[..., None], s_sel, NEG)
            s_sel = s_sel.reshape(b, h, Q_CHUNK, topk * MOBA_BLOCK)
            p = jax.nn.softmax(jnp.concatenate([s_own, s_sel], axis=-1), axis=-1)
            p_own = p[..., :MOBA_BLOCK]
            p_sel = p[..., MOBA_BLOCK:].reshape(b, h, Q_CHUNK, topk, MOBA_BLOCK)
            o = (jnp.einsum('bhqp,bhpd->bhqd', p_own, v_own.astype(jnp.float32))
                 + jnp.einsum('bhqkp,bhqkpd->bhqd', p_sel, v_sel.astype(jnp.float32)))
        else:
            p = jax.nn.softmax(s_own, axis=-1)
            o = jnp.einsum('bhqp,bhpd->bhqd', p, v_own.astype(jnp.float32))
        return o.astype(q_i.dtype)

    out = lax.map(chunk_attend, xs)
    out = out.transpose(1, 0, 3, 2, 4).reshape(b, s_pad, h, dh)
    return out[:, :s]


def short_conv(u, w):
    return lax.conv_general_dilated(
        u, w[:, None, :].astype(u.dtype), window_strides=(1,), padding=((CONV_K - 1, 0),),
        dimension_numbers=('NWC', 'WIO', 'NWC'), feature_group_count=u.shape[-1])


def cross_attention(n, m, w_q, w_kv, w_o):
    b, s, _ = n.shape
    ml = m.shape[1]
    qx = (n @ w_q).reshape(b, s, XATTN_HEADS, XATTN_HEAD_DIM)
    kx, vx = jnp.split(m @ w_kv, 2, axis=-1)
    kx = kx.reshape(b, ml, XATTN_HEADS, XATTN_HEAD_DIM)
    vx = vx.reshape(b, ml, XATTN_HEADS, XATTN_HEAD_DIM)
    sc = jnp.einsum('bshd,bmhd->bhsm', qx.astype(jnp.float32), kx.astype(jnp.float32)) * (XATTN_HEAD_DIM ** -0.5)
    p = jax.nn.softmax(sc, axis=-1)
    o = jnp.einsum('bhsm,bmhd->bshd', p, vx.astype(jnp.float32)).astype(n.dtype)
    return o.reshape(b, s, XATTN_WIDTH) @ w_o


def setup_inputs(seed: int = 0) -> dict:
    key = jax.random.key(seed)
    ks = jax.random.split(key, 24)
    L, D, F = DEPTH, D_MODEL, D_FF
    nrm = lambda k, shape, fan_in: jax.random.normal(k, shape, jnp.float32) * (fan_in ** -0.5)
    gain = lambda k, shape: 1.0 + 0.02 * jax.random.normal(k, shape, jnp.float32)
    return {
        "x": jax.random.normal(ks[0], (BATCH, SEQ, D), jnp.float32),
        "mem": jax.random.normal(ks[1], (BATCH, MEM_LEN, D), jnp.float32),
        "ffn1_norm": gain(ks[2], (L, D)),
        "ffn1_w_gate": nrm(ks[3], (L, D, F), D),
        "ffn1_w_up": nrm(ks[4], (L, D, F), D),
        "ffn1_w_down": nrm(ks[5], (L, F, D), F),
        "mix_norm": gain(ks[6], (L, D)),
        "w_in": nrm(ks[7], (L, D, IN_WIDTH), D),
        "conv_w": nrm(ks[8], (L, CONV_K, CONV_WIDTH), CONV_K),
        "attn_out_norm": gain(ks[9], (L, ATTN_WIDTH)),
        "conv_out_norm": gain(ks[10], (L, CONV_WIDTH)),
        "w_out": nrm(ks[11], (L, MIX_WIDTH, D), MIX_WIDTH),
        "xattn_norm": gain(ks[12], (L, D)),
        "mem_norm": gain(ks[13], (L, D)),
        "xattn_w_q": nrm(ks[14], (L, D, XATTN_WIDTH), D),
        "xattn_w_kv": nrm(ks[15], (L, D, 2 * XATTN_WIDTH), D),
        "xattn_w_o": nrm(ks[16], (L, XATTN_WIDTH, D), XATTN_WIDTH),
        "ffn2_norm": gain(ks[17], (L, D)),
        "ffn2_w_gate": nrm(ks[18], (L, D, F), D),
        "ffn2_w_up": nrm(ks[19], (L, D, F), D),
        "ffn2_w_down": nrm(ks[20], (L, F, D), F),
        "final_norm": gain(ks[21], (D,)),
    }


def reference(x, mem, ffn1_norm, ffn1_w_gate, ffn1_w_up, ffn1_w_down, mix_norm, w_in, conv_w,
              attn_out_norm, conv_out_norm, w_out, xattn_norm, mem_norm, xattn_w_q, xattn_w_kv,
              xattn_w_o, ffn2_norm, ffn2_w_gate, ffn2_w_up, ffn2_w_down, final_norm):
    b, s, _ = x.shape
    A, C = ATTN_WIDTH, CONV_WIDTH
    h = x
    for l in range(DEPTH):
        h = h + 0.5 * swiglu(rmsnorm(h, ffn1_norm[l]), ffn1_w_gate[l], ffn1_w_up[l], ffn1_w_down[l])
        n = rmsnorm(h, mix_norm[l])
        proj = n @ w_in[l]
        q, k, v, c_gate, b_gate, u = jnp.split(proj, [A, 2 * A, 3 * A, 3 * A + C, 3 * A + 2 * C], axis=-1)
        hs = (b, s, ATTN_HEADS, HEAD_DIM)
        a_out = moba_attention(q.reshape(hs), k.reshape(hs), v.reshape(hs)).reshape(b, s, A)
        c_out = b_gate * short_conv(c_gate * u, conv_w[l])
        mixed = jnp.concatenate([rmsnorm(a_out, attn_out_norm[l]), rmsnorm(c_out, conv_out_norm[l])], axis=-1)
        h = h + mixed @ w_out[l]
        h = h + cross_attention(rmsnorm(h, xattn_norm[l]), rmsnorm(mem, mem_norm[l]),
                                xattn_w_q[l], xattn_w_kv[l], xattn_w_o[l])
        h = h + 0.5 * swiglu(rmsnorm(h, ffn2_norm[l]), ffn2_w_gate[l], ffn2_w_up[l], ffn2_w_down[l])
    return rmsnorm(h, final_norm)
```

```cpp
#define ONE_LAUNCH 0
#define FAST_MASK 0x1021
#include <hip/hip_runtime.h>
#include <cstdio>
#include <cstdint>
namespace pg8 {
#define PG8_LAS __attribute__((address_space(3)))
typedef unsigned short bf16_t;
typedef short bf16x8 __attribute__((ext_vector_type(8)));
typedef float f32x4 __attribute__((ext_vector_type(4)));
typedef unsigned u32x4 __attribute__((ext_vector_type(4)));
constexpr int BM = 256, BK = 64, HALF = 128, HTB = HALF * BK * 2  , STAGE_BYTES = 8 * HTB, NXCD = 8, WGM = 8;

__host__ __device__ __forceinline__ int lds_byte(int r, int c) { const int st = (r >> 4) * 2 + (c >> 5), rr = r & 15, cc = c & 31, ob = rr * 64 + cc * 2; return st * 1024 + (ob ^ (((ob >> 9) & 1) << 5)); }
__host__ __device__ __forceinline__ void stage_rc(int b, int& R, int& C) { const int st = b / 1024, sb = b % 1024, swz = sb ^ (((sb >> 9) & 1) << 5); R = (st >> 1) * 16 + swz / 64; C = (st & 1) * 32 + (swz % 64) / 2; }
__host__ __device__ __forceinline__ int perm32(int rho) { const int n = rho >> 4, i = rho & 15; return 8 * (i >> 2) + 4 * n + (i & 3); }

struct Unit { int pm, pn; };
struct Gemm { const bf16_t* A; const bf16_t* Bt; int M, N, K; };

struct StaticOrder {
    int nM, nN, nwg, G, c;
    __host__ __device__ void init(int M, int N, int G_, int c_) { nM = M / BM; nN = N / BM; nwg = nM * nN; G = G_; c = c_; }
    __host__ __device__ bool next(int i, Unit& u) const {
        const long L = (long)i * G + c; if (L >= nwg) return false;
        int wgid = (int)L; { const int q = nwg / NXCD, r = nwg % NXCD, xcd = wgid % NXCD, off = wgid / NXCD; wgid = (xcd < r ? xcd * (q + 1) : r * (q + 1) + (xcd - r) * q) + off; }
        const int nig = WGM * nN, gid = wgid / nig, fm = gid * WGM, gsz = (nM - fm) < WGM ? (nM - fm) : WGM;
        u.pm = fm + ((wgid % nig) % gsz); u.pn = (wgid % nig) / gsz; return true;
    }
    __device__ __forceinline__ void a_ready(const Unit&) const {}
    __device__ __forceinline__ void done(const Unit&) const {}
};

__device__ __forceinline__ unsigned cvt_pk_bf16(float lo, float hi) { unsigned r; asm volatile("v_cvt_pk_bf16_f32 %0, %1, %2" : "=v"(r) : "v"(lo), "v"(hi)); return r; }
__device__ __forceinline__ u32x4 pack8(const f32x4 v0, const f32x4 v1) { u32x4 w; w.x = cvt_pk_bf16(v0[0], v0[1]); w.y = cvt_pk_bf16(v0[2], v0[3]); w.z = cvt_pk_bf16(v1[0], v1[1]); w.w = cvt_pk_bf16(v1[2], v1[3]); return w; }
constexpr float RMS_EPS = 1e-6f;
__device__ __forceinline__ float silu_mul(float g, float u) { return g * u * __builtin_amdgcn_rcpf(1.0f + __builtin_amdgcn_exp2f(-1.4426950408889634f * g)); }

struct EpiSwiglu {
    static constexpr bool PERM = true, AFTER_DRAIN = false; static constexpr int MIDT = 0;
    bf16_t* O; int ldo; const float* ss;
    __device__ __forceinline__ void mid(f32x4 (&)[2][2][4][2], const Unit&, int, int) const {}
    __device__ __forceinline__ void operator()(const f32x4 (&acc)[2][2][4][2], const Unit& u, int wr, int wc, int fr_, int fq_) const {
        int fr = fr_, fq = fq_; asm volatile("" : "+v"(fr), "+v"(fq));
        const int row0 = u.pm * BM + wr * 64 + fr, col0 = u.pn * HALF + wc * 32 + 8 * fq;
#pragma unroll
        for (int ai = 0; ai < 2; ++ai)
#pragma unroll
            for (int m = 0; m < 4; ++m) { const int row = row0 + ai * HALF + m * 16; const float rs = rsqrtf(ss[row] * (1.0f / 2048.0f) + RMS_EPS);
                f32x4 o0, o1;
#pragma unroll
                for (int j = 0; j < 4; ++j) { o0[j] = silu_mul(acc[ai][0][m][0][j] * rs, acc[ai][1][m][0][j] * rs); o1[j] = silu_mul(acc[ai][0][m][1][j] * rs, acc[ai][1][m][1][j] * rs); }
                *(u32x4*)(O + (size_t)row * ldo + col0) = pack8(o0, o1); }
    }
};
template <int MIDT_> struct EpiResid {
    static constexpr bool PERM = true, AFTER_DRAIN = false; static constexpr int MIDT = MIDT_;
    const float* R; float* H; bf16_t* HB; float* ssn; float alpha; const float* midss;
    __device__ __forceinline__ void mid(f32x4 (&acc)[2][2][4][2], const Unit& u, int wr, int fr) const {
        const int row0 = u.pm * BM + wr * 64 + fr;
#pragma unroll
        for (int ai = 0; ai < 2; ++ai)
#pragma unroll
            for (int m = 0; m < 4; ++m) { const float s = rsqrtf(midss[row0 + ai * HALF + m * 16] * (1.0f / 1024.0f) + RMS_EPS);
#pragma unroll
                for (int bj = 0; bj < 2; ++bj)
#pragma unroll
                    for (int n = 0; n < 2; ++n) acc[ai][bj][m][n] = acc[ai][bj][m][n] * s; }
    }
    __device__ __forceinline__ void operator()(const f32x4 (&acc)[2][2][4][2], const Unit& u, int wr, int wc, int fr_, int fq_) const {
        int fr = fr_, fq = fq_; asm volatile("" : "+v"(fr), "+v"(fq));
        const int row0 = u.pm * BM + wr * 64 + fr, col0 = u.pn * BM + wc * 32 + 8 * fq;
#pragma unroll
        for (int ai = 0; ai < 2; ++ai)
#pragma unroll
            for (int m = 0; m < 4; ++m) { const int row = row0 + ai * HALF + m * 16; const size_t off = (size_t)row * 2048 + col0; float sq = 0.f;
#pragma unroll
                for (int bj = 0; bj < 2; ++bj) { const f32x4 r0 = *(const f32x4*)(R + off + bj * HALF), r1 = *(const f32x4*)(R + off + bj * HALF + 4);
                    const f32x4 h0 = r0 + acc[ai][bj][m][0] * alpha, h1 = r1 + acc[ai][bj][m][1] * alpha;
                    *(f32x4*)(H + off + bj * HALF) = h0; *(f32x4*)(H + off + bj * HALF + 4) = h1;
                    if (HB) *(u32x4*)(HB + off + bj * HALF) = pack8(h0, h1);
                    sq += (h0[0] * h0[0] + h0[1] * h0[1]) + (h0[2] * h0[2] + h0[3] * h0[3]) + (h1[0] * h1[0] + h1[1] * h1[1]) + (h1[2] * h1[2] + h1[3] * h1[3]); }
                sq += __shfl_xor(sq, 16); sq += __shfl_xor(sq, 32);
                if (fq == 0) unsafeAtomicAdd(ssn + row, sq);
                asm volatile("" ::: "memory"); }
    }
};
struct EpiWin {
    static constexpr bool PERM = true, AFTER_DRAIN = false; static constexpr int MIDT = 0;
    bf16_t *Q, *K, *V, *CU, *BG; float* kms; const float* ss;
    __device__ __forceinline__ void mid(f32x4 (&)[2][2][4][2], const Unit&, int, int) const {}
    __device__ __forceinline__ void operator()(const f32x4 (&acc)[2][2][4][2], const Unit& u, int wr, int wc, int fr_, int fq_) const {
        int fr = fr_, fq = fq_; asm volatile("" : "+v"(fr), "+v"(fq));
        const int row0 = u.pm * BM + wr * 64 + fr, pn = u.pn;
        if (pn >= 12 && pn < 20) {
            const int col0 = (pn - 12) * HALF + wc * 32 + 8 * fq;
#pragma unroll
            for (int ai = 0; ai < 2; ++ai)
#pragma unroll
                for (int m = 0; m < 4; ++m) { const int row = row0 + ai * HALF + m * 16; float rs = rsqrtf(ss[row] * (1.0f / 2048.0f) + RMS_EPS); rs = rs * rs;
                    const f32x4 o0 = acc[ai][0][m][0] * acc[ai][1][m][0] * rs, o1 = acc[ai][0][m][1] * acc[ai][1][m][1] * rs;
                    *(u32x4*)(CU + (size_t)row * 1024 + col0) = pack8(o0, o1); }
        } else {
            bf16_t* base = pn < 4 ? Q : pn < 8 ? K : pn < 12 ? V : BG; const int colt = (pn & 3) * BM, col0 = colt + wc * 32 + 8 * fq; const bool isk = (pn >= 4 && pn < 8);
            float rsv[2][4];
#pragma unroll
            for (int ai = 0; ai < 2; ++ai)
#pragma unroll
                for (int m = 0; m < 4; ++m) rsv[ai][m] = rsqrtf(ss[row0 + ai * HALF + m * 16] * (1.0f / 2048.0f) + RMS_EPS);
#pragma unroll
            for (int ai = 0; ai < 2; ++ai)
#pragma unroll
                for (int m = 0; m < 4; ++m) { const int row = row0 + ai * HALF + m * 16;
#pragma unroll
                    for (int bj = 0; bj < 2; ++bj) *(u32x4*)(base + (size_t)row * 1024 + col0 + bj * HALF) = pack8(acc[ai][bj][m][0] * rsv[ai][m], acc[ai][bj][m][1] * rsv[ai][m]); }
            if (isk) {
#pragma unroll
                for (int bj = 0; bj < 2; ++bj)
#pragma unroll
                    for (int n = 0; n < 2; ++n) { f32x4 c = (f32x4){0.f, 0.f, 0.f, 0.f};
#pragma unroll
                        for (int ai = 0; ai < 2; ++ai)
#pragma unroll
                            for (int m = 0; m < 4; ++m) { float r2 = rsv[ai][m]; asm volatile("" : "+v"(r2)); c += acc[ai][bj][m][n] * r2; }
#pragma unroll
                        for (int j = 0; j < 4; ++j) { float v = c[j]; v += __shfl_xor(v, 1); v += __shfl_xor(v, 2); v += __shfl_xor(v, 4); v += __shfl_xor(v, 8);
                            const int col = col0 + bj * HALF + 4 * n + j;
                            if (fr == 0) unsafeAtomicAdd(kms + ((size_t)u.pm * 8 + (col >> 7)) * 128 + (col & 127), v); }
                        asm volatile("" ::: "memory"); }
            }
        }
    }
};
struct EpiScaleBf16 {
    static constexpr bool PERM = true, AFTER_DRAIN = false; static constexpr int MIDT = 0;
    bf16_t* O; int ldo; const float* ss;
    __device__ __forceinline__ void mid(f32x4 (&)[2][2][4][2], const Unit&, int, int) const {}
    __device__ __forceinline__ void operator()(const f32x4 (&acc)[2][2][4][2], const Unit& u, int wr, int wc, int fr_, int fq_) const {
        int fr = fr_, fq = fq_; asm volatile("" : "+v"(fr), "+v"(fq));
        const int row0 = u.pm * BM + wr * 64 + fr, col0 = u.pn * BM + wc * 32 + 8 * fq;
#pragma unroll
        for (int ai = 0; ai < 2; ++ai)
#pragma unroll
            for (int m = 0; m < 4; ++m) { const int row = row0 + ai * HALF + m * 16; const float rs = ss ? rsqrtf(ss[row] * (1.0f / 2048.0f) + RMS_EPS) : 1.0f;
#pragma unroll
                for (int bj = 0; bj < 2; ++bj) *(u32x4*)(O + (size_t)row * ldo + col0 + bj * HALF) = pack8(acc[ai][bj][m][0] * rs, acc[ai][bj][m][1] * rs); }
    }
};

template <class Epi, class Sched, bool ALIGN_EPI = false, bool SP2 = false>
__device__ __forceinline__ void gemm_phase(PG8_LAS unsigned char* lds, const Gemm g, const Sched& S, const Epi& E) {
    int tid_ = threadIdx.x; asm volatile("" : "+v"(tid_));
    const int tid = tid_, wid = __builtin_amdgcn_readfirstlane(tid >> 6), lane = tid & 63, wr = wid >> 2, wc = wid & 3, fr = lane & 15, fq = lane >> 4;
    const int K = g.K, nt = K / BK;
    unsigned voffA[2], voffB[2];
#pragma unroll
    for (int i = 0; i < 2; ++i) { int R, C; stage_rc(tid * 16 + i * 8192, R, C); const int Rb = Epi::PERM ? ((R & ~31) + perm32(R & 31)) : R;
        voffA[i] = (unsigned)(R * K + C) * 2u; voffB[i] = (unsigned)(Rb * K + C) * 2u; }
    const size_t kstep = (size_t)(BK * 2);
    const size_t hstep = (size_t)HALF * K * 2;
    const size_t tstep = 2 * hstep;
    const unsigned ldsw = (unsigned)wid * 1024u;
    const int aoff = lds_byte(wr * 64 + fr, fq * 8), boff = lds_byte(wc * 32 + fr, fq * 8);
#define PG8_SA(b, h) (((b) * 2 + (h)) * HTB)
#define PG8_SB(b, h) ((4 + (b) * 2 + (h)) * HTB)
#define PG8_STAGE(bufoff, gbase, voff) do { _Pragma("unroll") for (int _i = 0; _i < 2; ++_i) \
        __builtin_amdgcn_global_load_lds((const unsigned*)((const char*)(gbase) + (voff)[_i]), (PG8_LAS unsigned*)(lds + (bufoff) + ldsw + _i * 8192), 16, 0, 0); } while (0)
#define PG8_LDA(dst, b, h) do { _Pragma("unroll") for (int m = 0; m < 4; ++m) _Pragma("unroll") for (int k = 0; k < 2; ++k) dst[m][k] = *(const PG8_LAS bf16x8*)(lds + PG8_SA(b, h) + aoff + m * 2048 + k * 1024); } while (0)
#define PG8_LDB(dst, b, h) do { _Pragma("unroll") for (int n = 0; n < 2; ++n) _Pragma("unroll") for (int k = 0; k < 2; ++k) dst[n][k] = *(const PG8_LAS bf16x8*)(lds + PG8_SB(b, h) + boff + n * 2048 + k * 1024); } while (0)
#define PG8_MMA(ai, bj, At, Bt) do { __builtin_amdgcn_s_setprio(1); _Pragma("unroll") for (int m = 0; m < 4; ++m) _Pragma("unroll") for (int n = 0; n < 2; ++n) _Pragma("unroll") for (int k = 0; k < 2; ++k) \
        acc[ai][bj][m][n] = __builtin_amdgcn_mfma_f32_16x16x32_bf16(Bt[n][k], At[m][k], acc[ai][bj][m][n], 0, 0, 0); __builtin_amdgcn_s_setprio(0); } while (0)
#define PG8_WAIT_V(n) asm volatile("s_waitcnt vmcnt(" #n ")" ::: "memory")
#define PG8_WAIT_L(n) asm volatile("s_waitcnt lgkmcnt(" #n ")" ::: "memory")
#define PG8_BAR __builtin_amdgcn_s_barrier()
#define PG8_SCHED __builtin_amdgcn_sched_barrier(0)
    Unit cur, nxt; int ui = 0;
    if (!S.next(0, cur)) return;
    f32x4 acc[2][2][4][2];
#pragma unroll
    for (int a = 0; a < 2; ++a)
#pragma unroll
        for (int b = 0; b < 2; ++b)
#pragma unroll
            for (int m = 0; m < 4; ++m)
#pragma unroll
                for (int n = 0; n < 2; ++n) acc[a][b][m][n] = (f32x4){0.f, 0.f, 0.f, 0.f};
    bf16x8 At[4][2], B0[2][2], B1[2][2];
    const char* cA = (const char*)g.A + (size_t)cur.pm * tstep; const char* cB = (const char*)g.Bt + (size_t)cur.pn * tstep;
    S.a_ready(cur);
    if constexpr (SP2) {
        PG8_STAGE(PG8_SB(0, 0), cB, voffB); PG8_STAGE(PG8_SB(0, 1), cB + hstep, voffB); PG8_STAGE(PG8_SA(0, 0), cA, voffA); PG8_STAGE(PG8_SA(0, 1), cA + hstep, voffA);
        if (wr == 1) PG8_BAR;
        PG8_WAIT_V(2); PG8_BAR;
        PG8_STAGE(PG8_SB(1, 0), cB + kstep, voffB); PG8_STAGE(PG8_SA(1, 0), cA + kstep, voffA); PG8_STAGE(PG8_SB(1, 1), cB + hstep + kstep, voffB);
        PG8_WAIT_V(6); PG8_BAR;
    } else {
        PG8_STAGE(PG8_SB(0, 0), cB, voffB); PG8_STAGE(PG8_SA(0, 0), cA, voffA); PG8_STAGE(PG8_SB(0, 1), cB + hstep, voffB); PG8_STAGE(PG8_SA(0, 1), cA + hstep, voffA);
        if (wr == 1) PG8_BAR;
        PG8_WAIT_V(4); PG8_BAR;
        PG8_STAGE(PG8_SB(1, 0), cB + kstep, voffB); PG8_STAGE(PG8_SA(1, 0), cA + kstep, voffA); PG8_STAGE(PG8_SB(1, 1), cB + hstep + kstep, voffB);
        PG8_WAIT_V(6); PG8_BAR;
    }
    for (;;) {
        const bool has_next = S.next(ui + 1, nxt);
        const char* nA = has_next ? (const char*)g.A + (size_t)nxt.pm * tstep : cA; const char* nB = has_next ? (const char*)g.Bt + (size_t)nxt.pn * tstep : cB;
        for (int t = 0; t < nt; t += 2) {
            if constexpr (Epi::MIDT > 0) { if (t == Epi::MIDT) E.mid(acc, cur, wr, fr); }
            const bool last = (t == nt - 2);
            const char* a1 = cA + (size_t)(t + 1) * kstep;
            const char* a2 = last ? nA : cA + (size_t)(t + 2) * kstep; const char* b2 = last ? nB : cB + (size_t)(t + 2) * kstep;
            const char* a3 = a2 + kstep; const char* b3 = b2 + kstep;
            if (last && has_next) S.a_ready(nxt);
            if constexpr (SP2) {
            PG8_LDB(B0, 0, 0); PG8_LDB(B1, 0, 1); PG8_SCHED; PG8_LDA(At, 0, 0); PG8_STAGE(PG8_SA(1, 1), a1 + hstep, voffA);
            PG8_WAIT_V(8); PG8_WAIT_L(0); PG8_BAR; PG8_MMA(0, 0, At, B0); PG8_MMA(0, 1, At, B1); PG8_BAR; PG8_SCHED;
            PG8_LDA(At, 0, 1); PG8_STAGE(PG8_SB(0, 0), b2, voffB); PG8_STAGE(PG8_SB(0, 1), b2 + hstep, voffB); PG8_STAGE(PG8_SA(0, 0), a2, voffA);
            PG8_WAIT_V(8); PG8_WAIT_L(0); PG8_BAR; PG8_MMA(1, 0, At, B0); PG8_MMA(1, 1, At, B1); PG8_BAR; PG8_SCHED;
            PG8_LDB(B0, 1, 0); PG8_LDB(B1, 1, 1); PG8_SCHED; PG8_LDA(At, 1, 0); PG8_STAGE(PG8_SA(0, 1), a2 + hstep, voffA);
            PG8_WAIT_V(8); PG8_WAIT_L(0); PG8_BAR; PG8_MMA(0, 0, At, B0); PG8_MMA(0, 1, At, B1); PG8_BAR; PG8_SCHED;
            PG8_LDA(At, 1, 1); PG8_STAGE(PG8_SB(1, 0), b3, voffB); PG8_STAGE(PG8_SB(1, 1), b3 + hstep, voffB); PG8_STAGE(PG8_SA(1, 0), a3, voffA);
            PG8_WAIT_V(8); PG8_WAIT_L(0); PG8_BAR; PG8_MMA(1, 0, At, B0); PG8_MMA(1, 1, At, B1); PG8_BAR; PG8_SCHED;
            } else {
            PG8_LDB(B0, 0, 0); PG8_SCHED; PG8_LDA(At, 0, 0); PG8_STAGE(PG8_SA(1, 1), a1 + hstep, voffA);
            PG8_WAIT_L(8); PG8_BAR; PG8_WAIT_L(0); PG8_MMA(0, 0, At, B0); PG8_BAR; PG8_SCHED;
            PG8_LDB(B1, 0, 1); PG8_STAGE(PG8_SB(0, 0), b2, voffB);
            PG8_BAR; PG8_WAIT_L(0); PG8_MMA(0, 1, At, B1); PG8_BAR;
            PG8_LDA(At, 0, 1); PG8_STAGE(PG8_SA(0, 0), a2, voffA);
            PG8_BAR; PG8_WAIT_L(0); PG8_MMA(1, 0, At, B0); PG8_BAR; PG8_SCHED;
            PG8_STAGE(PG8_SB(0, 1), b2 + hstep, voffB);
            PG8_WAIT_V(6); PG8_BAR; PG8_MMA(1, 1, At, B1); PG8_BAR;
            PG8_LDB(B0, 1, 0); PG8_SCHED; PG8_LDA(At, 1, 0); PG8_STAGE(PG8_SA(0, 1), a2 + hstep, voffA);
            PG8_WAIT_L(8); PG8_BAR; PG8_WAIT_L(0); PG8_MMA(0, 0, At, B0); PG8_BAR; PG8_SCHED;
            PG8_LDB(B1, 1, 1); PG8_STAGE(PG8_SB(1, 0), b3, voffB);
            PG8_BAR; PG8_WAIT_L(0); PG8_MMA(0, 1, At, B1); PG8_BAR;
            PG8_LDA(At, 1, 1); PG8_STAGE(PG8_SA(1, 0), a3, voffA);
            PG8_BAR; PG8_WAIT_L(0); PG8_MMA(1, 0, At, B0); PG8_BAR; PG8_SCHED;
            PG8_STAGE(PG8_SB(1, 1), b3 + hstep, voffB);
            PG8_WAIT_V(6); PG8_BAR; PG8_MMA(1, 1, At, B1); PG8_BAR;
            }
        }
        if constexpr (ALIGN_EPI) { if (wr == 0) PG8_BAR; }
        if constexpr (!Epi::AFTER_DRAIN) { E(acc, cur, wr, wc, fr, fq); S.done(cur); }
        if (!has_next) break;
#pragma unroll
        for (int a = 0; a < 2; ++a)
#pragma unroll
            for (int b = 0; b < 2; ++b)
#pragma unroll
                for (int m = 0; m < 4; ++m)
#pragma unroll
                    for (int n = 0; n < 2; ++n) acc[a][b][m][n] = (f32x4){0.f, 0.f, 0.f, 0.f};
        cur = nxt; cA = nA; cB = nB; ++ui;
        if constexpr (ALIGN_EPI) { if (wr == 1) PG8_BAR; }
    }
    PG8_WAIT_V(0);
    if constexpr (!ALIGN_EPI) { if (wr == 0) PG8_BAR; }
    PG8_BAR;
    if constexpr (Epi::AFTER_DRAIN) { E.fused(acc, cur, wr, wc, fr, fq, lds, wid, lane); S.done(cur); }
#undef PG8_SA
#undef PG8_SB
#undef PG8_STAGE
#undef PG8_LDA
#undef PG8_LDB
#undef PG8_MMA
#undef PG8_WAIT_V
#undef PG8_WAIT_L
#undef PG8_BAR
#undef PG8_SCHED
}
}

#define PG8_SP2 true
#define PG8_ALIGN true
namespace att {
typedef unsigned short bf16;
using bf16x8 = __attribute__((ext_vector_type(8))) short;
using s16x4  = __attribute__((ext_vector_type(4))) short;
using f32x16 = __attribute__((ext_vector_type(16))) float;
using u32x4  = __attribute__((ext_vector_type(4))) unsigned;
#define ATT_LAS __attribute__((address_space(3)))
typedef ATT_LAS char* lptr;
constexpr int   D = 128, NW = 8, QBLK = 32, KVBLK = 64;
constexpr float SCALE = 0.088388347648318440f;
constexpr float THR = 8.f;
constexpr int SHM_V = KVBLK * D * 2, SHM_K = KVBLK * D * 2, SHM_ATTN = 2 * SHM_V + 2 * SHM_K + NW * 64 * 4;
#define KSWZ(row, colB) ((row) * 256 + ((colB) ^ (((row) & 7) << 4)))
#define SBAR() __builtin_amdgcn_sched_barrier(0)
__device__ __forceinline__ int crow(int r, int hi) { return (r & 3) + 8 * (r >> 2) + 4 * hi; }
__device__ __forceinline__ unsigned cvtpk(float lo, float hi) { unsigned r; asm volatile("v_cvt_pk_bf16_f32 %0, %1, %2" : "=v"(r) : "v"(lo), "v"(hi)); return r; }
__device__ __forceinline__ void partialSM(f32x16& p0, f32x16& p1, float& m_reg, float& mn, float& alpha) {
  constexpr float C = SCALE * 1.4426950408889634f;
  float pmax = p0[0];
#pragma unroll
  for (int r = 1; r < 16; ++r) pmax = fmaxf(pmax, p0[r]);
#pragma unroll
  for (int r = 0; r < 16; ++r) pmax = fmaxf(pmax, p1[r]);
  { auto rr = __builtin_amdgcn_permlane32_swap(__float_as_uint(pmax), __float_as_uint(pmax), false, false);
    pmax = fmaxf(__uint_as_float(rr[0]), __uint_as_float(rr[1])); }
  if (__builtin_expect(__all(pmax - m_reg <= THR / SCALE), 1)) { mn = m_reg; alpha = 1.f; }
  else { mn = fmaxf(m_reg, pmax); alpha = __builtin_amdgcn_exp2f((m_reg - mn) * C); m_reg = mn; }
  float mnC = -mn * C;
#pragma unroll
  for (int r = 0; r < 16; ++r) p0[r] = fmaf(p0[r], C, mnC);
#pragma unroll
  for (int r = 0; r < 16; ++r) p1[r] = fmaf(p1[r], C, mnC);
#pragma unroll
  for (int r = 0; r < 16; ++r) p0[r] = __builtin_amdgcn_exp2f(p0[r]);
}
__device__ __forceinline__ void finishSM(f32x16& p0, f32x16& p1, float alpha, float& l_reg, bf16x8& pa0, bf16x8& pa1, bf16x8& pa2, bf16x8& pa3) {
#pragma unroll
  for (int r = 0; r < 16; ++r) p1[r] = __builtin_amdgcn_exp2f(p1[r]);
  float ps = 0;
#pragma unroll
  for (int r = 0; r < 16; ++r) ps += p0[r];
#pragma unroll
  for (int r = 0; r < 16; ++r) ps += p1[r];
  { auto rr = __builtin_amdgcn_permlane32_swap(__float_as_uint(ps), __float_as_uint(ps), false, false);
    ps = __uint_as_float(rr[0]) + __uint_as_float(rr[1]); }
  l_reg = l_reg * alpha + ps;
#define PK4(P, BASE, OUT) do { unsigned a0 = cvtpk(P[BASE + 0], P[BASE + 1]), a1 = cvtpk(P[BASE + 2], P[BASE + 3]);   \
    unsigned b0 = cvtpk(P[BASE + 4], P[BASE + 5]), b1 = cvtpk(P[BASE + 6], P[BASE + 7]);                              \
    auto r0 = __builtin_amdgcn_permlane32_swap(a0, b0, false, false); auto r1 = __builtin_amdgcn_permlane32_swap(a1, b1, false, false); \
    u32x4 w = {r0[0], r1[0], r0[1], r1[1]}; OUT = *reinterpret_cast<bf16x8*>(&w); } while (0)
  PK4(p0, 0, pa0); PK4(p0, 8, pa1); PK4(p1, 0, pa2); PK4(p1, 8, pa3);
#undef PK4
}
__device__ __forceinline__ void qkt(f32x16& p0, f32x16& p1, lptr Ks, const bf16x8* qr, int r32, int hi) {
  p0 = f32x16{}; p1 = f32x16{};
#pragma unroll
  for (int d0 = 0; d0 < 8; ++d0) { int cb = (d0 * 16 + hi * 8) * 2;
    bf16x8 b0 = *reinterpret_cast<const ATT_LAS bf16x8*>(Ks + KSWZ(r32, cb));
    bf16x8 b1 = *reinterpret_cast<const ATT_LAS bf16x8*>(Ks + KSWZ(32 + r32, cb));
    p0 = __builtin_amdgcn_mfma_f32_32x32x16_bf16(b0, qr[d0], p0, 0, 0, 0);
    p1 = __builtin_amdgcn_mfma_f32_32x32x16_bf16(b1, qr[d0], p1, 0, 0, 0); }
}
__device__ __forceinline__ int v_st(int k, int c) { const int kk = (k & ~0xC) | ((k & 4) << 1) | ((k & 8) >> 1); return ((kk >> 3) * 4 + (c >> 5)) * 512 + ((kk & 7) * 32 + (c & 31)) * 2; }
__device__ __forceinline__ int v_rd_base(int lane) { return ((lane & 3) << 3) | (((lane >> 2) & 3) << 6) | (((lane >> 4) & 1) << 5) | (((lane >> 5) & 1) << 8); }
constexpr int v_rd_off(int d0, int ks, int half) { return d0 * 512 + ks * 4096 + half * 2048; }
template <int OFF> __device__ __forceinline__ s16x4 tr_read(int vb) {
  s16x4 r; asm volatile("ds_read_b64_tr_b16 %0, %1 offset:%2" : "=&v"(r) : "v"(vb), "i"(OFF) : "memory"); return r;
}
template <int D0> __device__ __forceinline__ void pv_one(f32x16& od, int vb, bf16x8 pa0, bf16x8 pa1, bf16x8 pa2, bf16x8 pa3) {
  const s16x4 l0 = tr_read<v_rd_off(D0, 0, 0)>(vb), h0 = tr_read<v_rd_off(D0, 0, 1)>(vb), l1 = tr_read<v_rd_off(D0, 1, 0)>(vb), h1 = tr_read<v_rd_off(D0, 1, 1)>(vb);
  const s16x4 l2 = tr_read<v_rd_off(D0, 2, 0)>(vb), h2 = tr_read<v_rd_off(D0, 2, 1)>(vb), l3 = tr_read<v_rd_off(D0, 3, 0)>(vb), h3 = tr_read<v_rd_off(D0, 3, 1)>(vb);
  asm volatile("s_waitcnt lgkmcnt(0)" ::: "memory"); SBAR();
#define PK(L, H) (bf16x8){L[0], L[1], L[2], L[3], H[0], H[1], H[2], H[3]}
  od = __builtin_amdgcn_mfma_f32_32x32x16_bf16(pa0, PK(l0, h0), od, 0, 0, 0);
  od = __builtin_amdgcn_mfma_f32_32x32x16_bf16(pa1, PK(l1, h1), od, 0, 0, 0);
  od = __builtin_amdgcn_mfma_f32_32x32x16_bf16(pa2, PK(l2, h2), od, 0, 0, 0);
  od = __builtin_amdgcn_mfma_f32_32x32x16_bf16(pa3, PK(l3, h3), od, 0, 0, 0);
#undef PK
}
__device__ __forceinline__ void pv_d0(f32x16* o, int vb, bf16x8 pa0, bf16x8 pa1, bf16x8 pa2, bf16x8 pa3) {
  pv_one<0>(o[0], vb, pa0, pa1, pa2, pa3); pv_one<1>(o[1], vb, pa0, pa1, pa2, pa3); pv_one<2>(o[2], vb, pa0, pa1, pa2, pa3); pv_one<3>(o[3], vb, pa0, pa1, pa2, pa3);
}
__device__ __forceinline__ void moba_mask(f32x16& p0, f32x16& p1, int tile, int qb, unsigned sel, int qi, int w0, int hi) {
  const float NINF = -__builtin_inff();
  const int jb = tile >> 2;
  if (jb < qb) {
    const bool ok = ((sel >> jb) & 1u) != 0u;
    if (!__all(ok)) {
#pragma unroll
      for (int r = 0; r < 16; ++r) { p0[r] = ok ? p0[r] : NINF; p1[r] = ok ? p1[r] : NINF; }
    }
  } else {
    const int k0 = (tile & 3) * 64;
    if (k0 + 63 > w0) {
      int lim = qi - k0 - 4 * hi; asm volatile("" : "+v"(lim));
#pragma unroll
      for (int r = 0; r < 16; ++r) { const int kc = (r & 3) + 8 * (r >> 2); p0[r] = (kc <= lim) ? p0[r] : NINF; p1[r] = (kc + 32 <= lim) ? p1[r] : NINF; }
    }
  }
}

template <bool MOBA, int LDQ, int LDK, int LDO, int SDEPTH>
__device__ __forceinline__ void attn_body(const bf16* __restrict__ Qb, const bf16* __restrict__ Kh, const bf16* __restrict__ Vh, bf16* __restrict__ Ob, int seq, lptr lds,
                                          int qb, const float* __restrict__ kms, int kms_stride, float* __restrict__ ssq) {
  int tid_ = threadIdx.x; asm volatile("" : "+v"(tid_));
  const int tid = tid_, wid = tid >> 6, lane = tid & 63, r32 = lane & 31, hi = lane >> 5;
  lptr V_lds = lds; lptr K_lds = lds + 2 * SHM_V;
  ATT_LAS float* ws = (ATT_LAS float*)(lds + 2 * SHM_V + 2 * SHM_K) + wid * 64; ATT_LAS float* li_l = ws; ATT_LAS float* al_l = ws + 32;
  float m_reg = -1e30f, l_reg = 0; f32x16 o[4] = {}; bf16x8 qr[8];
  unsigned qoff = (unsigned)((wid * QBLK + r32) * LDQ + hi * 8); asm volatile("" : "+v"(qoff));
  const bf16* Qw = Qb + qoff;
#pragma unroll
  for (int d0 = 0; d0 < 8; ++d0) qr[d0] = *reinterpret_cast<const bf16x8*>(Qw + d0 * 16);
  const int sr = tid >> 4, sc = (tid & 15) * 8, vst0 = v_st(sr, sc), vst1 = v_st(32 + sr, sc);
  const int vb0 = (int)(uintptr_t)V_lds + v_rd_base(lane);
  struct { bf16x8 vs0, vs1, ks0, ks1; } sr_[SDEPTH];
  const unsigned so0 = (unsigned)(sr * LDK + sc), so1 = (unsigned)((32 + sr) * LDK + sc);
#define SLOAD(i, k0) do { const bf16* Vt_ = Vh + (long)(k0) * LDK; const bf16* Kt_ = Kh + (long)(k0) * LDK; \
    sr_[i].vs0 = *reinterpret_cast<const bf16x8*>(Vt_ + so0); sr_[i].vs1 = *reinterpret_cast<const bf16x8*>(Vt_ + so1); \
    sr_[i].ks0 = *reinterpret_cast<const bf16x8*>(Kt_ + so0); sr_[i].ks1 = *reinterpret_cast<const bf16x8*>(Kt_ + so1); } while (0)
#define SWRITE(b, i) do { *(ATT_LAS bf16x8*)(V_lds + (b) * SHM_V + vst0) = sr_[i].vs0;          \
    *(ATT_LAS bf16x8*)(V_lds + (b) * SHM_V + vst1) = sr_[i].vs1; int kc = sc * 2;               \
    *(ATT_LAS bf16x8*)(K_lds + (b) * SHM_K + KSWZ(sr, kc)) = sr_[i].ks0;                       \
    *(ATT_LAS bf16x8*)(K_lds + (b) * SHM_K + KSWZ(32 + sr, kc)) = sr_[i].ks1; } while (0)
#define SWAIT() do { if constexpr (SDEPTH == 2) asm volatile("s_waitcnt vmcnt(4)" ::: "memory"); else asm volatile("s_waitcnt vmcnt(0)" ::: "memory"); } while (0)
#define RESC(a) do { if (__any((a) < 1.f)) { if (hi == 0) al_l[r32] = (a); asm volatile("s_waitcnt lgkmcnt(0)" ::: "memory"); \
    _Pragma("unroll") for (int d = 0; d < 4; ++d) _Pragma("unroll") for (int r = 0; r < 16; ++r) o[d][r] *= al_l[crow(r, hi)]; } } while (0)
  f32x16 pA0, pA1, pB0, pB1; float mnA, mnB, alA, alB; bf16x8 pa0, pa1, pa2, pa3; const int NT = seq / KVBLK;
  constexpr int SE = 0, SO = SDEPTH - 1;
  unsigned sel = 0u; const int qi = wid * QBLK + r32, w0 = wid * QBLK;
  SLOAD(SE, 0);
  if constexpr (MOBA) {
    { const int j = sr & 15; const float* src = kms + (size_t)j * kms_stride + sc; const float4 x0 = *reinterpret_cast<const float4*>(src), x1 = *reinterpret_cast<const float4*>(src + 4);
      const float xv[8] = {x0.x, x0.y, x0.z, x0.w, x1.x, x1.y, x1.z, x1.w}; unsigned w[4];
#pragma unroll
      for (int e = 0; e < 4; ++e) { const unsigned h2 = cvtpk(xv[2 * e], xv[2 * e + 1]); const float f0 = __uint_as_float(h2 << 16), f1 = __uint_as_float(h2 & 0xffff0000u);
        const unsigned l2 = cvtpk(xv[2 * e] - f0, xv[2 * e + 1] - f1); w[e] = (sr < 16) ? h2 : l2; }
      u32x4 wv = {w[0], w[1], w[2], w[3]}; *(ATT_LAS u32x4*)(K_lds + KSWZ(sr, sc * 2)) = wv; }
    __syncthreads();
    f32x16 g = f32x16{};
#pragma unroll
    for (int d0 = 0; d0 < 8; ++d0) { const int cb = (d0 * 16 + hi * 8) * 2; const bf16x8 b0 = *reinterpret_cast<const ATT_LAS bf16x8*>(K_lds + KSWZ(r32, cb));
      g = __builtin_amdgcn_mfma_f32_32x32x16_bf16(b0, qr[d0], g, 0, 0, 0); }
    float G[16];
#pragma unroll
    for (int r = 0; r < 8; ++r) { const float own = g[r] + g[r + 8]; const float oth = __shfl_xor(own, 32); const int lb = (r & 3) + 8 * (r >> 2);
      G[lb] = hi ? oth : own; G[lb + 4] = hi ? own : oth; }
    const float NINF = -__builtin_inff();
#pragma unroll
    for (int j = 0; j < 16; ++j) G[j] = (j < qb) ? G[j] : NINF;
#pragma unroll
    for (int it = 0; it < 3; ++it) { float mx = NINF; int mi = -1;
#pragma unroll
      for (int j = 0; j < 16; ++j) { const bool gt = G[j] > mx; mx = gt ? G[j] : mx; mi = gt ? j : mi; }
      if (mi >= 0) sel |= 1u << mi;
#pragma unroll
      for (int j = 0; j < 16; ++j) G[j] = (j == mi) ? NINF : G[j]; }
    __syncthreads();
  }
  asm volatile("s_waitcnt vmcnt(0)" ::: "memory"); SWRITE(0, SE); __syncthreads();
  qkt(pA0, pA1, K_lds, qr, r32, hi);
  if constexpr (MOBA) moba_mask(pA0, pA1, 0, qb, sel, qi, w0, hi);
  partialSM(pA0, pA1, m_reg, mnA, alA);
  SLOAD(SO, KVBLK); if constexpr (SDEPTH == 2) { if (2 < NT) SLOAD(SE, 2 * KVBLK); }
  SWAIT(); SWRITE(1, SO); __syncthreads();
  for (int j = 1; j + 1 < NT; j += 2) {
    SBAR(); qkt(pB0, pB1, K_lds + SHM_K, qr, r32, hi);
    finishSM(pA0, pA1, alA, l_reg, pa0, pa1, pa2, pa3); SBAR();
    SLOAD(SO, (j + SDEPTH) * KVBLK); SBAR();
    pv_d0(o, vb0, pa0, pa1, pa2, pa3);
    if constexpr (MOBA) moba_mask(pB0, pB1, j, qb, sel, qi, w0, hi);
    partialSM(pB0, pB1, m_reg, mnB, alB);
    __syncthreads(); SWAIT(); SWRITE(0, SE);
    RESC(alB); __syncthreads();
    SBAR(); qkt(pA0, pA1, K_lds, qr, r32, hi);
    finishSM(pB0, pB1, alB, l_reg, pa0, pa1, pa2, pa3); SBAR();
    if (SDEPTH == 1 || j + 3 < NT) SLOAD(SE, (j + 1 + SDEPTH) * KVBLK); SBAR();
    pv_d0(o, vb0 + SHM_V, pa0, pa1, pa2, pa3);
    if constexpr (MOBA) moba_mask(pA0, pA1, j + 1, qb, sel, qi, w0, hi);
    partialSM(pA0, pA1, m_reg, mnA, alA);
    __syncthreads(); SWAIT(); SWRITE(1, SO);
    RESC(alA); __syncthreads();
  }
  SBAR(); qkt(pB0, pB1, K_lds + SHM_K, qr, r32, hi);
  finishSM(pA0, pA1, alA, l_reg, pa0, pa1, pa2, pa3); SBAR();
  pv_d0(o, vb0, pa0, pa1, pa2, pa3);
  if constexpr (MOBA) moba_mask(pB0, pB1, NT - 1, qb, sel, qi, w0, hi);
  partialSM(pB0, pB1, m_reg, mnB, alB);
  __syncthreads(); RESC(alB);
  finishSM(pB0, pB1, alB, l_reg, pa0, pa1, pa2, pa3); SBAR();
  pv_d0(o, vb0 + SHM_V, pa0, pa1, pa2, pa3);
  if (hi == 0) li_l[r32] = l_reg; asm volatile("s_waitcnt lgkmcnt(0)" ::: "memory");
  float rli[16];
#pragma unroll
  for (int r = 0; r < 16; ++r) rli[r] = __builtin_amdgcn_rcpf(li_l[crow(r, hi)]);
  int ohi = hi * 4, ocol = r32; asm volatile("" : "+v"(ohi), "+v"(ocol));
  bf16* Ow = Ob + (long)(wid * QBLK) * LDO;
#pragma unroll
  for (int r = 0; r < 16; ++r) { const int orow = (r & 3) + 8 * (r >> 2) + ohi; float sq = 0.f;
#pragma unroll
    for (int d0 = 0; d0 < 4; ++d0) { const float v = o[d0][r] * rli[r]; sq += v * v; Ow[(unsigned)(orow * LDO + d0 * 32 + ocol)] = (bf16)(cvtpk(v, v) & 0xffffu); }
    if constexpr (MOBA) { sq += __shfl_xor(sq, 1); sq += __shfl_xor(sq, 2); sq += __shfl_xor(sq, 4); sq += __shfl_xor(sq, 8); sq += __shfl_xor(sq, 16);
      if (ocol == 0) unsafeAtomicAdd(ssq + wid * QBLK + orow, sq); } }
  __syncthreads();
#undef SLOAD
#undef SWRITE
#undef SWAIT
#undef RESC
}
#undef KSWZ
#undef SBAR
}

constexpr int NWAVES = 8;
constexpr int BATCH = 4, SEQ = 4096, D = 2048, M = BATCH * SEQ, FF = 5632, AW = 1024, CW = 1024, INW = 6144, MEML = 256, XW = 512, NH = 8, XH = 4, NBLK = 16;
constexpr int NPH = 13;
#ifndef FAST_MASK
#define FAST_MASK 0x1fff
#endif
#ifndef ONE_LAUNCH
#define ONE_LAUNCH 1
#endif
constexpr size_t MiB = 1u << 20, KiB = 1u << 10;
constexpr size_t WS_CTL = 0, CTL_ZERO_BYTES = 1 * MiB;
constexpr size_t CTL_BAR = 64 * KiB, BAR_STRIDE = 16 * KiB;
constexpr size_t CTL_SS = 320 * KiB;
constexpr size_t CTL_KMS = 704 * KiB;
constexpr size_t WS_WGU1 = 2 * MiB, WS_WD1 = 46 * MiB, WS_WGU2 = 68 * MiB, WS_WD2 = 112 * MiB, WS_WIN = 134 * MiB, WS_WOUT = 158 * MiB, WS_WQ = 166 * MiB, WS_WKV = 168 * MiB, WS_WO = 172 * MiB;
constexpr size_t WS_MEMN = 174 * MiB, WS_KVX = 178 * MiB, WS_HB = 180 * MiB, WS_MIXED = 244 * MiB, WS_ACT = 308 * MiB;
constexpr size_t WS_Q = 308 * MiB, WS_K = 340 * MiB, WS_V = 372 * MiB, WS_CU = 404 * MiB, WS_BG = 436 * MiB;
constexpr size_t WS_QX = 308 * MiB, WS_OX = 324 * MiB;
constexpr size_t WS_END = 484 * MiB;
static_assert(WS_ACT + (size_t)M * FF * 2 <= WS_END && WS_BG + (size_t)M * 1024 * 2 <= WS_END && CTL_KMS + BATCH * 16 * 8 * 128 * 4 <= CTL_ZERO_BYTES && CTL_SS + 6 * M * 4 <= CTL_KMS, "d_ws map");
constexpr int RING_OFF = 0, RING_BYTES = 131072;
constexpr int LDSCTL_OFF = RING_BYTES, MISC_OFF = LDSCTL_OFF + 320;
constexpr int LDS_BYTES = 147456;
static_assert(MISC_OFF + 128 <= LDS_BYTES && att::SHM_ATTN <= RING_BYTES, "LDS map");

#define GAS __attribute__((address_space(1)))
#define LAS __attribute__((address_space(3)))
typedef unsigned short bf16;
typedef unsigned v4u __attribute__((ext_vector_type(4)));
typedef unsigned v2u __attribute__((ext_vector_type(2)));
typedef float f32x4 __attribute__((ext_vector_type(4)));
typedef short bf16x8 __attribute__((ext_vector_type(8)));
typedef GAS unsigned gu32;
#define RLX_AGENT __ATOMIC_RELAXED, __HIP_MEMORY_SCOPE_AGENT
#define LDS_WAIT() asm volatile("s_waitcnt lgkmcnt(0)" ::: "memory")
#define VM_WAIT() asm volatile("s_waitcnt vmcnt(0)" ::: "memory")
__device__ __forceinline__ unsigned pk2(float lo, float hi) { return pg8::cvt_pk_bf16(lo, hi); }
__device__ __forceinline__ float bflo(unsigned w) { return __uint_as_float(w << 16); }
__device__ __forceinline__ float bfhi(unsigned w) { return __uint_as_float(w & 0xffff0000u); }
__device__ __forceinline__ float wave_sum(float v) {
#pragma unroll
    for (int o = 1; o < 64; o <<= 1) v += __shfl_xor(v, o);
    return v;
}
#define XB_TMO      128
#define XB_XCNT(j)  (256  + 64 * (j))
#define XB_XSUB(j)  (1280 + 64 * (j))
#define XB_XGEN(j)  (2304 + 64 * (j))
#define XB_TOP      3328
#define XB_TOPGEN   3392
#define XCD_BAR_WORDS 3456
#define XB_SPIN_CAP (1u << 18)

__device__ __forceinline__ unsigned xb_ld(unsigned* p)              { return __hip_atomic_load(p, __ATOMIC_RELAXED, __HIP_MEMORY_SCOPE_AGENT); }
__device__ __forceinline__ unsigned xb_add(unsigned* p, unsigned v) { return __hip_atomic_fetch_add(p, v, __ATOMIC_RELAXED, __HIP_MEMORY_SCOPE_AGENT); }
__device__ __forceinline__ unsigned xb_xcc_id() { return (unsigned)__builtin_amdgcn_s_getreg((3 << 11) | 20) & 0xFu; }
#define XB_SPIN(cond, bar) do { unsigned _sp = 0; while (cond) { __builtin_amdgcn_s_sleep(1); \
    if ((++_sp & 255u) == 0u) { if (xb_ld(&(bar)[XB_TMO])) break; if (_sp > XB_SPIN_CAP) { atomicAdd(&(bar)[XB_TMO], 1u); break; } } } } while (0)

struct XcdBarrier {
    unsigned* bar; unsigned x;
    volatile LAS unsigned* st;
};

__device__ __forceinline__ XcdBarrier xcd_barrier_post(unsigned* bar, volatile LAS unsigned* st) {
    XcdBarrier b; b.bar = bar; b.x = xb_xcc_id(); b.st = st;
    if (threadIdx.x == 0) (void)xb_add(&bar[XB_XCNT(b.x)], 1u);
    return b;
}
__device__ __forceinline__ void xcd_barrier_complete(unsigned* bar, unsigned x, unsigned& nloc, unsigned& nx) {
    const unsigned G = gridDim.x * gridDim.y * gridDim.z;
    unsigned sum, cnt, mine, sp = 0u;
    for (;;) {
        sum = 0u; cnt = 0u; mine = 0u;
#pragma unroll
        for (unsigned j = 0; j < 16; ++j) { const unsigned c = xb_ld(&bar[XB_XCNT(j)]); sum += c; cnt += (c > 0u) ? 1u : 0u; mine = (j == x) ? c : mine; }
        if (sum == G) break;
        __builtin_amdgcn_s_sleep(1);
        if ((++sp & 255u) == 0u) { if (xb_ld(&bar[XB_TMO])) break; if (sp > XB_SPIN_CAP) { atomicAdd(&bar[XB_TMO], 1u); break; } }
    }
    nloc = mine > 0u ? mine : 1u; nx = cnt > 0u ? cnt : 1u;
}

__device__ __forceinline__ void xcd_barrier(const XcdBarrier& b) {
    asm volatile("s_waitcnt vmcnt(0)" ::: "memory");
    __syncthreads();
    if (threadIdx.x == 0) {
        unsigned* bar = b.bar;
        __builtin_amdgcn_s_waitcnt(0);
        unsigned nloc = b.st[0], nx = b.st[1];
        if (nloc == 0u) { xcd_barrier_complete(bar, b.x, nloc, nx); b.st[0] = nloc; b.st[1] = nx; }
        const unsigned old = xb_add(&bar[XB_XSUB(b.x)], 1u);
        const unsigned gen = old / nloc;
        if (old + 1u == (gen + 1u) * nloc) {
            __builtin_amdgcn_fence(__ATOMIC_RELEASE, "agent");
            asm volatile("s_waitcnt vmcnt(0)" ::: "memory");
            const unsigned og = xb_add(&bar[XB_TOP], 1u);
            const unsigned tg = og / nx;
            if (og + 1u == (tg + 1u) * nx) xb_add(&bar[XB_TOPGEN], 1u);
            else XB_SPIN(xb_ld(&bar[XB_TOPGEN]) == tg, bar);
            __builtin_amdgcn_fence(__ATOMIC_ACQUIRE, "agent");
            xb_add(&bar[XB_XGEN(b.x)], 1u);
            asm volatile("s_waitcnt vmcnt(0)" ::: "memory");
        } else {
            XB_SPIN(xb_ld(&bar[XB_XGEN(b.x)]) == gen, bar);
            __builtin_amdgcn_fence(__ATOMIC_ACQUIRE, "agent");
            asm volatile("s_waitcnt vmcnt(0)" ::: "memory");
        }
    }
    __syncthreads();
}

namespace nv {
typedef float f32x4 __attribute__((ext_vector_type(4)));
typedef short bf16x8 __attribute__((ext_vector_type(8)));
constexpr float EPS = 1e-6f;
template <class F> __global__ __launch_bounds__(256) void gemm(const bf16* __restrict__ A, const bf16* __restrict__ Bt, int K, F f) {
    const int wave = threadIdx.x >> 6, lane = threadIdx.x & 63;
    const int row0 = blockIdx.y * 64 + wave * 16, col0 = blockIdx.x * 64;
    f32x4 acc[4], acc2[4];
#pragma unroll
    for (int c = 0; c < 4; ++c) { acc[c] = (f32x4){0.f, 0.f, 0.f, 0.f}; acc2[c] = (f32x4){0.f, 0.f, 0.f, 0.f}; }
    const bf16* ap = A + (size_t)(row0 + (lane & 15)) * K + 8 * (lane >> 4);
    const bf16* bp[4]; const bf16* bp2[4];
#pragma unroll
    for (int c = 0; c < 4; ++c) { const int col = col0 + 16 * c + (lane & 15); bp[c] = Bt + (size_t)f.brow(col) * K + 8 * (lane >> 4); bp2[c] = Bt + (size_t)f.brow2(col) * K + 8 * (lane >> 4); }
    for (int k0 = 0; k0 < K; k0 += 32) {
        if (F::MIDK > 0 && k0 == F::MIDK) {
#pragma unroll
            for (int j = 0; j < 4; ++j) { const float s = f.midscale(row0 + (lane >> 4) * 4 + j);
#pragma unroll
                for (int c = 0; c < 4; ++c) acc[c][j] *= s; }
        }
        const bf16x8 a = *(const bf16x8*)(ap + k0);
#pragma unroll
        for (int c = 0; c < 4; ++c) { const bf16x8 b = *(const bf16x8*)(bp[c] + k0); acc[c] = __builtin_amdgcn_mfma_f32_16x16x32_bf16(a, b, acc[c], 0, 0, 0);
            if (F::DUAL) { const bf16x8 b2 = *(const bf16x8*)(bp2[c] + k0); acc2[c] = __builtin_amdgcn_mfma_f32_16x16x32_bf16(a, b2, acc2[c], 0, 0, 0); } }
    }
#pragma unroll
    for (int j = 0; j < 4; ++j) { const int row = row0 + (lane >> 4) * 4 + j; float sq = 0.f;
#pragma unroll
        for (int c = 0; c < 4; ++c) { const float h = f.store(row, col0 + 16 * c + (lane & 15), acc[c][j], acc2[c][j]); sq += h * h; }
        if (F::ROWSS) { sq += __shfl_xor(sq, 1); sq += __shfl_xor(sq, 2); sq += __shfl_xor(sq, 4); sq += __shfl_xor(sq, 8); if ((lane & 15) == 0) f.addss(row, sq); } }
}
__device__ __forceinline__ bf16 tobf(float v) { return (bf16)(pg8::cvt_pk_bf16(v, v) & 0xffffu); }
struct FSwiglu { static constexpr bool DUAL = true, ROWSS = false; static constexpr int MIDK = 0; bf16* O; const float* ss;
    __device__ int brow(int col) const { return (col >> 7) * 256 + (col & 127); } __device__ int brow2(int col) const { return brow(col) + 128; } __device__ float midscale(int) const { return 1.f; } __device__ void addss(int, float) const {}
    __device__ float store(int row, int col, float a, float a2) const { const float rs = rsqrtf(ss[row] * (1.0f / 2048.0f) + EPS), g = a * rs, u = a2 * rs; O[(size_t)row * FF + col] = tobf(g / (1.0f + __expf(-g)) * u); return 0.f; } };
template <int MIDK_> struct FResid { static constexpr bool DUAL = false, ROWSS = true; static constexpr int MIDK = MIDK_; const float* R; float* H; bf16* HB; float* ssn; float alpha; const float* midss;
    __device__ int brow(int col) const { return col; } __device__ int brow2(int col) const { return col; } __device__ float midscale(int row) const { return rsqrtf(midss[row] * (1.0f / 1024.0f) + EPS); }
    __device__ void addss(int row, float s) const { unsafeAtomicAdd(ssn + row, s); }
    __device__ float store(int row, int col, float a, float) const { const size_t o = (size_t)row * 2048 + col; const float h = R[o] + alpha * a; H[o] = h; if (HB) HB[o] = tobf(h); return h; } };
struct FWin { static constexpr bool DUAL = true, ROWSS = false; static constexpr int MIDK = 0; bf16 *Q, *K, *V, *CU, *BG; const float* ss;
    __device__ int brow(int col) const { if (col < 3072) return col; if (col < 4096) { const int j = col - 3072; return 3072 + (j >> 7) * 256 + (j & 127); } return 5120 + (col - 4096); }
    __device__ int brow2(int col) const { return (col >= 3072 && col < 4096) ? brow(col) + 128 : brow(col); } __device__ float midscale(int) const { return 1.f; } __device__ void addss(int, float) const {}
    __device__ float store(int row, int col, float a, float a2) const { const float rs = rsqrtf(ss[row] * (1.0f / 2048.0f) + EPS); const size_t o = (size_t)row * 1024 + (col & 1023);
        if (col < 1024) Q[o] = tobf(a * rs); else if (col < 2048) K[o] = tobf(a * rs); else if (col < 3072) V[o] = tobf(a * rs); else if (col < 4096) CU[o] = tobf((a * rs) * (a2 * rs)); else BG[o] = tobf(a * rs); return 0.f; } };
struct FScale { static constexpr bool DUAL = false, ROWSS = false; static constexpr int MIDK = 0; bf16* O; int ldo; const float* ss;
    __device__ int brow(int col) const { return col; } __device__ int brow2(int col) const { return col; } __device__ float midscale(int) const { return 1.f; } __device__ void addss(int, float) const {}
    __device__ float store(int row, int col, float a, float) const { const float rs = ss ? rsqrtf(ss[row] * (1.0f / 2048.0f) + EPS) : 1.0f; O[(size_t)row * ldo + col] = tobf(a * rs); return 0.f; } };
__global__ __launch_bounds__(256) void kmean(const bf16* __restrict__ K, float* __restrict__ kms) {
    const int i = blockIdx.x * 256 + threadIdx.x; const int d = i & 127, h = (i >> 7) & 7, bb = i >> 10;
    float s = 0.f; for (int r = 0; r < 256; ++r) s += __uint_as_float((unsigned)K[((size_t)bb * 256 + r) * 1024 + h * 128 + d] << 16);
    kms[i] = s;
}
__global__ __launch_bounds__(256) void moba(const bf16* __restrict__ Q, const bf16* __restrict__ K, const bf16* __restrict__ V, const float* __restrict__ kms, bf16* __restrict__ AO, float* __restrict__ ssA) {
    const int wave = threadIdx.x >> 6, lane = threadIdx.x & 63; const int idx = blockIdx.x * 4 + wave; const int h = idx & 7, row = idx >> 3, b = row >> 12, t = row & 4095, qb = t >> 8;
    const unsigned qw = *(const unsigned*)(Q + (size_t)row * 1024 + h * 128 + 2 * lane); const float q0 = bflo(qw), q1 = bfhi(qw);
    unsigned sel = 0u;
    { float g[16];
#pragma unroll
      for (int j = 0; j < 16; ++j) { const float* km = kms + ((size_t)(b * 16 + j) * 8 + h) * 128 + 2 * lane; const float p = wave_sum(q0 * km[0] + q1 * km[1]); g[j] = (j < qb) ? p : -__builtin_inff(); }
#pragma unroll
      for (int it = 0; it < 3; ++it) { float mx = -__builtin_inff(); int mi = -1;
#pragma unroll
        for (int j = 0; j < 16; ++j) { const bool gt = g[j] > mx; mx = gt ? g[j] : mx; mi = gt ? j : mi; }
        if (mi >= 0) sel |= 1u << mi;
#pragma unroll
        for (int j = 0; j < 16; ++j) g[j] = (j == mi) ? -__builtin_inff() : g[j]; } }
    sel |= 1u << qb;
    float m = -1e30f, l = 0.f, o0 = 0.f, o1 = 0.f;
    for (int jb = 0; jb <= qb; ++jb) { if (!((sel >> jb) & 1u)) continue;
        const int nk = (jb < qb) ? 256 : (t & 255) + 1;
        for (int kk = 0; kk < nk; ++kk) { const size_t ko = ((size_t)b * 4096 + jb * 256 + kk) * 1024 + h * 128 + 2 * lane;
            const unsigned kw = *(const unsigned*)(K + ko), vw = *(const unsigned*)(V + ko);
            const float s = wave_sum(q0 * bflo(kw) + q1 * bfhi(kw)) * 0.088388347648318440f;
            const float mn = fmaxf(m, s), a = __expf(m - mn), p = __expf(s - mn);
            l = l * a + p; o0 = o0 * a + p * bflo(vw); o1 = o1 * a + p * bfhi(vw); m = mn; } }
    const float il = 1.0f / l; o0 *= il; o1 *= il;
    *(unsigned*)(AO + (size_t)row * 2048 + h * 128 + 2 * lane) = pk2(o0, o1);
    const float sq = wave_sum(o0 * o0 + o1 * o1); if (lane == 0) unsafeAtomicAdd(ssA + row, sq);
}
__global__ __launch_bounds__(256) void xattn(const bf16* __restrict__ QX, const bf16* __restrict__ KVX, bf16* __restrict__ OX) {
    const int wave = threadIdx.x >> 6, lane = threadIdx.x & 63; const int idx = blockIdx.x * 4 + wave; const int h = idx & 3, row = idx >> 2, b = row >> 12;
    const unsigned qw = *(const unsigned*)(QX + (size_t)row * 512 + h * 128 + 2 * lane); const float q0 = bflo(qw), q1 = bfhi(qw);
    float m = -1e30f, l = 0.f, o0 = 0.f, o1 = 0.f;
    for (int kk = 0; kk < 256; ++kk) { const size_t ko = ((size_t)b * 256 + kk) * 1024 + h * 128 + 2 * lane;
        const unsigned kw = *(const unsigned*)(KVX + ko), vw = *(const unsigned*)(KVX + ko + 512);
        const float s = wave_sum(q0 * bflo(kw) + q1 * bfhi(kw)) * 0.088388347648318440f;
        const float mn = fmaxf(m, s), a = __expf(m - mn), p = __expf(s - mn);
        l = l * a + p; o0 = o0 * a + p * bflo(vw); o1 = o1 * a + p * bfhi(vw); m = mn; }
    const float il = 1.0f / l;
    *(unsigned*)(OX + (size_t)row * 512 + h * 128 + 2 * lane) = pk2(o0 * il, o1 * il);
}
}


struct Frame {
    LAS unsigned char* lds;
    volatile LAS unsigned* MISC;
    int tid, lane, wave;
    int vcu, G;
};
struct Args { const float* in[22]; float* out; unsigned char* ws; int ph_lo, ph_hi; };
enum { I_X = 0, I_MEM, I_F1N, I_F1G, I_F1U, I_F1D, I_MIXN, I_WIN, I_CONVW, I_AON, I_CON, I_WOUT, I_XN, I_MEMNRM, I_XQ, I_XKV, I_XO, I_F2N, I_F2G, I_F2U, I_F2D, I_FINAL };

__device__ __forceinline__ void p0_transpose_item(const float* W, int pitch, const float* gain, bf16* WT, int dstK, int dkoff, int drow0, int k0, LAS float* scr, int lane) {
#pragma unroll 8
    for (int i = 0; i < 32; ++i) { const int kk = 2 * i + (lane >> 5); const float g = gain ? gain[k0 + kk] : 1.0f; scr[kk * 33 + (lane & 31)] = W[(size_t)(k0 + kk) * pitch + (lane & 31)] * g; }
    LDS_WAIT(); asm volatile("" ::: "memory");
    const int c = lane & 7;
#pragma unroll
    for (int j = 0; j < 4; ++j) { const int n = (lane >> 3) + 8 * j; const LAS float* s = scr + (8 * c) * 33 + n;
        v4u o; o.x = pk2(s[0 * 33], s[1 * 33]); o.y = pk2(s[2 * 33], s[3 * 33]); o.z = pk2(s[4 * 33], s[5 * 33]); o.w = pk2(s[6 * 33], s[7 * 33]);
        *(GAS v4u*)(WT + (size_t)(drow0 + n) * dstK + dkoff + k0 + 8 * c) = o; }
    LDS_WAIT(); asm volatile("" ::: "memory");
}
__device__ __forceinline__ void p0_prologue(Frame& F_, const Args& a) {
    Frame F = F_; asm volatile("" : "+v"(F.lane));
    LAS float* scr = (LAS float*)(F.lds + RING_OFF + F.wave * 16384);
    const int gw = F.vcu * NWAVES + F.wave, NGW = F.G * NWAVES;
    unsigned char* ws = a.ws;
    constexpr int I_FF = (D / 64) * (FF / 32), I_FD = (FF / 64) * (D / 32), I_IN = (D / 64) * (1024 / 32), I_OUT = (1024 / 64) * (D / 32), I_XQn = (D / 64) * (XW / 32), I_XKVn = (D / 64) * (1024 / 32), I_XOn = (XW / 64) * (D / 32);
    constexpr int NITEMS = 4 * I_FF + 2 * I_FD + 6 * I_IN + 2 * I_OUT + I_XQn + I_XKVn + I_XOn;
    for (int it = gw; it < NITEMS; it += NGW) {
        int r = it; const float* src = nullptr; const float* gain = nullptr; bf16* dst = nullptr; int pitch = 0, ncols = 0, dstK = 0, dkoff = 0, rowoff = 0, mode = 0; bool hit = false;
#define JOB(cnt, SRC, PITCH, NCOLS, GAIN, DST, DSTK, DKOFF, ROWOFF, MODE) if (!hit) { if (r < (cnt)) { hit = true; src = (SRC); pitch = (PITCH); ncols = (NCOLS); gain = (GAIN); dst = (bf16*)(ws + (DST)); dstK = (DSTK); dkoff = (DKOFF); rowoff = (ROWOFF); mode = (MODE); } else r -= (cnt); }
        JOB(I_FF, a.in[I_F1G], FF, FF, a.in[I_F1N], WS_WGU1, D, 0, 0, 1)
        JOB(I_FF, a.in[I_F1U], FF, FF, a.in[I_F1N], WS_WGU1, D, 0, 0, 2)
        JOB(I_FD, a.in[I_F1D], D, D, nullptr, WS_WD1, FF, 0, 0, 0)
        JOB(I_FF, a.in[I_F2G], FF, FF, a.in[I_F2N], WS_WGU2, D, 0, 0, 1)
        JOB(I_FF, a.in[I_F2U], FF, FF, a.in[I_F2N], WS_WGU2, D, 0, 0, 2)
        JOB(I_FD, a.in[I_F2D], D, D, nullptr, WS_WD2, FF, 0, 0, 0)
        JOB(I_IN, a.in[I_WIN] + 0, INW, 1024, a.in[I_MIXN], WS_WIN, D, 0, 0, 0)
        JOB(I_IN, a.in[I_WIN] + 1024, INW, 1024, a.in[I_MIXN], WS_WIN, D, 0, 1024, 0)
        JOB(I_IN, a.in[I_WIN] + 2048, INW, 1024, a.in[I_MIXN], WS_WIN, D, 0, 2048, 0)
        JOB(I_IN, a.in[I_WIN] + 3072, INW, 1024, a.in[I_MIXN], WS_WIN, D, 0, 3072, 1)
        JOB(I_IN, a.in[I_WIN] + 5120, INW, 1024, a.in[I_MIXN], WS_WIN, D, 0, 3072, 2)
        JOB(I_IN, a.in[I_WIN] + 4096, INW, 1024, a.in[I_MIXN], WS_WIN, D, 0, 5120, 0)
        JOB(I_OUT, a.in[I_WOUT], D, D, a.in[I_AON], WS_WOUT, D, 0, 0, 0)
        JOB(I_OUT, a.in[I_WOUT] + (size_t)1024 * D, D, D, a.in[I_CON], WS_WOUT, D, 1024, 0, 0)
        JOB(I_XQn, a.in[I_XQ], XW, XW, a.in[I_XN], WS_WQ, D, 0, 0, 0)
        JOB(I_XKVn, a.in[I_XKV], 1024, 1024, nullptr, WS_WKV, D, 0, 0, 0)
        JOB(I_XOn, a.in[I_XO], D, D, nullptr, WS_WO, XW, 0, 0, 0)
#undef JOB
        const int nblk = ncols / 32, kb = r / nblk, nb = r % nblk, k0 = 64 * kb, n0 = 32 * nb;
        const int drow0 = rowoff + (mode ? (n0 >> 7) * 256 + (n0 & 127) + (mode == 2 ? 128 : 0) : n0);
        p0_transpose_item(src + n0, pitch, gain, dst, dstK, dkoff, drow0, k0, scr, F.lane);
    }
    { bf16* HB = (bf16*)(ws + WS_HB); float* ss0 = (float*)(ws + WS_CTL + CTL_SS);
      for (int m = gw; m < M; m += NGW) { const GAS f32x4* xr = (const GAS f32x4*)(a.in[I_X] + (size_t)m * D) + F.lane; GAS v2u* o8 = (GAS v2u*)(HB + (size_t)m * D) + F.lane; float s = 0.f;
#pragma unroll
          for (int j = 0; j < 8; ++j) { const f32x4 v = xr[64 * j]; s += (v.x * v.x + v.y * v.y) + (v.z * v.z + v.w * v.w); v2u w; w.x = pk2(v.x, v.y); w.y = pk2(v.z, v.w); o8[64 * j] = w; }
          s = wave_sum(s); if (F.lane == 0) ss0[m] = s; } }
    { bf16* MN = (bf16*)(ws + WS_MEMN); const float* gm = a.in[I_MEMNRM];
      for (int m = gw; m < BATCH * MEML; m += NGW) { const GAS f32x4* xr = (const GAS f32x4*)(a.in[I_MEM] + (size_t)m * D) + F.lane; GAS v2u* o8 = (GAS v2u*)(MN + (size_t)m * D) + F.lane; f32x4 v[8]; float s = 0.f;
#pragma unroll
          for (int j = 0; j < 8; ++j) { v[j] = xr[64 * j]; s += (v[j].x * v[j].x + v[j].y * v[j].y) + (v[j].z * v[j].z + v[j].w * v[j].w); }
          const float rs = rsqrtf(wave_sum(s) * (1.0f / D) + 1e-6f);
#pragma unroll
          for (int j = 0; j < 8; ++j) { const f32x4 g = *((const GAS f32x4*)gm + F.lane + 64 * j); v2u w; w.x = pk2(v[j].x * rs * g.x, v[j].y * rs * g.y); w.y = pk2(v[j].z * rs * g.z, v[j].w * rs * g.w); o8[64 * j] = w; } } }
}
__device__ __forceinline__ void p5_conv(Frame& F_, const Args& a) {
    Frame F = F_; asm volatile("" : "+v"(F.lane));
    const int gw = F.vcu * NWAVES + F.wave, NGW = F.G * NWAVES; unsigned char* ws = a.ws;
    const bf16* CU = (const bf16*)(ws + WS_CU); const bf16* BG = (const bf16*)(ws + WS_BG); bf16* MX = (bf16*)(ws + WS_MIXED); const float* cw = a.in[I_CONVW];
    for (int m = gw; m < M; m += NGW) { const int t = m & (SEQ - 1); float y[16]; float s = 0.f;
#pragma unroll
        for (int gsel = 0; gsel < 2; ++gsel) { const int ch = gsel * 512 + F.lane * 8;
            const v4u c0 = *(const GAS v4u*)(CU + (size_t)m * 1024 + ch); v4u c1 = (v4u){0u, 0u, 0u, 0u}, c2 = (v4u){0u, 0u, 0u, 0u};
            if (t >= 1) c1 = *(const GAS v4u*)(CU + (size_t)(m - 1) * 1024 + ch);
            if (t >= 2) c2 = *(const GAS v4u*)(CU + (size_t)(m - 2) * 1024 + ch);
            const v4u bg = *(const GAS v4u*)(BG + (size_t)m * 1024 + ch);
            const f32x4 w0a = *(const GAS f32x4*)(cw + ch), w0b = *(const GAS f32x4*)(cw + ch + 4), w1a = *(const GAS f32x4*)(cw + 1024 + ch), w1b = *(const GAS f32x4*)(cw + 1024 + ch + 4), w2a = *(const GAS f32x4*)(cw + 2048 + ch), w2b = *(const GAS f32x4*)(cw + 2048 + ch + 4);
#pragma unroll
            for (int e = 0; e < 4; ++e) { const unsigned x0 = c0[e], x1 = c1[e], x2 = c2[e], bw = bg[e];
                const float wl0 = e < 2 ? w0a[2 * e] : w0b[2 * e - 4], wh0 = e < 2 ? w0a[2 * e + 1] : w0b[2 * e - 3];
                const float wl1 = e < 2 ? w1a[2 * e] : w1b[2 * e - 4], wh1 = e < 2 ? w1a[2 * e + 1] : w1b[2 * e - 3];
                const float wl2 = e < 2 ? w2a[2 * e] : w2b[2 * e - 4], wh2 = e < 2 ? w2a[2 * e + 1] : w2b[2 * e - 3];
                const float lo = bflo(bw) * (wl0 * bflo(x2) + wl1 * bflo(x1) + wl2 * bflo(x0)), hi = bfhi(bw) * (wh0 * bfhi(x2) + wh1 * bfhi(x1) + wh2 * bfhi(x0));
                y[gsel * 8 + 2 * e] = lo; y[gsel * 8 + 2 * e + 1] = hi; s += lo * lo + hi * hi; } }
        const float rs = rsqrtf(wave_sum(s) * (1.0f / 1024.0f) + 1e-6f);
#pragma unroll
        for (int gsel = 0; gsel < 2; ++gsel) { v4u o; o.x = pk2(y[gsel * 8 + 0] * rs, y[gsel * 8 + 1] * rs); o.y = pk2(y[gsel * 8 + 2] * rs, y[gsel * 8 + 3] * rs); o.z = pk2(y[gsel * 8 + 4] * rs, y[gsel * 8 + 5] * rs); o.w = pk2(y[gsel * 8 + 6] * rs, y[gsel * 8 + 7] * rs);
            *(GAS v4u*)(MX + (size_t)m * 2048 + 1024 + gsel * 512 + F.lane * 8) = o; } }
}
__device__ __forceinline__ void p12_final(Frame& F_, const Args& a) {
    Frame F = F_; asm volatile("" : "+v"(F.lane));
    const int gw = F.vcu * NWAVES + F.wave, NGW = F.G * NWAVES; const float* ss4 = (const float*)(a.ws + WS_CTL + CTL_SS) + 5 * M; const float* gf = a.in[I_FINAL];
    for (int m = gw; m < M; m += NGW) { GAS f32x4* xr = (GAS f32x4*)(a.out + (size_t)m * D) + F.lane; const float rs = rsqrtf(ss4[m] * (1.0f / D) + 1e-6f);
#pragma unroll
        for (int j = 0; j < 8; ++j) { const f32x4 v = xr[64 * j]; const f32x4 g = *((const GAS f32x4*)gf + F.lane + 64 * j); xr[64 * j] = v * g * rs; } }
}

#ifndef MOBA_SDEPTH
#define MOBA_SDEPTH 1
#endif
__global__ void __launch_bounds__(NWAVES * 64, 2) fwd_kernel(Args args) {
    extern __shared__ __attribute__((aligned(16))) unsigned char lds[];
    Frame F;
    F.lds = (LAS unsigned char*)lds;
    F.MISC = (volatile LAS unsigned*)(F.lds + MISC_OFF);
    F.tid = threadIdx.x; F.lane = F.tid & 63; F.wave = __builtin_amdgcn_readfirstlane(F.tid >> 6);
    F.G = gridDim.x; { const int bx = blockIdx.x; F.vcu = (F.G % 8 == 0) ? (bx % 8) * (F.G / 8) + bx / 8 : bx; }
    unsigned char* ws = args.ws;
    for (int u = F.tid; u < (LDS_BYTES - LDSCTL_OFF) / 4; u += NWAVES * 64) ((LAS unsigned*)(F.lds + LDSCTL_OFF))[u] = 0u;
    __syncthreads();
    const int lo = args.ph_lo, hi = args.ph_hi; const bool multi = (hi - lo) > 1;
    XcdBarrier bar; bar.bar = (unsigned*)(ws + WS_CTL + CTL_BAR + (size_t)lo * BAR_STRIDE); bar.x = 0; bar.st = nullptr;
    if (multi) bar = xcd_barrier_post((unsigned*)(ws + WS_CTL + CTL_BAR + (size_t)lo * BAR_STRIDE), F.MISC + 8);
#ifndef PH_ENABLE
#define PH_ENABLE 0x1fff
#endif
#define IN(k) ((((PH_ENABLE) >> (k)) & 1) && lo <= (k) && (k) < hi)
#define SEAM(k) do { if (IN(k) && IN((k) + 1)) xcd_barrier(bar); } while (0)
    float* SS = (float*)(ws + WS_CTL + CTL_SS);
    float* KMS = (float*)(ws + WS_CTL + CTL_KMS);
    bf16* HB = (bf16*)(ws + WS_HB); bf16* ACT = (bf16*)(ws + WS_ACT); bf16* MIXED = (bf16*)(ws + WS_MIXED);
    bf16* Qb = (bf16*)(ws + WS_Q); bf16* Kb = (bf16*)(ws + WS_K); bf16* Vb = (bf16*)(ws + WS_V); bf16* CUb = (bf16*)(ws + WS_CU); bf16* BGb = (bf16*)(ws + WS_BG);
    bf16* QX = (bf16*)(ws + WS_QX); bf16* OX = (bf16*)(ws + WS_OX); bf16* KVX = (bf16*)(ws + WS_KVX);
    const int bx = (int)blockIdx.x;

    if (IN(0)) { p0_prologue(F, args); } SEAM(0);
    if (IN(1)) { pg8::Gemm g{HB, (const bf16*)(ws + WS_WGU1), M, 2 * FF, D}; pg8::StaticOrder S; S.init(M, 2 * FF, F.G, bx);
        pg8::EpiSwiglu E{ACT, FF, SS}; pg8::gemm_phase<pg8::EpiSwiglu, pg8::StaticOrder, PG8_ALIGN, PG8_SP2>(F.lds + RING_OFF, g, S, E); } SEAM(1);
    if (IN(2)) { pg8::Gemm g{ACT, (const bf16*)(ws + WS_WD1), M, D, FF}; pg8::StaticOrder S; S.init(M, D, F.G, bx);
        pg8::EpiResid<0> E{args.in[I_X], args.out, HB, SS + M, 0.5f, nullptr}; pg8::gemm_phase<pg8::EpiResid<0>, pg8::StaticOrder, PG8_ALIGN, PG8_SP2>(F.lds + RING_OFF, g, S, E); } SEAM(2);
    if (IN(3)) { pg8::Gemm g{HB, (const bf16*)(ws + WS_WIN), M, INW, D}; pg8::StaticOrder S; S.init(M, INW, F.G, bx);
        pg8::EpiWin E{Qb, Kb, Vb, CUb, BGb, KMS, SS + M}; pg8::gemm_phase<pg8::EpiWin, pg8::StaticOrder, PG8_ALIGN, PG8_SP2>(F.lds + RING_OFF, g, S, E); } SEAM(3);
    if (IN(4)) {
        for (int u = bx; u < BATCH * NH * 8; u += F.G) { const int b = u >> 6, h = (u >> 3) & 7, p = u & 7;
#pragma unroll 1
            for (int half = 0; half < 2; ++half) { const int qb = half ? 15 - p : p; const size_t r0 = (size_t)b * SEQ + (size_t)qb * 256;
                att::attn_body<true, 1024, 1024, 2048, MOBA_SDEPTH>(Qb + r0 * 1024 + h * 128, Kb + (size_t)b * SEQ * 1024 + h * 128, Vb + (size_t)b * SEQ * 1024 + h * 128, MIXED + r0 * 2048 + h * 128,
                                                       256 * (qb + 1), (att::lptr)(F.lds + RING_OFF), qb, KMS + ((size_t)b * 16 * 8 + h) * 128, 8 * 128, SS + 2 * M + r0); } } }
    if (IN(5)) { p5_conv(F, args); } SEAM(5);
    if (IN(6)) { pg8::Gemm g{MIXED, (const bf16*)(ws + WS_WOUT), M, D, D}; pg8::StaticOrder S; S.init(M, D, F.G, bx);
        pg8::EpiResid<16> E{args.out, args.out, HB, SS + 3 * M, 1.0f, SS + 2 * M}; pg8::gemm_phase<pg8::EpiResid<16>, pg8::StaticOrder, PG8_ALIGN, PG8_SP2>(F.lds + RING_OFF, g, S, E); } SEAM(6);
    if (IN(7)) { { pg8::Gemm g{HB, (const bf16*)(ws + WS_WQ), M, XW, D}; pg8::StaticOrder S; S.init(M, XW, F.G, bx);
          pg8::EpiScaleBf16 E{QX, XW, SS + 3 * M}; pg8::gemm_phase<pg8::EpiScaleBf16, pg8::StaticOrder, PG8_ALIGN, PG8_SP2>(F.lds + RING_OFF, g, S, E); }
        { pg8::Gemm g{(const bf16*)(ws + WS_MEMN), (const bf16*)(ws + WS_WKV), BATCH * MEML, 1024, D}; pg8::StaticOrder S; S.init(BATCH * MEML, 1024, F.G, (bx + F.G - 128) % F.G);
          pg8::EpiScaleBf16 E{KVX, 1024, nullptr}; pg8::gemm_phase<pg8::EpiScaleBf16, pg8::StaticOrder, PG8_ALIGN, PG8_SP2>(F.lds + RING_OFF, g, S, E); } } SEAM(7);
    if (IN(8)) {
        for (int u = bx; u < BATCH * XH * 16; u += F.G) { const int b = u >> 6, h = (u >> 4) & 3, qb = u & 15; const size_t r0 = (size_t)b * SEQ + (size_t)qb * 256;
            att::attn_body<false, 512, 1024, 512, 2>(QX + r0 * 512 + h * 128, KVX + (size_t)b * MEML * 1024 + h * 128, KVX + (size_t)b * MEML * 1024 + 512 + h * 128, OX + r0 * 512 + h * 128,
                                                  MEML, (att::lptr)(F.lds + RING_OFF), 0, nullptr, 0, nullptr); } } SEAM(8);
    if (IN(9)) { pg8::Gemm g{OX, (const bf16*)(ws + WS_WO), M, D, XW}; pg8::StaticOrder S; S.init(M, D, F.G, bx);
        pg8::EpiResid<0> E{args.out, args.out, HB, SS + 4 * M, 1.0f, nullptr}; pg8::gemm_phase<pg8::EpiResid<0>, pg8::StaticOrder, PG8_ALIGN, PG8_SP2>(F.lds + RING_OFF, g, S, E); } SEAM(9);
    if (IN(10)) { pg8::Gemm g{HB, (const bf16*)(ws + WS_WGU2), M, 2 * FF, D}; pg8::StaticOrder S; S.init(M, 2 * FF, F.G, bx);
        pg8::EpiSwiglu E{ACT, FF, SS + 4 * M}; pg8::gemm_phase<pg8::EpiSwiglu, pg8::StaticOrder, PG8_ALIGN, PG8_SP2>(F.lds + RING_OFF, g, S, E); } SEAM(10);
    if (IN(11)) { pg8::Gemm g{ACT, (const bf16*)(ws + WS_WD2), M, D, FF}; pg8::StaticOrder S; S.init(M, D, F.G, bx);
        pg8::EpiResid<0> E{args.out, args.out, nullptr, SS + 5 * M, 0.5f, nullptr}; pg8::gemm_phase<pg8::EpiResid<0>, pg8::StaticOrder, PG8_ALIGN, PG8_SP2>(F.lds + RING_OFF, g, S, E); } SEAM(11);
    if (IN(12)) { p12_final(F, args); }
#undef IN
#undef SEAM
}

extern "C" void kernel_launch(void* const* d_in, const int* in_sizes, int n_in, void* d_out, int out_size, void* d_ws, size_t ws_size, hipStream_t stream) {
    static int grid = 0;
    if (grid == 0) {
        if (n_in != 22 || in_sizes[0] != M * D || out_size != M * D || ws_size < WS_END) { fprintf(stderr, "kernel_launch: shape mismatch (n_in %d, in0 %d, out %d, ws %zu; need ws >= %zu); nothing launched\n", n_in, n_in > 0 ? in_sizes[0] : -1, out_size, ws_size, (size_t)WS_END); grid = -1; return; }
        int dev = 0, cus = 0, per_cu = 0;
        if (hipGetDevice(&dev) != hipSuccess || hipDeviceGetAttribute(&cus, hipDeviceAttributeMultiprocessorCount, dev) != hipSuccess) { grid = -1; return; }
        if (hipFuncSetAttribute((const void*)fwd_kernel, hipFuncAttributeMaxDynamicSharedMemorySize, LDS_BYTES) != hipSuccess) { fprintf(stderr, "kernel_launch: hipFuncSetAttribute failed\n"); grid = -1; return; }
        if (hipOccupancyMaxActiveBlocksPerMultiprocessor(&per_cu, (const void*)fwd_kernel, NWAVES * 64, LDS_BYTES) != hipSuccess || per_cu < 1) { fprintf(stderr, "kernel_launch: occupancy query reports %d workgroups per CU\n", per_cu); }
        (void)hipGetLastError();
        grid = cus;
    }
    if (grid < 0) return;
    if (hipMemsetAsync((char*)d_ws + WS_CTL, 0, CTL_ZERO_BYTES, stream) != hipSuccess) { fprintf(stderr, "kernel_launch: hipMemsetAsync failed\n"); return; }
    Args a{};
    for (int i = 0; i < 22; ++i) a.in[i] = (const float*)d_in[i];
    a.out = (float*)d_out; a.ws = (unsigned char*)d_ws;
    unsigned char* ws = (unsigned char*)d_ws; float* SS = (float*)(ws + WS_CTL + CTL_SS); float* KMS = (float*)(ws + WS_CTL + CTL_KMS); float* out = (float*)d_out;
    bf16* HB = (bf16*)(ws + WS_HB); bf16* ACT = (bf16*)(ws + WS_ACT); bf16* MIXED = (bf16*)(ws + WS_MIXED);
    bf16* Qb = (bf16*)(ws + WS_Q); bf16* Kb = (bf16*)(ws + WS_K); bf16* Vb = (bf16*)(ws + WS_V); bf16* CUb = (bf16*)(ws + WS_CU); bf16* BGb = (bf16*)(ws + WS_BG);
    bf16* QX = (bf16*)(ws + WS_QX); bf16* OX = (bf16*)(ws + WS_OX); bf16* KVX = (bf16*)(ws + WS_KVX);
    (void)SS; (void)KMS; (void)out; (void)HB; (void)ACT; (void)MIXED; (void)Qb; (void)Kb; (void)Vb; (void)CUb; (void)BGb; (void)QX; (void)OX; (void)KVX;
#if ONE_LAUNCH
    a.ph_lo = 0; a.ph_hi = NPH;
    hipLaunchKernelGGL(fwd_kernel, dim3(grid), dim3(NWAVES * 64), LDS_BYTES, stream, a);
#else
    for (int ph = 0; ph < NPH; ++ph) {
        if ((FAST_MASK >> ph) & 1) { a.ph_lo = ph; a.ph_hi = ph + 1; hipLaunchKernelGGL(fwd_kernel, dim3(grid), dim3(NWAVES * 64), LDS_BYTES, stream, a); continue; }
        switch (ph) {
        case 1: hipLaunchKernelGGL((nv::gemm<nv::FSwiglu>), dim3(FF / 64, M / 64), dim3(256), 0, stream, HB, (const bf16*)(ws + WS_WGU1), D, nv::FSwiglu{ACT, SS}); break;
        case 2: hipLaunchKernelGGL((nv::gemm<nv::FResid<0>>), dim3(D / 64, M / 64), dim3(256), 0, stream, ACT, (const bf16*)(ws + WS_WD1), FF, nv::FResid<0>{a.in[I_X], out, HB, SS + M, 0.5f, nullptr}); break;
        case 3: hipLaunchKernelGGL((nv::gemm<nv::FWin>), dim3(5120 / 64, M / 64), dim3(256), 0, stream, HB, (const bf16*)(ws + WS_WIN), D, nv::FWin{Qb, Kb, Vb, CUb, BGb, SS + M});
                hipLaunchKernelGGL(nv::kmean, dim3(BATCH * 16 * 8 * 128 / 256), dim3(256), 0, stream, Kb, KMS); break;
        case 4: hipLaunchKernelGGL(nv::moba, dim3(M * NH / 4), dim3(256), 0, stream, Qb, Kb, Vb, KMS, MIXED, SS + 2 * M); break;
        case 6: hipLaunchKernelGGL((nv::gemm<nv::FResid<1024>>), dim3(D / 64, M / 64), dim3(256), 0, stream, MIXED, (const bf16*)(ws + WS_WOUT), D, nv::FResid<1024>{out, out, HB, SS + 3 * M, 1.0f, SS + 2 * M}); break;
        case 7: hipLaunchKernelGGL((nv::gemm<nv::FScale>), dim3(XW / 64, M / 64), dim3(256), 0, stream, HB, (const bf16*)(ws + WS_WQ), D, nv::FScale{QX, XW, SS + 3 * M});
                hipLaunchKernelGGL((nv::gemm<nv::FScale>), dim3(1024 / 64, BATCH * MEML / 64), dim3(256), 0, stream, (const bf16*)(ws + WS_MEMN), (const bf16*)(ws + WS_WKV), D, nv::FScale{KVX, 1024, nullptr}); break;
        case 8: hipLaunchKernelGGL(nv::xattn, dim3(M * XH / 4), dim3(256), 0, stream, QX, KVX, OX); break;
        case 9: hipLaunchKernelGGL((nv::gemm<nv::FResid<0>>), dim3(D / 64, M / 64), dim3(256), 0, stream, OX, (const bf16*)(ws + WS_WO), XW, nv::FResid<0>{out, out, HB, SS + 4 * M, 1.0f, nullptr}); break;
        case 10: hipLaunchKernelGGL((nv::gemm<nv::FSwiglu>), dim3(FF / 64, M / 64), dim3(256), 0, stream, HB, (const bf16*)(ws + WS_WGU2), D, nv::FSwiglu{ACT, SS + 4 * M}); break;
        case 11: hipLaunchKernelGGL((nv::gemm<nv::FResid<0>>), dim3(D / 64, M / 64), dim3(256), 0, stream, ACT, (const bf16*)(ws + WS_WD2), FF, nv::FResid<0>{out, out, nullptr, SS + 5 * M, 0.5f, nullptr}); break;
        default: break;
        }
    }
#endif
    const hipError_t le = hipPeekAtLastError();
    if (le != hipSuccess) fprintf(stderr, "kernel_launch: launch failed: %s\n", hipGetErrorName(le));
}
```

```cpp
#define ONE_LAUNCH 1
#define FAST_MASK 0x1fff
#include <hip/hip_runtime.h>
#include <cstdio>
#include <cstdint>
namespace pg8 {
#define PG8_LAS __attribute__((address_space(3)))
typedef unsigned short bf16_t;
typedef short bf16x8 __attribute__((ext_vector_type(8)));
typedef float f32x4 __attribute__((ext_vector_type(4)));
typedef unsigned u32x4 __attribute__((ext_vector_type(4)));
constexpr int BM = 256, BK = 64, HALF = 128, HTB = HALF * BK * 2  , STAGE_BYTES = 8 * HTB, NXCD = 8, WGM = 8;

__host__ __device__ __forceinline__ int lds_byte(int r, int c) { const int st = (r >> 4) * 2 + (c >> 5), rr = r & 15, cc = c & 31, ob = rr * 64 + cc * 2; return st * 1024 + (ob ^ (((ob >> 9) & 1) << 5)); }
__host__ __device__ __forceinline__ void stage_rc(int b, int& R, int& C) { const int st = b / 1024, sb = b % 1024, swz = sb ^ (((sb >> 9) & 1) << 5); R = (st >> 1) * 16 + swz / 64; C = (st & 1) * 32 + (swz % 64) / 2; }
__host__ __device__ __forceinline__ int perm32(int rho) { const int n = rho >> 4, i = rho & 15; return 8 * (i >> 2) + 4 * n + (i & 3); }

struct Unit { int pm, pn; };
struct Gemm { const bf16_t* A; const bf16_t* Bt; int M, N, K; };

struct StaticOrder {
    int nM, nN, nwg, G, c;
    __host__ __device__ void init(int M, int N, int G_, int c_) { nM = M / BM; nN = N / BM; nwg = nM * nN; G = G_; c = c_; }
    __host__ __device__ bool next(int i, Unit& u) const {
        const long L = (long)i * G + c; if (L >= nwg) return false;
        int wgid = (int)L; { const int q = nwg / NXCD, r = nwg % NXCD, xcd = wgid % NXCD, off = wgid / NXCD; wgid = (xcd < r ? xcd * (q + 1) : r * (q + 1) + (xcd - r) * q) + off; }
        const int nig = WGM * nN, gid = wgid / nig, fm = gid * WGM, gsz = (nM - fm) < WGM ? (nM - fm) : WGM;
        u.pm = fm + ((wgid % nig) % gsz); u.pn = (wgid % nig) / gsz; return true;
    }
    __device__ __forceinline__ void a_ready(const Unit&) const {}
    __device__ __forceinline__ void done(const Unit&) const {}
};

__device__ __forceinline__ unsigned cvt_pk_bf16(float lo, float hi) { unsigned r; asm volatile("v_cvt_pk_bf16_f32 %0, %1, %2" : "=v"(r) : "v"(lo), "v"(hi)); return r; }
__device__ __forceinline__ u32x4 pack8(const f32x4 v0, const f32x4 v1) { u32x4 w; w.x = cvt_pk_bf16(v0[0], v0[1]); w.y = cvt_pk_bf16(v0[2], v0[3]); w.z = cvt_pk_bf16(v1[0], v1[1]); w.w = cvt_pk_bf16(v1[2], v1[3]); return w; }
constexpr float RMS_EPS = 1e-6f;
__device__ __forceinline__ float silu_mul(float g, float u) { return g * u * __builtin_amdgcn_rcpf(1.0f + __builtin_amdgcn_exp2f(-1.4426950408889634f * g)); }

struct EpiSwiglu {
    static constexpr bool PERM = true, AFTER_DRAIN = false; static constexpr int MIDT = 0;
    bf16_t* O; int ldo; const float* ss;
    __device__ __forceinline__ void mid(f32x4 (&)[2][2][4][2], const Unit&, int, int) const {}
    __device__ __forceinline__ void operator()(const f32x4 (&acc)[2][2][4][2], const Unit& u, int wr, int wc, int fr_, int fq_) const {
        int fr = fr_, fq = fq_; asm volatile("" : "+v"(fr), "+v"(fq));
        const int row0 = u.pm * BM + wr * 64 + fr, col0 = u.pn * HALF + wc * 32 + 8 * fq;
#pragma unroll
        for (int ai = 0; ai < 2; ++ai)
#pragma unroll
            for (int m = 0; m < 4; ++m) { const int row = row0 + ai * HALF + m * 16; const float rs = rsqrtf(ss[row] * (1.0f / 2048.0f) + RMS_EPS);
                f32x4 o0, o1;
#pragma unroll
                for (int j = 0; j < 4; ++j) { o0[j] = silu_mul(acc[ai][0][m][0][j] * rs, acc[ai][1][m][0][j] * rs); o1[j] = silu_mul(acc[ai][0][m][1][j] * rs, acc[ai][1][m][1][j] * rs); }
                *(u32x4*)(O + (size_t)row * ldo + col0) = pack8(o0, o1); }
    }
};
template <int MIDT_> struct EpiResid {
    static constexpr bool PERM = true, AFTER_DRAIN = false; static constexpr int MIDT = MIDT_;
    const float* R; float* H; bf16_t* HB; float* ssn; float alpha; const float* midss;
    __device__ __forceinline__ void mid(f32x4 (&acc)[2][2][4][2], const Unit& u, int wr, int fr) const {
        const int row0 = u.pm * BM + wr * 64 + fr;
#pragma unroll
        for (int ai = 0; ai < 2; ++ai)
#pragma unroll
            for (int m = 0; m < 4; ++m) { const float s = rsqrtf(midss[row0 + ai * HALF + m * 16] * (1.0f / 1024.0f) + RMS_EPS);
#pragma unroll
                for (int bj = 0; bj < 2; ++bj)
#pragma unroll
                    for (int n = 0; n < 2; ++n) acc[ai][bj][m][n] = acc[ai][bj][m][n] * s; }
    }
    __device__ __forceinline__ void operator()(const f32x4 (&acc)[2][2][4][2], const Unit& u, int wr, int wc, int fr_, int fq_) const {
        int fr = fr_, fq = fq_; asm volatile("" : "+v"(fr), "+v"(fq));
        const int row0 = u.pm * BM + wr * 64 + fr, col0 = u.pn * BM + wc * 32 + 8 * fq;
#pragma unroll
        for (int ai = 0; ai < 2; ++ai)
#pragma unroll
            for (int m = 0; m < 4; ++m) { const int row = row0 + ai * HALF + m * 16; const size_t off = (size_t)row * 2048 + col0; float sq = 0.f;
#pragma unroll
                for (int bj = 0; bj < 2; ++bj) { const f32x4 r0 = *(const f32x4*)(R + off + bj * HALF), r1 = *(const f32x4*)(R + off + bj * HALF + 4);
                    const f32x4 h0 = r0 + acc[ai][bj][m][0] * alpha, h1 = r1 + acc[ai][bj][m][1] * alpha;
                    *(f32x4*)(H + off + bj * HALF) = h0; *(f32x4*)(H + off + bj * HALF + 4) = h1;
                    if (HB) *(u32x4*)(HB + off + bj * HALF) = pack8(h0, h1);
                    sq += (h0[0] * h0[0] + h0[1] * h0[1]) + (h0[2] * h0[2] + h0[3] * h0[3]) + (h1[0] * h1[0] + h1[1] * h1[1]) + (h1[2] * h1[2] + h1[3] * h1[3]); }
                sq += __shfl_xor(sq, 16); sq += __shfl_xor(sq, 32);
                if (fq == 0) unsafeAtomicAdd(ssn + row, sq);
                asm volatile("" ::: "memory"); }
    }
};
struct EpiWin {
    static constexpr bool PERM = true, AFTER_DRAIN = false; static constexpr int MIDT = 0;
    bf16_t *Q, *K, *V, *CU, *BG; float* kms; const float* ss;
    __device__ __forceinline__ void mid(f32x4 (&)[2][2][4][2], const Unit&, int, int) const {}
    __device__ __forceinline__ void operator()(const f32x4 (&acc)[2][2][4][2], const Unit& u, int wr, int wc, int fr_, int fq_) const {
        int fr = fr_, fq = fq_; asm volatile("" : "+v"(fr), "+v"(fq));
        const int row0 = u.pm * BM + wr * 64 + fr, pn = u.pn;
        if (pn >= 12 && pn < 20) {
            const int col0 = (pn - 12) * HALF + wc * 32 + 8 * fq;
#pragma unroll
            for (int ai = 0; ai < 2; ++ai)
#pragma unroll
                for (int m = 0; m < 4; ++m) { const int row = row0 + ai * HALF + m * 16; float rs = rsqrtf(ss[row] * (1.0f / 2048.0f) + RMS_EPS); rs = rs * rs;
                    const f32x4 o0 = acc[ai][0][m][0] * acc[ai][1][m][0] * rs, o1 = acc[ai][0][m][1] * acc[ai][1][m][1] * rs;
                    *(u32x4*)(CU + (size_t)row * 1024 + col0) = pack8(o0, o1); }
        } else {
            bf16_t* base = pn < 4 ? Q : pn < 8 ? K : pn < 12 ? V : BG; const int colt = (pn & 3) * BM, col0 = colt + wc * 32 + 8 * fq; const bool isk = (pn >= 4 && pn < 8);
            float rsv[2][4];
#pragma unroll
            for (int ai = 0; ai < 2; ++ai)
#pragma unroll
                for (int m = 0; m < 4; ++m) rsv[ai][m] = rsqrtf(ss[row0 + ai * HALF + m * 16] * (1.0f / 2048.0f) + RMS_EPS);
#pragma unroll
            for (int ai = 0; ai < 2; ++ai)
#pragma unroll
                for (int m = 0; m < 4; ++m) { const int row = row0 + ai * HALF + m * 16;
#pragma unroll
                    for (int bj = 0; bj < 2; ++bj) *(u32x4*)(base + (size_t)row * 1024 + col0 + bj * HALF) = pack8(acc[ai][bj][m][0] * rsv[ai][m], acc[ai][bj][m][1] * rsv[ai][m]); }
            if (isk) {
#pragma unroll
                for (int bj = 0; bj < 2; ++bj)
#pragma unroll
                    for (int n = 0; n < 2; ++n) { f32x4 c = (f32x4){0.f, 0.f, 0.f, 0.f};
#pragma unroll
                        for (int ai = 0; ai < 2; ++ai)
#pragma unroll
                            for (int m = 0; m < 4; ++m) { float r2 = rsv[ai][m]; asm volatile("" : "+v"(r2)); c += acc[ai][bj][m][n] * r2; }
#pragma unroll
                        for (int j = 0; j < 4; ++j) { float v = c[j]; v += __shfl_xor(v, 1); v += __shfl_xor(v, 2); v += __shfl_xor(v, 4); v += __shfl_xor(v, 8);
                            const int col = col0 + bj * HALF + 4 * n + j;
                            if (fr == 0) unsafeAtomicAdd(kms + ((size_t)u.pm * 8 + (col >> 7)) * 128 + (col & 127), v); }
                        asm volatile("" ::: "memory"); }
            }
        }
    }
};
struct EpiScaleBf16 {
    static constexpr bool PERM = true, AFTER_DRAIN = false; static constexpr int MIDT = 0;
    bf16_t* O; int ldo; const float* ss;
    __device__ __forceinline__ void mid(f32x4 (&)[2][2][4][2], const Unit&, int, int) const {}
    __device__ __forceinline__ void operator()(const f32x4 (&acc)[2][2][4][2], const Unit& u, int wr, int wc, int fr_, int fq_) const {
        int fr = fr_, fq = fq_; asm volatile("" : "+v"(fr), "+v"(fq));
        const int row0 = u.pm * BM + wr * 64 + fr, col0 = u.pn * BM + wc * 32 + 8 * fq;
#pragma unroll
        for (int ai = 0; ai < 2; ++ai)
#pragma unroll
            for (int m = 0; m < 4; ++m) { const int row = row0 + ai * HALF + m * 16; const float rs = ss ? rsqrtf(ss[row] * (1.0f / 2048.0f) + RMS_EPS) : 1.0f;
#pragma unroll
                for (int bj = 0; bj < 2; ++bj) *(u32x4*)(O + (size_t)row * ldo + col0 + bj * HALF) = pack8(acc[ai][bj][m][0] * rs, acc[ai][bj][m][1] * rs); }
    }
};

template <class Epi, class Sched, bool ALIGN_EPI = false, bool SP2 = false>
__device__ __forceinline__ void gemm_phase(PG8_LAS unsigned char* lds, const Gemm g, const Sched& S, const Epi& E) {
    int tid_ = threadIdx.x; asm volatile("" : "+v"(tid_));
    const int tid = tid_, wid = __builtin_amdgcn_readfirstlane(tid >> 6), lane = tid & 63, wr = wid >> 2, wc = wid & 3, fr = lane & 15, fq = lane >> 4;
    const int K = g.K, nt = K / BK;
    unsigned voffA[2], voffB[2];
#pragma unroll
    for (int i = 0; i < 2; ++i) { int R, C; stage_rc(tid * 16 + i * 8192, R, C); const int Rb = Epi::PERM ? ((R & ~31) + perm32(R & 31)) : R;
        voffA[i] = (unsigned)(R * K + C) * 2u; voffB[i] = (unsigned)(Rb * K + C) * 2u; }
    const size_t kstep = (size_t)(BK * 2);
    const size_t hstep = (size_t)HALF * K * 2;
    const size_t tstep = 2 * hstep;
    const unsigned ldsw = (unsigned)wid * 1024u;
    const int aoff = lds_byte(wr * 64 + fr, fq * 8), boff = lds_byte(wc * 32 + fr, fq * 8);
#define PG8_SA(b, h) (((b) * 2 + (h)) * HTB)
#define PG8_SB(b, h) ((4 + (b) * 2 + (h)) * HTB)
#define PG8_STAGE(bufoff, gbase, voff) do { _Pragma("unroll") for (int _i = 0; _i < 2; ++_i) \
        __builtin_amdgcn_global_load_lds((const unsigned*)((const char*)(gbase) + (voff)[_i]), (PG8_LAS unsigned*)(lds + (bufoff) + ldsw + _i * 8192), 16, 0, 0); } while (0)
#define PG8_LDA(dst, b, h) do { _Pragma("unroll") for (int m = 0; m < 4; ++m) _Pragma("unroll") for (int k = 0; k < 2; ++k) dst[m][k] = *(const PG8_LAS bf16x8*)(lds + PG8_SA(b, h) + aoff + m * 2048 + k * 1024); } while (0)
#define PG8_LDB(dst, b, h) do { _Pragma("unroll") for (int n = 0; n < 2; ++n) _Pragma("unroll") for (int k = 0; k < 2; ++k) dst[n][k] = *(const PG8_LAS bf16x8*)(lds + PG8_SB(b, h) + boff + n * 2048 + k * 1024); } while (0)
#define PG8_MMA(ai, bj, At, Bt) do { __builtin_amdgcn_s_setprio(1); _Pragma("unroll") for (int m = 0; m < 4; ++m) _Pragma("unroll") for (int n = 0; n < 2; ++n) _Pragma("unroll") for (int k = 0; k < 2; ++k) \
        acc[ai][bj][m][n] = __builtin_amdgcn_mfma_f32_16x16x32_bf16(Bt[n][k], At[m][k], acc[ai][bj][m][n], 0, 0, 0); __builtin_amdgcn_s_setprio(0); } while (0)
#define PG8_WAIT_V(n) asm volatile("s_waitcnt vmcnt(" #n ")" ::: "memory")
#define PG8_WAIT_L(n) asm volatile("s_waitcnt lgkmcnt(" #n ")" ::: "memory")
#define PG8_BAR __builtin_amdgcn_s_barrier()
#define PG8_SCHED __builtin_amdgcn_sched_barrier(0)
    Unit cur, nxt; int ui = 0;
    if (!S.next(0, cur)) return;
    f32x4 acc[2][2][4][2];
#pragma unroll
    for (int a = 0; a < 2; ++a)
#pragma unroll
        for (int b = 0; b < 2; ++b)
#pragma unroll
            for (int m = 0; m < 4; ++m)
#pragma unroll
                for (int n = 0; n < 2; ++n) acc[a][b][m][n] = (f32x4){0.f, 0.f, 0.f, 0.f};
    bf16x8 At[4][2], B0[2][2], B1[2][2];
    const char* cA = (const char*)g.A + (size_t)cur.pm * tstep; const char* cB = (const char*)g.Bt + (size_t)cur.pn * tstep;
    S.a_ready(cur);
    if constexpr (SP2) {
        PG8_STAGE(PG8_SB(0, 0), cB, voffB); PG8_STAGE(PG8_SB(0, 1), cB + hstep, voffB); PG8_STAGE(PG8_SA(0, 0), cA, voffA); PG8_STAGE(PG8_SA(0, 1), cA + hstep, voffA);
        if (wr == 1) PG8_BAR;
        PG8_WAIT_V(2); PG8_BAR;
        PG8_STAGE(PG8_SB(1, 0), cB + kstep, voffB); PG8_STAGE(PG8_SA(1, 0), cA + kstep, voffA); PG8_STAGE(PG8_SB(1, 1), cB + hstep + kstep, voffB);
        PG8_WAIT_V(6); PG8_BAR;
    } else {
        PG8_STAGE(PG8_SB(0, 0), cB, voffB); PG8_STAGE(PG8_SA(0, 0), cA, voffA); PG8_STAGE(PG8_SB(0, 1), cB + hstep, voffB); PG8_STAGE(PG8_SA(0, 1), cA + hstep, voffA);
        if (wr == 1) PG8_BAR;
        PG8_WAIT_V(4); PG8_BAR;
        PG8_STAGE(PG8_SB(1, 0), cB + kstep, voffB); PG8_STAGE(PG8_SA(1, 0), cA + kstep, voffA); PG8_STAGE(PG8_SB(1, 1), cB + hstep + kstep, voffB);
        PG8_WAIT_V(6); PG8_BAR;
    }
    for (;;) {
        const bool has_next = S.next(ui + 1, nxt);
        const char* nA = has_next ? (const char*)g.A + (size_t)nxt.pm * tstep : cA; const char* nB = has_next ? (const char*)g.Bt + (size_t)nxt.pn * tstep : cB;
        for (int t = 0; t < nt; t += 2) {
            if constexpr (Epi::MIDT > 0) { if (t == Epi::MIDT) E.mid(acc, cur, wr, fr); }
            const bool last = (t == nt - 2);
            const char* a1 = cA + (size_t)(t + 1) * kstep;
            const char* a2 = last ? nA : cA + (size_t)(t + 2) * kstep; const char* b2 = last ? nB : cB + (size_t)(t + 2) * kstep;
            const char* a3 = a2 + kstep; const char* b3 = b2 + kstep;
            if (last && has_next) S.a_ready(nxt);
            if constexpr (SP2) {
            PG8_LDB(B0, 0, 0); PG8_LDB(B1, 0, 1); PG8_SCHED; PG8_LDA(At, 0, 0); PG8_STAGE(PG8_SA(1, 1), a1 + hstep, voffA);
            PG8_WAIT_V(8); PG8_WAIT_L(0); PG8_BAR; PG8_MMA(0, 0, At, B0); PG8_MMA(0, 1, At, B1); PG8_BAR; PG8_SCHED;
            PG8_LDA(At, 0, 1); PG8_STAGE(PG8_SB(0, 0), b2, voffB); PG8_STAGE(PG8_SB(0, 1), b2 + hstep, voffB); PG8_STAGE(PG8_SA(0, 0), a2, voffA);
            PG8_WAIT_V(8); PG8_WAIT_L(0); PG8_BAR; PG8_MMA(1, 0, At, B0); PG8_MMA(1, 1, At, B1); PG8_BAR; PG8_SCHED;
            PG8_LDB(B0, 1, 0); PG8_LDB(B1, 1, 1); PG8_SCHED; PG8_LDA(At, 1, 0); PG8_STAGE(PG8_SA(0, 1), a2 + hstep, voffA);
            PG8_WAIT_V(8); PG8_WAIT_L(0); PG8_BAR; PG8_MMA(0, 0, At, B0); PG8_MMA(0, 1, At, B1); PG8_BAR; PG8_SCHED;
            PG8_LDA(At, 1, 1); PG8_STAGE(PG8_SB(1, 0), b3, voffB); PG8_STAGE(PG8_SB(1, 1), b3 + hstep, voffB); PG8_STAGE(PG8_SA(1, 0), a3, voffA);
            PG8_WAIT_V(8); PG8_WAIT_L(0); PG8_BAR; PG8_MMA(1, 0, At, B0); PG8_MMA(1, 1, At, B1); PG8_BAR; PG8_SCHED;
            } else {
            PG8_LDB(B0, 0, 0); PG8_SCHED; PG8_LDA(At, 0, 0); PG8_STAGE(PG8_SA(1, 1), a1 + hstep, voffA);
            PG8_WAIT_L(8); PG8_BAR; PG8_WAIT_L(0); PG8_MMA(0, 0, At, B0); PG8_BAR; PG8_SCHED;
            PG8_LDB(B1, 0, 1); PG8_STAGE(PG8_SB(0, 0), b2, voffB);
            PG8_BAR; PG8_WAIT_L(0); PG8_MMA(0, 1, At, B1); PG8_BAR;
            PG8_LDA(At, 0, 1); PG8_STAGE(PG8_SA(0, 0), a2, voffA);
            PG8_BAR; PG8_WAIT_L(0); PG8_MMA(1, 0, At, B0); PG8_BAR; PG8_SCHED;
            PG8_STAGE(PG8_SB(0, 1), b2 + hstep, voffB);
            PG8_WAIT_V(6); PG8_BAR; PG8_MMA(1, 1, At, B1); PG8_BAR;
            PG8_LDB(B0, 1, 0); PG8_SCHED; PG8_LDA(At, 1, 0); PG8_STAGE(PG8_SA(0, 1), a2 + hstep, voffA);
            PG8_WAIT_L(8); PG8_BAR; PG8_WAIT_L(0); PG8_MMA(0, 0, At, B0); PG8_BAR; PG8_SCHED;
            PG8_LDB(B1, 1, 1); PG8_STAGE(PG8_SB(1, 0), b3, voffB);
            PG8_BAR; PG8_WAIT_L(0); PG8_MMA(0, 1, At, B1); PG8_BAR;
            PG8_LDA(At, 1, 1); PG8_STAGE(PG8_SA(1, 0), a3, voffA);
            PG8_BAR; PG8_WAIT_L(0); PG8_MMA(1, 0, At, B0); PG8_BAR; PG8_SCHED;
            PG8_STAGE(PG8_SB(1, 1), b3 + hstep, voffB);
            PG8_WAIT_V(6); PG8_BAR; PG8_MMA(1, 1, At, B1); PG8_BAR;
            }
        }
        if constexpr (ALIGN_EPI) { if (wr == 0) PG8_BAR; }
        if constexpr (!Epi::AFTER_DRAIN) { E(acc, cur, wr, wc, fr, fq); S.done(cur); }
        if (!has_next) break;
#pragma unroll
        for (int a = 0; a < 2; ++a)
#pragma unroll
            for (int b = 0; b < 2; ++b)
#pragma unroll
                for (int m = 0; m < 4; ++m)
#pragma unroll
                    for (int n = 0; n < 2; ++n) acc[a][b][m][n] = (f32x4){0.f, 0.f, 0.f, 0.f};
        cur = nxt; cA = nA; cB = nB; ++ui;
        if constexpr (ALIGN_EPI) { if (wr == 1) PG8_BAR; }
    }
    PG8_WAIT_V(0);
    if constexpr (!ALIGN_EPI) { if (wr == 0) PG8_BAR; }
    PG8_BAR;
    if constexpr (Epi::AFTER_DRAIN) { E.fused(acc, cur, wr, wc, fr, fq, lds, wid, lane); S.done(cur); }
#undef PG8_SA
#undef PG8_SB
#undef PG8_STAGE
#undef PG8_LDA
#undef PG8_LDB
#undef PG8_MMA
#undef PG8_WAIT_V
#undef PG8_WAIT_L
#undef PG8_BAR
#undef PG8_SCHED
}
}

#define PG8_SP2 true
#define PG8_ALIGN true
namespace att {
typedef unsigned short bf16;
using bf16x8 = __attribute__((ext_vector_type(8))) short;
using s16x4  = __attribute__((ext_vector_type(4))) short;
using f32x16 = __attribute__((ext_vector_type(16))) float;
using u32x4  = __attribute__((ext_vector_type(4))) unsigned;
#define ATT_LAS __attribute__((address_space(3)))
typedef ATT_LAS char* lptr;
constexpr int   D = 128, NW = 8, QBLK = 32, KVBLK = 64;
constexpr float SCALE = 0.088388347648318440f;
constexpr float THR = 8.f;
constexpr int SHM_V = KVBLK * D * 2, SHM_K = KVBLK * D * 2, SHM_ATTN = 2 * SHM_V + 2 * SHM_K + NW * 64 * 4;
#define KSWZ(row, colB) ((row) * 256 + ((colB) ^ (((row) & 7) << 4)))
#define SBAR() __builtin_amdgcn_sched_barrier(0)
__device__ __forceinline__ int crow(int r, int hi) { return (r & 3) + 8 * (r >> 2) + 4 * hi; }
__device__ __forceinline__ unsigned cvtpk(float lo, float hi) { unsigned r; asm volatile("v_cvt_pk_bf16_f32 %0, %1, %2" : "=v"(r) : "v"(lo), "v"(hi)); return r; }
__device__ __forceinline__ void partialSM(f32x16& p0, f32x16& p1, float& m_reg, float& mn, float& alpha) {
  constexpr float C = SCALE * 1.4426950408889634f;
  float pmax = p0[0];
#pragma unroll
  for (int r = 1; r < 16; ++r) pmax = fmaxf(pmax, p0[r]);
#pragma unroll
  for (int r = 0; r < 16; ++r) pmax = fmaxf(pmax, p1[r]);
  { auto rr = __builtin_amdgcn_permlane32_swap(__float_as_uint(pmax), __float_as_uint(pmax), false, false);
    pmax = fmaxf(__uint_as_float(rr[0]), __uint_as_float(rr[1])); }
  if (__builtin_expect(__all(pmax - m_reg <= THR / SCALE), 1)) { mn = m_reg; alpha = 1.f; }
  else { mn = fmaxf(m_reg, pmax); alpha = __builtin_amdgcn_exp2f((m_reg - mn) * C); m_reg = mn; }
  float mnC = -mn * C;
#pragma unroll
  for (int r = 0; r < 16; ++r) p0[r] = fmaf(p0[r], C, mnC);
#pragma unroll
  for (int r = 0; r < 16; ++r) p1[r] = fmaf(p1[r], C, mnC);
#pragma unroll
  for (int r = 0; r < 16; ++r) p0[r] = __builtin_amdgcn_exp2f(p0[r]);
}
__device__ __forceinline__ void finishSM(f32x16& p0, f32x16& p1, float alpha, float& l_reg, bf16x8& pa0, bf16x8& pa1, bf16x8& pa2, bf16x8& pa3) {
#pragma unroll
  for (int r = 0; r < 16; ++r) p1[r] = __builtin_amdgcn_exp2f(p1[r]);
  float ps = 0;
#pragma unroll
  for (int r = 0; r < 16; ++r) ps += p0[r];
#pragma unroll
  for (int r = 0; r < 16; ++r) ps += p1[r];
  { auto rr = __builtin_amdgcn_permlane32_swap(__float_as_uint(ps), __float_as_uint(ps), false, false);
    ps = __uint_as_float(rr[0]) + __uint_as_float(rr[1]); }
  l_reg = l_reg * alpha + ps;
#define PK4(P, BASE, OUT) do { unsigned a0 = cvtpk(P[BASE + 0], P[BASE + 1]), a1 = cvtpk(P[BASE + 2], P[BASE + 3]);   \
    unsigned b0 = cvtpk(P[BASE + 4], P[BASE + 5]), b1 = cvtpk(P[BASE + 6], P[BASE + 7]);                              \
    auto r0 = __builtin_amdgcn_permlane32_swap(a0, b0, false, false); auto r1 = __builtin_amdgcn_permlane32_swap(a1, b1, false, false); \
    u32x4 w = {r0[0], r1[0], r0[1], r1[1]}; OUT = *reinterpret_cast<bf16x8*>(&w); } while (0)
  PK4(p0, 0, pa0); PK4(p0, 8, pa1); PK4(p1, 0, pa2); PK4(p1, 8, pa3);
#undef PK4
}
__device__ __forceinline__ void qkt(f32x16& p0, f32x16& p1, lptr Ks, const bf16x8* qr, int r32, int hi) {
  p0 = f32x16{}; p1 = f32x16{};
#pragma unroll
  for (int d0 = 0; d0 < 8; ++d0) { int cb = (d0 * 16 + hi * 8) * 2;
    bf16x8 b0 = *reinterpret_cast<const ATT_LAS bf16x8*>(Ks + KSWZ(r32, cb));
    bf16x8 b1 = *reinterpret_cast<const ATT_LAS bf16x8*>(Ks + KSWZ(32 + r32, cb));
    p0 = __builtin_amdgcn_mfma_f32_32x32x16_bf16(b0, qr[d0], p0, 0, 0, 0);
    p1 = __builtin_amdgcn_mfma_f32_32x32x16_bf16(b1, qr[d0], p1, 0, 0, 0); }
}
__device__ __forceinline__ int v_st(int k, int c) { const int kk = (k & ~0xC) | ((k & 4) << 1) | ((k & 8) >> 1); return ((kk >> 3) * 4 + (c >> 5)) * 512 + ((kk & 7) * 32 + (c & 31)) * 2; }
__device__ __forceinline__ int v_rd_base(int lane) { return ((lane & 3) << 3) | (((lane >> 2) & 3) << 6) | (((lane >> 4) & 1) << 5) | (((lane >> 5) & 1) << 8); }
constexpr int v_rd_off(int d0, int ks, int half) { return d0 * 512 + ks * 4096 + half * 2048; }
template <int OFF> __device__ __forceinline__ s16x4 tr_read(int vb) {
  s16x4 r; asm volatile("ds_read_b64_tr_b16 %0, %1 offset:%2" : "=&v"(r) : "v"(vb), "i"(OFF) : "memory"); return r;
}
template <int D0> __device__ __forceinline__ void pv_one(f32x16& od, int vb, bf16x8 pa0, bf16x8 pa1, bf16x8 pa2, bf16x8 pa3) {
  const s16x4 l0 = tr_read<v_rd_off(D0, 0, 0)>(vb), h0 = tr_read<v_rd_off(D0, 0, 1)>(vb), l1 = tr_read<v_rd_off(D0, 1, 0)>(vb), h1 = tr_read<v_rd_off(D0, 1, 1)>(vb);
  const s16x4 l2 = tr_read<v_rd_off(D0, 2, 0)>(vb), h2 = tr_read<v_rd_off(D0, 2, 1)>(vb), l3 = tr_read<v_rd_off(D0, 3, 0)>(vb), h3 = tr_read<v_rd_off(D0, 3, 1)>(vb);
  asm volatile("s_waitcnt lgkmcnt(0)" ::: "memory"); SBAR();
#define PK(L, H) (bf16x8){L[0], L[1], L[2], L[3], H[0], H[1], H[2], H[3]}
  od = __builtin_amdgcn_mfma_f32_32x32x16_bf16(pa0, PK(l0, h0), od, 0, 0, 0);
  od = __builtin_amdgcn_mfma_f32_32x32x16_bf16(pa1, PK(l1, h1), od, 0, 0, 0);
  od = __builtin_amdgcn_mfma_f32_32x32x16_bf16(pa2, PK(l2, h2), od, 0, 0, 0);
  od = __builtin_amdgcn_mfma_f32_32x32x16_bf16(pa3, PK(l3, h3), od, 0, 0, 0);
#undef PK
}
__device__ __forceinline__ void pv_d0(f32x16* o, int vb, bf16x8 pa0, bf16x8 pa1, bf16x8 pa2, bf16x8 pa3) {
  pv_one<0>(o[0], vb, pa0, pa1, pa2, pa3); pv_one<1>(o[1], vb, pa0, pa1, pa2, pa3); pv_one<2>(o[2], vb, pa0, pa1, pa2, pa3); pv_one<3>(o[3], vb, pa0, pa1, pa2, pa3);
}
__device__ __forceinline__ void moba_mask(f32x16& p0, f32x16& p1, int tile, int qb, unsigned sel, int qi, int w0, int hi) {
  const float NINF = -__builtin_inff();
  const int jb = tile >> 2;
  if (jb < qb) {
    const bool ok = ((sel >> jb) & 1u) != 0u;
    if (!__all(ok)) {
#pragma unroll
      for (int r = 0; r < 16; ++r) { p0[r] = ok ? p0[r] : NINF; p1[r] = ok ? p1[r] : NINF; }
    }
  } else {
    const int k0 = (tile & 3) * 64;
    if (k0 + 63 > w0) {
      int lim = qi - k0 - 4 * hi; asm volatile("" : "+v"(lim));
#pragma unroll
      for (int r = 0; r < 16; ++r) { const int kc = (r & 3) + 8 * (r >> 2); p0[r] = (kc <= lim) ? p0[r] : NINF; p1[r] = (kc + 32 <= lim) ? p1[r] : NINF; }
    }
  }
}

template <bool MOBA, int LDQ, int LDK, int LDO, int SDEPTH>
__device__ __forceinline__ void attn_body(const bf16* __restrict__ Qb, const bf16* __restrict__ Kh, const bf16* __restrict__ Vh, bf16* __restrict__ Ob, int seq, lptr lds,
                                          int qb, const float* __restrict__ kms, int kms_stride, float* __restrict__ ssq) {
  int tid_ = threadIdx.x; asm volatile("" : "+v"(tid_));
  const int tid = tid_, wid = tid >> 6, lane = tid & 63, r32 = lane & 31, hi = lane >> 5;
  lptr V_lds = lds; lptr K_lds = lds + 2 * SHM_V;
  ATT_LAS float* ws = (ATT_LAS float*)(lds + 2 * SHM_V + 2 * SHM_K) + wid * 64; ATT_LAS float* li_l = ws; ATT_LAS float* al_l = ws + 32;
  float m_reg = -1e30f, l_reg = 0; f32x16 o[4] = {}; bf16x8 qr[8];
  unsigned qoff = (unsigned)((wid * QBLK + r32) * LDQ + hi * 8); asm volatile("" : "+v"(qoff));
  const bf16* Qw = Qb + qoff;
#pragma unroll
  for (int d0 = 0; d0 < 8; ++d0) qr[d0] = *reinterpret_cast<const bf16x8*>(Qw + d0 * 16);
  const int sr = tid >> 4, sc = (tid & 15) * 8, vst0 = v_st(sr, sc), vst1 = v_st(32 + sr, sc);
  const int vb0 = (int)(uintptr_t)V_lds + v_rd_base(lane);
  struct { bf16x8 vs0, vs1, ks0, ks1; } sr_[SDEPTH];
  const unsigned so0 = (unsigned)(sr * LDK + sc), so1 = (unsigned)((32 + sr) * LDK + sc);
#define SLOAD(i, k0) do { const bf16* Vt_ = Vh + (long)(k0) * LDK; const bf16* Kt_ = Kh + (long)(k0) * LDK; \
    sr_[i].vs0 = *reinterpret_cast<const bf16x8*>(Vt_ + so0); sr_[i].vs1 = *reinterpret_cast<const bf16x8*>(Vt_ + so1); \
    sr_[i].ks0 = *reinterpret_cast<const bf16x8*>(Kt_ + so0); sr_[i].ks1 = *reinterpret_cast<const bf16x8*>(Kt_ + so1); } while (0)
#define SWRITE(b, i) do { *(ATT_LAS bf16x8*)(V_lds + (b) * SHM_V + vst0) = sr_[i].vs0;          \
    *(ATT_LAS bf16x8*)(V_lds + (b) * SHM_V + vst1) = sr_[i].vs1; int kc = sc * 2;               \
    *(ATT_LAS bf16x8*)(K_lds + (b) * SHM_K + KSWZ(sr, kc)) = sr_[i].ks0;                       \
    *(ATT_LAS bf16x8*)(K_lds + (b) * SHM_K + KSWZ(32 + sr, kc)) = sr_[i].ks1; } while (0)
#define SWAIT() do { if constexpr (SDEPTH == 2) asm volatile("s_waitcnt vmcnt(4)" ::: "memory"); else asm volatile("s_waitcnt vmcnt(0)" ::: "memory"); } while (0)
#define RESC(a) do { if (__any((a) < 1.f)) { if (hi == 0) al_l[r32] = (a); asm volatile("s_waitcnt lgkmcnt(0)" ::: "memory"); \
    _Pragma("unroll") for (int d = 0; d < 4; ++d) _Pragma("unroll") for (int r = 0; r < 16; ++r) o[d][r] *= al_l[crow(r, hi)]; } } while (0)
  f32x16 pA0, pA1, pB0, pB1; float mnA, mnB, alA, alB; bf16x8 pa0, pa1, pa2, pa3; const int NT = seq / KVBLK;
  constexpr int SE = 0, SO = SDEPTH - 1;
  unsigned sel = 0u; const int qi = wid * QBLK + r32, w0 = wid * QBLK;
  SLOAD(SE, 0);
  if constexpr (MOBA) {
    { const int j = sr & 15; const float* src = kms + (size_t)j * kms_stride + sc; const float4 x0 = *reinterpret_cast<const float4*>(src), x1 = *reinterpret_cast<const float4*>(src + 4);
      const float xv[8] = {x0.x, x0.y, x0.z, x0.w, x1.x, x1.y, x1.z, x1.w}; unsigned w[4];
#pragma unroll
      for (int e = 0; e < 4; ++e) { const unsigned h2 = cvtpk(xv[2 * e], xv[2 * e + 1]); const float f0 = __uint_as_float(h2 << 16), f1 = __uint_as_float(h2 & 0xffff0000u);
        const unsigned l2 = cvtpk(xv[2 * e] - f0, xv[2 * e + 1] - f1); w[e] = (sr < 16) ? h2 : l2; }
      u32x4 wv = {w[0], w[1], w[2], w[3]}; *(ATT_LAS u32x4*)(K_lds + KSWZ(sr, sc * 2)) = wv; }
    __syncthreads();
    f32x16 g = f32x16{};
#pragma unroll
    for (int d0 = 0; d0 < 8; ++d0) { const int cb = (d0 * 16 + hi * 8) * 2; const bf16x8 b0 = *reinterpret_cast<const ATT_LAS bf16x8*>(K_lds + KSWZ(r32, cb));
      g = __builtin_amdgcn_mfma_f32_32x32x16_bf16(b0, qr[d0], g, 0, 0, 0); }
    float G[16];
#pragma unroll
    for (int r = 0; r < 8; ++r) { const float own = g[r] + g[r + 8]; const float oth = __shfl_xor(own, 32); const int lb = (r & 3) + 8 * (r >> 2);
      G[lb] = hi ? oth : own; G[lb + 4] = hi ? own : oth; }
    const float NINF = -__builtin_inff();
#pragma unroll
    for (int j = 0; j < 16; ++j) G[j] = (j < qb) ? G[j] : NINF;
#pragma unroll
    for (int it = 0; it < 3; ++it) { float mx = NINF; int mi = -1;
#pragma unroll
      for (int j = 0; j < 16; ++j) { const bool gt = G[j] > mx; mx = gt ? G[j] : mx; mi = gt ? j : mi; }
      if (mi >= 0) sel |= 1u << mi;
#pragma unroll
      for (int j = 0; j < 16; ++j) G[j] = (j == mi) ? NINF : G[j]; }
    __syncthreads();
  }
  asm volatile("s_waitcnt vmcnt(0)" ::: "memory"); SWRITE(0, SE); __syncthreads();
  qkt(pA0, pA1, K_lds, qr, r32, hi);
  if constexpr (MOBA) moba_mask(pA0, pA1, 0, qb, sel, qi, w0, hi);
  partialSM(pA0, pA1, m_reg, mnA, alA);
  SLOAD(SO, KVBLK); if constexpr (SDEPTH == 2) { if (2 < NT) SLOAD(SE, 2 * KVBLK); }
  SWAIT(); SWRITE(1, SO); __syncthreads();
  for (int j = 1; j + 1 < NT; j += 2) {
    SBAR(); qkt(pB0, pB1, K_lds + SHM_K, qr, r32, hi);
    finishSM(pA0, pA1, alA, l_reg, pa0, pa1, pa2, pa3); SBAR();
    SLOAD(SO, (j + SDEPTH) * KVBLK); SBAR();
    pv_d0(o, vb0, pa0, pa1, pa2, pa3);
    if constexpr (MOBA) moba_mask(pB0, pB1, j, qb, sel, qi, w0, hi);
    partialSM(pB0, pB1, m_reg, mnB, alB);
    __syncthreads(); SWAIT(); SWRITE(0, SE);
    RESC(alB); __syncthreads();
    SBAR(); qkt(pA0, pA1, K_lds, qr, r32, hi);
    finishSM(pB0, pB1, alB, l_reg, pa0, pa1, pa2, pa3); SBAR();
    if (SDEPTH == 1 || j + 3 < NT) SLOAD(SE, (j + 1 + SDEPTH) * KVBLK); SBAR();
    pv_d0(o, vb0 + SHM_V, pa0, pa1, pa2, pa3);
    if constexpr (MOBA) moba_mask(pA0, pA1, j + 1, qb, sel, qi, w0, hi);
    partialSM(pA0, pA1, m_reg, mnA, alA);
    __syncthreads(); SWAIT(); SWRITE(1, SO);
    RESC(alA); __syncthreads();
  }
  SBAR(); qkt(pB0, pB1, K_lds + SHM_K, qr, r32, hi);
  finishSM(pA0, pA1, alA, l_reg, pa0, pa1, pa2, pa3); SBAR();
  pv_d0(o, vb0, pa0, pa1, pa2, pa3);
  if constexpr (MOBA) moba_mask(pB0, pB1, NT - 1, qb, sel, qi, w0, hi);
  partialSM(pB0, pB1, m_reg, mnB, alB);
  __syncthreads(); RESC(alB);
  finishSM(pB0, pB1, alB, l_reg, pa0, pa1, pa2, pa3); SBAR();
  pv_d0(o, vb0 + SHM_V, pa0, pa1, pa2, pa3);
  if (hi == 0) li_l[r32] = l_reg; asm volatile("s_waitcnt lgkmcnt(0)" ::: "memory");
  float rli[16];
#pragma unroll
  for (int r = 0; r < 16; ++r) rli[r] = __builtin_amdgcn_rcpf(li_l[crow(r, hi)]);
  int ohi = hi * 4, ocol = r32; asm volatile("" : "+v"(ohi), "+v"(ocol));
  bf16* Ow = Ob + (long)(wid * QBLK) * LDO;
#pragma unroll
  for (int r = 0; r < 16; ++r) { const int orow = (r & 3) + 8 * (r >> 2) + ohi; float sq = 0.f;
#pragma unroll
    for (int d0 = 0; d0 < 4; ++d0) { const float v = o[d0][r] * rli[r]; sq += v * v; Ow[(unsigned)(orow * LDO + d0 * 32 + ocol)] = (bf16)(cvtpk(v, v) & 0xffffu); }
    if constexpr (MOBA) { sq += __shfl_xor(sq, 1); sq += __shfl_xor(sq, 2); sq += __shfl_xor(sq, 4); sq += __shfl_xor(sq, 8); sq += __shfl_xor(sq, 16);
      if (ocol == 0) unsafeAtomicAdd(ssq + wid * QBLK + orow, sq); } }
  __syncthreads();
#undef SLOAD
#undef SWRITE
#undef SWAIT
#undef RESC
}
#undef KSWZ
#undef SBAR
}

constexpr int NWAVES = 8;
constexpr int BATCH = 4, SEQ = 4096, D = 2048, M = BATCH * SEQ, FF = 5632, AW = 1024, CW = 1024, INW = 6144, MEML = 256, XW = 512, NH = 8, XH = 4, NBLK = 16;
constexpr int NPH = 13;
#ifndef FAST_MASK
#define FAST_MASK 0x1fff
#endif
#ifndef ONE_LAUNCH
#define ONE_LAUNCH 1
#endif
constexpr size_t MiB = 1u << 20, KiB = 1u << 10;
constexpr size_t WS_CTL = 0, CTL_ZERO_BYTES = 1 * MiB;
constexpr size_t CTL_BAR = 64 * KiB, BAR_STRIDE = 16 * KiB;
constexpr size_t CTL_SS = 320 * KiB;
constexpr size_t CTL_KMS = 704 * KiB;
constexpr size_t WS_WGU1 = 2 * MiB, WS_WD1 = 46 * MiB, WS_WGU2 = 68 * MiB, WS_WD2 = 112 * MiB, WS_WIN = 134 * MiB, WS_WOUT = 158 * MiB, WS_WQ = 166 * MiB, WS_WKV = 168 * MiB, WS_WO = 172 * MiB;
constexpr size_t WS_MEMN = 174 * MiB, WS_KVX = 178 * MiB, WS_HB = 180 * MiB, WS_MIXED = 244 * MiB, WS_ACT = 308 * MiB;
constexpr size_t WS_Q = 308 * MiB, WS_K = 340 * MiB, WS_V = 372 * MiB, WS_CU = 404 * MiB, WS_BG = 436 * MiB;
constexpr size_t WS_QX = 308 * MiB, WS_OX = 324 * MiB;
constexpr size_t WS_END = 484 * MiB;
static_assert(WS_ACT + (size_t)M * FF * 2 <= WS_END && WS_BG + (size_t)M * 1024 * 2 <= WS_END && CTL_KMS + BATCH * 16 * 8 * 128 * 4 <= CTL_ZERO_BYTES && CTL_SS + 6 * M * 4 <= CTL_KMS, "d_ws map");
constexpr int RING_OFF = 0, RING_BYTES = 131072;
constexpr int LDSCTL_OFF = RING_BYTES, MISC_OFF = LDSCTL_OFF + 320;
constexpr int LDS_BYTES = 147456;
static_assert(MISC_OFF + 128 <= LDS_BYTES && att::SHM_ATTN <= RING_BYTES, "LDS map");

#define GAS __attribute__((address_space(1)))
#define LAS __attribute__((address_space(3)))
typedef unsigned short bf16;
typedef unsigned v4u __attribute__((ext_vector_type(4)));
typedef unsigned v2u __attribute__((ext_vector_type(2)));
typedef float f32x4 __attribute__((ext_vector_type(4)));
typedef short bf16x8 __attribute__((ext_vector_type(8)));
typedef GAS unsigned gu32;
#define RLX_AGENT __ATOMIC_RELAXED, __HIP_MEMORY_SCOPE_AGENT
#define LDS_WAIT() asm volatile("s_waitcnt lgkmcnt(0)" ::: "memory")
#define VM_WAIT() asm volatile("s_waitcnt vmcnt(0)" ::: "memory")
__device__ __forceinline__ unsigned pk2(float lo, float hi) { return pg8::cvt_pk_bf16(lo, hi); }
__device__ __forceinline__ float bflo(unsigned w) { return __uint_as_float(w << 16); }
__device__ __forceinline__ float bfhi(unsigned w) { return __uint_as_float(w & 0xffff0000u); }
__device__ __forceinline__ float wave_sum(float v) {
#pragma unroll
    for (int o = 1; o < 64; o <<= 1) v += __shfl_xor(v, o);
    return v;
}
#define XB_TMO      128
#define XB_XCNT(j)  (256  + 64 * (j))
#define XB_XSUB(j)  (1280 + 64 * (j))
#define XB_XGEN(j)  (2304 + 64 * (j))
#define XB_TOP      3328
#define XB_TOPGEN   3392
#define XCD_BAR_WORDS 3456
#define XB_SPIN_CAP (1u << 18)

__device__ __forceinline__ unsigned xb_ld(unsigned* p)              { return __hip_atomic_load(p, __ATOMIC_RELAXED, __HIP_MEMORY_SCOPE_AGENT); }
__device__ __forceinline__ unsigned xb_add(unsigned* p, unsigned v) { return __hip_atomic_fetch_add(p, v, __ATOMIC_RELAXED, __HIP_MEMORY_SCOPE_AGENT); }
__device__ __forceinline__ unsigned xb_xcc_id() { return (unsigned)__builtin_amdgcn_s_getreg((3 << 11) | 20) & 0xFu; }
#define XB_SPIN(cond, bar) do { unsigned _sp = 0; while (cond) { __builtin_amdgcn_s_sleep(1); \
    if ((++_sp & 255u) == 0u) { if (xb_ld(&(bar)[XB_TMO])) break; if (_sp > XB_SPIN_CAP) { atomicAdd(&(bar)[XB_TMO], 1u); break; } } } } while (0)

struct XcdBarrier {
    unsigned* bar; unsigned x;
    volatile LAS unsigned* st;
};

__device__ __forceinline__ XcdBarrier xcd_barrier_post(unsigned* bar, volatile LAS unsigned* st) {
    XcdBarrier b; b.bar = bar; b.x = xb_xcc_id(); b.st = st;
    if (threadIdx.x == 0) (void)xb_add(&bar[XB_XCNT(b.x)], 1u);
    return b;
}
__device__ __forceinline__ void xcd_barrier_complete(unsigned* bar, unsigned x, unsigned& nloc, unsigned& nx) {
    const unsigned G = gridDim.x * gridDim.y * gridDim.z;
    unsigned sum, cnt, mine, sp = 0u;
    for (;;) {
        sum = 0u; cnt = 0u; mine = 0u;
#pragma unroll
        for (unsigned j = 0; j < 16; ++j) { const unsigned c = xb_ld(&bar[XB_XCNT(j)]); sum += c; cnt += (c > 0u) ? 1u : 0u; mine = (j == x) ? c : mine; }
        if (sum == G) break;
        __builtin_amdgcn_s_sleep(1);
        if ((++sp & 255u) == 0u) { if (xb_ld(&bar[XB_TMO])) break; if (sp > XB_SPIN_CAP) { atomicAdd(&bar[XB_TMO], 1u); break; } }
    }
    nloc = mine > 0u ? mine : 1u; nx = cnt > 0u ? cnt : 1u;
}

__device__ __forceinline__ void xcd_barrier(const XcdBarrier& b) {
    asm volatile("s_waitcnt vmcnt(0)" ::: "memory");
    __syncthreads();
    if (threadIdx.x == 0) {
        unsigned* bar = b.bar;
        __builtin_amdgcn_s_waitcnt(0);
        unsigned nloc = b.st[0], nx = b.st[1];
        if (nloc == 0u) { xcd_barrier_complete(bar, b.x, nloc, nx); b.st[0] = nloc; b.st[1] = nx; }
        const unsigned old = xb_add(&bar[XB_XSUB(b.x)], 1u);
        const unsigned gen = old / nloc;
        if (old + 1u == (gen + 1u) * nloc) {
            __builtin_amdgcn_fence(__ATOMIC_RELEASE, "agent");
            asm volatile("s_waitcnt vmcnt(0)" ::: "memory");
            const unsigned og = xb_add(&bar[XB_TOP], 1u);
            const unsigned tg = og / nx;
            if (og + 1u == (tg + 1u) * nx) xb_add(&bar[XB_TOPGEN], 1u);
            else XB_SPIN(xb_ld(&bar[XB_TOPGEN]) == tg, bar);
            __builtin_amdgcn_fence(__ATOMIC_ACQUIRE, "agent");
            xb_add(&bar[XB_XGEN(b.x)], 1u);
            asm volatile("s_waitcnt vmcnt(0)" ::: "memory");
        } else {
            XB_SPIN(xb_ld(&bar[XB_XGEN(b.x)]) == gen, bar);
            __builtin_amdgcn_fence(__ATOMIC_ACQUIRE, "agent");
            asm volatile("s_waitcnt vmcnt(0)" ::: "memory");
        }
    }
    __syncthreads();
}

namespace nv {
typedef float f32x4 __attribute__((ext_vector_type(4)));
typedef short bf16x8 __attribute__((ext_vector_type(8)));
constexpr float EPS = 1e-6f;
template <class F> __global__ __launch_bounds__(256) void gemm(const bf16* __restrict__ A, const bf16* __restrict__ Bt, int K, F f) {
    const int wave = threadIdx.x >> 6, lane = threadIdx.x & 63;
    const int row0 = blockIdx.y * 64 + wave * 16, col0 = blockIdx.x * 64;
    f32x4 acc[4], acc2[4];
#pragma unroll
    for (int c = 0; c < 4; ++c) { acc[c] = (f32x4){0.f, 0.f, 0.f, 0.f}; acc2[c] = (f32x4){0.f, 0.f, 0.f, 0.f}; }
    const bf16* ap = A + (size_t)(row0 + (lane & 15)) * K + 8 * (lane >> 4);
    const bf16* bp[4]; const bf16* bp2[4];
#pragma unroll
    for (int c = 0; c < 4; ++c) { const int col = col0 + 16 * c + (lane & 15); bp[c] = Bt + (size_t)f.brow(col) * K + 8 * (lane >> 4); bp2[c] = Bt + (size_t)f.brow2(col) * K + 8 * (lane >> 4); }
    for (int k0 = 0; k0 < K; k0 += 32) {
        if (F::MIDK > 0 && k0 == F::MIDK) {
#pragma unroll
            for (int j = 0; j < 4; ++j) { const float s = f.midscale(row0 + (lane >> 4) * 4 + j);
#pragma unroll
                for (int c = 0; c < 4; ++c) acc[c][j] *= s; }
        }
        const bf16x8 a = *(const bf16x8*)(ap + k0);
#pragma unroll
        for (int c = 0; c < 4; ++c) { const bf16x8 b = *(const bf16x8*)(bp[c] + k0); acc[c] = __builtin_amdgcn_mfma_f32_16x16x32_bf16(a, b, acc[c], 0, 0, 0);
            if (F::DUAL) { const bf16x8 b2 = *(const bf16x8*)(bp2[c] + k0); acc2[c] = __builtin_amdgcn_mfma_f32_16x16x32_bf16(a, b2, acc2[c], 0, 0, 0); } }
    }
#pragma unroll
    for (int j = 0; j < 4; ++j) { const int row = row0 + (lane >> 4) * 4 + j; float sq = 0.f;
#pragma unroll
        for (int c = 0; c < 4; ++c) { const float h = f.store(row, col0 + 16 * c + (lane & 15), acc[c][j], acc2[c][j]); sq += h * h; }
        if (F::ROWSS) { sq += __shfl_xor(sq, 1); sq += __shfl_xor(sq, 2); sq += __shfl_xor(sq, 4); sq += __shfl_xor(sq, 8); if ((lane & 15) == 0) f.addss(row, sq); } }
}
__device__ __forceinline__ bf16 tobf(float v) { return (bf16)(pg8::cvt_pk_bf16(v, v) & 0xffffu); }
struct FSwiglu { static constexpr bool DUAL = true, ROWSS = false; static constexpr int MIDK = 0; bf16* O; const float* ss;
    __device__ int brow(int col) const { return (col >> 7) * 256 + (col & 127); } __device__ int brow2(int col) const { return brow(col) + 128; } __device__ float midscale(int) const { return 1.f; } __device__ void addss(int, float) const {}
    __device__ float store(int row, int col, float a, float a2) const { const float rs = rsqrtf(ss[row] * (1.0f / 2048.0f) + EPS), g = a * rs, u = a2 * rs; O[(size_t)row * FF + col] = tobf(g / (1.0f + __expf(-g)) * u); return 0.f; } };
template <int MIDK_> struct FResid { static constexpr bool DUAL = false, ROWSS = true; static constexpr int MIDK = MIDK_; const float* R; float* H; bf16* HB; float* ssn; float alpha; const float* midss;
    __device__ int brow(int col) const { return col; } __device__ int brow2(int col) const { return col; } __device__ float midscale(int row) const { return rsqrtf(midss[row] * (1.0f / 1024.0f) + EPS); }
    __device__ void addss(int row, float s) const { unsafeAtomicAdd(ssn + row, s); }
    __device__ float store(int row, int col, float a, float) const { const size_t o = (size_t)row * 2048 + col; const float h = R[o] + alpha * a; H[o] = h; if (HB) HB[o] = tobf(h); return h; } };
struct FWin { static constexpr bool DUAL = true, ROWSS = false; static constexpr int MIDK = 0; bf16 *Q, *K, *V, *CU, *BG; const float* ss;
    __device__ int brow(int col) const { if (col < 3072) return col; if (col < 4096) { const int j = col - 3072; return 3072 + (j >> 7) * 256 + (j & 127); } return 5120 + (col - 4096); }
    __device__ int brow2(int col) const { return (col >= 3072 && col < 4096) ? brow(col) + 128 : brow(col); } __device__ float midscale(int) const { return 1.f; } __device__ void addss(int, float) const {}
    __device__ float store(int row, int col, float a, float a2) const { const float rs = rsqrtf(ss[row] * (1.0f / 2048.0f) + EPS); const size_t o = (size_t)row * 1024 + (col & 1023);
        if (col < 1024) Q[o] = tobf(a * rs); else if (col < 2048) K[o] = tobf(a * rs); else if (col < 3072) V[o] = tobf(a * rs); else if (col < 4096) CU[o] = tobf((a * rs) * (a2 * rs)); else BG[o] = tobf(a * rs); return 0.f; } };
struct FScale { static constexpr bool DUAL = false, ROWSS = false; static constexpr int MIDK = 0; bf16* O; int ldo; const float* ss;
    __device__ int brow(int col) const { return col; } __device__ int brow2(int col) const { return col; } __device__ float midscale(int) const { return 1.f; } __device__ void addss(int, float) const {}
    __device__ float store(int row, int col, float a, float) const { const float rs = ss ? rsqrtf(ss[row] * (1.0f / 2048.0f) + EPS) : 1.0f; O[(size_t)row * ldo + col] = tobf(a * rs); return 0.f; } };
__global__ __launch_bounds__(256) void kmean(const bf16* __restrict__ K, float* __restrict__ kms) {
    const int i = blockIdx.x * 256 + threadIdx.x; const int d = i & 127, h = (i >> 7) & 7, bb = i >> 10;
    float s = 0.f; for (int r = 0; r < 256; ++r) s += __uint_as_float((unsigned)K[((size_t)bb * 256 + r) * 1024 + h * 128 + d] << 16);
    kms[i] = s;
}
__global__ __launch_bounds__(256) void moba(const bf16* __restrict__ Q, const bf16* __restrict__ K, const bf16* __restrict__ V, const float* __restrict__ kms, bf16* __restrict__ AO, float* __restrict__ ssA) {
    const int wave = threadIdx.x >> 6, lane = threadIdx.x & 63; const int idx = blockIdx.x * 4 + wave; const int h = idx & 7, row = idx >> 3, b = row >> 12, t = row & 4095, qb = t >> 8;
    const unsigned qw = *(const unsigned*)(Q + (size_t)row * 1024 + h * 128 + 2 * lane); const float q0 = bflo(qw), q1 = bfhi(qw);
    unsigned sel = 0u;
    { float g[16];
#pragma unroll
      for (int j = 0; j < 16; ++j) { const float* km = kms + ((size_t)(b * 16 + j) * 8 + h) * 128 + 2 * lane; const float p = wave_sum(q0 * km[0] + q1 * km[1]); g[j] = (j < qb) ? p : -__builtin_inff(); }
#pragma unroll
      for (int it = 0; it < 3; ++it) { float mx = -__builtin_inff(); int mi = -1;
#pragma unroll
        for (int j = 0; j < 16; ++j) { const bool gt = g[j] > mx; mx = gt ? g[j] : mx; mi = gt ? j : mi; }
        if (mi >= 0) sel |= 1u << mi;
#pragma unroll
        for (int j = 0; j < 16; ++j) g[j] = (j == mi) ? -__builtin_inff() : g[j]; } }
    sel |= 1u << qb;
    float m = -1e30f, l = 0.f, o0 = 0.f, o1 = 0.f;
    for (int jb = 0; jb <= qb; ++jb) { if (!((sel >> jb) & 1u)) continue;
        const int nk = (jb < qb) ? 256 : (t & 255) + 1;
        for (int kk = 0; kk < nk; ++kk) { const size_t ko = ((size_t)b * 4096 + jb * 256 + kk) * 1024 + h * 128 + 2 * lane;
            const unsigned kw = *(const unsigned*)(K + ko), vw = *(const unsigned*)(V + ko);
            const float s = wave_sum(q0 * bflo(kw) + q1 * bfhi(kw)) * 0.088388347648318440f;
            const float mn = fmaxf(m, s), a = __expf(m - mn), p = __expf(s - mn);
            l = l * a + p; o0 = o0 * a + p * bflo(vw); o1 = o1 * a + p * bfhi(vw); m = mn; } }
    const float il = 1.0f / l; o0 *= il; o1 *= il;
    *(unsigned*)(AO + (size_t)row * 2048 + h * 128 + 2 * lane) = pk2(o0, o1);
    const float sq = wave_sum(o0 * o0 + o1 * o1); if (lane == 0) unsafeAtomicAdd(ssA + row, sq);
}
__global__ __launch_bounds__(256) void xattn(const bf16* __restrict__ QX, const bf16* __restrict__ KVX, bf16* __restrict__ OX) {
    const int wave = threadIdx.x >> 6, lane = threadIdx.x & 63; const int idx = blockIdx.x * 4 + wave; const int h = idx & 3, row = idx >> 2, b = row >> 12;
    const unsigned qw = *(const unsigned*)(QX + (size_t)row * 512 + h * 128 + 2 * lane); const float q0 = bflo(qw), q1 = bfhi(qw);
    float m = -1e30f, l = 0.f, o0 = 0.f, o1 = 0.f;
    for (int kk = 0; kk < 256; ++kk) { const size_t ko = ((size_t)b * 256 + kk) * 1024 + h * 128 + 2 * lane;
        const unsigned kw = *(const unsigned*)(KVX + ko), vw = *(const unsigned*)(KVX + ko + 512);
        const float s = wave_sum(q0 * bflo(kw) + q1 * bfhi(kw)) * 0.088388347648318440f;
        const float mn = fmaxf(m, s), a = __expf(m - mn), p = __expf(s - mn);
        l = l * a + p; o0 = o0 * a + p * bflo(vw); o1 = o1 * a + p * bfhi(vw); m = mn; }
    const float il = 1.0f / l;
    *(unsigned*)(OX + (size_t)row * 512 + h * 128 + 2 * lane) = pk2(o0 * il, o1 * il);
}
}


struct Frame {
    LAS unsigned char* lds;
    volatile LAS unsigned* MISC;
    int tid, lane, wave;
    int vcu, G;
};
struct Args { const float* in[22]; float* out; unsigned char* ws; int ph_lo, ph_hi; };
enum { I_X = 0, I_MEM, I_F1N, I_F1G, I_F1U, I_F1D, I_MIXN, I_WIN, I_CONVW, I_AON, I_CON, I_WOUT, I_XN, I_MEMNRM, I_XQ, I_XKV, I_XO, I_F2N, I_F2G, I_F2U, I_F2D, I_FINAL };

__device__ __forceinline__ void p0_transpose_item(const float* W, int pitch, const float* gain, bf16* WT, int dstK, int dkoff, int drow0, int k0, LAS float* scr, int lane) {
#pragma unroll 8
    for (int i = 0; i < 32; ++i) { const int kk = 2 * i + (lane >> 5); const float g = gain ? gain[k0 + kk] : 1.0f; scr[kk * 33 + (lane & 31)] = W[(size_t)(k0 + kk) * pitch + (lane & 31)] * g; }
    LDS_WAIT(); asm volatile("" ::: "memory");
    const int c = lane & 7;
#pragma unroll
    for (int j = 0; j < 4; ++j) { const int n = (lane >> 3) + 8 * j; const LAS float* s = scr + (8 * c) * 33 + n;
        v4u o; o.x = pk2(s[0 * 33], s[1 * 33]); o.y = pk2(s[2 * 33], s[3 * 33]); o.z = pk2(s[4 * 33], s[5 * 33]); o.w = pk2(s[6 * 33], s[7 * 33]);
        *(GAS v4u*)(WT + (size_t)(drow0 + n) * dstK + dkoff + k0 + 8 * c) = o; }
    LDS_WAIT(); asm volatile("" ::: "memory");
}
__device__ __forceinline__ void p0_prologue(Frame& F_, const Args& a) {
    Frame F = F_; asm volatile("" : "+v"(F.lane));
    LAS float* scr = (LAS float*)(F.lds + RING_OFF + F.wave * 16384);
    const int gw = F.vcu * NWAVES + F.wave, NGW = F.G * NWAVES;
    unsigned char* ws = a.ws;
    constexpr int I_FF = (D / 64) * (FF / 32), I_FD = (FF / 64) * (D / 32), I_IN = (D / 64) * (1024 / 32), I_OUT = (1024 / 64) * (D / 32), I_XQn = (D / 64) * (XW / 32), I_XKVn = (D / 64) * (1024 / 32), I_XOn = (XW / 64) * (D / 32);
    constexpr int NITEMS = 4 * I_FF + 2 * I_FD + 6 * I_IN + 2 * I_OUT + I_XQn + I_XKVn + I_XOn;
    for (int it = gw; it < NITEMS; it += NGW) {
        int r = it; const float* src = nullptr; const float* gain = nullptr; bf16* dst = nullptr; int pitch = 0, ncols = 0, dstK = 0, dkoff = 0, rowoff = 0, mode = 0; bool hit = false;
#define JOB(cnt, SRC, PITCH, NCOLS, GAIN, DST, DSTK, DKOFF, ROWOFF, MODE) if (!hit) { if (r < (cnt)) { hit = true; src = (SRC); pitch = (PITCH); ncols = (NCOLS); gain = (GAIN); dst = (bf16*)(ws + (DST)); dstK = (DSTK); dkoff = (DKOFF); rowoff = (ROWOFF); mode = (MODE); } else r -= (cnt); }
        JOB(I_FF, a.in[I_F1G], FF, FF, a.in[I_F1N], WS_WGU1, D, 0, 0, 1)
        JOB(I_FF, a.in[I_F1U], FF, FF, a.in[I_F1N], WS_WGU1, D, 0, 0, 2)
        JOB(I_FD, a.in[I_F1D], D, D, nullptr, WS_WD1, FF, 0, 0, 0)
        JOB(I_FF, a.in[I_F2G], FF, FF, a.in[I_F2N], WS_WGU2, D, 0, 0, 1)
        JOB(I_FF, a.in[I_F2U], FF, FF, a.in[I_F2N], WS_WGU2, D, 0, 0, 2)
        JOB(I_FD, a.in[I_F2D], D, D, nullptr, WS_WD2, FF, 0, 0, 0)
        JOB(I_IN, a.in[I_WIN] + 0, INW, 1024, a.in[I_MIXN], WS_WIN, D, 0, 0, 0)
        JOB(I_IN, a.in[I_WIN] + 1024, INW, 1024, a.in[I_MIXN], WS_WIN, D, 0, 1024, 0)
        JOB(I_IN, a.in[I_WIN] + 2048, INW, 1024, a.in[I_MIXN], WS_WIN, D, 0, 2048, 0)
        JOB(I_IN, a.in[I_WIN] + 3072, INW, 1024, a.in[I_MIXN], WS_WIN, D, 0, 3072, 1)
        JOB(I_IN, a.in[I_WIN] + 5120, INW, 1024, a.in[I_MIXN], WS_WIN, D, 0, 3072, 2)
        JOB(I_IN, a.in[I_WIN] + 4096, INW, 1024, a.in[I_MIXN], WS_WIN, D, 0, 5120, 0)
        JOB(I_OUT, a.in[I_WOUT], D, D, a.in[I_AON], WS_WOUT, D, 0, 0, 0)
        JOB(I_OUT, a.in[I_WOUT] + (size_t)1024 * D, D, D, a.in[I_CON], WS_WOUT, D, 1024, 0, 0)
        JOB(I_XQn, a.in[I_XQ], XW, XW, a.in[I_XN], WS_WQ, D, 0, 0, 0)
        JOB(I_XKVn, a.in[I_XKV], 1024, 1024, nullptr, WS_WKV, D, 0, 0, 0)
        JOB(I_XOn, a.in[I_XO], D, D, nullptr, WS_WO, XW, 0, 0, 0)
#undef JOB
        const int nblk = ncols / 32, kb = r / nblk, nb = r % nblk, k0 = 64 * kb, n0 = 32 * nb;
        const int drow0 = rowoff + (mode ? (n0 >> 7) * 256 + (n0 & 127) + (mode == 2 ? 128 : 0) : n0);
        p0_transpose_item(src + n0, pitch, gain, dst, dstK, dkoff, drow0, k0, scr, F.lane);
    }
    { bf16* HB = (bf16*)(ws + WS_HB); float* ss0 = (float*)(ws + WS_CTL + CTL_SS);
      for (int m = gw; m < M; m += NGW) { const GAS f32x4* xr = (const GAS f32x4*)(a.in[I_X] + (size_t)m * D) + F.lane; GAS v2u* o8 = (GAS v2u*)(HB + (size_t)m * D) + F.lane; float s = 0.f;
#pragma unroll
          for (int j = 0; j < 8; ++j) { const f32x4 v = xr[64 * j]; s += (v.x * v.x + v.y * v.y) + (v.z * v.z + v.w * v.w); v2u w; w.x = pk2(v.x, v.y); w.y = pk2(v.z, v.w); o8[64 * j] = w; }
          s = wave_sum(s); if (F.lane == 0) ss0[m] = s; } }
    { bf16* MN = (bf16*)(ws + WS_MEMN); const float* gm = a.in[I_MEMNRM];
      for (int m = gw; m < BATCH * MEML; m += NGW) { const GAS f32x4* xr = (const GAS f32x4*)(a.in[I_MEM] + (size_t)m * D) + F.lane; GAS v2u* o8 = (GAS v2u*)(MN + (size_t)m * D) + F.lane; f32x4 v[8]; float s = 0.f;
#pragma unroll
          for (int j = 0; j < 8; ++j) { v[j] = xr[64 * j]; s += (v[j].x * v[j].x + v[j].y * v[j].y) + (v[j].z * v[j].z + v[j].w * v[j].w); }
          const float rs = rsqrtf(wave_sum(s) * (1.0f / D) + 1e-6f);
#pragma unroll
          for (int j = 0; j < 8; ++j) { const f32x4 g = *((const GAS f32x4*)gm + F.lane + 64 * j); v2u w; w.x = pk2(v[j].x * rs * g.x, v[j].y * rs * g.y); w.y = pk2(v[j].z * rs * g.z, v[j].w * rs * g.w); o8[64 * j] = w; } } }
}
__device__ __forceinline__ void p5_conv(Frame& F_, const Args& a) {
    Frame F = F_; asm volatile("" : "+v"(F.lane));
    const int gw = F.vcu * NWAVES + F.wave, NGW = F.G * NWAVES; unsigned char* ws = a.ws;
    const bf16* CU = (const bf16*)(ws + WS_CU); const bf16* BG = (const bf16*)(ws + WS_BG); bf16* MX = (bf16*)(ws + WS_MIXED); const float* cw = a.in[I_CONVW];
    for (int m = gw; m < M; m += NGW) { const int t = m & (SEQ - 1); float y[16]; float s = 0.f;
#pragma unroll
        for (int gsel = 0; gsel < 2; ++gsel) { const int ch = gsel * 512 + F.lane * 8;
            const v4u c0 = *(const GAS v4u*)(CU + (size_t)m * 1024 + ch); v4u c1 = (v4u){0u, 0u, 0u, 0u}, c2 = (v4u){0u, 0u, 0u, 0u};
            if (t >= 1) c1 = *(const GAS v4u*)(CU + (size_t)(m - 1) * 1024 + ch);
            if (t >= 2) c2 = *(const GAS v4u*)(CU + (size_t)(m - 2) * 1024 + ch);
            const v4u bg = *(const GAS v4u*)(BG + (size_t)m * 1024 + ch);
            const f32x4 w0a = *(const GAS f32x4*)(cw + ch), w0b = *(const GAS f32x4*)(cw + ch + 4), w1a = *(const GAS f32x4*)(cw + 1024 + ch), w1b = *(const GAS f32x4*)(cw + 1024 + ch + 4), w2a = *(const GAS f32x4*)(cw + 2048 + ch), w2b = *(const GAS f32x4*)(cw + 2048 + ch + 4);
#pragma unroll
            for (int e = 0; e < 4; ++e) { const unsigned x0 = c0[e], x1 = c1[e], x2 = c2[e], bw = bg[e];
                const float wl0 = e < 2 ? w0a[2 * e] : w0b[2 * e - 4], wh0 = e < 2 ? w0a[2 * e + 1] : w0b[2 * e - 3];
                const float wl1 = e < 2 ? w1a[2 * e] : w1b[2 * e - 4], wh1 = e < 2 ? w1a[2 * e + 1] : w1b[2 * e - 3];
                const float wl2 = e < 2 ? w2a[2 * e] : w2b[2 * e - 4], wh2 = e < 2 ? w2a[2 * e + 1] : w2b[2 * e - 3];
                const float lo = bflo(bw) * (wl0 * bflo(x2) + wl1 * bflo(x1) + wl2 * bflo(x0)), hi = bfhi(bw) * (wh0 * bfhi(x2) + wh1 * bfhi(x1) + wh2 * bfhi(x0));
                y[gsel * 8 + 2 * e] = lo; y[gsel * 8 + 2 * e + 1] = hi; s += lo * lo + hi * hi; } }
        const float rs = rsqrtf(wave_sum(s) * (1.0f / 1024.0f) + 1e-6f);
#pragma unroll
        for (int gsel = 0; gsel < 2; ++gsel) { v4u o; o.x = pk2(y[gsel * 8 + 0] * rs, y[gsel * 8 + 1] * rs); o.y = pk2(y[gsel * 8 + 2] * rs, y[gsel * 8 + 3] * rs); o.z = pk2(y[gsel * 8 + 4] * rs, y[gsel * 8 + 5] * rs); o.w = pk2(y[gsel * 8 + 6] * rs, y[gsel * 8 + 7] * rs);
            *(GAS v4u*)(MX + (size_t)m * 2048 + 1024 + gsel * 512 + F.lane * 8) = o; } }
}
__device__ __forceinline__ void p12_final(Frame& F_, const Args& a) {
    Frame F = F_; asm volatile("" : "+v"(F.lane));
    const int gw = F.vcu * NWAVES + F.wave, NGW = F.G * NWAVES; const float* ss4 = (const float*)(a.ws + WS_CTL + CTL_SS) + 5 * M; const float* gf = a.in[I_FINAL];
    for (int m = gw; m < M; m += NGW) { GAS f32x4* xr = (GAS f32x4*)(a.out + (size_t)m * D) + F.lane; const float rs = rsqrtf(ss4[m] * (1.0f / D) + 1e-6f);
#pragma unroll
        for (int j = 0; j < 8; ++j) { const f32x4 v = xr[64 * j]; const f32x4 g = *((const GAS f32x4*)gf + F.lane + 64 * j); xr[64 * j] = v * g * rs; } }
}

#ifndef MOBA_SDEPTH
#define MOBA_SDEPTH 1
#endif
__global__ void __launch_bounds__(NWAVES * 64, 2) fwd_kernel(Args args) {
    extern __shared__ __attribute__((aligned(16))) unsigned char lds[];
    Frame F;
    F.lds = (LAS unsigned char*)lds;
    F.MISC = (volatile LAS unsigned*)(F.lds + MISC_OFF);
    F.tid = threadIdx.x; F.lane = F.tid & 63; F.wave = __builtin_amdgcn_readfirstlane(F.tid >> 6);
    F.G = gridDim.x; { const int bx = blockIdx.x; F.vcu = (F.G % 8 == 0) ? (bx % 8) * (F.G / 8) + bx / 8 : bx; }
    unsigned char* ws = args.ws;
    for (int u = F.tid; u < (LDS_BYTES - LDSCTL_OFF) / 4; u += NWAVES * 64) ((LAS unsigned*)(F.lds + LDSCTL_OFF))[u] = 0u;
    __syncthreads();
    const int lo = args.ph_lo, hi = args.ph_hi; const bool multi = (hi - lo) > 1;
    XcdBarrier bar; bar.bar = (unsigned*)(ws + WS_CTL + CTL_BAR + (size_t)lo * BAR_STRIDE); bar.x = 0; bar.st = nullptr;
    if (multi) bar = xcd_barrier_post((unsigned*)(ws + WS_CTL + CTL_BAR + (size_t)lo * BAR_STRIDE), F.MISC + 8);
#ifndef PH_ENABLE
#define PH_ENABLE 0x1fff
#endif
#define IN(k) ((((PH_ENABLE) >> (k)) & 1) && lo <= (k) && (k) < hi)
#define SEAM(k) do { if (IN(k) && IN((k) + 1)) xcd_barrier(bar); } while (0)
    float* SS = (float*)(ws + WS_CTL + CTL_SS);
    float* KMS = (float*)(ws + WS_CTL + CTL_KMS);
    bf16* HB = (bf16*)(ws + WS_HB); bf16* ACT = (bf16*)(ws + WS_ACT); bf16* MIXED = (bf16*)(ws + WS_MIXED);
    bf16* Qb = (bf16*)(ws + WS_Q); bf16* Kb = (bf16*)(ws + WS_K); bf16* Vb = (bf16*)(ws + WS_V); bf16* CUb = (bf16*)(ws + WS_CU); bf16* BGb = (bf16*)(ws + WS_BG);
    bf16* QX = (bf16*)(ws + WS_QX); bf16* OX = (bf16*)(ws + WS_OX); bf16* KVX = (bf16*)(ws + WS_KVX);
    const int bx = (int)blockIdx.x;

    if (IN(0)) { p0_prologue(F, args); } SEAM(0);
    if (IN(1)) { pg8::Gemm g{HB, (const bf16*)(ws + WS_WGU1), M, 2 * FF, D}; pg8::StaticOrder S; S.init(M, 2 * FF, F.G, bx);
        pg8::EpiSwiglu E{ACT, FF, SS}; pg8::gemm_phase<pg8::EpiSwiglu, pg8::StaticOrder, PG8_ALIGN, PG8_SP2>(F.lds + RING_OFF, g, S, E); } SEAM(1);
    if (IN(2)) { pg8::Gemm g{ACT, (const bf16*)(ws + WS_WD1), M, D, FF}; pg8::StaticOrder S; S.init(M, D, F.G, bx);
        pg8::EpiResid<0> E{args.in[I_X], args.out, HB, SS + M, 0.5f, nullptr}; pg8::gemm_phase<pg8::EpiResid<0>, pg8::StaticOrder, PG8_ALIGN, PG8_SP2>(F.lds + RING_OFF, g, S, E); } SEAM(2);
    if (IN(3)) { pg8::Gemm g{HB, (const bf16*)(ws + WS_WIN), M, INW, D}; pg8::StaticOrder S; S.init(M, INW, F.G, bx);
        pg8::EpiWin E{Qb, Kb, Vb, CUb, BGb, KMS, SS + M}; pg8::gemm_phase<pg8::EpiWin, pg8::StaticOrder, PG8_ALIGN, PG8_SP2>(F.lds + RING_OFF, g, S, E); } SEAM(3);
    if (IN(4)) {
        for (int u = bx; u < BATCH * NH * 8; u += F.G) { const int b = u >> 6, h = (u >> 3) & 7, p = u & 7;
#pragma unroll 1
            for (int half = 0; half < 2; ++half) { const int qb = half ? 15 - p : p; const size_t r0 = (size_t)b * SEQ + (size_t)qb * 256;
                att::attn_body<true, 1024, 1024, 2048, MOBA_SDEPTH>(Qb + r0 * 1024 + h * 128, Kb + (size_t)b * SEQ * 1024 + h * 128, Vb + (size_t)b * SEQ * 1024 + h * 128, MIXED + r0 * 2048 + h * 128,
                                                       256 * (qb + 1), (att::lptr)(F.lds + RING_OFF), qb, KMS + ((size_t)b * 16 * 8 + h) * 128, 8 * 128, SS + 2 * M + r0); } } }
    if (IN(5)) { p5_conv(F, args); } SEAM(5);
    if (IN(6)) { pg8::Gemm g{MIXED, (const bf16*)(ws + WS_WOUT), M, D, D}; pg8::StaticOrder S; S.init(M, D, F.G, bx);
        pg8::EpiResid<16> E{args.out, args.out, HB, SS + 3 * M, 1.0f, SS + 2 * M}; pg8::gemm_phase<pg8::EpiResid<16>, pg8::StaticOrder, PG8_ALIGN, PG8_SP2>(F.lds + RING_OFF, g, S, E); } SEAM(6);
    if (IN(7)) { { pg8::Gemm g{HB, (const bf16*)(ws + WS_WQ), M, XW, D}; pg8::StaticOrder S; S.init(M, XW, F.G, bx);
          pg8::EpiScaleBf16 E{QX, XW, SS + 3 * M}; pg8::gemm_phase<pg8::EpiScaleBf16, pg8::StaticOrder, PG8_ALIGN, PG8_SP2>(F.lds + RING_OFF, g, S, E); }
        { pg8::Gemm g{(const bf16*)(ws + WS_MEMN), (const bf16*)(ws + WS_WKV), BATCH * MEML, 1024, D}; pg8::StaticOrder S; S.init(BATCH * MEML, 1024, F.G, (bx + F.G - 128) % F.G);
          pg8::EpiScaleBf16 E{KVX, 1024, nullptr}; pg8::gemm_phase<pg8::EpiScaleBf16, pg8::StaticOrder, PG8_ALIGN, PG8_SP2>(F.lds + RING_OFF, g, S, E); } } SEAM(7);
    if (IN(8)) {
        for (int u = bx; u < BATCH * XH * 16; u += F.G) { const int b = u >> 6, h = (u >> 4) & 3, qb = u & 15; const size_t r0 = (size_t)b * SEQ + (size_t)qb * 256;
            att::attn_body<false, 512, 1024, 512, 2>(QX + r0 * 512 + h * 128, KVX + (size_t)b * MEML * 1024 + h * 128, KVX + (size_t)b * MEML * 1024 + 512 + h * 128, OX + r0 * 512 + h * 128,
                                                  MEML, (att::lptr)(F.lds + RING_OFF), 0, nullptr, 0, nullptr); } } SEAM(8);
    if (IN(9)) { pg8::Gemm g{OX, (const bf16*)(ws + WS_WO), M, D, XW}; pg8::StaticOrder S; S.init(M, D, F.G, bx);
        pg8::EpiResid<0> E{args.out, args.out, HB, SS + 4 * M, 1.0f, nullptr}; pg8::gemm_phase<pg8::EpiResid<0>, pg8::StaticOrder, PG8_ALIGN, PG8_SP2>(F.lds + RING_OFF, g, S, E); } SEAM(9);
    if (IN(10)) { pg8::Gemm g{HB, (const bf16*)(ws + WS_WGU2), M, 2 * FF, D}; pg8::StaticOrder S; S.init(M, 2 * FF, F.G, bx);
        pg8::EpiSwiglu E{ACT, FF, SS + 4 * M}; pg8::gemm_phase<pg8::EpiSwiglu, pg8::StaticOrder, PG8_ALIGN, PG8_SP2>(F.lds + RING_OFF, g, S, E); } SEAM(10);
    if (IN(11)) { pg8::Gemm g{ACT, (const bf16*)(ws + WS_WD2), M, D, FF}; pg8::StaticOrder S; S.init(M, D, F.G, bx);
        pg8::EpiResid<0> E{args.out, args.out, nullptr, SS + 5 * M, 0.5f, nullptr}; pg8::gemm_phase<pg8::EpiResid<0>, pg8::StaticOrder, PG8_ALIGN, PG8_SP2>(F.lds + RING_OFF, g, S, E); } SEAM(11);
    if (IN(12)) { p12_final(F, args); }
#undef IN
#undef SEAM
}

extern "C" void kernel_launch(void* const* d_in, const int* in_sizes, int n_in, void* d_out, int out_size, void* d_ws, size_t ws_size, hipStream_t stream) {
    static int grid = 0;
    if (grid == 0) {
        if (n_in != 22 || in_sizes[0] != M * D || out_size != M * D || ws_size < WS_END) { fprintf(stderr, "kernel_launch: shape mismatch (n_in %d, in0 %d, out %d, ws %zu; need ws >= %zu); nothing launched\n", n_in, n_in > 0 ? in_sizes[0] : -1, out_size, ws_size, (size_t)WS_END); grid = -1; return; }
        int dev = 0, cus = 0, per_cu = 0;
        if (hipGetDevice(&dev) != hipSuccess || hipDeviceGetAttribute(&cus, hipDeviceAttributeMultiprocessorCount, dev) != hipSuccess) { grid = -1; return; }
        if (hipFuncSetAttribute((const void*)fwd_kernel, hipFuncAttributeMaxDynamicSharedMemorySize, LDS_BYTES) != hipSuccess) { fprintf(stderr, "kernel_launch: hipFuncSetAttribute failed\n"); grid = -1; return; }
        if (hipOccupancyMaxActiveBlocksPerMultiprocessor(&per_cu, (const void*)fwd_kernel, NWAVES * 64, LDS_BYTES) != hipSuccess || per_cu < 1) { fprintf(stderr, "kernel_launch: occupancy query reports %d workgroups per CU\n", per_cu); }
        (void)hipGetLastError();
        grid = cus;
    }
    if (grid < 0) return;
    if (hipMemsetAsync((char*)d_ws + WS_CTL, 0, CTL_ZERO_BYTES, stream) != hipSuccess) { fprintf(stderr, "kernel_launch: hipMemsetAsync failed\n"); return; }
    Args a{};
    for (int i = 0; i < 22; ++i) a.in[i] = (const float*)d_in[i];
    a.out = (float*)d_out; a.ws = (unsigned char*)d_ws;
    unsigned char* ws = (unsigned char*)d_ws; float* SS = (float*)(ws + WS_CTL + CTL_SS); float* KMS = (float*)(ws + WS_CTL + CTL_KMS); float* out = (float*)d_out;
    bf16* HB = (bf16*)(ws + WS_HB); bf16* ACT = (bf16*)(ws + WS_ACT); bf16* MIXED = (bf16*)(ws + WS_MIXED);
    bf16* Qb = (bf16*)(ws + WS_Q); bf16* Kb = (bf16*)(ws + WS_K); bf16* Vb = (bf16*)(ws + WS_V); bf16* CUb = (bf16*)(ws + WS_CU); bf16* BGb = (bf16*)(ws + WS_BG);
    bf16* QX = (bf16*)(ws + WS_QX); bf16* OX = (bf16*)(ws + WS_OX); bf16* KVX = (bf16*)(ws + WS_KVX);
    (void)SS; (void)KMS; (void)out; (void)HB; (void)ACT; (void)MIXED; (void)Qb; (void)Kb; (void)Vb; (void)CUb; (void)BGb; (void)QX; (void)OX; (void)KVX;
#if ONE_LAUNCH
    a.ph_lo = 0; a.ph_hi = NPH;
    hipLaunchKernelGGL(fwd_kernel, dim3(grid), dim3(NWAVES * 64), LDS_BYTES, stream, a);
#else
    for (int ph = 0; ph < NPH; ++ph) {
        if ((FAST_MASK >> ph) & 1) { a.ph_lo = ph; a.ph_hi = ph + 1; hipLaunchKernelGGL(fwd_kernel, dim3(grid), dim3(NWAVES * 64), LDS_BYTES, stream, a); continue; }
        switch (ph) {
        case 1: hipLaunchKernelGGL((nv::gemm<nv::FSwiglu>), dim3(FF / 64, M / 64), dim3(256), 0, stream, HB, (const bf16*)(ws + WS_WGU1), D, nv::FSwiglu{ACT, SS}); break;
        case 2: hipLaunchKernelGGL((nv::gemm<nv::FResid<0>>), dim3(D / 64, M / 64), dim3(256), 0, stream, ACT, (const bf16*)(ws + WS_WD1), FF, nv::FResid<0>{a.in[I_X], out, HB, SS + M, 0.5f, nullptr}); break;
        case 3: hipLaunchKernelGGL((nv::gemm<nv::FWin>), dim3(5120 / 64, M / 64), dim3(256), 0, stream, HB, (const bf16*)(ws + WS_WIN), D, nv::FWin{Qb, Kb, Vb, CUb, BGb, SS + M});
                hipLaunchKernelGGL(nv::kmean, dim3(BATCH * 16 * 8 * 128 / 256), dim3(256), 0, stream, Kb, KMS); break;
        case 4: hipLaunchKernelGGL(nv::moba, dim3(M * NH / 4), dim3(256), 0, stream, Qb, Kb, Vb, KMS, MIXED, SS + 2 * M); break;
        case 6: hipLaunchKernelGGL((nv::gemm<nv::FResid<1024>>), dim3(D / 64, M / 64), dim3(256), 0, stream, MIXED, (const bf16*)(ws + WS_WOUT), D, nv::FResid<1024>{out, out, HB, SS + 3 * M, 1.0f, SS + 2 * M}); break;
        case 7: hipLaunchKernelGGL((nv::gemm<nv::FScale>), dim3(XW / 64, M / 64), dim3(256), 0, stream, HB, (const bf16*)(ws + WS_WQ), D, nv::FScale{QX, XW, SS + 3 * M});
                hipLaunchKernelGGL((nv::gemm<nv::FScale>), dim3(1024 / 64, BATCH * MEML / 64), dim3(256), 0, stream, (const bf16*)(ws + WS_MEMN), (const bf16*)(ws + WS_WKV), D, nv::FScale{KVX, 1024, nullptr}); break;
        case 8: hipLaunchKernelGGL(nv::xattn, dim3(M * XH / 4), dim3(256), 0, stream, QX, KVX, OX); break;
        case 9: hipLaunchKernelGGL((nv::gemm<nv::FResid<0>>), dim3(D / 64, M / 64), dim3(256), 0, stream, OX, (const bf16*)(ws + WS_WO), XW, nv::FResid<0>{out, out, HB, SS + 4 * M, 1.0f, nullptr}); break;
        case 10: hipLaunchKernelGGL((nv::gemm<nv::FSwiglu>), dim3(FF / 64, M / 64), dim3(256), 0, stream, HB, (const bf16*)(ws + WS_WGU2), D, nv::FSwiglu{ACT, SS + 4 * M}); break;
        case 11: hipLaunchKernelGGL((nv::gemm<nv::FResid<0>>), dim3(D / 64, M / 64), dim3(256), 0, stream, ACT, (const bf16*)(ws + WS_WD2), FF, nv::FResid<0>{out, out, nullptr, SS + 5 * M, 0.5f, nullptr}); break;
        default: break;
        }
    }
#endif
    const hipError_t le = hipPeekAtLastError();
    if (le != hipSuccess) fprintf(stderr, "kernel_launch: launch failed: %s\n", hipGetErrorName(le));
}
```

```cpp
#define ONE_LAUNCH 1
#define FAST_MASK 0x1fff
#include <hip/hip_runtime.h>
#include <cstdio>
#include <cstdint>
namespace pg8 {
#define PG8_LAS __attribute__((address_space(3)))
typedef unsigned short bf16_t;
typedef short bf16x8 __attribute__((ext_vector_type(8)));
typedef float f32x4 __attribute__((ext_vector_type(4)));
typedef unsigned u32x4 __attribute__((ext_vector_type(4)));
constexpr int BM = 256, BK = 64, HALF = 128, HTB = HALF * BK * 2  , STAGE_BYTES = 8 * HTB, NXCD = 8, WGM = 8;

__host__ __device__ __forceinline__ int lds_byte(int r, int c) { const int st = (r >> 4) * 2 + (c >> 5), rr = r & 15, cc = c & 31, ob = rr * 64 + cc * 2; return st * 1024 + (ob ^ (((ob >> 9) & 1) << 5)); }
__host__ __device__ __forceinline__ void stage_rc(int b, int& R, int& C) { const int st = b / 1024, sb = b % 1024, swz = sb ^ (((sb >> 9) & 1) << 5); R = (st >> 1) * 16 + swz / 64; C = (st & 1) * 32 + (swz % 64) / 2; }
__host__ __device__ __forceinline__ int perm32(int rho) { const int n = rho >> 4, i = rho & 15; return 8 * (i >> 2) + 4 * n + (i & 3); }

struct Unit { int pm, pn; };
struct Gemm { const bf16_t* A; const bf16_t* Bt; int M, N, K; };

struct StaticOrder {
    int nM, nN, nwg, G, c;
    __host__ __device__ void init(int M, int N, int G_, int c_) { nM = M / BM; nN = N / BM; nwg = nM * nN; G = G_; c = c_; }
    __host__ __device__ bool next(int i, Unit& u) const {
        const long L = (long)i * G + c; if (L >= nwg) return false;
        int wgid = (int)L; { const int q = nwg / NXCD, r = nwg % NXCD, xcd = wgid % NXCD, off = wgid / NXCD; wgid = (xcd < r ? xcd * (q + 1) : r * (q + 1) + (xcd - r) * q) + off; }
        const int nig = WGM * nN, gid = wgid / nig, fm = gid * WGM, gsz = (nM - fm) < WGM ? (nM - fm) : WGM;
        u.pm = fm + ((wgid % nig) % gsz); u.pn = (wgid % nig) / gsz; return true;
    }
    __device__ __forceinline__ void a_ready(const Unit&) const {}
    __device__ __forceinline__ void done(const Unit&) const {}
};

__device__ __forceinline__ unsigned cvt_pk_bf16(float lo, float hi) { unsigned r; asm volatile("v_cvt_pk_bf16_f32 %0, %1, %2" : "=v"(r) : "v"(lo), "v"(hi)); return r; }
__device__ __forceinline__ u32x4 pack8(const f32x4 v0, const f32x4 v1) { u32x4 w; w.x = cvt_pk_bf16(v0[0], v0[1]); w.y = cvt_pk_bf16(v0[2], v0[3]); w.z = cvt_pk_bf16(v1[0], v1[1]); w.w = cvt_pk_bf16(v1[2], v1[3]); return w; }
constexpr float RMS_EPS = 1e-6f;
__device__ __forceinline__ float silu_mul(float g, float u) { return g * u * __builtin_amdgcn_rcpf(1.0f + __builtin_amdgcn_exp2f(-1.4426950408889634f * g)); }

struct EpiSwiglu {
    static constexpr bool PERM = true, AFTER_DRAIN = false; static constexpr int MIDT = 0;
    bf16_t* O; int ldo; const float* ss;
    __device__ __forceinline__ void mid(f32x4 (&)[2][2][4][2], const Unit&, int, int) const {}
    __device__ __forceinline__ void operator()(const f32x4 (&acc)[2][2][4][2], const Unit& u, int wr, int wc, int fr_, int fq_) const {
        int fr = fr_, fq = fq_; asm volatile("" : "+v"(fr), "+v"(fq));
        const int row0 = u.pm * BM + wr * 64 + fr, col0 = u.pn * HALF + wc * 32 + 8 * fq;
#pragma unroll
        for (int ai = 0; ai < 2; ++ai)
#pragma unroll
            for (int m = 0; m < 4; ++m) { const int row = row0 + ai * HALF + m * 16; const float rs = rsqrtf(ss[row] * (1.0f / 2048.0f) + RMS_EPS);
                f32x4 o0, o1;
#pragma unroll
                for (int j = 0; j < 4; ++j) { o0[j] = silu_mul(acc[ai][0][m][0][j] * rs, acc[ai][1][m][0][j] * rs); o1[j] = silu_mul(acc[ai][0][m][1][j] * rs, acc[ai][1][m][1][j] * rs); }
                *(u32x4*)(O + (size_t)row * ldo + col0) = pack8(o0, o1); }
    }
};
template <int MIDT_, bool RBF, bool OF32> struct EpiResid {
    static constexpr bool PERM = true, AFTER_DRAIN = false; static constexpr int MIDT = MIDT_;
    const float* R; const bf16_t* RB; float* H; bf16_t* HB; float* ssn; float alpha; const float* midss;
    __device__ __forceinline__ void mid(f32x4 (&acc)[2][2][4][2], const Unit& u, int wr, int fr) const {
        const int row0 = u.pm * BM + wr * 64 + fr;
#pragma unroll
        for (int ai = 0; ai < 2; ++ai)
#pragma unroll
            for (int m = 0; m < 4; ++m) { const float s = rsqrtf(midss[row0 + ai * HALF + m * 16] * (1.0f / 1024.0f) + RMS_EPS);
#pragma unroll
                for (int bj = 0; bj < 2; ++bj)
#pragma unroll
                    for (int n = 0; n < 2; ++n) acc[ai][bj][m][n] = acc[ai][bj][m][n] * s; }
    }
    __device__ __forceinline__ void operator()(const f32x4 (&acc)[2][2][4][2], const Unit& u, int wr, int wc, int fr_, int fq_) const {
        int fr = fr_, fq = fq_; asm volatile("" : "+v"(fr), "+v"(fq));
        const int row0 = u.pm * BM + wr * 64 + fr, col0 = u.pn * BM + wc * 32 + 8 * fq;
#pragma unroll
        for (int ai = 0; ai < 2; ++ai)
#pragma unroll
            for (int m = 0; m < 4; ++m) { const int row = row0 + ai * HALF + m * 16; const size_t off = (size_t)row * 2048 + col0; float sq = 0.f;
#pragma unroll
                for (int bj = 0; bj < 2; ++bj) { f32x4 r0, r1;
                    if constexpr (RBF) { const u32x4 w = *(const u32x4*)(RB + off + bj * HALF);
                        r0 = (f32x4){__uint_as_float(w.x << 16), __uint_as_float(w.x & 0xffff0000u), __uint_as_float(w.y << 16), __uint_as_float(w.y & 0xffff0000u)};
                        r1 = (f32x4){__uint_as_float(w.z << 16), __uint_as_float(w.z & 0xffff0000u), __uint_as_float(w.w << 16), __uint_as_float(w.w & 0xffff0000u)}; }
                    else { r0 = *(const f32x4*)(R + off + bj * HALF); r1 = *(const f32x4*)(R + off + bj * HALF + 4); }
                    const f32x4 h0 = r0 + acc[ai][bj][m][0] * alpha, h1 = r1 + acc[ai][bj][m][1] * alpha;
                    if constexpr (OF32) { *(f32x4*)(H + off + bj * HALF) = h0; *(f32x4*)(H + off + bj * HALF + 4) = h1; }
                    else *(u32x4*)(HB + off + bj * HALF) = pack8(h0, h1);
                    sq += (h0[0] * h0[0] + h0[1] * h0[1]) + (h0[2] * h0[2] + h0[3] * h0[3]) + (h1[0] * h1[0] + h1[1] * h1[1]) + (h1[2] * h1[2] + h1[3] * h1[3]); }
                sq += __shfl_xor(sq, 16); sq += __shfl_xor(sq, 32);
                if (fq == 0) unsafeAtomicAdd(ssn + row, sq);
                asm volatile("" ::: "memory"); }
    }
};
struct EpiWin {
    static constexpr bool PERM = true, AFTER_DRAIN = false; static constexpr int MIDT = 0;
    bf16_t *Q, *K, *V, *CU, *BG; float* kms; const float* ss;
    __device__ __forceinline__ void mid(f32x4 (&)[2][2][4][2], const Unit&, int, int) const {}
    __device__ __forceinline__ void operator()(const f32x4 (&acc)[2][2][4][2], const Unit& u, int wr, int wc, int fr_, int fq_) const {
        int fr = fr_, fq = fq_; asm volatile("" : "+v"(fr), "+v"(fq));
        const int row0 = u.pm * BM + wr * 64 + fr, pn = u.pn;
        if (pn >= 12 && pn < 20) {
            const int col0 = (pn - 12) * HALF + wc * 32 + 8 * fq;
#pragma unroll
            for (int ai = 0; ai < 2; ++ai)
#pragma unroll
                for (int m = 0; m < 4; ++m) { const int row = row0 + ai * HALF + m * 16; float rs = rsqrtf(ss[row] * (1.0f / 2048.0f) + RMS_EPS); rs = rs * rs;
                    const f32x4 o0 = acc[ai][0][m][0] * acc[ai][1][m][0] * rs, o1 = acc[ai][0][m][1] * acc[ai][1][m][1] * rs;
                    *(u32x4*)(CU + (size_t)row * 1024 + col0) = pack8(o0, o1); }
        } else {
            bf16_t* base = pn < 4 ? Q : pn < 8 ? K : pn < 12 ? V : BG; const int colt = (pn & 3) * BM, col0 = colt + wc * 32 + 8 * fq; const bool isk = (pn >= 4 && pn < 8);
            float rsv[2][4];
#pragma unroll
            for (int ai = 0; ai < 2; ++ai)
#pragma unroll
                for (int m = 0; m < 4; ++m) rsv[ai][m] = rsqrtf(ss[row0 + ai * HALF + m * 16] * (1.0f / 2048.0f) + RMS_EPS);
#pragma unroll
            for (int ai = 0; ai < 2; ++ai)
#pragma unroll
                for (int m = 0; m < 4; ++m) { const int row = row0 + ai * HALF + m * 16;
#pragma unroll
                    for (int bj = 0; bj < 2; ++bj) *(u32x4*)(base + (size_t)row * 1024 + col0 + bj * HALF) = pack8(acc[ai][bj][m][0] * rsv[ai][m], acc[ai][bj][m][1] * rsv[ai][m]); }
            if (isk) {
#pragma unroll
                for (int bj = 0; bj < 2; ++bj)
#pragma unroll
                    for (int n = 0; n < 2; ++n) { f32x4 c = (f32x4){0.f, 0.f, 0.f, 0.f};
#pragma unroll
                        for (int ai = 0; ai < 2; ++ai)
#pragma unroll
                            for (int m = 0; m < 4; ++m) { float r2 = rsv[ai][m]; asm volatile("" : "+v"(r2)); c += acc[ai][bj][m][n] * r2; }
#pragma unroll
                        for (int j = 0; j < 4; ++j) { float v = c[j]; v += __shfl_xor(v, 1); v += __shfl_xor(v, 2); v += __shfl_xor(v, 4); v += __shfl_xor(v, 8);
                            const int col = col0 + bj * HALF + 4 * n + j;
                            if (fr == 0) unsafeAtomicAdd(kms + ((size_t)u.pm * 8 + (col >> 7)) * 128 + (col & 127), v); }
                        asm volatile("" ::: "memory"); }
            }
        }
    }
};
struct EpiScaleBf16 {
    static constexpr bool PERM = true, AFTER_DRAIN = false; static constexpr int MIDT = 0;
    bf16_t* O; int ldo; const float* ss;
    __device__ __forceinline__ void mid(f32x4 (&)[2][2][4][2], const Unit&, int, int) const {}
    __device__ __forceinline__ void operator()(const f32x4 (&acc)[2][2][4][2], const Unit& u, int wr, int wc, int fr_, int fq_) const {
        int fr = fr_, fq = fq_; asm volatile("" : "+v"(fr), "+v"(fq));
        const int row0 = u.pm * BM + wr * 64 + fr, col0 = u.pn * BM + wc * 32 + 8 * fq;
#pragma unroll
        for (int ai = 0; ai < 2; ++ai)
#pragma unroll
            for (int m = 0; m < 4; ++m) { const int row = row0 + ai * HALF + m * 16; const float rs = ss ? rsqrtf(ss[row] * (1.0f / 2048.0f) + RMS_EPS) : 1.0f;
#pragma unroll
                for (int bj = 0; bj < 2; ++bj) *(u32x4*)(O + (size_t)row * ldo + col0 + bj * HALF) = pack8(acc[ai][bj][m][0] * rs, acc[ai][bj][m][1] * rs); }
    }
};

template <class Epi, class Sched, bool ALIGN_EPI = false, bool SP2 = false>
__device__ __forceinline__ void gemm_phase(PG8_LAS unsigned char* lds, const Gemm g, const Sched& S, const Epi& E) {
    int tid_ = threadIdx.x; asm volatile("" : "+v"(tid_));
    const int tid = tid_, wid = __builtin_amdgcn_readfirstlane(tid >> 6), lane = tid & 63, wr = wid >> 2, wc = wid & 3, fr = lane & 15, fq = lane >> 4;
    const int K = g.K, nt = K / BK;
    unsigned voffA[2], voffB[2];
#pragma unroll
    for (int i = 0; i < 2; ++i) { int R, C; stage_rc(tid * 16 + i * 8192, R, C); const int Rb = Epi::PERM ? ((R & ~31) + perm32(R & 31)) : R;
        voffA[i] = (unsigned)(R * K + C) * 2u; voffB[i] = (unsigned)(Rb * K + C) * 2u; }
    const size_t kstep = (size_t)(BK * 2);
    const size_t hstep = (size_t)HALF * K * 2;
    const size_t tstep = 2 * hstep;
    const unsigned ldsw = (unsigned)wid * 1024u;
    const int aoff = lds_byte(wr * 64 + fr, fq * 8), boff = lds_byte(wc * 32 + fr, fq * 8);
#define PG8_SA(b, h) (((b) * 2 + (h)) * HTB)
#define PG8_SB(b, h) ((4 + (b) * 2 + (h)) * HTB)
#define PG8_STAGE(bufoff, gbase, voff) do { _Pragma("unroll") for (int _i = 0; _i < 2; ++_i) \
        __builtin_amdgcn_global_load_lds((const unsigned*)((const char*)(gbase) + (voff)[_i]), (PG8_LAS unsigned*)(lds + (bufoff) + ldsw + _i * 8192), 16, 0, 0); } while (0)
#define PG8_LDA(dst, b, h) do { _Pragma("unroll") for (int m = 0; m < 4; ++m) _Pragma("unroll") for (int k = 0; k < 2; ++k) dst[m][k] = *(const PG8_LAS bf16x8*)(lds + PG8_SA(b, h) + aoff + m * 2048 + k * 1024); } while (0)
#define PG8_LDB(dst, b, h) do { _Pragma("unroll") for (int n = 0; n < 2; ++n) _Pragma("unroll") for (int k = 0; k < 2; ++k) dst[n][k] = *(const PG8_LAS bf16x8*)(lds + PG8_SB(b, h) + boff + n * 2048 + k * 1024); } while (0)
#define PG8_MMA(ai, bj, At, Bt) do { __builtin_amdgcn_s_setprio(1); _Pragma("unroll") for (int m = 0; m < 4; ++m) _Pragma("unroll") for (int n = 0; n < 2; ++n) _Pragma("unroll") for (int k = 0; k < 2; ++k) \
        acc[ai][bj][m][n] = __builtin_amdgcn_mfma_f32_16x16x32_bf16(Bt[n][k], At[m][k], acc[ai][bj][m][n], 0, 0, 0); __builtin_amdgcn_s_setprio(0); } while (0)
#define PG8_WAIT_V(n) asm volatile("s_waitcnt vmcnt(" #n ")" ::: "memory")
#define PG8_WAIT_L(n) asm volatile("s_waitcnt lgkmcnt(" #n ")" ::: "memory")
#define PG8_BAR __builtin_amdgcn_s_barrier()
#define PG8_SCHED __builtin_amdgcn_sched_barrier(0)
    Unit cur, nxt; int ui = 0;
    if (!S.next(0, cur)) return;
    f32x4 acc[2][2][4][2];
#pragma unroll
    for (int a = 0; a < 2; ++a)
#pragma unroll
        for (int b = 0; b < 2; ++b)
#pragma unroll
            for (int m = 0; m < 4; ++m)
#pragma unroll
                for (int n = 0; n < 2; ++n) acc[a][b][m][n] = (f32x4){0.f, 0.f, 0.f, 0.f};
    bf16x8 At[4][2], B0[2][2], B1[2][2];
    const char* cA = (const char*)g.A + (size_t)cur.pm * tstep; const char* cB = (const char*)g.Bt + (size_t)cur.pn * tstep;
    S.a_ready(cur);
    if constexpr (SP2) {
        PG8_STAGE(PG8_SB(0, 0), cB, voffB); PG8_STAGE(PG8_SB(0, 1), cB + hstep, voffB); PG8_STAGE(PG8_SA(0, 0), cA, voffA); PG8_STAGE(PG8_SA(0, 1), cA + hstep, voffA);
        if (wr == 1) PG8_BAR;
        PG8_WAIT_V(2); PG8_BAR;
        PG8_STAGE(PG8_SB(1, 0), cB + kstep, voffB); PG8_STAGE(PG8_SA(1, 0), cA + kstep, voffA); PG8_STAGE(PG8_SB(1, 1), cB + hstep + kstep, voffB);
        PG8_WAIT_V(6); PG8_BAR;
    } else {
        PG8_STAGE(PG8_SB(0, 0), cB, voffB); PG8_STAGE(PG8_SA(0, 0), cA, voffA); PG8_STAGE(PG8_SB(0, 1), cB + hstep, voffB); PG8_STAGE(PG8_SA(0, 1), cA + hstep, voffA);
        if (wr == 1) PG8_BAR;
        PG8_WAIT_V(4); PG8_BAR;
        PG8_STAGE(PG8_SB(1, 0), cB + kstep, voffB); PG8_STAGE(PG8_SA(1, 0), cA + kstep, voffA); PG8_STAGE(PG8_SB(1, 1), cB + hstep + kstep, voffB);
        PG8_WAIT_V(6); PG8_BAR;
    }
    for (;;) {
        const bool has_next = S.next(ui + 1, nxt);
        const char* nA = has_next ? (const char*)g.A + (size_t)nxt.pm * tstep : cA; const char* nB = has_next ? (const char*)g.Bt + (size_t)nxt.pn * tstep : cB;
        for (int t = 0; t < nt; t += 2) {
            if constexpr (Epi::MIDT > 0) { if (t == Epi::MIDT) E.mid(acc, cur, wr, fr); }
            const bool last = (t == nt - 2);
            const char* a1 = cA + (size_t)(t + 1) * kstep;
            const char* a2 = last ? nA : cA + (size_t)(t + 2) * kstep; const char* b2 = last ? nB : cB + (size_t)(t + 2) * kstep;
            const char* a3 = a2 + kstep; const char* b3 = b2 + kstep;
            if (last && has_next) S.a_ready(nxt);
            if constexpr (SP2) {
            PG8_LDB(B0, 0, 0); PG8_LDB(B1, 0, 1); PG8_SCHED; PG8_LDA(At, 0, 0); PG8_STAGE(PG8_SA(1, 1), a1 + hstep, voffA);
            PG8_WAIT_V(8); PG8_WAIT_L(0); PG8_BAR; PG8_MMA(0, 0, At, B0); PG8_MMA(0, 1, At, B1); PG8_BAR; PG8_SCHED;
            PG8_LDA(At, 0, 1); PG8_STAGE(PG8_SB(0, 0), b2, voffB); PG8_STAGE(PG8_SB(0, 1), b2 + hstep, voffB); PG8_STAGE(PG8_SA(0, 0), a2, voffA);
            PG8_WAIT_V(8); PG8_WAIT_L(0); PG8_BAR; PG8_MMA(1, 0, At, B0); PG8_MMA(1, 1, At, B1); PG8_BAR; PG8_SCHED;
            PG8_LDB(B0, 1, 0); PG8_LDB(B1, 1, 1); PG8_SCHED; PG8_LDA(At, 1, 0); PG8_STAGE(PG8_SA(0, 1), a2 + hstep, voffA);
            PG8_WAIT_V(8); PG8_WAIT_L(0); PG8_BAR; PG8_MMA(0, 0, At, B0); PG8_MMA(0, 1, At, B1); PG8_BAR; PG8_SCHED;
            PG8_LDA(At, 1, 1); PG8_STAGE(PG8_SB(1, 0), b3, voffB); PG8_STAGE(PG8_SB(1, 1), b3 + hstep, voffB); PG8_STAGE(PG8_SA(1, 0), a3, voffA);
            PG8_WAIT_V(8); PG8_WAIT_L(0); PG8_BAR; PG8_MMA(1, 0, At, B0); PG8_MMA(1, 1, At, B1); PG8_BAR; PG8_SCHED;
            } else {
            PG8_LDB(B0, 0, 0); PG8_SCHED; PG8_LDA(At, 0, 0); PG8_STAGE(PG8_SA(1, 1), a1 + hstep, voffA);
            PG8_WAIT_L(8); PG8_BAR; PG8_WAIT_L(0); PG8_MMA(0, 0, At, B0); PG8_BAR; PG8_SCHED;
            PG8_LDB(B1, 0, 1); PG8_STAGE(PG8_SB(0, 0), b2, voffB);
            PG8_BAR; PG8_WAIT_L(0); PG8_MMA(0, 1, At, B1); PG8_BAR;
            PG8_LDA(At, 0, 1); PG8_STAGE(PG8_SA(0, 0), a2, voffA);
            PG8_BAR; PG8_WAIT_L(0); PG8_MMA(1, 0, At, B0); PG8_BAR; PG8_SCHED;
            PG8_STAGE(PG8_SB(0, 1), b2 + hstep, voffB);
            PG8_WAIT_V(6); PG8_BAR; PG8_MMA(1, 1, At, B1); PG8_BAR;
            PG8_LDB(B0, 1, 0); PG8_SCHED; PG8_LDA(At, 1, 0); PG8_STAGE(PG8_SA(0, 1), a2 + hstep, voffA);
            PG8_WAIT_L(8); PG8_BAR; PG8_WAIT_L(0); PG8_MMA(0, 0, At, B0); PG8_BAR; PG8_SCHED;
            PG8_LDB(B1, 1, 1); PG8_STAGE(PG8_SB(1, 0), b3, voffB);
            PG8_BAR; PG8_WAIT_L(0); PG8_MMA(0, 1, At, B1); PG8_BAR;
            PG8_LDA(At, 1, 1); PG8_STAGE(PG8_SA(1, 0), a3, voffA);
            PG8_BAR; PG8_WAIT_L(0); PG8_MMA(1, 0, At, B0); PG8_BAR; PG8_SCHED;
            PG8_STAGE(PG8_SB(1, 1), b3 + hstep, voffB);
            PG8_WAIT_V(6); PG8_BAR; PG8_MMA(1, 1, At, B1); PG8_BAR;
            }
        }
        if constexpr (ALIGN_EPI) { if (wr == 0) PG8_BAR; }
        if constexpr (!Epi::AFTER_DRAIN) { E(acc, cur, wr, wc, fr, fq); S.done(cur); }
        if (!has_next) break;
#pragma unroll
        for (int a = 0; a < 2; ++a)
#pragma unroll
            for (int b = 0; b < 2; ++b)
#pragma unroll
                for (int m = 0; m < 4; ++m)
#pragma unroll
                    for (int n = 0; n < 2; ++n) acc[a][b][m][n] = (f32x4){0.f, 0.f, 0.f, 0.f};
        cur = nxt; cA = nA; cB = nB; ++ui;
        if constexpr (ALIGN_EPI) { if (wr == 1) PG8_BAR; }
    }
    PG8_WAIT_V(0);
    if constexpr (!ALIGN_EPI) { if (wr == 0) PG8_BAR; }
    PG8_BAR;
    if constexpr (Epi::AFTER_DRAIN) { E.fused(acc, cur, wr, wc, fr, fq, lds, wid, lane); S.done(cur); }
#undef PG8_SA
#undef PG8_SB
#undef PG8_STAGE
#undef PG8_LDA
#undef PG8_LDB
#undef PG8_MMA
#undef PG8_WAIT_V
#undef PG8_WAIT_L
#undef PG8_BAR
#undef PG8_SCHED
}
}

#define PG8_SP2 true
#define PG8_ALIGN true
namespace att {
typedef unsigned short bf16;
using bf16x8 = __attribute__((ext_vector_type(8))) short;
using s16x4  = __attribute__((ext_vector_type(4))) short;
using f32x16 = __attribute__((ext_vector_type(16))) float;
using u32x4  = __attribute__((ext_vector_type(4))) unsigned;
#define ATT_LAS __attribute__((address_space(3)))
typedef ATT_LAS char* lptr;
constexpr int   D = 128, NW = 8, QBLK = 32, KVBLK = 64;
constexpr float SCALE = 0.088388347648318440f;
constexpr float THR = 8.f;
constexpr int SHM_V = KVBLK * D * 2, SHM_K = KVBLK * D * 2, SHM_ATTN = 2 * SHM_V + 2 * SHM_K + NW * 64 * 4;
#define KSWZ(row, colB) ((row) * 256 + ((colB) ^ (((row) & 7) << 4)))
#define SBAR() __builtin_amdgcn_sched_barrier(0)
__device__ __forceinline__ int crow(int r, int hi) { return (r & 3) + 8 * (r >> 2) + 4 * hi; }
__device__ __forceinline__ unsigned cvtpk(float lo, float hi) { unsigned r; asm volatile("v_cvt_pk_bf16_f32 %0, %1, %2" : "=v"(r) : "v"(lo), "v"(hi)); return r; }
__device__ __forceinline__ void partialSM(f32x16& p0, f32x16& p1, float& m_reg, float& mn, float& alpha) {
  constexpr float C = SCALE * 1.4426950408889634f;
  float pmax = p0[0];
#pragma unroll
  for (int r = 1; r < 16; ++r) pmax = fmaxf(pmax, p0[r]);
#pragma unroll
  for (int r = 0; r < 16; ++r) pmax = fmaxf(pmax, p1[r]);
  { auto rr = __builtin_amdgcn_permlane32_swap(__float_as_uint(pmax), __float_as_uint(pmax), false, false);
    pmax = fmaxf(__uint_as_float(rr[0]), __uint_as_float(rr[1])); }
  if (__builtin_expect(__all(pmax - m_reg <= THR / SCALE), 1)) { mn = m_reg; alpha = 1.f; }
  else { mn = fmaxf(m_reg, pmax); alpha = __builtin_amdgcn_exp2f((m_reg - mn) * C); m_reg = mn; }
  float mnC = -mn * C;
#pragma unroll
  for (int r = 0; r < 16; ++r) p0[r] = fmaf(p0[r], C, mnC);
#pragma unroll
  for (int r = 0; r < 16; ++r) p1[r] = fmaf(p1[r], C, mnC);
#pragma unroll
  for (int r = 0; r < 16; ++r) p0[r] = __builtin_amdgcn_exp2f(p0[r]);
}
__device__ __forceinline__ void finishSM(f32x16& p0, f32x16& p1, float alpha, float& l_reg, bf16x8& pa0, bf16x8& pa1, bf16x8& pa2, bf16x8& pa3) {
#pragma unroll
  for (int r = 0; r < 16; ++r) p1[r] = __builtin_amdgcn_exp2f(p1[r]);
  float ps = 0;
#pragma unroll
  for (int r = 0; r < 16; ++r) ps += p0[r];
#pragma unroll
  for (int r = 0; r < 16; ++r) ps += p1[r];
  { auto rr = __builtin_amdgcn_permlane32_swap(__float_as_uint(ps), __float_as_uint(ps), false, false);
    ps = __uint_as_float(rr[0]) + __uint_as_float(rr[1]); }
  l_reg = l_reg * alpha + ps;
#define PK4(P, BASE, OUT) do { unsigned a0 = cvtpk(P[BASE + 0], P[BASE + 1]), a1 = cvtpk(P[BASE + 2], P[BASE + 3]);   \
    unsigned b0 = cvtpk(P[BASE + 4], P[BASE + 5]), b1 = cvtpk(P[BASE + 6], P[BASE + 7]);                              \
    auto r0 = __builtin_amdgcn_permlane32_swap(a0, b0, false, false); auto r1 = __builtin_amdgcn_permlane32_swap(a1, b1, false, false); \
    u32x4 w = {r0[0], r1[0], r0[1], r1[1]}; OUT = *reinterpret_cast<bf16x8*>(&w); } while (0)
  PK4(p0, 0, pa0); PK4(p0, 8, pa1); PK4(p1, 0, pa2); PK4(p1, 8, pa3);
#undef PK4
}
__device__ __forceinline__ void qkt(f32x16& p0, f32x16& p1, lptr Ks, const bf16x8* qr, int r32, int hi) {
  p0 = f32x16{}; p1 = f32x16{};
#pragma unroll
  for (int d0 = 0; d0 < 8; ++d0) { int cb = (d0 * 16 + hi * 8) * 2;
    bf16x8 b0 = *reinterpret_cast<const ATT_LAS bf16x8*>(Ks + KSWZ(r32, cb));
    bf16x8 b1 = *reinterpret_cast<const ATT_LAS bf16x8*>(Ks + KSWZ(32 + r32, cb));
    p0 = __builtin_amdgcn_mfma_f32_32x32x16_bf16(b0, qr[d0], p0, 0, 0, 0);
    p1 = __builtin_amdgcn_mfma_f32_32x32x16_bf16(b1, qr[d0], p1, 0, 0, 0); }
}
__device__ __forceinline__ int v_st(int k, int c) { const int kk = (k & ~0xC) | ((k & 4) << 1) | ((k & 8) >> 1); return ((kk >> 3) * 4 + (c >> 5)) * 512 + ((kk & 7) * 32 + (c & 31)) * 2; }
__device__ __forceinline__ int v_rd_base(int lane) { return ((lane & 3) << 3) | (((lane >> 2) & 3) << 6) | (((lane >> 4) & 1) << 5) | (((lane >> 5) & 1) << 8); }
constexpr int v_rd_off(int d0, int ks, int half) { return d0 * 512 + ks * 4096 + half * 2048; }
template <int OFF> __device__ __forceinline__ s16x4 tr_read(int vb) {
  s16x4 r; asm volatile("ds_read_b64_tr_b16 %0, %1 offset:%2" : "=&v"(r) : "v"(vb), "i"(OFF) : "memory"); return r;
}
template <int D0> __device__ __forceinline__ void pv_one(f32x16& od, int vb, bf16x8 pa0, bf16x8 pa1, bf16x8 pa2, bf16x8 pa3) {
  const s16x4 l0 = tr_read<v_rd_off(D0, 0, 0)>(vb), h0 = tr_read<v_rd_off(D0, 0, 1)>(vb), l1 = tr_read<v_rd_off(D0, 1, 0)>(vb), h1 = tr_read<v_rd_off(D0, 1, 1)>(vb);
  const s16x4 l2 = tr_read<v_rd_off(D0, 2, 0)>(vb), h2 = tr_read<v_rd_off(D0, 2, 1)>(vb), l3 = tr_read<v_rd_off(D0, 3, 0)>(vb), h3 = tr_read<v_rd_off(D0, 3, 1)>(vb);
  asm volatile("s_waitcnt lgkmcnt(0)" ::: "memory"); SBAR();
#define PK(L, H) (bf16x8){L[0], L[1], L[2], L[3], H[0], H[1], H[2], H[3]}
  od = __builtin_amdgcn_mfma_f32_32x32x16_bf16(pa0, PK(l0, h0), od, 0, 0, 0);
  od = __builtin_amdgcn_mfma_f32_32x32x16_bf16(pa1, PK(l1, h1), od, 0, 0, 0);
  od = __builtin_amdgcn_mfma_f32_32x32x16_bf16(pa2, PK(l2, h2), od, 0, 0, 0);
  od = __builtin_amdgcn_mfma_f32_32x32x16_bf16(pa3, PK(l3, h3), od, 0, 0, 0);
#undef PK
}
__device__ __forceinline__ void pv_d0(f32x16* o, int vb, bf16x8 pa0, bf16x8 pa1, bf16x8 pa2, bf16x8 pa3) {
  pv_one<0>(o[0], vb, pa0, pa1, pa2, pa3); pv_one<1>(o[1], vb, pa0, pa1, pa2, pa3); pv_one<2>(o[2], vb, pa0, pa1, pa2, pa3); pv_one<3>(o[3], vb, pa0, pa1, pa2, pa3);
}
__device__ __forceinline__ void moba_mask(f32x16& p0, f32x16& p1, int tile, int qb, unsigned sel, int qi, int w0, int hi) {
  const float NINF = -__builtin_inff();
  const int jb = tile >> 2;
  if (jb < qb) {
    const bool ok = ((sel >> jb) & 1u) != 0u;
    if (!__all(ok)) {
#pragma unroll
      for (int r = 0; r < 16; ++r) { p0[r] = ok ? p0[r] : NINF; p1[r] = ok ? p1[r] : NINF; }
    }
  } else {
    const int k0 = (tile & 3) * 64;
    if (k0 + 63 > w0) {
      int lim = qi - k0 - 4 * hi; asm volatile("" : "+v"(lim));
#pragma unroll
      for (int r = 0; r < 16; ++r) { const int kc = (r & 3) + 8 * (r >> 2); p0[r] = (kc <= lim) ? p0[r] : NINF; p1[r] = (kc + 32 <= lim) ? p1[r] : NINF; }
    }
  }
}

template <bool MOBA, int LDQ, int LDK, int LDO, int SDEPTH>
__device__ __forceinline__ void attn_body(const bf16* __restrict__ Qb, const bf16* __restrict__ Kh, const bf16* __restrict__ Vh, bf16* __restrict__ Ob, int seq, lptr lds,
                                          int qb, const float* __restrict__ kms, int kms_stride, float* __restrict__ ssq) {
  int tid_ = threadIdx.x; asm volatile("" : "+v"(tid_));
  const int tid = tid_, wid = tid >> 6, lane = tid & 63, r32 = lane & 31, hi = lane >> 5;
  lptr V_lds = lds; lptr K_lds = lds + 2 * SHM_V;
  ATT_LAS float* ws = (ATT_LAS float*)(lds + 2 * SHM_V + 2 * SHM_K) + wid * 64; ATT_LAS float* li_l = ws; ATT_LAS float* al_l = ws + 32;
  float m_reg = -1e30f, l_reg = 0; f32x16 o[4] = {}; bf16x8 qr[8];
  unsigned qoff = (unsigned)((wid * QBLK + r32) * LDQ + hi * 8); asm volatile("" : "+v"(qoff));
  const bf16* Qw = Qb + qoff;
#pragma unroll
  for (int d0 = 0; d0 < 8; ++d0) qr[d0] = *reinterpret_cast<const bf16x8*>(Qw + d0 * 16);
  const int sr = tid >> 4, sc = (tid & 15) * 8, vst0 = v_st(sr, sc), vst1 = v_st(32 + sr, sc);
  const int vb0 = (int)(uintptr_t)V_lds + v_rd_base(lane);
  struct { bf16x8 vs0, vs1, ks0, ks1; } sr_[SDEPTH];
  const unsigned so0 = (unsigned)(sr * LDK + sc), so1 = (unsigned)((32 + sr) * LDK + sc);
#define SLOAD(i, k0) do { const bf16* Vt_ = Vh + (long)(k0) * LDK; const bf16* Kt_ = Kh + (long)(k0) * LDK; \
    sr_[i].vs0 = *reinterpret_cast<const bf16x8*>(Vt_ + so0); sr_[i].vs1 = *reinterpret_cast<const bf16x8*>(Vt_ + so1); \
    sr_[i].ks0 = *reinterpret_cast<const bf16x8*>(Kt_ + so0); sr_[i].ks1 = *reinterpret_cast<const bf16x8*>(Kt_ + so1); } while (0)
#define SWRITE(b, i) do { *(ATT_LAS bf16x8*)(V_lds + (b) * SHM_V + vst0) = sr_[i].vs0;          \
    *(ATT_LAS bf16x8*)(V_lds + (b) * SHM_V + vst1) = sr_[i].vs1; int kc = sc * 2;               \
    *(ATT_LAS bf16x8*)(K_lds + (b) * SHM_K + KSWZ(sr, kc)) = sr_[i].ks0;                       \
    *(ATT_LAS bf16x8*)(K_lds + (b) * SHM_K + KSWZ(32 + sr, kc)) = sr_[i].ks1; } while (0)
#define SWAIT() do { if constexpr (SDEPTH == 2) asm volatile("s_waitcnt vmcnt(4)" ::: "memory"); else asm volatile("s_waitcnt vmcnt(0)" ::: "memory"); } while (0)
#define RESC(a) do { if (__any((a) < 1.f)) { if (hi == 0) al_l[r32] = (a); asm volatile("s_waitcnt lgkmcnt(0)" ::: "memory"); \
    _Pragma("unroll") for (int d = 0; d < 4; ++d) _Pragma("unroll") for (int r = 0; r < 16; ++r) o[d][r] *= al_l[crow(r, hi)]; } } while (0)
  f32x16 pA0, pA1, pB0, pB1; float mnA, mnB, alA, alB; bf16x8 pa0, pa1, pa2, pa3; const int NT = seq / KVBLK;
  constexpr int SE = 0, SO = SDEPTH - 1;
  unsigned sel = 0u; const int qi = wid * QBLK + r32, w0 = wid * QBLK;
  SLOAD(SE, 0);
  if constexpr (MOBA) {
    { const int j = sr & 15; const float* src = kms + (size_t)j * kms_stride + sc; const float4 x0 = *reinterpret_cast<const float4*>(src), x1 = *reinterpret_cast<const float4*>(src + 4);
      const float xv[8] = {x0.x, x0.y, x0.z, x0.w, x1.x, x1.y, x1.z, x1.w}; unsigned w[4];
#pragma unroll
      for (int e = 0; e < 4; ++e) { const unsigned h2 = cvtpk(xv[2 * e], xv[2 * e + 1]); const float f0 = __uint_as_float(h2 << 16), f1 = __uint_as_float(h2 & 0xffff0000u);
        const unsigned l2 = cvtpk(xv[2 * e] - f0, xv[2 * e + 1] - f1); w[e] = (sr < 16) ? h2 : l2; }
      u32x4 wv = {w[0], w[1], w[2], w[3]}; *(ATT_LAS u32x4*)(K_lds + KSWZ(sr, sc * 2)) = wv; }
    __syncthreads();
    f32x16 g = f32x16{};
#pragma unroll
    for (int d0 = 0; d0 < 8; ++d0) { const int cb = (d0 * 16 + hi * 8) * 2; const bf16x8 b0 = *reinterpret_cast<const ATT_LAS bf16x8*>(K_lds + KSWZ(r32, cb));
      g = __builtin_amdgcn_mfma_f32_32x32x16_bf16(b0, qr[d0], g, 0, 0, 0); }
    float G[16];
#pragma unroll
    for (int r = 0; r < 8; ++r) { const float own = g[r] + g[r + 8]; const float oth = __shfl_xor(own, 32); const int lb = (r & 3) + 8 * (r >> 2);
      G[lb] = hi ? oth : own; G[lb + 4] = hi ? own : oth; }
    const float NINF = -__builtin_inff();
#pragma unroll
    for (int j = 0; j < 16; ++j) G[j] = (j < qb) ? G[j] : NINF;
#pragma unroll
    for (int it = 0; it < 3; ++it) { float mx = NINF; int mi = -1;
#pragma unroll
      for (int j = 0; j < 16; ++j) { const bool gt = G[j] > mx; mx = gt ? G[j] : mx; mi = gt ? j : mi; }
      if (mi >= 0) sel |= 1u << mi;
#pragma unroll
      for (int j = 0; j < 16; ++j) G[j] = (j == mi) ? NINF : G[j]; }
    __syncthreads();
  }
  asm volatile("s_waitcnt vmcnt(0)" ::: "memory"); SWRITE(0, SE); __syncthreads();
  qkt(pA0, pA1, K_lds, qr, r32, hi);
  if constexpr (MOBA) moba_mask(pA0, pA1, 0, qb, sel, qi, w0, hi);
  partialSM(pA0, pA1, m_reg, mnA, alA);
  SLOAD(SO, KVBLK); if constexpr (SDEPTH == 2) { if (2 < NT) SLOAD(SE, 2 * KVBLK); }
  SWAIT(); SWRITE(1, SO); __syncthreads();
  for (int j = 1; j + 1 < NT; j += 2) {
    SBAR(); qkt(pB0, pB1, K_lds + SHM_K, qr, r32, hi);
    finishSM(pA0, pA1, alA, l_reg, pa0, pa1, pa2, pa3); SBAR();
    SLOAD(SO, (j + SDEPTH) * KVBLK); SBAR();
    pv_d0(o, vb0, pa0, pa1, pa2, pa3);
    if constexpr (MOBA) moba_mask(pB0, pB1, j, qb, sel, qi, w0, hi);
    partialSM(pB0, pB1, m_reg, mnB, alB);
    __syncthreads(); SWAIT(); SWRITE(0, SE);
    RESC(alB); __syncthreads();
    SBAR(); qkt(pA0, pA1, K_lds, qr, r32, hi);
    finishSM(pB0, pB1, alB, l_reg, pa0, pa1, pa2, pa3); SBAR();
    if (SDEPTH == 1 || j + 3 < NT) SLOAD(SE, (j + 1 + SDEPTH) * KVBLK); SBAR();
    pv_d0(o, vb0 + SHM_V, pa0, pa1, pa2, pa3);
    if constexpr (MOBA) moba_mask(pA0, pA1, j + 1, qb, sel, qi, w0, hi);
    partialSM(pA0, pA1, m_reg, mnA, alA);
    __syncthreads(); SWAIT(); SWRITE(1, SO);
    RESC(alA); __syncthreads();
  }
  SBAR(); qkt(pB0, pB1, K_lds + SHM_K, qr, r32, hi);
  finishSM(pA0, pA1, alA, l_reg, pa0, pa1, pa2, pa3); SBAR();
  pv_d0(o, vb0, pa0, pa1, pa2, pa3);
  if constexpr (MOBA) moba_mask(pB0, pB1, NT - 1, qb, sel, qi, w0, hi);
  partialSM(pB0, pB1, m_reg, mnB, alB);
  __syncthreads(); RESC(alB);
  finishSM(pB0, pB1, alB, l_reg, pa0, pa1, pa2, pa3); SBAR();
  pv_d0(o, vb0 + SHM_V, pa0, pa1, pa2, pa3);
  if (hi == 0) li_l[r32] = l_reg; asm volatile("s_waitcnt lgkmcnt(0)" ::: "memory");
  float rli[16];
#pragma unroll
  for (int r = 0; r < 16; ++r) rli[r] = __builtin_amdgcn_rcpf(li_l[crow(r, hi)]);
  int ohi = hi * 4, ocol = r32; asm volatile("" : "+v"(ohi), "+v"(ocol));
  bf16* Ow = Ob + (long)(wid * QBLK) * LDO;
#pragma unroll
  for (int r = 0; r < 16; ++r) { const int orow = (r & 3) + 8 * (r >> 2) + ohi; float sq = 0.f;
#pragma unroll
    for (int d0 = 0; d0 < 4; ++d0) { const float v = o[d0][r] * rli[r]; sq += v * v; Ow[(unsigned)(orow * LDO + d0 * 32 + ocol)] = (bf16)(cvtpk(v, v) & 0xffffu); }
    if constexpr (MOBA) { sq += __shfl_xor(sq, 1); sq += __shfl_xor(sq, 2); sq += __shfl_xor(sq, 4); sq += __shfl_xor(sq, 8); sq += __shfl_xor(sq, 16);
      if (ocol == 0) unsafeAtomicAdd(ssq + wid * QBLK + orow, sq); } }
  __syncthreads();
#undef SLOAD
#undef SWRITE
#undef SWAIT
#undef RESC
}
#undef KSWZ
#undef SBAR
}

constexpr int NWAVES = 8;
constexpr int BATCH = 4, SEQ = 4096, D = 2048, M = BATCH * SEQ, FF = 5632, AW = 1024, CW = 1024, INW = 6144, MEML = 256, XW = 512, NH = 8, XH = 4, NBLK = 16;
constexpr int NPH = 13;
#ifndef FAST_MASK
#define FAST_MASK 0x1fff
#endif
#ifndef ONE_LAUNCH
#define ONE_LAUNCH 1
#endif
constexpr size_t MiB = 1u << 20, KiB = 1u << 10;
constexpr size_t WS_CTL = 0, CTL_ZERO_BYTES = 1 * MiB;
constexpr size_t CTL_BAR = 64 * KiB, BAR_STRIDE = 16 * KiB;
constexpr size_t CTL_SS = 320 * KiB;
constexpr size_t CTL_KMS = 704 * KiB;
constexpr size_t WS_WGU1 = 2 * MiB, WS_WD1 = 46 * MiB, WS_WGU2 = 68 * MiB, WS_WD2 = 112 * MiB, WS_WIN = 134 * MiB, WS_WOUT = 158 * MiB, WS_WQ = 166 * MiB, WS_WKV = 168 * MiB, WS_WO = 172 * MiB;
constexpr size_t WS_MEMN = 174 * MiB, WS_KVX = 178 * MiB, WS_HB = 180 * MiB, WS_MIXED = 244 * MiB, WS_ACT = 308 * MiB;
constexpr size_t WS_Q = 308 * MiB, WS_K = 340 * MiB, WS_V = 372 * MiB, WS_CU = 404 * MiB, WS_BG = 436 * MiB;
constexpr size_t WS_QX = 308 * MiB, WS_OX = 324 * MiB;
constexpr size_t WS_DUMMY = 484 * MiB;
constexpr size_t WS_END = 486 * MiB;
static_assert(WS_ACT + (size_t)M * FF * 2 <= WS_END && WS_BG + (size_t)M * 1024 * 2 <= WS_END && CTL_KMS + BATCH * 16 * 8 * 128 * 4 <= CTL_ZERO_BYTES && CTL_SS + 6 * M * 4 <= CTL_KMS, "d_ws map");
constexpr int RING_OFF = 0, RING_BYTES = 131072;
constexpr int LDSCTL_OFF = RING_BYTES, MISC_OFF = LDSCTL_OFF + 320;
constexpr int LDS_BYTES = 147456;
static_assert(MISC_OFF + 128 <= LDS_BYTES && att::SHM_ATTN <= RING_BYTES, "LDS map");

#define GAS __attribute__((address_space(1)))
#define LAS __attribute__((address_space(3)))
typedef unsigned short bf16;
typedef unsigned v4u __attribute__((ext_vector_type(4)));
typedef unsigned v2u __attribute__((ext_vector_type(2)));
typedef float f32x4 __attribute__((ext_vector_type(4)));
typedef short bf16x8 __attribute__((ext_vector_type(8)));
typedef GAS unsigned gu32;
#define RLX_AGENT __ATOMIC_RELAXED, __HIP_MEMORY_SCOPE_AGENT
#define LDS_WAIT() asm volatile("s_waitcnt lgkmcnt(0)" ::: "memory")
#define VM_WAIT() asm volatile("s_waitcnt vmcnt(0)" ::: "memory")
__device__ __forceinline__ unsigned pk2(float lo, float hi) { return pg8::cvt_pk_bf16(lo, hi); }
__device__ __forceinline__ float bflo(unsigned w) { return __uint_as_float(w << 16); }
__device__ __forceinline__ float bfhi(unsigned w) { return __uint_as_float(w & 0xffff0000u); }
__device__ __forceinline__ float wave_sum(float v) {
#pragma unroll
    for (int o = 1; o < 64; o <<= 1) v += __shfl_xor(v, o);
    return v;
}
#define XB_TMO      128
#define XB_XCNT(j)  (256  + 64 * (j))
#define XB_XSUB(j)  (1280 + 64 * (j))
#define XB_XGEN(j)  (2304 + 64 * (j))
#define XB_TOP      3328
#define XB_TOPGEN   3392
#define XCD_BAR_WORDS 3456
#define XB_SPIN_CAP (1u << 18)

__device__ __forceinline__ unsigned xb_ld(unsigned* p)              { return __hip_atomic_load(p, __ATOMIC_RELAXED, __HIP_MEMORY_SCOPE_AGENT); }
__device__ __forceinline__ unsigned xb_add(unsigned* p, unsigned v) { return __hip_atomic_fetch_add(p, v, __ATOMIC_RELAXED, __HIP_MEMORY_SCOPE_AGENT); }
__device__ __forceinline__ unsigned xb_xcc_id() { return (unsigned)__builtin_amdgcn_s_getreg((3 << 11) | 20) & 0xFu; }
#define XB_SPIN(cond, bar) do { unsigned _sp = 0; while (cond) { __builtin_amdgcn_s_sleep(1); \
    if ((++_sp & 255u) == 0u) { if (xb_ld(&(bar)[XB_TMO])) break; if (_sp > XB_SPIN_CAP) { atomicAdd(&(bar)[XB_TMO], 1u); break; } } } } while (0)

struct XcdBarrier {
    unsigned* bar; unsigned x;
    volatile LAS unsigned* st;
};

__device__ __forceinline__ XcdBarrier xcd_barrier_post(unsigned* bar, volatile LAS unsigned* st) {
    XcdBarrier b; b.bar = bar; b.x = xb_xcc_id(); b.st = st;
    if (threadIdx.x == 0) (void)xb_add(&bar[XB_XCNT(b.x)], 1u);
    return b;
}
__device__ __forceinline__ void xcd_barrier_complete(unsigned* bar, unsigned x, unsigned& nloc, unsigned& nx) {
    const unsigned G = gridDim.x * gridDim.y * gridDim.z;
    unsigned sum, cnt, mine, sp = 0u;
    for (;;) {
        sum = 0u; cnt = 0u; mine = 0u;
#pragma unroll
        for (unsigned j = 0; j < 16; ++j) { const unsigned c = xb_ld(&bar[XB_XCNT(j)]); sum += c; cnt += (c > 0u) ? 1u : 0u; mine = (j == x) ? c : mine; }
        if (sum == G) break;
        __builtin_amdgcn_s_sleep(1);
        if ((++sp & 255u) == 0u) { if (xb_ld(&bar[XB_TMO])) break; if (sp > XB_SPIN_CAP) { atomicAdd(&bar[XB_TMO], 1u); break; } }
    }
    nloc = mine > 0u ? mine : 1u; nx = cnt > 0u ? cnt : 1u;
}

__device__ __forceinline__ void xcd_barrier(const XcdBarrier& b) {
    asm volatile("s_waitcnt vmcnt(0)" ::: "memory");
    __syncthreads();
    if (threadIdx.x == 0) {
        unsigned* bar = b.bar;
        __builtin_amdgcn_s_waitcnt(0);
        unsigned nloc = b.st[0], nx = b.st[1];
        if (nloc == 0u) { xcd_barrier_complete(bar, b.x, nloc, nx); b.st[0] = nloc; b.st[1] = nx; }
        const unsigned old = xb_add(&bar[XB_XSUB(b.x)], 1u);
        const unsigned gen = old / nloc;
        if (old + 1u == (gen + 1u) * nloc) {
            __builtin_amdgcn_fence(__ATOMIC_RELEASE, "agent");
            asm volatile("s_waitcnt vmcnt(0)" ::: "memory");
            const unsigned og = xb_add(&bar[XB_TOP], 1u);
            const unsigned tg = og / nx;
            if (og + 1u == (tg + 1u) * nx) xb_add(&bar[XB_TOPGEN], 1u);
            else XB_SPIN(xb_ld(&bar[XB_TOPGEN]) == tg, bar);
            __builtin_amdgcn_fence(__ATOMIC_ACQUIRE, "agent");
            xb_add(&bar[XB_XGEN(b.x)], 1u);
            asm volatile("s_waitcnt vmcnt(0)" ::: "memory");
        } else {
            XB_SPIN(xb_ld(&bar[XB_XGEN(b.x)]) == gen, bar);
            __builtin_amdgcn_fence(__ATOMIC_ACQUIRE, "agent");
            asm volatile("s_waitcnt vmcnt(0)" ::: "memory");
        }
    }
    __syncthreads();
}

namespace nv {
typedef float f32x4 __attribute__((ext_vector_type(4)));
typedef short bf16x8 __attribute__((ext_vector_type(8)));
constexpr float EPS = 1e-6f;
template <class F> __global__ __launch_bounds__(256) void gemm(const bf16* __restrict__ A, const bf16* __restrict__ Bt, int K, F f) {
    const int wave = threadIdx.x >> 6, lane = threadIdx.x & 63;
    const int row0 = blockIdx.y * 64 + wave * 16, col0 = blockIdx.x * 64;
    f32x4 acc[4], acc2[4];
#pragma unroll
    for (int c = 0; c < 4; ++c) { acc[c] = (f32x4){0.f, 0.f, 0.f, 0.f}; acc2[c] = (f32x4){0.f, 0.f, 0.f, 0.f}; }
    const bf16* ap = A + (size_t)(row0 + (lane & 15)) * K + 8 * (lane >> 4);
    const bf16* bp[4]; const bf16* bp2[4];
#pragma unroll
    for (int c = 0; c < 4; ++c) { const int col = col0 + 16 * c + (lane & 15); bp[c] = Bt + (size_t)f.brow(col) * K + 8 * (lane >> 4); bp2[c] = Bt + (size_t)f.brow2(col) * K + 8 * (lane >> 4); }
    for (int k0 = 0; k0 < K; k0 += 32) {
        if (F::MIDK > 0 && k0 == F::MIDK) {
#pragma unroll
            for (int j = 0; j < 4; ++j) { const float s = f.midscale(row0 + (lane >> 4) * 4 + j);
#pragma unroll
                for (int c = 0; c < 4; ++c) acc[c][j] *= s; }
        }
        const bf16x8 a = *(const bf16x8*)(ap + k0);
#pragma unroll
        for (int c = 0; c < 4; ++c) { const bf16x8 b = *(const bf16x8*)(bp[c] + k0); acc[c] = __builtin_amdgcn_mfma_f32_16x16x32_bf16(a, b, acc[c], 0, 0, 0);
            if (F::DUAL) { const bf16x8 b2 = *(const bf16x8*)(bp2[c] + k0); acc2[c] = __builtin_amdgcn_mfma_f32_16x16x32_bf16(a, b2, acc2[c], 0, 0, 0); } }
    }
#pragma unroll
    for (int j = 0; j < 4; ++j) { const int row = row0 + (lane >> 4) * 4 + j; float sq = 0.f;
#pragma unroll
        for (int c = 0; c < 4; ++c) { const float h = f.store(row, col0 + 16 * c + (lane & 15), acc[c][j], acc2[c][j]); sq += h * h; }
        if (F::ROWSS) { sq += __shfl_xor(sq, 1); sq += __shfl_xor(sq, 2); sq += __shfl_xor(sq, 4); sq += __shfl_xor(sq, 8); if ((lane & 15) == 0) f.addss(row, sq); } }
}
__device__ __forceinline__ bf16 tobf(float v) { return (bf16)(pg8::cvt_pk_bf16(v, v) & 0xffffu); }
struct FSwiglu { static constexpr bool DUAL = true, ROWSS = false; static constexpr int MIDK = 0; bf16* O; const float* ss;
    __device__ int brow(int col) const { return (col >> 7) * 256 + (col & 127); } __device__ int brow2(int col) const { return brow(col) + 128; } __device__ float midscale(int) const { return 1.f; } __device__ void addss(int, float) const {}
    __device__ float store(int row, int col, float a, float a2) const { const float rs = rsqrtf(ss[row] * (1.0f / 2048.0f) + EPS), g = a * rs, u = a2 * rs; O[(size_t)row * FF + col] = tobf(g / (1.0f + __expf(-g)) * u); return 0.f; } };
template <int MIDK_, bool RBF, bool OF32> struct FResid { static constexpr bool DUAL = false, ROWSS = true; static constexpr int MIDK = MIDK_; const float* R; const bf16* RB; float* H; bf16* HB; float* ssn; float alpha; const float* midss;
    __device__ int brow(int col) const { return col; } __device__ int brow2(int col) const { return col; } __device__ float midscale(int row) const { return rsqrtf(midss[row] * (1.0f / 1024.0f) + EPS); }
    __device__ void addss(int row, float s) const { unsafeAtomicAdd(ssn + row, s); }
    __device__ float store(int row, int col, float a, float) const { const size_t o = (size_t)row * 2048 + col; const float r = RBF ? __uint_as_float((unsigned)RB[o] << 16) : R[o]; const float h = r + alpha * a; if (OF32) H[o] = h; else HB[o] = tobf(h); return h; } };
struct FWin { static constexpr bool DUAL = true, ROWSS = false; static constexpr int MIDK = 0; bf16 *Q, *K, *V, *CU, *BG; const float* ss;
    __device__ int brow(int col) const { if (col < 3072) return col; if (col < 4096) { const int j = col - 3072; return 3072 + (j >> 7) * 256 + (j & 127); } return 5120 + (col - 4096); }
    __device__ int brow2(int col) const { return (col >= 3072 && col < 4096) ? brow(col) + 128 : brow(col); } __device__ float midscale(int) const { return 1.f; } __device__ void addss(int, float) const {}
    __device__ float store(int row, int col, float a, float a2) const { const float rs = rsqrtf(ss[row] * (1.0f / 2048.0f) + EPS); const size_t o = (size_t)row * 1024 + (col & 1023);
        if (col < 1024) Q[o] = tobf(a * rs); else if (col < 2048) K[o] = tobf(a * rs); else if (col < 3072) V[o] = tobf(a * rs); else if (col < 4096) CU[o] = tobf((a * rs) * (a2 * rs)); else BG[o] = tobf(a * rs); return 0.f; } };
struct FScale { static constexpr bool DUAL = false, ROWSS = false; static constexpr int MIDK = 0; bf16* O; int ldo; const float* ss;
    __device__ int brow(int col) const { return col; } __device__ int brow2(int col) const { return col; } __device__ float midscale(int) const { return 1.f; } __device__ void addss(int, float) const {}
    __device__ float store(int row, int col, float a, float) const { const float rs = ss ? rsqrtf(ss[row] * (1.0f / 2048.0f) + EPS) : 1.0f; O[(size_t)row * ldo + col] = tobf(a * rs); return 0.f; } };
__global__ __launch_bounds__(256) void kmean(const bf16* __restrict__ K, float* __restrict__ kms) {
    const int i = blockIdx.x * 256 + threadIdx.x; const int d = i & 127, h = (i >> 7) & 7, bb = i >> 10;
    float s = 0.f; for (int r = 0; r < 256; ++r) s += __uint_as_float((unsigned)K[((size_t)bb * 256 + r) * 1024 + h * 128 + d] << 16);
    kms[i] = s;
}
__global__ __launch_bounds__(256) void moba(const bf16* __restrict__ Q, const bf16* __restrict__ K, const bf16* __restrict__ V, const float* __restrict__ kms, bf16* __restrict__ AO, float* __restrict__ ssA) {
    const int wave = threadIdx.x >> 6, lane = threadIdx.x & 63; const int idx = blockIdx.x * 4 + wave; const int h = idx & 7, row = idx >> 3, b = row >> 12, t = row & 4095, qb = t >> 8;
    const unsigned qw = *(const unsigned*)(Q + (size_t)row * 1024 + h * 128 + 2 * lane); const float q0 = bflo(qw), q1 = bfhi(qw);
    unsigned sel = 0u;
    { float g[16];
#pragma unroll
      for (int j = 0; j < 16; ++j) { const float* km = kms + ((size_t)(b * 16 + j) * 8 + h) * 128 + 2 * lane; const float p = wave_sum(q0 * km[0] + q1 * km[1]); g[j] = (j < qb) ? p : -__builtin_inff(); }
#pragma unroll
      for (int it = 0; it < 3; ++it) { float mx = -__builtin_inff(); int mi = -1;
#pragma unroll
        for (int j = 0; j < 16; ++j) { const bool gt = g[j] > mx; mx = gt ? g[j] : mx; mi = gt ? j : mi; }
        if (mi >= 0) sel |= 1u << mi;
#pragma unroll
        for (int j = 0; j < 16; ++j) g[j] = (j == mi) ? -__builtin_inff() : g[j]; } }
    sel |= 1u << qb;
    float m = -1e30f, l = 0.f, o0 = 0.f, o1 = 0.f;
    for (int jb = 0; jb <= qb; ++jb) { if (!((sel >> jb) & 1u)) continue;
        const int nk = (jb < qb) ? 256 : (t & 255) + 1;
        for (int kk = 0; kk < nk; ++kk) { const size_t ko = ((size_t)b * 4096 + jb * 256 + kk) * 1024 + h * 128 + 2 * lane;
            const unsigned kw = *(const unsigned*)(K + ko), vw = *(const unsigned*)(V + ko);
            const float s = wave_sum(q0 * bflo(kw) + q1 * bfhi(kw)) * 0.088388347648318440f;
            const float mn = fmaxf(m, s), a = __expf(m - mn), p = __expf(s - mn);
            l = l * a + p; o0 = o0 * a + p * bflo(vw); o1 = o1 * a + p * bfhi(vw); m = mn; } }
    const float il = 1.0f / l; o0 *= il; o1 *= il;
    *(unsigned*)(AO + (size_t)row * 2048 + h * 128 + 2 * lane) = pk2(o0, o1);
    const float sq = wave_sum(o0 * o0 + o1 * o1); if (lane == 0) unsafeAtomicAdd(ssA + row, sq);
}
__global__ __launch_bounds__(256) void xattn(const bf16* __restrict__ QX, const bf16* __restrict__ KVX, bf16* __restrict__ OX) {
    const int wave = threadIdx.x >> 6, lane = threadIdx.x & 63; const int idx = blockIdx.x * 4 + wave; const int h = idx & 3, row = idx >> 2, b = row >> 12;
    const unsigned qw = *(const unsigned*)(QX + (size_t)row * 512 + h * 128 + 2 * lane); const float q0 = bflo(qw), q1 = bfhi(qw);
    float m = -1e30f, l = 0.f, o0 = 0.f, o1 = 0.f;
    for (int kk = 0; kk < 256; ++kk) { const size_t ko = ((size_t)b * 256 + kk) * 1024 + h * 128 + 2 * lane;
        const unsigned kw = *(const unsigned*)(KVX + ko), vw = *(const unsigned*)(KVX + ko + 512);
        const float s = wave_sum(q0 * bflo(kw) + q1 * bfhi(kw)) * 0.088388347648318440f;
        const float mn = fmaxf(m, s), a = __expf(m - mn), p = __expf(s - mn);
        l = l * a + p; o0 = o0 * a + p * bflo(vw); o1 = o1 * a + p * bfhi(vw); m = mn; }
    const float il = 1.0f / l;
    *(unsigned*)(OX + (size_t)row * 512 + h * 128 + 2 * lane) = pk2(o0 * il, o1 * il);
}
}


struct Frame {
    LAS unsigned char* lds;
    volatile LAS unsigned* MISC;
    int tid, lane, wave;
    int vcu, G;
};
struct Args { const float* in[22]; float* out; unsigned char* ws; int ph_lo, ph_hi; };
enum { I_X = 0, I_MEM, I_F1N, I_F1G, I_F1U, I_F1D, I_MIXN, I_WIN, I_CONVW, I_AON, I_CON, I_WOUT, I_XN, I_MEMNRM, I_XQ, I_XKV, I_XO, I_F2N, I_F2G, I_F2U, I_F2D, I_FINAL };

__device__ __forceinline__ void p0_transpose_item(const float* W, int pitch, const float* gain, bf16* WT, int dstK, int dkoff, int drow0, int k0, LAS float* scr, int lane) {
    float v[32];
    const float* wp = W + (size_t)(k0 + (lane >> 5)) * pitch + (lane & 31);
#pragma unroll
    for (int i = 0; i < 32; ++i) v[i] = wp[(size_t)(2 * i) * pitch];
    const int c = lane & 7;
    f32x4 g0 = (f32x4){1.f, 1.f, 1.f, 1.f}, g1 = g0;
    if (gain) { g0 = *(const GAS f32x4*)(gain + k0 + 8 * c); g1 = *(const GAS f32x4*)(gain + k0 + 8 * c + 4); }
#pragma unroll
    for (int i = 0; i < 32; ++i) scr[(2 * i + (lane >> 5)) * 33 + (lane & 31)] = v[i];
    LDS_WAIT(); asm volatile("" ::: "memory");
#pragma unroll
    for (int j = 0; j < 4; ++j) { const int n = (lane >> 3) + 8 * j; const LAS float* s = scr + (8 * c) * 33 + n;
        v4u o; o.x = pk2(s[0 * 33] * g0.x, s[1 * 33] * g0.y); o.y = pk2(s[2 * 33] * g0.z, s[3 * 33] * g0.w); o.z = pk2(s[4 * 33] * g1.x, s[5 * 33] * g1.y); o.w = pk2(s[6 * 33] * g1.z, s[7 * 33] * g1.w);
        *(GAS v4u*)(WT + (size_t)(drow0 + n) * dstK + dkoff + k0 + 8 * c) = o; }
    LDS_WAIT(); asm volatile("" ::: "memory");
}
__device__ __forceinline__ void p0_prologue(Frame& F_, const Args& a) {
    Frame F = F_; asm volatile("" : "+v"(F.lane));
    LAS float* scr = (LAS float*)(F.lds + RING_OFF + F.wave * 16384);
    const int gw = F.vcu * NWAVES + F.wave, NGW = F.G * NWAVES;
    unsigned char* ws = a.ws;
    constexpr int I_FF = (D / 64) * (FF / 32), I_FD = (FF / 64) * (D / 32), I_IN = (D / 64) * (1024 / 32), I_OUT = (1024 / 64) * (D / 32), I_XQn = (D / 64) * (XW / 32), I_XKVn = (D / 64) * (1024 / 32), I_XOn = (XW / 64) * (D / 32);
    constexpr int NITEMS = 4 * I_FF + 2 * I_FD + 6 * I_IN + 2 * I_OUT + I_XQn + I_XKVn + I_XOn;
    for (int it = gw; it < NITEMS; it += NGW) {
        int r = it; const float* src = nullptr; const float* gain = nullptr; bf16* dst = nullptr; int pitch = 0, ncols = 0, dstK = 0, dkoff = 0, rowoff = 0, mode = 0; bool hit = false;
#define JOB(cnt, SRC, PITCH, NCOLS, GAIN, DST, DSTK, DKOFF, ROWOFF, MODE) if (!hit) { if (r < (cnt)) { hit = true; src = (SRC); pitch = (PITCH); ncols = (NCOLS); gain = (GAIN); dst = (bf16*)(ws + (DST)); dstK = (DSTK); dkoff = (DKOFF); rowoff = (ROWOFF); mode = (MODE); } else r -= (cnt); }
        JOB(I_FF, a.in[I_F1G], FF, FF, a.in[I_F1N], WS_WGU1, D, 0, 0, 1)
        JOB(I_FF, a.in[I_F1U], FF, FF, a.in[I_F1N], WS_WGU1, D, 0, 0, 2)
        JOB(I_FD, a.in[I_F1D], D, D, nullptr, WS_WD1, FF, 0, 0, 0)
        JOB(I_FF, a.in[I_F2G], FF, FF, a.in[I_F2N], WS_WGU2, D, 0, 0, 1)
        JOB(I_FF, a.in[I_F2U], FF, FF, a.in[I_F2N], WS_WGU2, D, 0, 0, 2)
        JOB(I_FD, a.in[I_F2D], D, D, nullptr, WS_WD2, FF, 0, 0, 0)
        JOB(I_IN, a.in[I_WIN] + 0, INW, 1024, a.in[I_MIXN], WS_WIN, D, 0, 0, 0)
        JOB(I_IN, a.in[I_WIN] + 1024, INW, 1024, a.in[I_MIXN], WS_WIN, D, 0, 1024, 0)
        JOB(I_IN, a.in[I_WIN] + 2048, INW, 1024, a.in[I_MIXN], WS_WIN, D, 0, 2048, 0)
        JOB(I_IN, a.in[I_WIN] + 3072, INW, 1024, a.in[I_MIXN], WS_WIN, D, 0, 3072, 1)
        JOB(I_IN, a.in[I_WIN] + 5120, INW, 1024, a.in[I_MIXN], WS_WIN, D, 0, 3072, 2)
        JOB(I_IN, a.in[I_WIN] + 4096, INW, 1024, a.in[I_MIXN], WS_WIN, D, 0, 5120, 0)
        JOB(I_OUT, a.in[I_WOUT], D, D, a.in[I_AON], WS_WOUT, D, 0, 0, 0)
        JOB(I_OUT, a.in[I_WOUT] + (size_t)1024 * D, D, D, a.in[I_CON], WS_WOUT, D, 1024, 0, 0)
        JOB(I_XQn, a.in[I_XQ], XW, XW, a.in[I_XN], WS_WQ, D, 0, 0, 0)
        JOB(I_XKVn, a.in[I_XKV], 1024, 1024, nullptr, WS_WKV, D, 0, 0, 0)
        JOB(I_XOn, a.in[I_XO], D, D, nullptr, WS_WO, XW, 0, 0, 0)
#undef JOB
        const int nblk = ncols / 32, kb = r / nblk, nb = r % nblk, k0 = 64 * kb, n0 = 32 * nb;
        const int drow0 = rowoff + (mode ? (n0 >> 7) * 256 + (n0 & 127) + (mode == 2 ? 128 : 0) : n0);
        p0_transpose_item(src + n0, pitch, gain, dst, dstK, dkoff, drow0, k0, scr, F.lane);
    }
    { bf16* HB = (bf16*)(ws + WS_HB); float* ss0 = (float*)(ws + WS_CTL + CTL_SS);
      for (int m = gw; m < M; m += NGW) { const GAS f32x4* xr = (const GAS f32x4*)(a.in[I_X] + (size_t)m * D) + F.lane; GAS v2u* o8 = (GAS v2u*)(HB + (size_t)m * D) + F.lane; float s = 0.f;
#pragma unroll
          for (int j = 0; j < 8; ++j) { const f32x4 v = xr[64 * j]; s += (v.x * v.x + v.y * v.y) + (v.z * v.z + v.w * v.w); v2u w; w.x = pk2(v.x, v.y); w.y = pk2(v.z, v.w); o8[64 * j] = w; }
          s = wave_sum(s); if (F.lane == 0) ss0[m] = s; } }
    { bf16* MN = (bf16*)(ws + WS_MEMN); const float* gm = a.in[I_MEMNRM];
      for (int m = gw; m < BATCH * MEML; m += NGW) { const GAS f32x4* xr = (const GAS f32x4*)(a.in[I_MEM] + (size_t)m * D) + F.lane; GAS v2u* o8 = (GAS v2u*)(MN + (size_t)m * D) + F.lane; f32x4 v[8]; float s = 0.f;
#pragma unroll
          for (int j = 0; j < 8; ++j) { v[j] = xr[64 * j]; s += (v[j].x * v[j].x + v[j].y * v[j].y) + (v[j].z * v[j].z + v[j].w * v[j].w); }
          const float rs = rsqrtf(wave_sum(s) * (1.0f / D) + 1e-6f);
#pragma unroll
          for (int j = 0; j < 8; ++j) { const f32x4 g = *((const GAS f32x4*)gm + F.lane + 64 * j); v2u w; w.x = pk2(v[j].x * rs * g.x, v[j].y * rs * g.y); w.y = pk2(v[j].z * rs * g.z, v[j].w * rs * g.w); o8[64 * j] = w; } } }
}
__device__ __forceinline__ void p5_conv(Frame& F_, const Args& a) {
    Frame F = F_; asm volatile("" : "+v"(F.lane));
    const int gw = F.vcu * NWAVES + F.wave, NGW = F.G * NWAVES; unsigned char* ws = a.ws;
    const bf16* CU = (const bf16*)(ws + WS_CU); const bf16* BG = (const bf16*)(ws + WS_BG); bf16* MX = (bf16*)(ws + WS_MIXED); const float* cw = a.in[I_CONVW];
    for (int m = gw; m < M; m += NGW) { const int t = m & (SEQ - 1); float y[16]; float s = 0.f;
#pragma unroll
        for (int gsel = 0; gsel < 2; ++gsel) { const int ch = gsel * 512 + F.lane * 8;
            const v4u c0 = *(const GAS v4u*)(CU + (size_t)m * 1024 + ch); v4u c1 = (v4u){0u, 0u, 0u, 0u}, c2 = (v4u){0u, 0u, 0u, 0u};
            if (t >= 1) c1 = *(const GAS v4u*)(CU + (size_t)(m - 1) * 1024 + ch);
            if (t >= 2) c2 = *(const GAS v4u*)(CU + (size_t)(m - 2) * 1024 + ch);
            const v4u bg = *(const GAS v4u*)(BG + (size_t)m * 1024 + ch);
            const f32x4 w0a = *(const GAS f32x4*)(cw + ch), w0b = *(const GAS f32x4*)(cw + ch + 4), w1a = *(const GAS f32x4*)(cw + 1024 + ch), w1b = *(const GAS f32x4*)(cw + 1024 + ch + 4), w2a = *(const GAS f32x4*)(cw + 2048 + ch), w2b = *(const GAS f32x4*)(cw + 2048 + ch + 4);
#pragma unroll
            for (int e = 0; e < 4; ++e) { const unsigned x0 = c0[e], x1 = c1[e], x2 = c2[e], bw = bg[e];
                const float wl0 = e < 2 ? w0a[2 * e] : w0b[2 * e - 4], wh0 = e < 2 ? w0a[2 * e + 1] : w0b[2 * e - 3];
                const float wl1 = e < 2 ? w1a[2 * e] : w1b[2 * e - 4], wh1 = e < 2 ? w1a[2 * e + 1] : w1b[2 * e - 3];
                const float wl2 = e < 2 ? w2a[2 * e] : w2b[2 * e - 4], wh2 = e < 2 ? w2a[2 * e + 1] : w2b[2 * e - 3];
                const float lo = bflo(bw) * (wl0 * bflo(x2) + wl1 * bflo(x1) + wl2 * bflo(x0)), hi = bfhi(bw) * (wh0 * bfhi(x2) + wh1 * bfhi(x1) + wh2 * bfhi(x0));
                y[gsel * 8 + 2 * e] = lo; y[gsel * 8 + 2 * e + 1] = hi; s += lo * lo + hi * hi; } }
        const float rs = rsqrtf(wave_sum(s) * (1.0f / 1024.0f) + 1e-6f);
#pragma unroll
        for (int gsel = 0; gsel < 2; ++gsel) { v4u o; o.x = pk2(y[gsel * 8 + 0] * rs, y[gsel * 8 + 1] * rs); o.y = pk2(y[gsel * 8 + 2] * rs, y[gsel * 8 + 3] * rs); o.z = pk2(y[gsel * 8 + 4] * rs, y[gsel * 8 + 5] * rs); o.w = pk2(y[gsel * 8 + 6] * rs, y[gsel * 8 + 7] * rs);
            *(GAS v4u*)(MX + (size_t)m * 2048 + 1024 + gsel * 512 + F.lane * 8) = o; } }
}
__device__ __forceinline__ void p12_final(Frame& F_, const Args& a) {
    Frame F = F_; asm volatile("" : "+v"(F.lane));
    const int gw = F.vcu * NWAVES + F.wave, NGW = F.G * NWAVES; const float* ss4 = (const float*)(a.ws + WS_CTL + CTL_SS) + 5 * M; const float* gf = a.in[I_FINAL];
    for (int m = gw; m < M; m += NGW) { GAS f32x4* xr = (GAS f32x4*)(a.out + (size_t)m * D) + F.lane; const float rs = rsqrtf(ss4[m] * (1.0f / D) + 1e-6f);
#pragma unroll
        for (int j = 0; j < 8; ++j) { const f32x4 v = xr[64 * j]; const f32x4 g = *((const GAS f32x4*)gf + F.lane + 64 * j); xr[64 * j] = v * g * rs; } }
}

#ifndef DUP_MASK
#define DUP_MASK 0
#endif
#ifndef MOBA_SDEPTH
#define MOBA_SDEPTH 1
#endif
__global__ void __launch_bounds__(NWAVES * 64, 2) fwd_kernel(Args args) {
    extern __shared__ __attribute__((aligned(16))) unsigned char lds[];
    Frame F;
    F.lds = (LAS unsigned char*)lds;
    F.MISC = (volatile LAS unsigned*)(F.lds + MISC_OFF);
    F.tid = threadIdx.x; F.lane = F.tid & 63; F.wave = __builtin_amdgcn_readfirstlane(F.tid >> 6);
    F.G = gridDim.x; { const int bx = blockIdx.x; F.vcu = (F.G % 8 == 0) ? (bx % 8) * (F.G / 8) + bx / 8 : bx; }
    unsigned char* ws = args.ws;
    for (int u = F.tid; u < (LDS_BYTES - LDSCTL_OFF) / 4; u += NWAVES * 64) ((LAS unsigned*)(F.lds + LDSCTL_OFF))[u] = 0u;
    __syncthreads();
    const int lo = args.ph_lo, hi = args.ph_hi; const bool multi = (hi - lo) > 1;
    XcdBarrier bar; bar.bar = (unsigned*)(ws + WS_CTL + CTL_BAR + (size_t)lo * BAR_STRIDE); bar.x = 0; bar.st = nullptr;
    if (multi) bar = xcd_barrier_post((unsigned*)(ws + WS_CTL + CTL_BAR + (size_t)lo * BAR_STRIDE), F.MISC + 8);
#ifndef PH_ENABLE
#define PH_ENABLE 0x1fff
#endif
#define IN(k) ((((PH_ENABLE) >> (k)) & 1) && lo <= (k) && (k) < hi)
#define SEAM(k) do { if (IN(k) && IN((k) + 1)) xcd_barrier(bar); } while (0)
    float* SS = (float*)(ws + WS_CTL + CTL_SS);
    float* KMS = (float*)(ws + WS_CTL + CTL_KMS);
    bf16* HB = (bf16*)(ws + WS_HB); bf16* ACT = (bf16*)(ws + WS_ACT); bf16* MIXED = (bf16*)(ws + WS_MIXED);
    bf16* Qb = (bf16*)(ws + WS_Q); bf16* Kb = (bf16*)(ws + WS_K); bf16* Vb = (bf16*)(ws + WS_V); bf16* CUb = (bf16*)(ws + WS_CU); bf16* BGb = (bf16*)(ws + WS_BG);
    bf16* QX = (bf16*)(ws + WS_QX); bf16* OX = (bf16*)(ws + WS_OX); bf16* KVX = (bf16*)(ws + WS_KVX);
    const int bx = (int)blockIdx.x;

    if (IN(0)) { p0_prologue(F, args); } if (((DUP_MASK >> 0) & 1) && IN(0)) { p0_prologue(F, args); } SEAM(0);
    if (IN(1)) { pg8::Gemm g{HB, (const bf16*)(ws + WS_WGU1), M, 2 * FF, D}; pg8::StaticOrder S; S.init(M, 2 * FF, F.G, bx);
        pg8::EpiSwiglu E{ACT, FF, SS}; pg8::gemm_phase<pg8::EpiSwiglu, pg8::StaticOrder, PG8_ALIGN, PG8_SP2>(F.lds + RING_OFF, g, S, E); if (((DUP_MASK >> 1) & 1)) pg8::gemm_phase<pg8::EpiSwiglu, pg8::StaticOrder, PG8_ALIGN, PG8_SP2>(F.lds + RING_OFF, g, S, E); } SEAM(1);
    if (IN(2)) { pg8::Gemm g{ACT, (const bf16*)(ws + WS_WD1), M, D, FF}; pg8::StaticOrder S; S.init(M, D, F.G, bx);
        typedef pg8::EpiResid<0, false, false> EP; EP E{args.in[I_X], nullptr, nullptr, HB, SS + M, 0.5f, nullptr}; pg8::gemm_phase<EP, pg8::StaticOrder, PG8_ALIGN, PG8_SP2>(F.lds + RING_OFF, g, S, E); if (((DUP_MASK >> 2) & 1)) { EP E2{args.in[I_X], nullptr, nullptr, HB, (float*)(ws + WS_DUMMY), 0.5f, nullptr}; pg8::gemm_phase<EP, pg8::StaticOrder, PG8_ALIGN, PG8_SP2>(F.lds + RING_OFF, g, S, E2); } } SEAM(2);
    if (IN(3)) { pg8::Gemm g{HB, (const bf16*)(ws + WS_WIN), M, INW, D}; pg8::StaticOrder S; S.init(M, INW, F.G, bx);
        pg8::EpiWin E{Qb, Kb, Vb, CUb, BGb, KMS, SS + M}; pg8::gemm_phase<pg8::EpiWin, pg8::StaticOrder, PG8_ALIGN, PG8_SP2>(F.lds + RING_OFF, g, S, E); if (((DUP_MASK >> 3) & 1)) { pg8::EpiWin E2{Qb, Kb, Vb, CUb, BGb, (float*)(ws + WS_DUMMY), SS + M}; pg8::gemm_phase<pg8::EpiWin, pg8::StaticOrder, PG8_ALIGN, PG8_SP2>(F.lds + RING_OFF, g, S, E2); } } SEAM(3);
    if (IN(4)) for (int rep = 0; rep < (((DUP_MASK >> 4) & 1) ? 2 : 1); ++rep) {
        for (int u = F.vcu; u < BATCH * NH * 8; u += F.G) { const int b = u >> 6, h = (u >> 3) & 7, p = u & 7;
#pragma unroll 1
            for (int half = 0; half < 2; ++half) { const int qb = half ? 15 - p : p; const size_t r0 = (size_t)b * SEQ + (size_t)qb * 256;
                att::attn_body<true, 1024, 1024, 2048, MOBA_SDEPTH>(Qb + r0 * 1024 + h * 128, Kb + (size_t)b * SEQ * 1024 + h * 128, Vb + (size_t)b * SEQ * 1024 + h * 128, MIXED + r0 * 2048 + h * 128,
                                                       256 * (qb + 1), (att::lptr)(F.lds + RING_OFF), qb, KMS + ((size_t)b * 16 * 8 + h) * 128, 8 * 128, (rep ? (float*)(ws + WS_DUMMY) : SS + 2 * M) + r0); } } }
    if (IN(5)) { p5_conv(F, args); } if (((DUP_MASK >> 5) & 1) && IN(5)) { p5_conv(F, args); } SEAM(5);
    if (IN(6)) { pg8::Gemm g{MIXED, (const bf16*)(ws + WS_WOUT), M, D, D}; pg8::StaticOrder S; S.init(M, D, F.G, bx);
        typedef pg8::EpiResid<16, true, false> EP; EP E{nullptr, HB, nullptr, HB, SS + 3 * M, 1.0f, SS + 2 * M}; pg8::gemm_phase<EP, pg8::StaticOrder, PG8_ALIGN, PG8_SP2>(F.lds + RING_OFF, g, S, E); if (((DUP_MASK >> 6) & 1)) { EP E2{nullptr, HB, nullptr, HB, (float*)(ws + WS_DUMMY), 0.0f, SS + 2 * M}; pg8::gemm_phase<EP, pg8::StaticOrder, PG8_ALIGN, PG8_SP2>(F.lds + RING_OFF, g, S, E2); } } SEAM(6);
    if (IN(7)) for (int rep = 0; rep < (((DUP_MASK >> 7) & 1) ? 2 : 1); ++rep) { { pg8::Gemm g{HB, (const bf16*)(ws + WS_WQ), M, XW, D}; pg8::StaticOrder S; S.init(M, XW, F.G, bx);
          pg8::EpiScaleBf16 E{QX, XW, SS + 3 * M}; pg8::gemm_phase<pg8::EpiScaleBf16, pg8::StaticOrder, PG8_ALIGN, PG8_SP2>(F.lds + RING_OFF, g, S, E); }
        { pg8::Gemm g{(const bf16*)(ws + WS_MEMN), (const bf16*)(ws + WS_WKV), BATCH * MEML, 1024, D}; pg8::StaticOrder S; S.init(BATCH * MEML, 1024, F.G, (bx + F.G - 128) % F.G);
          pg8::EpiScaleBf16 E{KVX, 1024, nullptr}; pg8::gemm_phase<pg8::EpiScaleBf16, pg8::StaticOrder, PG8_ALIGN, PG8_SP2>(F.lds + RING_OFF, g, S, E); } } SEAM(7);
    if (IN(8)) for (int rep = 0; rep < (((DUP_MASK >> 8) & 1) ? 2 : 1); ++rep) {
        for (int u = F.vcu; u < BATCH * XH * 16; u += F.G) { const int b = u >> 6, h = (u >> 4) & 3, qb = u & 15; const size_t r0 = (size_t)b * SEQ + (size_t)qb * 256;
            att::attn_body<false, 512, 1024, 512, 2>(QX + r0 * 512 + h * 128, KVX + (size_t)b * MEML * 1024 + h * 128, KVX + (size_t)b * MEML * 1024 + 512 + h * 128, OX + r0 * 512 + h * 128,
                                                  MEML, (att::lptr)(F.lds + RING_OFF), 0, nullptr, 0, nullptr); } } SEAM(8);
    if (IN(9)) { pg8::Gemm g{OX, (const bf16*)(ws + WS_WO), M, D, XW}; pg8::StaticOrder S; S.init(M, D, F.G, bx);
        typedef pg8::EpiResid<0, true, false> EP; EP E{nullptr, HB, nullptr, HB, SS + 4 * M, 1.0f, nullptr}; pg8::gemm_phase<EP, pg8::StaticOrder, PG8_ALIGN, PG8_SP2>(F.lds + RING_OFF, g, S, E); if (((DUP_MASK >> 9) & 1)) { EP E2{nullptr, HB, nullptr, HB, (float*)(ws + WS_DUMMY), 0.0f, nullptr}; pg8::gemm_phase<EP, pg8::StaticOrder, PG8_ALIGN, PG8_SP2>(F.lds + RING_OFF, g, S, E2); } } SEAM(9);
    if (IN(10)) { pg8::Gemm g{HB, (const bf16*)(ws + WS_WGU2), M, 2 * FF, D}; pg8::StaticOrder S; S.init(M, 2 * FF, F.G, bx);
        pg8::EpiSwiglu E{ACT, FF, SS + 4 * M}; pg8::gemm_phase<pg8::EpiSwiglu, pg8::StaticOrder, PG8_ALIGN, PG8_SP2>(F.lds + RING_OFF, g, S, E); if (((DUP_MASK >> 10) & 1)) pg8::gemm_phase<pg8::EpiSwiglu, pg8::StaticOrder, PG8_ALIGN, PG8_SP2>(F.lds + RING_OFF, g, S, E); } SEAM(10);
    if (IN(11)) { pg8::Gemm g{ACT, (const bf16*)(ws + WS_WD2), M, D, FF}; pg8::StaticOrder S; S.init(M, D, F.G, bx);
        typedef pg8::EpiResid<0, true, true> EP; EP E{nullptr, HB, args.out, nullptr, SS + 5 * M, 0.5f, nullptr}; pg8::gemm_phase<EP, pg8::StaticOrder, PG8_ALIGN, PG8_SP2>(F.lds + RING_OFF, g, S, E); if (((DUP_MASK >> 11) & 1)) { EP E2{nullptr, HB, args.out, nullptr, (float*)(ws + WS_DUMMY), 0.5f, nullptr}; pg8::gemm_phase<EP, pg8::StaticOrder, PG8_ALIGN, PG8_SP2>(F.lds + RING_OFF, g, S, E2); } } SEAM(11);
    if (IN(12)) { p12_final(F, args); }
#undef IN
#undef SEAM
}

extern "C" void kernel_launch(void* const* d_in, const int* in_sizes, int n_in, void* d_out, int out_size, void* d_ws, size_t ws_size, hipStream_t stream) {
    static int grid = 0;
    if (grid == 0) {
        if (n_in != 22 || in_sizes[0] != M * D || out_size != M * D || ws_size < WS_END) { fprintf(stderr, "kernel_launch: shape mismatch (n_in %d, in0 %d, out %d, ws %zu; need ws >= %zu); nothing launched\n", n_in, n_in > 0 ? in_sizes[0] : -1, out_size, ws_size, (size_t)WS_END); grid = -1; return; }
        int dev = 0, cus = 0, per_cu = 0;
        if (hipGetDevice(&dev) != hipSuccess || hipDeviceGetAttribute(&cus, hipDeviceAttributeMultiprocessorCount, dev) != hipSuccess) { grid = -1; return; }
        if (hipFuncSetAttribute((const void*)fwd_kernel, hipFuncAttributeMaxDynamicSharedMemorySize, LDS_BYTES) != hipSuccess) { fprintf(stderr, "kernel_launch: hipFuncSetAttribute failed\n"); grid = -1; return; }
        if (hipOccupancyMaxActiveBlocksPerMultiprocessor(&per_cu, (const void*)fwd_kernel, NWAVES * 64, LDS_BYTES) != hipSuccess || per_cu < 1) { fprintf(stderr, "kernel_launch: occupancy query reports %d workgroups per CU\n", per_cu); }
        (void)hipGetLastError();
        grid = cus;
    }
    if (grid < 0) return;
    if (hipMemsetAsync((char*)d_ws + WS_CTL, 0, CTL_ZERO_BYTES, stream) != hipSuccess) { fprintf(stderr, "kernel_launch: hipMemsetAsync failed\n"); return; }
    Args a{};
    for (int i = 0; i < 22; ++i) a.in[i] = (const float*)d_in[i];
    a.out = (float*)d_out; a.ws = (unsigned char*)d_ws;
    unsigned char* ws = (unsigned char*)d_ws; float* SS = (float*)(ws + WS_CTL + CTL_SS); float* KMS = (float*)(ws + WS_CTL + CTL_KMS); float* out = (float*)d_out;
    bf16* HB = (bf16*)(ws + WS_HB); bf16* ACT = (bf16*)(ws + WS_ACT); bf16* MIXED = (bf16*)(ws + WS_MIXED);
    bf16* Qb = (bf16*)(ws + WS_Q); bf16* Kb = (bf16*)(ws + WS_K); bf16* Vb = (bf16*)(ws + WS_V); bf16* CUb = (bf16*)(ws + WS_CU); bf16* BGb = (bf16*)(ws + WS_BG);
    bf16* QX = (bf16*)(ws + WS_QX); bf16* OX = (bf16*)(ws + WS_OX); bf16* KVX = (bf16*)(ws + WS_KVX);
    (void)SS; (void)KMS; (void)out; (void)HB; (void)ACT; (void)MIXED; (void)Qb; (void)Kb; (void)Vb; (void)CUb; (void)BGb; (void)QX; (void)OX; (void)KVX;
#if ONE_LAUNCH
    a.ph_lo = 0; a.ph_hi = NPH;
    hipLaunchKernelGGL(fwd_kernel, dim3(grid), dim3(NWAVES * 64), LDS_BYTES, stream, a);
#else
    for (int ph = 0; ph < NPH; ++ph) {
        if ((FAST_MASK >> ph) & 1) { a.ph_lo = ph; a.ph_hi = ph + 1; hipLaunchKernelGGL(fwd_kernel, dim3(grid), dim3(NWAVES * 64), LDS_BYTES, stream, a); continue; }
        switch (ph) {
        case 1: hipLaunchKernelGGL((nv::gemm<nv::FSwiglu>), dim3(FF / 64, M / 64), dim3(256), 0, stream, HB, (const bf16*)(ws + WS_WGU1), D, nv::FSwiglu{ACT, SS}); break;
        case 2: hipLaunchKernelGGL((nv::gemm<nv::FResid<0, false, false>>), dim3(D / 64, M / 64), dim3(256), 0, stream, ACT, (const bf16*)(ws + WS_WD1), FF, nv::FResid<0, false, false>{a.in[I_X], nullptr, nullptr, HB, SS + M, 0.5f, nullptr}); break;
        case 3: hipLaunchKernelGGL((nv::gemm<nv::FWin>), dim3(5120 / 64, M / 64), dim3(256), 0, stream, HB, (const bf16*)(ws + WS_WIN), D, nv::FWin{Qb, Kb, Vb, CUb, BGb, SS + M});
                hipLaunchKernelGGL(nv::kmean, dim3(BATCH * 16 * 8 * 128 / 256), dim3(256), 0, stream, Kb, KMS); break;
        case 4: hipLaunchKernelGGL(nv::moba, dim3(M * NH / 4), dim3(256), 0, stream, Qb, Kb, Vb, KMS, MIXED, SS + 2 * M); break;
        case 6: hipLaunchKernelGGL((nv::gemm<nv::FResid<1024, true, false>>), dim3(D / 64, M / 64), dim3(256), 0, stream, MIXED, (const bf16*)(ws + WS_WOUT), D, nv::FResid<1024, true, false>{nullptr, HB, nullptr, HB, SS + 3 * M, 1.0f, SS + 2 * M}); break;
        case 7: hipLaunchKernelGGL((nv::gemm<nv::FScale>), dim3(XW / 64, M / 64), dim3(256), 0, stream, HB, (const bf16*)(ws + WS_WQ), D, nv::FScale{QX, XW, SS + 3 * M});
                hipLaunchKernelGGL((nv::gemm<nv::FScale>), dim3(1024 / 64, BATCH * MEML / 64), dim3(256), 0, stream, (const bf16*)(ws + WS_MEMN), (const bf16*)(ws + WS_WKV), D, nv::FScale{KVX, 1024, nullptr}); break;
        case 8: hipLaunchKernelGGL(nv::xattn, dim3(M * XH / 4), dim3(256), 0, stream, QX, KVX, OX); break;
        case 9: hipLaunchKernelGGL((nv::gemm<nv::FResid<0, true, false>>), dim3(D / 64, M / 64), dim3(256), 0, stream, OX, (const bf16*)(ws + WS_WO), XW, nv::FResid<0, true, false>{nullptr, HB, nullptr, HB, SS + 4 * M, 1.0f, nullptr}); break;
        case 10: hipLaunchKernelGGL((nv::gemm<nv::FSwiglu>), dim3(FF / 64, M / 64), dim3(256), 0, stream, HB, (const bf16*)(ws + WS_WGU2), D, nv::FSwiglu{ACT, SS + 4 * M}); break;
        case 11: hipLaunchKernelGGL((nv::gemm<nv::FResid<0, true, true>>), dim3(D / 64, M / 64), dim3(256), 0, stream, ACT, (const bf16*)(ws + WS_WD2), FF, nv::FResid<0, true, true>{nullptr, HB, out, nullptr, SS + 5 * M, 0.5f, nullptr}); break;
        default: break;
        }
    }
#endif
    const hipError_t le = hipPeekAtLastError();
    if (le != hipSuccess) fprintf(stderr, "kernel_launch: launch failed: %s\n", hipGetErrorName(le));
}
```

```cpp
#define ONE_LAUNCH 1
#define FAST_MASK 0x1fff
#define USE_FP8 0xC00
#include <hip/hip_runtime.h>
#include <cstdio>
#include <cstdint>
namespace pg8 {
#define PG8_LAS __attribute__((address_space(3)))
typedef unsigned short bf16_t;
typedef short bf16x8 __attribute__((ext_vector_type(8)));
typedef float f32x4 __attribute__((ext_vector_type(4)));
typedef unsigned u32x4 __attribute__((ext_vector_type(4)));
typedef int i32x4 __attribute__((ext_vector_type(4)));
typedef int i32x8 __attribute__((ext_vector_type(8)));
typedef unsigned u32x2 __attribute__((ext_vector_type(2)));
constexpr int BM = 256, BK = 64, HALF = 128, HTB = HALF * BK * 2  , STAGE_BYTES = 8 * HTB, NXCD = 8, WGM = 8;

__host__ __device__ __forceinline__ int lds_byte(int r, int c) { const int st = (r >> 4) * 2 + (c >> 5), rr = r & 15, cc = c & 31, ob = rr * 64 + cc * 2; return st * 1024 + (ob ^ (((ob >> 9) & 1) << 5)); }
__host__ __device__ __forceinline__ void stage_rc(int b, int& R, int& C) { const int st = b / 1024, sb = b % 1024, swz = sb ^ (((sb >> 9) & 1) << 5); R = (st >> 1) * 16 + swz / 64; C = (st & 1) * 32 + (swz % 64) / 2; }
__host__ __device__ __forceinline__ int perm32(int rho) { const int n = rho >> 4, i = rho & 15; return 8 * (i >> 2) + 4 * n + (i & 3); }

struct Unit { int pm, pn; };
struct Gemm { const bf16_t* A; const bf16_t* Bt; int M, N, K; };

struct StaticOrder {
    int nM, nN, nwg, G, c;
    __host__ __device__ void init(int M, int N, int G_, int c_) { nM = M / BM; nN = N / BM; nwg = nM * nN; G = G_; c = c_; }
    __host__ __device__ bool next(int i, Unit& u) const {
        const long L = (long)i * G + c; if (L >= nwg) return false;
        int wgid = (int)L; { const int q = nwg / NXCD, r = nwg % NXCD, xcd = wgid % NXCD, off = wgid / NXCD; wgid = (xcd < r ? xcd * (q + 1) : r * (q + 1) + (xcd - r) * q) + off; }
        const int nig = WGM * nN, gid = wgid / nig, fm = gid * WGM, gsz = (nM - fm) < WGM ? (nM - fm) : WGM;
        u.pm = fm + ((wgid % nig) % gsz); u.pn = (wgid % nig) / gsz; return true;
    }
    __device__ __forceinline__ void a_ready(const Unit&) const {}
    __device__ __forceinline__ void done(const Unit&) const {}
};

__device__ __forceinline__ unsigned cvt_pk_bf16(float lo, float hi) { unsigned r; asm volatile("v_cvt_pk_bf16_f32 %0, %1, %2" : "=v"(r) : "v"(lo), "v"(hi)); return r; }
__device__ __forceinline__ u32x4 pack8(const f32x4 v0, const f32x4 v1) { u32x4 w; w.x = cvt_pk_bf16(v0[0], v0[1]); w.y = cvt_pk_bf16(v0[2], v0[3]); w.z = cvt_pk_bf16(v1[0], v1[1]); w.w = cvt_pk_bf16(v1[2], v1[3]); return w; }
constexpr float RMS_EPS = 1e-6f;
typedef unsigned long long u64_t;
__device__ __forceinline__ float ss_val(const u64_t* ss, int row) { return (float)ss[row] * (1.0f / 65536.0f); }
__device__ __forceinline__ void ss_add(u64_t* ss, int row, float sq) { atomicAdd(ss + row, (u64_t)(unsigned)(sq * 65536.0f + 0.5f)); }
__device__ __forceinline__ float clamp_f8(float x) { return __builtin_amdgcn_fmed3f(x, -448.0f, 448.0f); }
__device__ __forceinline__ u32x2 pack8_f8(const f32x4 v0, const f32x4 v1) { int a = __builtin_amdgcn_cvt_pk_fp8_f32(clamp_f8(v0[0]), clamp_f8(v0[1]), 0, false); a = __builtin_amdgcn_cvt_pk_fp8_f32(clamp_f8(v0[2]), clamp_f8(v0[3]), a, true);
    int b = __builtin_amdgcn_cvt_pk_fp8_f32(clamp_f8(v1[0]), clamp_f8(v1[1]), 0, false); b = __builtin_amdgcn_cvt_pk_fp8_f32(clamp_f8(v1[2]), clamp_f8(v1[3]), b, true); u32x2 w; w.x = (unsigned)a; w.y = (unsigned)b; return w; }
__device__ __forceinline__ float silu_mul(float g, float u) { return g * u * __builtin_amdgcn_rcpf(1.0f + __builtin_amdgcn_exp2f(-1.4426950408889634f * g)); }

template <bool F8OUT> struct EpiSwiglu {
    static constexpr bool PERM = true, AFTER_DRAIN = false; static constexpr int MIDT = 0;
    bf16_t* O; unsigned char* O8; int ldo; const u64_t* ss; float asc, osc;
    __device__ __forceinline__ void mid(f32x4 (&)[2][2][4][2], const Unit&, int, int) const {}
    __device__ __forceinline__ void operator()(const f32x4 (&acc)[2][2][4][2], const Unit& u, int wr, int wc, int fr_, int fq_) const {
        int fr = fr_, fq = fq_; asm volatile("" : "+v"(fr), "+v"(fq));
        const int row0 = u.pm * BM + wr * 64 + fr, col0 = u.pn * HALF + wc * 32 + 8 * fq;
#pragma unroll
        for (int ai = 0; ai < 2; ++ai)
#pragma unroll
            for (int m = 0; m < 4; ++m) { const int row = row0 + ai * HALF + m * 16; const float rs = asc * rsqrtf(ss_val(ss, row) * (1.0f / 2048.0f) + RMS_EPS);
                f32x4 o0, o1;
#pragma unroll
                for (int j = 0; j < 4; ++j) { o0[j] = silu_mul(acc[ai][0][m][0][j] * rs, acc[ai][1][m][0][j] * rs); o1[j] = silu_mul(acc[ai][0][m][1][j] * rs, acc[ai][1][m][1][j] * rs); }
                if constexpr (F8OUT) *(u32x2*)(O8 + (size_t)row * ldo + col0) = pack8_f8(o0 * osc, o1 * osc);
                else *(u32x4*)(O + (size_t)row * ldo + col0) = pack8(o0, o1); }
    }
};
template <int MIDT_, bool RBF, bool OF32> struct EpiResid {
    static constexpr bool PERM = true, AFTER_DRAIN = false; static constexpr int MIDT = MIDT_;
    const float* R; const bf16_t* RB; float* H; bf16_t* HB; u64_t* ssn; float alpha; const u64_t* midss; unsigned char* HB8;
    __device__ __forceinline__ void mid(f32x4 (&acc)[2][2][4][2], const Unit& u, int wr, int fr) const {
        const int row0 = u.pm * BM + wr * 64 + fr;
#pragma unroll
        for (int ai = 0; ai < 2; ++ai)
#pragma unroll
            for (int m = 0; m < 4; ++m) { const float s = rsqrtf(ss_val(midss, row0 + ai * HALF + m * 16) * (1.0f / 1024.0f) + RMS_EPS);
#pragma unroll
                for (int bj = 0; bj < 2; ++bj)
#pragma unroll
                    for (int n = 0; n < 2; ++n) acc[ai][bj][m][n] = acc[ai][bj][m][n] * s; }
    }
    __device__ __forceinline__ void operator()(const f32x4 (&acc)[2][2][4][2], const Unit& u, int wr, int wc, int fr_, int fq_) const {
        int fr = fr_, fq = fq_; asm volatile("" : "+v"(fr), "+v"(fq));
        const int row0 = u.pm * BM + wr * 64 + fr, col0 = u.pn * BM + wc * 32 + 8 * fq;
#pragma unroll
        for (int ai = 0; ai < 2; ++ai)
#pragma unroll
            for (int m = 0; m < 4; ++m) { const int row = row0 + ai * HALF + m * 16; const size_t off = (size_t)row * 2048 + col0; float sq = 0.f;
#pragma unroll
                for (int bj = 0; bj < 2; ++bj) { f32x4 r0, r1;
                    if constexpr (RBF) { const u32x4 w = *(const u32x4*)(RB + off + bj * HALF);
                        r0 = (f32x4){__uint_as_float(w.x << 16), __uint_as_float(w.x & 0xffff0000u), __uint_as_float(w.y << 16), __uint_as_float(w.y & 0xffff0000u)};
                        r1 = (f32x4){__uint_as_float(w.z << 16), __uint_as_float(w.z & 0xffff0000u), __uint_as_float(w.w << 16), __uint_as_float(w.w & 0xffff0000u)}; }
                    else { r0 = *(const f32x4*)(R + off + bj * HALF); r1 = *(const f32x4*)(R + off + bj * HALF + 4); }
                    const f32x4 h0 = r0 + acc[ai][bj][m][0] * alpha, h1 = r1 + acc[ai][bj][m][1] * alpha;
                    if constexpr (OF32) { *(f32x4*)(H + off + bj * HALF) = h0; *(f32x4*)(H + off + bj * HALF + 4) = h1; }
                    else { *(u32x4*)(HB + off + bj * HALF) = pack8(h0, h1); if (HB8) *(u32x2*)(HB8 + off + bj * HALF) = pack8_f8(h0, h1); }
                    sq += (h0[0] * h0[0] + h0[1] * h0[1]) + (h0[2] * h0[2] + h0[3] * h0[3]) + (h1[0] * h1[0] + h1[1] * h1[1]) + (h1[2] * h1[2] + h1[3] * h1[3]); }
                sq += __shfl_xor(sq, 16); sq += __shfl_xor(sq, 32);
                if (fq == 0) ss_add(ssn, row, sq);
                asm volatile("" ::: "memory"); }
    }
};
struct EpiWin {
    static constexpr bool PERM = true, AFTER_DRAIN = false; static constexpr int MIDT = 0;
    bf16_t *Q, *K, *V, *CU, *BG; float* kms; const u64_t* ss;
    __device__ __forceinline__ void mid(f32x4 (&)[2][2][4][2], const Unit&, int, int) const {}
    __device__ __forceinline__ void operator()(const f32x4 (&acc)[2][2][4][2], const Unit& u, int wr, int wc, int fr_, int fq_) const {
        int fr = fr_, fq = fq_; asm volatile("" : "+v"(fr), "+v"(fq));
        const int row0 = u.pm * BM + wr * 64 + fr, pn = u.pn;
        if (pn >= 12 && pn < 20) {
            const int col0 = (pn - 12) * HALF + wc * 32 + 8 * fq;
#pragma unroll
            for (int ai = 0; ai < 2; ++ai)
#pragma unroll
                for (int m = 0; m < 4; ++m) { const int row = row0 + ai * HALF + m * 16; float rs = rsqrtf(ss_val(ss, row) * (1.0f / 2048.0f) + RMS_EPS); rs = rs * rs;
                    const f32x4 o0 = acc[ai][0][m][0] * acc[ai][1][m][0] * rs, o1 = acc[ai][0][m][1] * acc[ai][1][m][1] * rs;
                    *(u32x4*)(CU + (size_t)row * 1024 + col0) = pack8(o0, o1); }
        } else {
            bf16_t* base = pn < 4 ? Q : pn < 8 ? K : pn < 12 ? V : BG; const int colt = (pn & 3) * BM, col0 = colt + wc * 32 + 8 * fq; const bool isk = (pn >= 4 && pn < 8);
            float rsv[2][4];
#pragma unroll
            for (int ai = 0; ai < 2; ++ai)
#pragma unroll
                for (int m = 0; m < 4; ++m) rsv[ai][m] = rsqrtf(ss_val(ss, row0 + ai * HALF + m * 16) * (1.0f / 2048.0f) + RMS_EPS);
#pragma unroll
            for (int ai = 0; ai < 2; ++ai)
#pragma unroll
                for (int m = 0; m < 4; ++m) { const int row = row0 + ai * HALF + m * 16;
#pragma unroll
                    for (int bj = 0; bj < 2; ++bj) *(u32x4*)(base + (size_t)row * 1024 + col0 + bj * HALF) = pack8(acc[ai][bj][m][0] * rsv[ai][m], acc[ai][bj][m][1] * rsv[ai][m]); }
            if (isk) {
#pragma unroll
                for (int bj = 0; bj < 2; ++bj)
#pragma unroll
                    for (int n = 0; n < 2; ++n) { f32x4 c = (f32x4){0.f, 0.f, 0.f, 0.f};
#pragma unroll
                        for (int ai = 0; ai < 2; ++ai)
#pragma unroll
                            for (int m = 0; m < 4; ++m) { float r2 = rsv[ai][m]; asm volatile("" : "+v"(r2)); c += acc[ai][bj][m][n] * r2; }
#pragma unroll
                        for (int j = 0; j < 4; ++j) { float v = c[j]; v += __shfl_xor(v, 1); v += __shfl_xor(v, 2); v += __shfl_xor(v, 4); v += __shfl_xor(v, 8);
                            const int col = col0 + bj * HALF + 4 * n + j;
                            if (fr == 0) unsafeAtomicAdd(kms + ((size_t)u.pm * 8 + (col >> 7)) * 128 + (col & 127), v); }
                        asm volatile("" ::: "memory"); }
            }
        }
    }
};
struct EpiScaleBf16 {
    static constexpr bool PERM = true, AFTER_DRAIN = false; static constexpr int MIDT = 0;
    bf16_t* O; int ldo; const u64_t* ss; float asc;
    __device__ __forceinline__ void mid(f32x4 (&)[2][2][4][2], const Unit&, int, int) const {}
    __device__ __forceinline__ void operator()(const f32x4 (&acc)[2][2][4][2], const Unit& u, int wr, int wc, int fr_, int fq_) const {
        int fr = fr_, fq = fq_; asm volatile("" : "+v"(fr), "+v"(fq));
        const int row0 = u.pm * BM + wr * 64 + fr, col0 = u.pn * BM + wc * 32 + 8 * fq;
#pragma unroll
        for (int ai = 0; ai < 2; ++ai)
#pragma unroll
            for (int m = 0; m < 4; ++m) { const int row = row0 + ai * HALF + m * 16; const float rs = asc * (ss ? rsqrtf(ss_val(ss, row) * (1.0f / 2048.0f) + RMS_EPS) : 1.0f);
#pragma unroll
                for (int bj = 0; bj < 2; ++bj) *(u32x4*)(O + (size_t)row * ldo + col0 + bj * HALF) = pack8(acc[ai][bj][m][0] * rs, acc[ai][bj][m][1] * rs); }
    }
};

template <class Epi, class Sched, bool ALIGN_EPI = false, bool SP2 = false, bool FP8 = false>
__device__ __forceinline__ void gemm_phase(PG8_LAS unsigned char* lds, const Gemm g, const Sched& S, const Epi& E) {
    int tid_ = threadIdx.x; asm volatile("" : "+v"(tid_));
    const int tid = tid_, wid = __builtin_amdgcn_readfirstlane(tid >> 6), lane = tid & 63, wr = wid >> 2, wc = wid & 3, fr = lane & 15, fq = lane >> 4;
    const int KB = FP8 ? g.K : g.K * 2, nt = KB / (BK * 2);
    unsigned voffA[2], voffB[2];
#pragma unroll
    for (int i = 0; i < 2; ++i) { int R, C; stage_rc(tid * 16 + i * 8192, R, C); const int Rb = Epi::PERM ? ((R & ~31) + perm32(R & 31)) : R;
        voffA[i] = (unsigned)(R * KB + C * 2); voffB[i] = (unsigned)(Rb * KB + C * 2); }
    const size_t kstep = (size_t)(BK * 2);
    const size_t hstep = (size_t)HALF * KB;
    const size_t tstep = 2 * hstep;
    const unsigned ldsw = (unsigned)wid * 1024u;
    const int aoff = lds_byte(wr * 64 + fr, fq * 8), boff = lds_byte(wc * 32 + fr, fq * 8);
#define PG8_SA(b, h) (((b) * 2 + (h)) * HTB)
#define PG8_SB(b, h) ((4 + (b) * 2 + (h)) * HTB)
#define PG8_STAGE(bufoff, gbase, voff) do { _Pragma("unroll") for (int _i = 0; _i < 2; ++_i) \
        __builtin_amdgcn_global_load_lds((const unsigned*)((const char*)(gbase) + (voff)[_i]), (PG8_LAS unsigned*)(lds + (bufoff) + ldsw + _i * 8192), 16, 0, 0); } while (0)
#define PG8_LDA(dst, b, h) do { _Pragma("unroll") for (int m = 0; m < 4; ++m) _Pragma("unroll") for (int k = 0; k < 2; ++k) dst[m][k] = *(const PG8_LAS bf16x8*)(lds + PG8_SA(b, h) + aoff + m * 2048 + k * 1024); } while (0)
#define PG8_LDB(dst, b, h) do { _Pragma("unroll") for (int n = 0; n < 2; ++n) _Pragma("unroll") for (int k = 0; k < 2; ++k) dst[n][k] = *(const PG8_LAS bf16x8*)(lds + PG8_SB(b, h) + boff + n * 2048 + k * 1024); } while (0)
#define PG8_CAT(x) __builtin_shufflevector(__builtin_bit_cast(i32x4, (x)[0]), __builtin_bit_cast(i32x4, (x)[1]), 0, 1, 2, 3, 4, 5, 6, 7)
#define PG8_MMA(ai, bj, At, Bt) do { __builtin_amdgcn_s_setprio(1); _Pragma("unroll") for (int m = 0; m < 4; ++m) _Pragma("unroll") for (int n = 0; n < 2; ++n) { \
        if constexpr (FP8) { const i32x8 b8_ = PG8_CAT(Bt[n]), a8_ = PG8_CAT(At[m]); asm volatile("v_mfma_f32_16x16x128_f8f6f4 %0, %1, %2, %0" : "+v"(acc[ai][bj][m][n]) : "v"(b8_), "v"(a8_)); }   \
        else { _Pragma("unroll") for (int k = 0; k < 2; ++k) acc[ai][bj][m][n] = __builtin_amdgcn_mfma_f32_16x16x32_bf16(Bt[n][k], At[m][k], acc[ai][bj][m][n], 0, 0, 0); } } __builtin_amdgcn_s_setprio(0); } while (0)
#define PG8_WAIT_V(n) asm volatile("s_waitcnt vmcnt(" #n ")" ::: "memory")
#define PG8_WAIT_L(n) asm volatile("s_waitcnt lgkmcnt(" #n ")" ::: "memory")
#define PG8_BAR __builtin_amdgcn_s_barrier()
#define PG8_SCHED __builtin_amdgcn_sched_barrier(0)
    Unit cur, nxt; int ui = 0;
    if (!S.next(0, cur)) return;
    f32x4 acc[2][2][4][2];
#pragma unroll
    for (int a = 0; a < 2; ++a)
#pragma unroll
        for (int b = 0; b < 2; ++b)
#pragma unroll
            for (int m = 0; m < 4; ++m)
#pragma unroll
                for (int n = 0; n < 2; ++n) acc[a][b][m][n] = (f32x4){0.f, 0.f, 0.f, 0.f};
    bf16x8 At[4][2], B0[2][2], B1[2][2];
    const char* cA = (const char*)g.A + (size_t)cur.pm * tstep; const char* cB = (const char*)g.Bt + (size_t)cur.pn * tstep;
    S.a_ready(cur);
    if constexpr (SP2) {
        PG8_STAGE(PG8_SB(0, 0), cB, voffB); PG8_STAGE(PG8_SB(0, 1), cB + hstep, voffB); PG8_STAGE(PG8_SA(0, 0), cA, voffA); PG8_STAGE(PG8_SA(0, 1), cA + hstep, voffA);
        if (wr == 1) PG8_BAR;
        PG8_WAIT_V(2); PG8_BAR;
        PG8_STAGE(PG8_SB(1, 0), cB + kstep, voffB); PG8_STAGE(PG8_SA(1, 0), cA + kstep, voffA); PG8_STAGE(PG8_SB(1, 1), cB + hstep + kstep, voffB);
        PG8_WAIT_V(6); PG8_BAR;
    } else {
        PG8_STAGE(PG8_SB(0, 0), cB, voffB); PG8_STAGE(PG8_SA(0, 0), cA, voffA); PG8_STAGE(PG8_SB(0, 1), cB + hstep, voffB); PG8_STAGE(PG8_SA(0, 1), cA + hstep, voffA);
        if (wr == 1) PG8_BAR;
        PG8_WAIT_V(4); PG8_BAR;
        PG8_STAGE(PG8_SB(1, 0), cB + kstep, voffB); PG8_STAGE(PG8_SA(1, 0), cA + kstep, voffA); PG8_STAGE(PG8_SB(1, 1), cB + hstep + kstep, voffB);
        PG8_WAIT_V(6); PG8_BAR;
    }
    for (;;) {
        const bool has_next = S.next(ui + 1, nxt);
        const char* nA = has_next ? (const char*)g.A + (size_t)nxt.pm * tstep : cA; const char* nB = has_next ? (const char*)g.Bt + (size_t)nxt.pn * tstep : cB;
        for (int t = 0; t < nt; t += 2) {
            if constexpr (Epi::MIDT > 0) { if (t == Epi::MIDT) E.mid(acc, cur, wr, fr); }
            const bool last = (t == nt - 2);
            const char* a1 = cA + (size_t)(t + 1) * kstep;
            const char* a2 = last ? nA : cA + (size_t)(t + 2) * kstep; const char* b2 = last ? nB : cB + (size_t)(t + 2) * kstep;
            const char* a3 = a2 + kstep; const char* b3 = b2 + kstep;
            if (last && has_next) S.a_ready(nxt);
            if constexpr (SP2) {
            PG8_LDB(B0, 0, 0); PG8_LDB(B1, 0, 1); PG8_SCHED; PG8_LDA(At, 0, 0); PG8_STAGE(PG8_SA(1, 1), a1 + hstep, voffA);
            PG8_WAIT_V(8); PG8_WAIT_L(0); PG8_BAR; PG8_MMA(0, 0, At, B0); PG8_MMA(0, 1, At, B1); PG8_BAR; PG8_SCHED;
            PG8_LDA(At, 0, 1); PG8_STAGE(PG8_SB(0, 0), b2, voffB); PG8_STAGE(PG8_SB(0, 1), b2 + hstep, voffB); PG8_STAGE(PG8_SA(0, 0), a2, voffA);
            PG8_WAIT_V(8); PG8_WAIT_L(0); PG8_BAR; PG8_MMA(1, 0, At, B0); PG8_MMA(1, 1, At, B1); PG8_BAR; PG8_SCHED;
            PG8_LDB(B0, 1, 0); PG8_LDB(B1, 1, 1); PG8_SCHED; PG8_LDA(At, 1, 0); PG8_STAGE(PG8_SA(0, 1), a2 + hstep, voffA);
            PG8_WAIT_V(8); PG8_WAIT_L(0); PG8_BAR; PG8_MMA(0, 0, At, B0); PG8_MMA(0, 1, At, B1); PG8_BAR; PG8_SCHED;
            PG8_LDA(At, 1, 1); PG8_STAGE(PG8_SB(1, 0), b3, voffB); PG8_STAGE(PG8_SB(1, 1), b3 + hstep, voffB); PG8_STAGE(PG8_SA(1, 0), a3, voffA);
            PG8_WAIT_V(8); PG8_WAIT_L(0); PG8_BAR; PG8_MMA(1, 0, At, B0); PG8_MMA(1, 1, At, B1); PG8_BAR; PG8_SCHED;
            } else {
            PG8_LDB(B0, 0, 0); PG8_SCHED; PG8_LDA(At, 0, 0); PG8_STAGE(PG8_SA(1, 1), a1 + hstep, voffA);
            PG8_WAIT_L(8); PG8_BAR; PG8_WAIT_L(0); PG8_MMA(0, 0, At, B0); PG8_BAR; PG8_SCHED;
            PG8_LDB(B1, 0, 1); PG8_STAGE(PG8_SB(0, 0), b2, voffB);
            PG8_BAR; PG8_WAIT_L(0); PG8_MMA(0, 1, At, B1); PG8_BAR;
            PG8_LDA(At, 0, 1); PG8_STAGE(PG8_SA(0, 0), a2, voffA);
            PG8_BAR; PG8_WAIT_L(0); PG8_MMA(1, 0, At, B0); PG8_BAR; PG8_SCHED;
            PG8_STAGE(PG8_SB(0, 1), b2 + hstep, voffB);
            PG8_WAIT_V(6); PG8_BAR; PG8_MMA(1, 1, At, B1); PG8_BAR;
            PG8_LDB(B0, 1, 0); PG8_SCHED; PG8_LDA(At, 1, 0); PG8_STAGE(PG8_SA(0, 1), a2 + hstep, voffA);
            PG8_WAIT_L(8); PG8_BAR; PG8_WAIT_L(0); PG8_MMA(0, 0, At, B0); PG8_BAR; PG8_SCHED;
            PG8_LDB(B1, 1, 1); PG8_STAGE(PG8_SB(1, 0), b3, voffB);
            PG8_BAR; PG8_WAIT_L(0); PG8_MMA(0, 1, At, B1); PG8_BAR;
            PG8_LDA(At, 1, 1); PG8_STAGE(PG8_SA(1, 0), a3, voffA);
            PG8_BAR; PG8_WAIT_L(0); PG8_MMA(1, 0, At, B0); PG8_BAR; PG8_SCHED;
            PG8_STAGE(PG8_SB(1, 1), b3 + hstep, voffB);
            PG8_WAIT_V(6); PG8_BAR; PG8_MMA(1, 1, At, B1); PG8_BAR;
            }
        }
        if constexpr (FP8) {
            asm volatile("s_nop 15\n\ts_nop 15" ::: "memory");
#pragma unroll
            for (int a = 0; a < 2; ++a)
#pragma unroll
                for (int b = 0; b < 2; ++b)
#pragma unroll
                    for (int m = 0; m < 4; ++m)
#pragma unroll
                        for (int n = 0; n < 2; ++n) asm volatile("" : "+v"(acc[a][b][m][n]));
        }
        if constexpr (ALIGN_EPI) { if (wr == 0) PG8_BAR; }
        if constexpr (!Epi::AFTER_DRAIN) { E(acc, cur, wr, wc, fr, fq); S.done(cur); }
        if (!has_next) break;
#pragma unroll
        for (int a = 0; a < 2; ++a)
#pragma unroll
            for (int b = 0; b < 2; ++b)
#pragma unroll
                for (int m = 0; m < 4; ++m)
#pragma unroll
                    for (int n = 0; n < 2; ++n) acc[a][b][m][n] = (f32x4){0.f, 0.f, 0.f, 0.f};
        cur = nxt; cA = nA; cB = nB; ++ui;
        if constexpr (ALIGN_EPI) { if (wr == 1) PG8_BAR; }
    }
    PG8_WAIT_V(0);
    if constexpr (!ALIGN_EPI) { if (wr == 0) PG8_BAR; }
    PG8_BAR;
    if constexpr (Epi::AFTER_DRAIN) { E.fused(acc, cur, wr, wc, fr, fq, lds, wid, lane); S.done(cur); }
#undef PG8_SA
#undef PG8_SB
#undef PG8_STAGE
#undef PG8_LDA
#undef PG8_LDB
#undef PG8_MMA
#undef PG8_CAT
#undef PG8_WAIT_V
#undef PG8_WAIT_L
#undef PG8_BAR
#undef PG8_SCHED
}
}

#define PG8_SP2 true
#define PG8_ALIGN true
namespace att {
typedef unsigned short bf16;
using bf16x8 = __attribute__((ext_vector_type(8))) short;
using s16x4  = __attribute__((ext_vector_type(4))) short;
using f32x16 = __attribute__((ext_vector_type(16))) float;
using u32x4  = __attribute__((ext_vector_type(4))) unsigned;
#define ATT_LAS __attribute__((address_space(3)))
typedef ATT_LAS char* lptr;
constexpr int   D = 128, NW = 8, QBLK = 32, KVBLK = 64;
constexpr float SCALE = 0.088388347648318440f;
constexpr float THR = 8.f;
constexpr int SHM_V = KVBLK * D * 2, SHM_K = KVBLK * D * 2, SHM_ATTN = 2 * SHM_V + 2 * SHM_K + NW * 64 * 4;
#define KSWZ(row, colB) ((row) * 256 + ((colB) ^ (((row) & 7) << 4)))
#define SBAR() __builtin_amdgcn_sched_barrier(0)
__device__ __forceinline__ int crow(int r, int hi) { return (r & 3) + 8 * (r >> 2) + 4 * hi; }
__device__ __forceinline__ unsigned cvtpk(float lo, float hi) { unsigned r; asm volatile("v_cvt_pk_bf16_f32 %0, %1, %2" : "=v"(r) : "v"(lo), "v"(hi)); return r; }
__device__ __forceinline__ void partialSM(f32x16& p0, f32x16& p1, float& m_reg, float& mn, float& alpha) {
  constexpr float C = SCALE * 1.4426950408889634f;
  float pmax = p0[0];
#pragma unroll
  for (int r = 1; r < 16; ++r) pmax = fmaxf(pmax, p0[r]);
#pragma unroll
  for (int r = 0; r < 16; ++r) pmax = fmaxf(pmax, p1[r]);
  { auto rr = __builtin_amdgcn_permlane32_swap(__float_as_uint(pmax), __float_as_uint(pmax), false, false);
    pmax = fmaxf(__uint_as_float(rr[0]), __uint_as_float(rr[1])); }
  if (__builtin_expect(__all(pmax - m_reg <= THR / SCALE), 1)) { mn = m_reg; alpha = 1.f; }
  else { mn = fmaxf(m_reg, pmax); alpha = __builtin_amdgcn_exp2f((m_reg - mn) * C); m_reg = mn; }
  float mnC = -mn * C;
#pragma unroll
  for (int r = 0; r < 16; ++r) p0[r] = fmaf(p0[r], C, mnC);
#pragma unroll
  for (int r = 0; r < 16; ++r) p1[r] = fmaf(p1[r], C, mnC);
#pragma unroll
  for (int r = 0; r < 16; ++r) p0[r] = __builtin_amdgcn_exp2f(p0[r]);
}
__device__ __forceinline__ void finishSM(f32x16& p0, f32x16& p1, float alpha, float& l_reg, bf16x8& pa0, bf16x8& pa1, bf16x8& pa2, bf16x8& pa3) {
#pragma unroll
  for (int r = 0; r < 16; ++r) p1[r] = __builtin_amdgcn_exp2f(p1[r]);
  float ps = 0;
#pragma unroll
  for (int r = 0; r < 16; ++r) ps += p0[r];
#pragma unroll
  for (int r = 0; r < 16; ++r) ps += p1[r];
  { auto rr = __builtin_amdgcn_permlane32_swap(__float_as_uint(ps), __float_as_uint(ps), false, false);
    ps = __uint_as_float(rr[0]) + __uint_as_float(rr[1]); }
  l_reg = l_reg * alpha + ps;
#define PK4(P, BASE, OUT) do { unsigned a0 = cvtpk(P[BASE + 0], P[BASE + 1]), a1 = cvtpk(P[BASE + 2], P[BASE + 3]);   \
    unsigned b0 = cvtpk(P[BASE + 4], P[BASE + 5]), b1 = cvtpk(P[BASE + 6], P[BASE + 7]);                              \
    auto r0 = __builtin_amdgcn_permlane32_swap(a0, b0, false, false); auto r1 = __builtin_amdgcn_permlane32_swap(a1, b1, false, false); \
    u32x4 w = {r0[0], r1[0], r0[1], r1[1]}; OUT = *reinterpret_cast<bf16x8*>(&w); } while (0)
  PK4(p0, 0, pa0); PK4(p0, 8, pa1); PK4(p1, 0, pa2); PK4(p1, 8, pa3);
#undef PK4
}
__device__ __forceinline__ void qkt(f32x16& p0, f32x16& p1, lptr Ks, const bf16x8* qr, int r32, int hi) {
  p0 = f32x16{}; p1 = f32x16{};
#pragma unroll
  for (int d0 = 0; d0 < 8; ++d0) { int cb = (d0 * 16 + hi * 8) * 2;
    bf16x8 b0 = *reinterpret_cast<const ATT_LAS bf16x8*>(Ks + KSWZ(r32, cb));
    bf16x8 b1 = *reinterpret_cast<const ATT_LAS bf16x8*>(Ks + KSWZ(32 + r32, cb));
    p0 = __builtin_amdgcn_mfma_f32_32x32x16_bf16(b0, qr[d0], p0, 0, 0, 0);
    p1 = __builtin_amdgcn_mfma_f32_32x32x16_bf16(b1, qr[d0], p1, 0, 0, 0); }
}
__device__ __forceinline__ int v_st(int k, int c) { const int kk = (k & ~0xC) | ((k & 4) << 1) | ((k & 8) >> 1); return ((kk >> 3) * 4 + (c >> 5)) * 512 + ((kk & 7) * 32 + (c & 31)) * 2; }
__device__ __forceinline__ int v_rd_base(int lane) { return ((lane & 3) << 3) | (((lane >> 2) & 3) << 6) | (((lane >> 4) & 1) << 5) | (((lane >> 5) & 1) << 8); }
constexpr int v_rd_off(int d0, int ks, int half) { return d0 * 512 + ks * 4096 + half * 2048; }
template <int OFF> __device__ __forceinline__ s16x4 tr_read(int vb) {
  s16x4 r; asm volatile("ds_read_b64_tr_b16 %0, %1 offset:%2" : "=&v"(r) : "v"(vb), "i"(OFF) : "memory"); return r;
}
template <int D0> __device__ __forceinline__ void pv_one(f32x16& od, int vb, bf16x8 pa0, bf16x8 pa1, bf16x8 pa2, bf16x8 pa3) {
  const s16x4 l0 = tr_read<v_rd_off(D0, 0, 0)>(vb), h0 = tr_read<v_rd_off(D0, 0, 1)>(vb), l1 = tr_read<v_rd_off(D0, 1, 0)>(vb), h1 = tr_read<v_rd_off(D0, 1, 1)>(vb);
  const s16x4 l2 = tr_read<v_rd_off(D0, 2, 0)>(vb), h2 = tr_read<v_rd_off(D0, 2, 1)>(vb), l3 = tr_read<v_rd_off(D0, 3, 0)>(vb), h3 = tr_read<v_rd_off(D0, 3, 1)>(vb);
  asm volatile("s_waitcnt lgkmcnt(0)" ::: "memory"); SBAR();
#define PK(L, H) (bf16x8){L[0], L[1], L[2], L[3], H[0], H[1], H[2], H[3]}
  od = __builtin_amdgcn_mfma_f32_32x32x16_bf16(pa0, PK(l0, h0), od, 0, 0, 0);
  od = __builtin_amdgcn_mfma_f32_32x32x16_bf16(pa1, PK(l1, h1), od, 0, 0, 0);
  od = __builtin_amdgcn_mfma_f32_32x32x16_bf16(pa2, PK(l2, h2), od, 0, 0, 0);
  od = __builtin_amdgcn_mfma_f32_32x32x16_bf16(pa3, PK(l3, h3), od, 0, 0, 0);
#undef PK
}
__device__ __forceinline__ void pv_d0(f32x16* o, int vb, bf16x8 pa0, bf16x8 pa1, bf16x8 pa2, bf16x8 pa3) {
  pv_one<0>(o[0], vb, pa0, pa1, pa2, pa3); pv_one<1>(o[1], vb, pa0, pa1, pa2, pa3); pv_one<2>(o[2], vb, pa0, pa1, pa2, pa3); pv_one<3>(o[3], vb, pa0, pa1, pa2, pa3);
}
__device__ __forceinline__ void moba_mask(f32x16& p0, f32x16& p1, int tile, int qb, unsigned sel, int qi, int w0, int hi) {
  const float NINF = -__builtin_inff();
  const int jb = tile >> 2;
  if (jb < qb) {
    const bool ok = ((sel >> jb) & 1u) != 0u;
    if (!__all(ok)) {
#pragma unroll
      for (int r = 0; r < 16; ++r) { p0[r] = ok ? p0[r] : NINF; p1[r] = ok ? p1[r] : NINF; }
    }
  } else {
    const int k0 = (tile & 3) * 64;
    if (k0 + 63 > w0) {
      int lim = qi - k0 - 4 * hi; asm volatile("" : "+v"(lim));
#pragma unroll
      for (int r = 0; r < 16; ++r) { const int kc = (r & 3) + 8 * (r >> 2); p0[r] = (kc <= lim) ? p0[r] : NINF; p1[r] = (kc + 32 <= lim) ? p1[r] : NINF; }
    }
  }
}

template <bool MOBA, int LDQ, int LDK, int LDO, int SDEPTH, typename TO>
__device__ __forceinline__ void attn_body(const bf16* __restrict__ Qb, const bf16* __restrict__ Kh, const bf16* __restrict__ Vh, TO* __restrict__ Ob, int seq, lptr lds,
                                          int qb, const float* __restrict__ kms, int kms_stride, unsigned long long* __restrict__ ssq) {
  int tid_ = threadIdx.x; asm volatile("" : "+v"(tid_));
  const int tid = tid_, wid = tid >> 6, lane = tid & 63, r32 = lane & 31, hi = lane >> 5;
  lptr V_lds = lds; lptr K_lds = lds + 2 * SHM_V;
  ATT_LAS float* ws = (ATT_LAS float*)(lds + 2 * SHM_V + 2 * SHM_K) + wid * 64; ATT_LAS float* li_l = ws; ATT_LAS float* al_l = ws + 32;
  float m_reg = -1e30f, l_reg = 0; f32x16 o[4] = {}; bf16x8 qr[8];
  unsigned qoff = (unsigned)((wid * QBLK + r32) * LDQ + hi * 8); asm volatile("" : "+v"(qoff));
  const bf16* Qw = Qb + qoff;
#pragma unroll
  for (int d0 = 0; d0 < 8; ++d0) qr[d0] = *reinterpret_cast<const bf16x8*>(Qw + d0 * 16);
  const int sr = tid >> 4, sc = (tid & 15) * 8, vst0 = v_st(sr, sc), vst1 = v_st(32 + sr, sc);
  const int vb0 = (int)(uintptr_t)V_lds + v_rd_base(lane);
  struct { bf16x8 vs0, vs1, ks0, ks1; } sr_[SDEPTH];
  const unsigned so0 = (unsigned)(sr * LDK + sc), so1 = (unsigned)((32 + sr) * LDK + sc);
#define SLOAD(i, k0) do { const bf16* Vt_ = Vh + (long)(k0) * LDK; const bf16* Kt_ = Kh + (long)(k0) * LDK; \
    sr_[i].vs0 = *reinterpret_cast<const bf16x8*>(Vt_ + so0); sr_[i].vs1 = *reinterpret_cast<const bf16x8*>(Vt_ + so1); \
    sr_[i].ks0 = *reinterpret_cast<const bf16x8*>(Kt_ + so0); sr_[i].ks1 = *reinterpret_cast<const bf16x8*>(Kt_ + so1); } while (0)
#define SWRITE(b, i) do { *(ATT_LAS bf16x8*)(V_lds + (b) * SHM_V + vst0) = sr_[i].vs0;          \
    *(ATT_LAS bf16x8*)(V_lds + (b) * SHM_V + vst1) = sr_[i].vs1; int kc = sc * 2;               \
    *(ATT_LAS bf16x8*)(K_lds + (b) * SHM_K + KSWZ(sr, kc)) = sr_[i].ks0;                       \
    *(ATT_LAS bf16x8*)(K_lds + (b) * SHM_K + KSWZ(32 + sr, kc)) = sr_[i].ks1; } while (0)
#define SWAIT() do { if constexpr (SDEPTH == 2) asm volatile("s_waitcnt vmcnt(4)" ::: "memory"); else asm volatile("s_waitcnt vmcnt(0)" ::: "memory"); } while (0)
#define RESC(a) do { if (__any((a) < 1.f)) { if (hi == 0) al_l[r32] = (a); asm volatile("s_waitcnt lgkmcnt(0)" ::: "memory"); \
    _Pragma("unroll") for (int d = 0; d < 4; ++d) _Pragma("unroll") for (int r = 0; r < 16; ++r) o[d][r] *= al_l[crow(r, hi)]; } } while (0)
  f32x16 pA0, pA1, pB0, pB1; float mnA, mnB, alA, alB; bf16x8 pa0, pa1, pa2, pa3; const int NT = seq / KVBLK;
  constexpr int SE = 0, SO = SDEPTH - 1;
  unsigned sel = 0u; const int qi = wid * QBLK + r32, w0 = wid * QBLK;
  SLOAD(SE, 0);
  if constexpr (MOBA) {
    { const int j = sr & 15; const float* src = kms + (size_t)j * kms_stride + sc; const float4 x0 = *reinterpret_cast<const float4*>(src), x1 = *reinterpret_cast<const float4*>(src + 4);
      const float xv[8] = {x0.x, x0.y, x0.z, x0.w, x1.x, x1.y, x1.z, x1.w}; unsigned w[4];
#pragma unroll
      for (int e = 0; e < 4; ++e) { const unsigned h2 = cvtpk(xv[2 * e], xv[2 * e + 1]); const float f0 = __uint_as_float(h2 << 16), f1 = __uint_as_float(h2 & 0xffff0000u);
        const unsigned l2 = cvtpk(xv[2 * e] - f0, xv[2 * e + 1] - f1); w[e] = (sr < 16) ? h2 : l2; }
      u32x4 wv = {w[0], w[1], w[2], w[3]}; *(ATT_LAS u32x4*)(K_lds + KSWZ(sr, sc * 2)) = wv; }
    __syncthreads();
    f32x16 g = f32x16{};
#pragma unroll
    for (int d0 = 0; d0 < 8; ++d0) { const int cb = (d0 * 16 + hi * 8) * 2; const bf16x8 b0 = *reinterpret_cast<const ATT_LAS bf16x8*>(K_lds + KSWZ(r32, cb));
      g = __builtin_amdgcn_mfma_f32_32x32x16_bf16(b0, qr[d0], g, 0, 0, 0); }
    float G[16];
#pragma unroll
    for (int r = 0; r < 8; ++r) { const float own = g[r] + g[r + 8]; const float oth = __shfl_xor(own, 32); const int lb = (r & 3) + 8 * (r >> 2);
      G[lb] = hi ? oth : own; G[lb + 4] = hi ? own : oth; }
    const float NINF = -__builtin_inff();
#pragma unroll
    for (int j = 0; j < 16; ++j) G[j] = (j < qb) ? G[j] : NINF;
#pragma unroll
    for (int it = 0; it < 3; ++it) { float mx = NINF; int mi = -1;
#pragma unroll
      for (int j = 0; j < 16; ++j) { const bool gt = G[j] > mx; mx = gt ? G[j] : mx; mi = gt ? j : mi; }
      if (mi >= 0) sel |= 1u << mi;
#pragma unroll
      for (int j = 0; j < 16; ++j) G[j] = (j == mi) ? NINF : G[j]; }
    __syncthreads();
  }
  asm volatile("s_waitcnt vmcnt(0)" ::: "memory"); SWRITE(0, SE); __syncthreads();
  qkt(pA0, pA1, K_lds, qr, r32, hi);
  if constexpr (MOBA) moba_mask(pA0, pA1, 0, qb, sel, qi, w0, hi);
  partialSM(pA0, pA1, m_reg, mnA, alA);
  SLOAD(SO, KVBLK); if constexpr (SDEPTH == 2) { if (2 < NT) SLOAD(SE, 2 * KVBLK); }
  SWAIT(); SWRITE(1, SO); __syncthreads();
  for (int j = 1; j + 1 < NT; j += 2) {
    SBAR(); qkt(pB0, pB1, K_lds + SHM_K, qr, r32, hi);
    finishSM(pA0, pA1, alA, l_reg, pa0, pa1, pa2, pa3); SBAR();
    SLOAD(SO, (j + SDEPTH) * KVBLK); SBAR();
    pv_d0(o, vb0, pa0, pa1, pa2, pa3);
    if constexpr (MOBA) moba_mask(pB0, pB1, j, qb, sel, qi, w0, hi);
    partialSM(pB0, pB1, m_reg, mnB, alB);
    __syncthreads(); SWAIT(); SWRITE(0, SE);
    RESC(alB); __syncthreads();
    SBAR(); qkt(pA0, pA1, K_lds, qr, r32, hi);
    finishSM(pB0, pB1, alB, l_reg, pa0, pa1, pa2, pa3); SBAR();
    if (SDEPTH == 1 || j + 3 < NT) SLOAD(SE, (j + 1 + SDEPTH) * KVBLK); SBAR();
    pv_d0(o, vb0 + SHM_V, pa0, pa1, pa2, pa3);
    if constexpr (MOBA) moba_mask(pA0, pA1, j + 1, qb, sel, qi, w0, hi);
    partialSM(pA0, pA1, m_reg, mnA, alA);
    __syncthreads(); SWAIT(); SWRITE(1, SO);
    RESC(alA); __syncthreads();
  }
  SBAR(); qkt(pB0, pB1, K_lds + SHM_K, qr, r32, hi);
  finishSM(pA0, pA1, alA, l_reg, pa0, pa1, pa2, pa3); SBAR();
  pv_d0(o, vb0, pa0, pa1, pa2, pa3);
  if constexpr (MOBA) moba_mask(pB0, pB1, NT - 1, qb, sel, qi, w0, hi);
  partialSM(pB0, pB1, m_reg, mnB, alB);
  __syncthreads(); RESC(alB);
  finishSM(pB0, pB1, alB, l_reg, pa0, pa1, pa2, pa3); SBAR();
  pv_d0(o, vb0 + SHM_V, pa0, pa1, pa2, pa3);
  if (hi == 0) li_l[r32] = l_reg; asm volatile("s_waitcnt lgkmcnt(0)" ::: "memory");
  float rli[16];
#pragma unroll
  for (int r = 0; r < 16; ++r) rli[r] = __builtin_amdgcn_rcpf(li_l[crow(r, hi)]);
  int ohi = hi * 4, ocol = r32; asm volatile("" : "+v"(ohi), "+v"(ocol));
  TO* Ow = Ob + (long)(wid * QBLK) * LDO;
#pragma unroll
  for (int r = 0; r < 16; ++r) { const int orow = (r & 3) + 8 * (r >> 2) + ohi; float sq = 0.f;
#pragma unroll
    for (int d0 = 0; d0 < 4; ++d0) { const float v = o[d0][r] * rli[r]; sq += v * v; if constexpr (sizeof(TO) == 2) Ow[(unsigned)(orow * LDO + d0 * 32 + ocol)] = (TO)(cvtpk(v, v) & 0xffffu);
      else Ow[(unsigned)(orow * LDO + d0 * 32 + ocol)] = (TO)(__builtin_amdgcn_cvt_pk_fp8_f32(__builtin_amdgcn_fmed3f(v * 16.0f, -448.0f, 448.0f), 0.0f, 0, false) & 0xff); }
    if constexpr (MOBA) { sq += __shfl_xor(sq, 1); sq += __shfl_xor(sq, 2); sq += __shfl_xor(sq, 4); sq += __shfl_xor(sq, 8); sq += __shfl_xor(sq, 16);
      if (ocol == 0) pg8::ss_add(ssq, wid * QBLK + orow, sq); } }
  __syncthreads();
#undef SLOAD
#undef SWRITE
#undef SWAIT
#undef RESC
}
#undef KSWZ
#undef SBAR
}

constexpr int NWAVES = 8;
constexpr int BATCH = 4, SEQ = 4096, D = 2048, M = BATCH * SEQ, FF = 5632, AW = 1024, CW = 1024, INW = 6144, MEML = 256, XW = 512, NH = 8, XH = 4, NBLK = 16;
constexpr int NPH = 13;
#ifndef FAST_MASK
#define FAST_MASK 0x1fff
#endif
#ifndef ONE_LAUNCH
#define ONE_LAUNCH 1
#endif
constexpr size_t MiB = 1u << 20, KiB = 1u << 10;
constexpr size_t WS_CTL = 0, CTL_ZERO_BYTES = 1536 * KiB;
constexpr size_t CTL_BAR = 64 * KiB, BAR_STRIDE = 16 * KiB;
constexpr size_t CTL_SS = 320 * KiB;
constexpr size_t CTL_KMS = 1088 * KiB;
constexpr size_t WS_WGU1 = 2 * MiB, WS_WD1 = 46 * MiB, WS_WGU2 = 68 * MiB, WS_WD2 = 112 * MiB, WS_WIN = 134 * MiB, WS_WOUT = 158 * MiB, WS_WQ = 166 * MiB, WS_WKV = 168 * MiB, WS_WO = 172 * MiB;
constexpr size_t WS_MEMN = 174 * MiB, WS_KVX = 178 * MiB, WS_HB = 180 * MiB, WS_MIXED = 244 * MiB, WS_ACT = 308 * MiB;
constexpr size_t WS_Q = 308 * MiB, WS_K = 340 * MiB, WS_V = 372 * MiB, WS_CU = 404 * MiB, WS_BG = 436 * MiB;
constexpr size_t WS_QX = 308 * MiB, WS_OX = 324 * MiB;
constexpr size_t WS_HB8 = 340 * MiB, WS_ACT8 = 396 * MiB, WS_OX8 = 324 * MiB;
constexpr size_t WS_DUMMY = 484 * MiB;
constexpr size_t WS_END = 486 * MiB;
static_assert(WS_ACT + (size_t)M * FF * 2 <= WS_END && WS_BG + (size_t)M * 1024 * 2 <= WS_END && CTL_KMS + BATCH * 16 * 8 * 128 * 4 <= CTL_ZERO_BYTES && CTL_SS + 6 * M * 8 <= CTL_KMS && CTL_ZERO_BYTES <= WS_WGU1, "d_ws map");
constexpr int RING_OFF = 0, RING_BYTES = 131072;
constexpr int LDSCTL_OFF = RING_BYTES, MISC_OFF = LDSCTL_OFF + 320;
constexpr int LDS_BYTES = 147456;
static_assert(MISC_OFF + 128 <= LDS_BYTES && att::SHM_ATTN <= RING_BYTES, "LDS map");

#define GAS __attribute__((address_space(1)))
#define LAS __attribute__((address_space(3)))
typedef unsigned short bf16;
typedef unsigned v4u __attribute__((ext_vector_type(4)));
typedef unsigned v2u __attribute__((ext_vector_type(2)));
typedef float f32x4 __attribute__((ext_vector_type(4)));
typedef short bf16x8 __attribute__((ext_vector_type(8)));
typedef GAS unsigned gu32;
#define RLX_AGENT __ATOMIC_RELAXED, __HIP_MEMORY_SCOPE_AGENT
#define LDS_WAIT() asm volatile("s_waitcnt lgkmcnt(0)" ::: "memory")
#define VM_WAIT() asm volatile("s_waitcnt vmcnt(0)" ::: "memory")
__device__ __forceinline__ unsigned pk2(float lo, float hi) { return pg8::cvt_pk_bf16(lo, hi); }
__device__ __forceinline__ float bflo(unsigned w) { return __uint_as_float(w << 16); }
__device__ __forceinline__ float bfhi(unsigned w) { return __uint_as_float(w & 0xffff0000u); }
__device__ __forceinline__ float wave_sum(float v) {
#pragma unroll
    for (int o = 1; o < 64; o <<= 1) v += __shfl_xor(v, o);
    return v;
}
#define XB_TMO      128
#define XB_XCNT(j)  (256  + 64 * (j))
#define XB_XSUB(j)  (1280 + 64 * (j))
#define XB_XGEN(j)  (2304 + 64 * (j))
#define XB_TOP      3328
#define XB_TOPGEN   3392
#define XCD_BAR_WORDS 3456
#define XB_SPIN_CAP (1u << 18)

__device__ __forceinline__ unsigned xb_ld(unsigned* p)              { return __hip_atomic_load(p, __ATOMIC_RELAXED, __HIP_MEMORY_SCOPE_AGENT); }
__device__ __forceinline__ unsigned xb_add(unsigned* p, unsigned v) { return __hip_atomic_fetch_add(p, v, __ATOMIC_RELAXED, __HIP_MEMORY_SCOPE_AGENT); }
__device__ __forceinline__ unsigned xb_xcc_id() { return (unsigned)__builtin_amdgcn_s_getreg((3 << 11) | 20) & 0xFu; }
#define XB_SPIN(cond, bar) do { unsigned _sp = 0; while (cond) { __builtin_amdgcn_s_sleep(1); \
    if ((++_sp & 255u) == 0u) { if (xb_ld(&(bar)[XB_TMO])) break; if (_sp > XB_SPIN_CAP) { atomicAdd(&(bar)[XB_TMO], 1u); break; } } } } while (0)

struct XcdBarrier {
    unsigned* bar; unsigned x;
    volatile LAS unsigned* st;
};

__device__ __forceinline__ XcdBarrier xcd_barrier_post(unsigned* bar, volatile LAS unsigned* st) {
    XcdBarrier b; b.bar = bar; b.x = xb_xcc_id(); b.st = st;
    if (threadIdx.x == 0) (void)xb_add(&bar[XB_XCNT(b.x)], 1u);
    return b;
}
__device__ __forceinline__ void xcd_barrier_complete(unsigned* bar, unsigned x, unsigned& nloc, unsigned& nx) {
    const unsigned G = gridDim.x * gridDim.y * gridDim.z;
    unsigned sum, cnt, mine, sp = 0u;
    for (;;) {
        sum = 0u; cnt = 0u; mine = 0u;
#pragma unroll
        for (unsigned j = 0; j < 16; ++j) { const unsigned c = xb_ld(&bar[XB_XCNT(j)]); sum += c; cnt += (c > 0u) ? 1u : 0u; mine = (j == x) ? c : mine; }
        if (sum == G) break;
        __builtin_amdgcn_s_sleep(1);
        if ((++sp & 255u) == 0u) { if (xb_ld(&bar[XB_TMO])) break; if (sp > XB_SPIN_CAP) { atomicAdd(&bar[XB_TMO], 1u); break; } }
    }
    nloc = mine > 0u ? mine : 1u; nx = cnt > 0u ? cnt : 1u;
}

__device__ __forceinline__ void xcd_barrier(const XcdBarrier& b) {
    asm volatile("s_waitcnt vmcnt(0)" ::: "memory");
    __syncthreads();
    if (threadIdx.x == 0) {
        unsigned* bar = b.bar;
        __builtin_amdgcn_s_waitcnt(0);
        unsigned nloc = b.st[0], nx = b.st[1];
        if (nloc == 0u) { xcd_barrier_complete(bar, b.x, nloc, nx); b.st[0] = nloc; b.st[1] = nx; }
        const unsigned old = xb_add(&bar[XB_XSUB(b.x)], 1u);
        const unsigned gen = old / nloc;
        if (old + 1u == (gen + 1u) * nloc) {
            __builtin_amdgcn_fence(__ATOMIC_RELEASE, "agent");
            asm volatile("s_waitcnt vmcnt(0)" ::: "memory");
            const unsigned og = xb_add(&bar[XB_TOP], 1u);
            const unsigned tg = og / nx;
            if (og + 1u == (tg + 1u) * nx) xb_add(&bar[XB_TOPGEN], 1u);
            else XB_SPIN(xb_ld(&bar[XB_TOPGEN]) == tg, bar);
            __builtin_amdgcn_fence(__ATOMIC_ACQUIRE, "agent");
            xb_add(&bar[XB_XGEN(b.x)], 1u);
            asm volatile("s_waitcnt vmcnt(0)" ::: "memory");
        } else {
            XB_SPIN(xb_ld(&bar[XB_XGEN(b.x)]) == gen, bar);
            __builtin_amdgcn_fence(__ATOMIC_ACQUIRE, "agent");
            asm volatile("s_waitcnt vmcnt(0)" ::: "memory");
        }
    }
    __syncthreads();
}

namespace nv {
typedef float f32x4 __attribute__((ext_vector_type(4)));
typedef short bf16x8 __attribute__((ext_vector_type(8)));
constexpr float EPS = 1e-6f;
template <class F> __global__ __launch_bounds__(256) void gemm(const bf16* __restrict__ A, const bf16* __restrict__ Bt, int K, F f) {
    const int wave = threadIdx.x >> 6, lane = threadIdx.x & 63;
    const int row0 = blockIdx.y * 64 + wave * 16, col0 = blockIdx.x * 64;
    f32x4 acc[4], acc2[4];
#pragma unroll
    for (int c = 0; c < 4; ++c) { acc[c] = (f32x4){0.f, 0.f, 0.f, 0.f}; acc2[c] = (f32x4){0.f, 0.f, 0.f, 0.f}; }
    const bf16* ap = A + (size_t)(row0 + (lane & 15)) * K + 8 * (lane >> 4);
    const bf16* bp[4]; const bf16* bp2[4];
#pragma unroll
    for (int c = 0; c < 4; ++c) { const int col = col0 + 16 * c + (lane & 15); bp[c] = Bt + (size_t)f.brow(col) * K + 8 * (lane >> 4); bp2[c] = Bt + (size_t)f.brow2(col) * K + 8 * (lane >> 4); }
    for (int k0 = 0; k0 < K; k0 += 32) {
        if (F::MIDK > 0 && k0 == F::MIDK) {
#pragma unroll
            for (int j = 0; j < 4; ++j) { const float s = f.midscale(row0 + (lane >> 4) * 4 + j);
#pragma unroll
                for (int c = 0; c < 4; ++c) acc[c][j] *= s; }
        }
        const bf16x8 a = *(const bf16x8*)(ap + k0);
#pragma unroll
        for (int c = 0; c < 4; ++c) { const bf16x8 b = *(const bf16x8*)(bp[c] + k0); acc[c] = __builtin_amdgcn_mfma_f32_16x16x32_bf16(a, b, acc[c], 0, 0, 0);
            if (F::DUAL) { const bf16x8 b2 = *(const bf16x8*)(bp2[c] + k0); acc2[c] = __builtin_amdgcn_mfma_f32_16x16x32_bf16(a, b2, acc2[c], 0, 0, 0); } }
    }
#pragma unroll
    for (int j = 0; j < 4; ++j) { const int row = row0 + (lane >> 4) * 4 + j; float sq = 0.f;
#pragma unroll
        for (int c = 0; c < 4; ++c) { const float h = f.store(row, col0 + 16 * c + (lane & 15), acc[c][j], acc2[c][j]); sq += h * h; }
        if (F::ROWSS) { sq += __shfl_xor(sq, 1); sq += __shfl_xor(sq, 2); sq += __shfl_xor(sq, 4); sq += __shfl_xor(sq, 8); if ((lane & 15) == 0) f.addss(row, sq); } }
}
__device__ __forceinline__ bf16 tobf(float v) { return (bf16)(pg8::cvt_pk_bf16(v, v) & 0xffffu); }
struct FSwiglu { static constexpr bool DUAL = true, ROWSS = false; static constexpr int MIDK = 0; bf16* O; const pg8::u64_t* ss;
    __device__ int brow(int col) const { return (col >> 7) * 256 + (col & 127); } __device__ int brow2(int col) const { return brow(col) + 128; } __device__ float midscale(int) const { return 1.f; } __device__ void addss(int, float) const {}
    __device__ float store(int row, int col, float a, float a2) const { const float rs = rsqrtf(pg8::ss_val(ss, row) * (1.0f / 2048.0f) + EPS), g = a * rs, u = a2 * rs; O[(size_t)row * FF + col] = tobf(g / (1.0f + __expf(-g)) * u); return 0.f; } };
template <int MIDK_, bool RBF, bool OF32> struct FResid { static constexpr bool DUAL = false, ROWSS = true; static constexpr int MIDK = MIDK_; const float* R; const bf16* RB; float* H; bf16* HB; pg8::u64_t* ssn; float alpha; const pg8::u64_t* midss;
    __device__ int brow(int col) const { return col; } __device__ int brow2(int col) const { return col; } __device__ float midscale(int row) const { return rsqrtf(pg8::ss_val(midss, row) * (1.0f / 1024.0f) + EPS); }
    __device__ void addss(int row, float s) const { pg8::ss_add(ssn, row, s); }
    __device__ float store(int row, int col, float a, float) const { const size_t o = (size_t)row * 2048 + col; const float r = RBF ? __uint_as_float((unsigned)RB[o] << 16) : R[o]; const float h = r + alpha * a; if (OF32) H[o] = h; else HB[o] = tobf(h); return h; } };
struct FWin { static constexpr bool DUAL = true, ROWSS = false; static constexpr int MIDK = 0; bf16 *Q, *K, *V, *CU, *BG; const pg8::u64_t* ss;
    __device__ int brow(int col) const { if (col < 3072) return col; if (col < 4096) { const int j = col - 3072; return 3072 + (j >> 7) * 256 + (j & 127); } return 5120 + (col - 4096); }
    __device__ int brow2(int col) const { return (col >= 3072 && col < 4096) ? brow(col) + 128 : brow(col); } __device__ float midscale(int) const { return 1.f; } __device__ void addss(int, float) const {}
    __device__ float store(int row, int col, float a, float a2) const { const float rs = rsqrtf(pg8::ss_val(ss, row) * (1.0f / 2048.0f) + EPS); const size_t o = (size_t)row * 1024 + (col & 1023);
        if (col < 1024) Q[o] = tobf(a * rs); else if (col < 2048) K[o] = tobf(a * rs); else if (col < 3072) V[o] = tobf(a * rs); else if (col < 4096) CU[o] = tobf((a * rs) * (a2 * rs)); else BG[o] = tobf(a * rs); return 0.f; } };
struct FScale { static constexpr bool DUAL = false, ROWSS = false; static constexpr int MIDK = 0; bf16* O; int ldo; const pg8::u64_t* ss;
    __device__ int brow(int col) const { return col; } __device__ int brow2(int col) const { return col; } __device__ float midscale(int) const { return 1.f; } __device__ void addss(int, float) const {}
    __device__ float store(int row, int col, float a, float) const { const float rs = ss ? rsqrtf(pg8::ss_val(ss, row) * (1.0f / 2048.0f) + EPS) : 1.0f; O[(size_t)row * ldo + col] = tobf(a * rs); return 0.f; } };
__global__ __launch_bounds__(256) void kmean(const bf16* __restrict__ K, float* __restrict__ kms) {
    const int i = blockIdx.x * 256 + threadIdx.x; const int d = i & 127, h = (i >> 7) & 7, bb = i >> 10;
    float s = 0.f; for (int r = 0; r < 256; ++r) s += __uint_as_float((unsigned)K[((size_t)bb * 256 + r) * 1024 + h * 128 + d] << 16);
    kms[i] = s;
}
__global__ __launch_bounds__(256) void moba(const bf16* __restrict__ Q, const bf16* __restrict__ K, const bf16* __restrict__ V, const float* __restrict__ kms, bf16* __restrict__ AO, pg8::u64_t* __restrict__ ssA) {
    const int wave = threadIdx.x >> 6, lane = threadIdx.x & 63; const int idx = blockIdx.x * 4 + wave; const int h = idx & 7, row = idx >> 3, b = row >> 12, t = row & 4095, qb = t >> 8;
    const unsigned qw = *(const unsigned*)(Q + (size_t)row * 1024 + h * 128 + 2 * lane); const float q0 = bflo(qw), q1 = bfhi(qw);
    unsigned sel = 0u;
    { float g[16];
#pragma unroll
      for (int j = 0; j < 16; ++j) { const float* km = kms + ((size_t)(b * 16 + j) * 8 + h) * 128 + 2 * lane; const float p = wave_sum(q0 * km[0] + q1 * km[1]); g[j] = (j < qb) ? p : -__builtin_inff(); }
#pragma unroll
      for (int it = 0; it < 3; ++it) { float mx = -__builtin_inff(); int mi = -1;
#pragma unroll
        for (int j = 0; j < 16; ++j) { const bool gt = g[j] > mx; mx = gt ? g[j] : mx; mi = gt ? j : mi; }
        if (mi >= 0) sel |= 1u << mi;
#pragma unroll
        for (int j = 0; j < 16; ++j) g[j] = (j == mi) ? -__builtin_inff() : g[j]; } }
    sel |= 1u << qb;
    float m = -1e30f, l = 0.f, o0 = 0.f, o1 = 0.f;
    for (int jb = 0; jb <= qb; ++jb) { if (!((sel >> jb) & 1u)) continue;
        const int nk = (jb < qb) ? 256 : (t & 255) + 1;
        for (int kk = 0; kk < nk; ++kk) { const size_t ko = ((size_t)b * 4096 + jb * 256 + kk) * 1024 + h * 128 + 2 * lane;
            const unsigned kw = *(const unsigned*)(K + ko), vw = *(const unsigned*)(V + ko);
            const float s = wave_sum(q0 * bflo(kw) + q1 * bfhi(kw)) * 0.088388347648318440f;
            const float mn = fmaxf(m, s), a = __expf(m - mn), p = __expf(s - mn);
            l = l * a + p; o0 = o0 * a + p * bflo(vw); o1 = o1 * a + p * bfhi(vw); m = mn; } }
    const float il = 1.0f / l; o0 *= il; o1 *= il;
    *(unsigned*)(AO + (size_t)row * 2048 + h * 128 + 2 * lane) = pk2(o0, o1);
    const float sq = wave_sum(o0 * o0 + o1 * o1); if (lane == 0) pg8::ss_add(ssA, row, sq);
}
__global__ __launch_bounds__(256) void xattn(const bf16* __restrict__ QX, const bf16* __restrict__ KVX, bf16* __restrict__ OX) {
    const int wave = threadIdx.x >> 6, lane = threadIdx.x & 63; const int idx = blockIdx.x * 4 + wave; const int h = idx & 3, row = idx >> 2, b = row >> 12;
    const unsigned qw = *(const unsigned*)(QX + (size_t)row * 512 + h * 128 + 2 * lane); const float q0 = bflo(qw), q1 = bfhi(qw);
    float m = -1e30f, l = 0.f, o0 = 0.f, o1 = 0.f;
    for (int kk = 0; kk < 256; ++kk) { const size_t ko = ((size_t)b * 256 + kk) * 1024 + h * 128 + 2 * lane;
        const unsigned kw = *(const unsigned*)(KVX + ko), vw = *(const unsigned*)(KVX + ko + 512);
        const float s = wave_sum(q0 * bflo(kw) + q1 * bfhi(kw)) * 0.088388347648318440f;
        const float mn = fmaxf(m, s), a = __expf(m - mn), p = __expf(s - mn);
        l = l * a + p; o0 = o0 * a + p * bflo(vw); o1 = o1 * a + p * bfhi(vw); m = mn; }
    const float il = 1.0f / l;
    *(unsigned*)(OX + (size_t)row * 512 + h * 128 + 2 * lane) = pk2(o0 * il, o1 * il);
}
}


#ifndef USE_FP8
#define USE_FP8 0xE80
#endif
struct Frame {
    LAS unsigned char* lds;
    volatile LAS unsigned* MISC;
    int tid, lane, wave;
    int vcu, G;
};
struct Args { const float* in[22]; float* out; unsigned char* ws; int ph_lo, ph_hi; };
enum { I_X = 0, I_MEM, I_F1N, I_F1G, I_F1U, I_F1D, I_MIXN, I_WIN, I_CONVW, I_AON, I_CON, I_WOUT, I_XN, I_MEMNRM, I_XQ, I_XKV, I_XO, I_F2N, I_F2G, I_F2U, I_F2D, I_FINAL };

__device__ __forceinline__ void p0_transpose_item(const float* W, int pitch, const float* gain, bf16* WT, int dstK, int dkoff, int drow0, int k0, LAS float* scr, int lane, int f8) {
    float v[32];
    const float* wp = W + (size_t)(k0 + (lane >> 5)) * pitch + (lane & 31);
#pragma unroll
    for (int i = 0; i < 32; ++i) v[i] = wp[(size_t)(2 * i) * pitch];
    const int c = lane & 7;
    f32x4 g0 = (f32x4){1.f, 1.f, 1.f, 1.f}, g1 = g0;
    if (gain) { g0 = *(const GAS f32x4*)(gain + k0 + 8 * c); g1 = *(const GAS f32x4*)(gain + k0 + 8 * c + 4); }
#pragma unroll
    for (int i = 0; i < 32; ++i) scr[(2 * i + (lane >> 5)) * 33 + (lane & 31)] = v[i];
    LDS_WAIT(); asm volatile("" ::: "memory");
#pragma unroll
    for (int j = 0; j < 4; ++j) { const int n = (lane >> 3) + 8 * j; const LAS float* s = scr + (8 * c) * 33 + n;
        const f32x4 x0 = (f32x4){s[0 * 33], s[1 * 33], s[2 * 33], s[3 * 33]} * g0, x1 = (f32x4){s[4 * 33], s[5 * 33], s[6 * 33], s[7 * 33]} * g1;
        if (f8) { const pg8::u32x2 o = pg8::pack8_f8(x0 * 64.0f, x1 * 64.0f); *(GAS v2u*)((unsigned char*)WT + (size_t)(drow0 + n) * dstK + dkoff + k0 + 8 * c) = (v2u){o.x, o.y}; }
        else { v4u o; o.x = pk2(x0[0], x0[1]); o.y = pk2(x0[2], x0[3]); o.z = pk2(x1[0], x1[1]); o.w = pk2(x1[2], x1[3]); *(GAS v4u*)(WT + (size_t)(drow0 + n) * dstK + dkoff + k0 + 8 * c) = o; } }
    LDS_WAIT(); asm volatile("" ::: "memory");
}
__device__ __forceinline__ void p0_prologue(Frame& F_, const Args& a) {
    Frame F = F_; asm volatile("" : "+v"(F.lane));
    LAS float* scr = (LAS float*)(F.lds + RING_OFF + F.wave * 16384);
    const int gw = F.vcu * NWAVES + F.wave, NGW = F.G * NWAVES;
    unsigned char* ws = a.ws;
    constexpr int I_FF = (D / 64) * (FF / 32), I_FD = (FF / 64) * (D / 32), I_IN = (D / 64) * (1024 / 32), I_OUT = (1024 / 64) * (D / 32), I_XQn = (D / 64) * (XW / 32), I_XKVn = (D / 64) * (1024 / 32), I_XOn = (XW / 64) * (D / 32);
    constexpr int NITEMS = 4 * I_FF + 2 * I_FD + 6 * I_IN + 2 * I_OUT + I_XQn + I_XKVn + I_XOn;
    for (int it = gw; it < NITEMS; it += NGW) {
        int r = it; const float* src = nullptr; const float* gain = nullptr; bf16* dst = nullptr; int pitch = 0, ncols = 0, dstK = 0, dkoff = 0, rowoff = 0, mode = 0, f8 = 0; bool hit = false; constexpr int F8Q = (USE_FP8 >> 7) & 1, F8O = (USE_FP8 >> 9) & 1, F8G = (USE_FP8 >> 10) & 1, F8D = (USE_FP8 >> 11) & 1;
#define JOB(cnt, SRC, PITCH, NCOLS, GAIN, DST, DSTK, DKOFF, ROWOFF, MODE, F8J) if (!hit) { if (r < (cnt)) { hit = true; f8 = (F8J); src = (SRC); pitch = (PITCH); ncols = (NCOLS); gain = (GAIN); dst = (bf16*)(ws + (DST)); dstK = (DSTK); dkoff = (DKOFF); rowoff = (ROWOFF); mode = (MODE); } else r -= (cnt); }
        JOB(I_FF, a.in[I_F1G], FF, FF, a.in[I_F1N], WS_WGU1, D, 0, 0, 1, 0)
        JOB(I_FF, a.in[I_F1U], FF, FF, a.in[I_F1N], WS_WGU1, D, 0, 0, 2, 0)
        JOB(I_FD, a.in[I_F1D], D, D, nullptr, WS_WD1, FF, 0, 0, 0, 0)
        JOB(I_FF, a.in[I_F2G], FF, FF, a.in[I_F2N], WS_WGU2, D, 0, 0, 1, F8G)
        JOB(I_FF, a.in[I_F2U], FF, FF, a.in[I_F2N], WS_WGU2, D, 0, 0, 2, F8G)
        JOB(I_FD, a.in[I_F2D], D, D, nullptr, WS_WD2, FF, 0, 0, 0, F8D)
        JOB(I_IN, a.in[I_WIN] + 0, INW, 1024, a.in[I_MIXN], WS_WIN, D, 0, 0, 0, 0)
        JOB(I_IN, a.in[I_WIN] + 1024, INW, 1024, a.in[I_MIXN], WS_WIN, D, 0, 1024, 0, 0)
        JOB(I_IN, a.in[I_WIN] + 2048, INW, 1024, a.in[I_MIXN], WS_WIN, D, 0, 2048, 0, 0)
        JOB(I_IN, a.in[I_WIN] + 3072, INW, 1024, a.in[I_MIXN], WS_WIN, D, 0, 3072, 1, 0)
        JOB(I_IN, a.in[I_WIN] + 5120, INW, 1024, a.in[I_MIXN], WS_WIN, D, 0, 3072, 2, 0)
        JOB(I_IN, a.in[I_WIN] + 4096, INW, 1024, a.in[I_MIXN], WS_WIN, D, 0, 5120, 0, 0)
        JOB(I_OUT, a.in[I_WOUT], D, D, a.in[I_AON], WS_WOUT, D, 0, 0, 0, 0)
        JOB(I_OUT, a.in[I_WOUT] + (size_t)1024 * D, D, D, a.in[I_CON], WS_WOUT, D, 1024, 0, 0, 0)
        JOB(I_XQn, a.in[I_XQ], XW, XW, a.in[I_XN], WS_WQ, D, 0, 0, 0, F8Q)
        JOB(I_XKVn, a.in[I_XKV], 1024, 1024, nullptr, WS_WKV, D, 0, 0, 0, 0)
        JOB(I_XOn, a.in[I_XO], D, D, nullptr, WS_WO, XW, 0, 0, 0, F8O)
#undef JOB
        const int nblk = ncols / 32, kb = r / nblk, nb = r % nblk, k0 = 64 * kb, n0 = 32 * nb;
        const int drow0 = rowoff + (mode ? (n0 >> 7) * 256 + (n0 & 127) + (mode == 2 ? 128 : 0) : n0);
        p0_transpose_item(src + n0, pitch, gain, dst, dstK, dkoff, drow0, k0, scr, F.lane, f8);
    }
    { bf16* HB = (bf16*)(ws + WS_HB); pg8::u64_t* ss0 = (pg8::u64_t*)(ws + WS_CTL + CTL_SS);
      for (int m = gw; m < M; m += NGW) { const GAS f32x4* xr = (const GAS f32x4*)(a.in[I_X] + (size_t)m * D) + F.lane; GAS v2u* o8 = (GAS v2u*)(HB + (size_t)m * D) + F.lane; float s = 0.f;
#pragma unroll
          for (int j = 0; j < 8; ++j) { const f32x4 v = xr[64 * j]; s += (v.x * v.x + v.y * v.y) + (v.z * v.z + v.w * v.w); v2u w; w.x = pk2(v.x, v.y); w.y = pk2(v.z, v.w); o8[64 * j] = w; }
          s = wave_sum(s); if (F.lane == 0) ss0[m] = (pg8::u64_t)(s * 65536.0f + 0.5f); } }
    { bf16* MN = (bf16*)(ws + WS_MEMN); const float* gm = a.in[I_MEMNRM];
      for (int m = gw; m < BATCH * MEML; m += NGW) { const GAS f32x4* xr = (const GAS f32x4*)(a.in[I_MEM] + (size_t)m * D) + F.lane; GAS v2u* o8 = (GAS v2u*)(MN + (size_t)m * D) + F.lane; f32x4 v[8]; float s = 0.f;
#pragma unroll
          for (int j = 0; j < 8; ++j) { v[j] = xr[64 * j]; s += (v[j].x * v[j].x + v[j].y * v[j].y) + (v[j].z * v[j].z + v[j].w * v[j].w); }
          const float rs = rsqrtf(wave_sum(s) * (1.0f / D) + 1e-6f);
#pragma unroll
          for (int j = 0; j < 8; ++j) { const f32x4 g = *((const GAS f32x4*)gm + F.lane + 64 * j); v2u w; w.x = pk2(v[j].x * rs * g.x, v[j].y * rs * g.y); w.y = pk2(v[j].z * rs * g.z, v[j].w * rs * g.w); o8[64 * j] = w; } } }
}
__device__ __forceinline__ void p5_conv(Frame& F_, const Args& a) {
    Frame F = F_; asm volatile("" : "+v"(F.lane));
    const int gw = F.vcu * NWAVES + F.wave, NGW = F.G * NWAVES; unsigned char* ws = a.ws;
    const bf16* CU = (const bf16*)(ws + WS_CU); const bf16* BG = (const bf16*)(ws + WS_BG); bf16* MX = (bf16*)(ws + WS_MIXED); const float* cw = a.in[I_CONVW];
    for (int m = gw; m < M; m += NGW) { const int t = m & (SEQ - 1); float y[16]; float s = 0.f;
#pragma unroll
        for (int gsel = 0; gsel < 2; ++gsel) { const int ch = gsel * 512 + F.lane * 8;
            const v4u c0 = *(const GAS v4u*)(CU + (size_t)m * 1024 + ch); v4u c1 = (v4u){0u, 0u, 0u, 0u}, c2 = (v4u){0u, 0u, 0u, 0u};
            if (t >= 1) c1 = *(const GAS v4u*)(CU + (size_t)(m - 1) * 1024 + ch);
            if (t >= 2) c2 = *(const GAS v4u*)(CU + (size_t)(m - 2) * 1024 + ch);
            const v4u bg = *(const GAS v4u*)(BG + (size_t)m * 1024 + ch);
            const f32x4 w0a = *(const GAS f32x4*)(cw + ch), w0b = *(const GAS f32x4*)(cw + ch + 4), w1a = *(const GAS f32x4*)(cw + 1024 + ch), w1b = *(const GAS f32x4*)(cw + 1024 + ch + 4), w2a = *(const GAS f32x4*)(cw + 2048 + ch), w2b = *(const GAS f32x4*)(cw + 2048 + ch + 4);
#pragma unroll
            for (int e = 0; e < 4; ++e) { const unsigned x0 = c0[e], x1 = c1[e], x2 = c2[e], bw = bg[e];
                const float wl0 = e < 2 ? w0a[2 * e] : w0b[2 * e - 4], wh0 = e < 2 ? w0a[2 * e + 1] : w0b[2 * e - 3];
                const float wl1 = e < 2 ? w1a[2 * e] : w1b[2 * e - 4], wh1 = e < 2 ? w1a[2 * e + 1] : w1b[2 * e - 3];
                const float wl2 = e < 2 ? w2a[2 * e] : w2b[2 * e - 4], wh2 = e < 2 ? w2a[2 * e + 1] : w2b[2 * e - 3];
                const float lo = bflo(bw) * (wl0 * bflo(x2) + wl1 * bflo(x1) + wl2 * bflo(x0)), hi = bfhi(bw) * (wh0 * bfhi(x2) + wh1 * bfhi(x1) + wh2 * bfhi(x0));
                y[gsel * 8 + 2 * e] = lo; y[gsel * 8 + 2 * e + 1] = hi; s += lo * lo + hi * hi; } }
        const float rs = rsqrtf(wave_sum(s) * (1.0f / 1024.0f) + 1e-6f);
#pragma unroll
        for (int gsel = 0; gsel < 2; ++gsel) { v4u o; o.x = pk2(y[gsel * 8 + 0] * rs, y[gsel * 8 + 1] * rs); o.y = pk2(y[gsel * 8 + 2] * rs, y[gsel * 8 + 3] * rs); o.z = pk2(y[gsel * 8 + 4] * rs, y[gsel * 8 + 5] * rs); o.w = pk2(y[gsel * 8 + 6] * rs, y[gsel * 8 + 7] * rs);
            *(GAS v4u*)(MX + (size_t)m * 2048 + 1024 + gsel * 512 + F.lane * 8) = o; } }
}
__device__ __forceinline__ void p12_final(Frame& F_, const Args& a) {
    Frame F = F_; asm volatile("" : "+v"(F.lane));
    const int gw = F.vcu * NWAVES + F.wave, NGW = F.G * NWAVES; const pg8::u64_t* ss4 = (const pg8::u64_t*)(a.ws + WS_CTL + CTL_SS) + 5 * M; const float* gf = a.in[I_FINAL];
    for (int m = gw; m < M; m += NGW) { GAS f32x4* xr = (GAS f32x4*)(a.out + (size_t)m * D) + F.lane; const float rs = rsqrtf(pg8::ss_val(ss4, m) * (1.0f / D) + 1e-6f);
#pragma unroll
        for (int j = 0; j < 8; ++j) { const f32x4 v = xr[64 * j]; const f32x4 g = *((const GAS f32x4*)gf + F.lane + 64 * j); xr[64 * j] = v * g * rs; } }
}

#ifndef DUP_MASK
#define DUP_MASK 0
#endif
#ifndef MOBA_SDEPTH
#define MOBA_SDEPTH 1
#endif
__global__ void __launch_bounds__(NWAVES * 64, 2) fwd_kernel(Args args) {
    extern __shared__ __attribute__((aligned(16))) unsigned char lds[];
    Frame F;
    F.lds = (LAS unsigned char*)lds;
    F.MISC = (volatile LAS unsigned*)(F.lds + MISC_OFF);
    F.tid = threadIdx.x; F.lane = F.tid & 63; F.wave = __builtin_amdgcn_readfirstlane(F.tid >> 6);
    F.G = gridDim.x; { const int bx = blockIdx.x; F.vcu = (F.G % 8 == 0) ? (bx % 8) * (F.G / 8) + bx / 8 : bx; }
    unsigned char* ws = args.ws;
    for (int u = F.tid; u < (LDS_BYTES - LDSCTL_OFF) / 4; u += NWAVES * 64) ((LAS unsigned*)(F.lds + LDSCTL_OFF))[u] = 0u;
    __syncthreads();
    const int lo = args.ph_lo, hi = args.ph_hi; const bool multi = (hi - lo) > 1;
    XcdBarrier bar; bar.bar = (unsigned*)(ws + WS_CTL + CTL_BAR + (size_t)lo * BAR_STRIDE); bar.x = 0; bar.st = nullptr;
    if (multi) bar = xcd_barrier_post((unsigned*)(ws + WS_CTL + CTL_BAR + (size_t)lo * BAR_STRIDE), F.MISC + 8);
#ifndef PH_ENABLE
#define PH_ENABLE 0x1fff
#endif
#define IN(k) ((((PH_ENABLE) >> (k)) & 1) && lo <= (k) && (k) < hi)
#define SEAM(k) do { if (IN(k) && IN((k) + 1)) xcd_barrier(bar); } while (0)
    pg8::u64_t* SS = (pg8::u64_t*)(ws + WS_CTL + CTL_SS);
    float* KMS = (float*)(ws + WS_CTL + CTL_KMS);
    bf16* HB = (bf16*)(ws + WS_HB); bf16* ACT = (bf16*)(ws + WS_ACT); bf16* MIXED = (bf16*)(ws + WS_MIXED);
    bf16* Qb = (bf16*)(ws + WS_Q); bf16* Kb = (bf16*)(ws + WS_K); bf16* Vb = (bf16*)(ws + WS_V); bf16* CUb = (bf16*)(ws + WS_CU); bf16* BGb = (bf16*)(ws + WS_BG);
    bf16* QX = (bf16*)(ws + WS_QX); bf16* OX = (bf16*)(ws + WS_OX); bf16* KVX = (bf16*)(ws + WS_KVX);
    const int bx = (int)blockIdx.x;

#ifndef F8_SP2
#define F8_SP2 PG8_SP2
#endif
#ifndef F8_ALIGN
#define F8_ALIGN PG8_ALIGN
#endif
#define GEMM_RUN(EPI, FP8FLAG, G_, S_, E_) pg8::gemm_phase<EPI, pg8::StaticOrder, (FP8FLAG) ? F8_ALIGN : PG8_ALIGN, (FP8FLAG) ? F8_SP2 : PG8_SP2, FP8FLAG>(F.lds + RING_OFF, G_, S_, E_)
#define DUPQ(k) (((DUP_MASK) >> (k)) & 1)
    pg8::u64_t* DUMMY = (pg8::u64_t*)(ws + WS_DUMMY);
    unsigned char* HB8 = ws + WS_HB8; unsigned char* ACT8 = ws + WS_ACT8; unsigned char* OX8 = ws + WS_OX8;
    constexpr bool F7 = ((USE_FP8 >> 7) & 1) != 0, F9 = ((USE_FP8 >> 9) & 1) != 0, F10 = ((USE_FP8 >> 10) & 1) != 0, F11 = ((USE_FP8 >> 11) & 1) != 0;
    constexpr float WSC = 1.0f / 64.0f;
    if (IN(0)) { p0_prologue(F, args); if (DUPQ(0)) p0_prologue(F, args); } SEAM(0);
    if (IN(1)) { pg8::Gemm g{HB, (const bf16*)(ws + WS_WGU1), M, 2 * FF, D}; pg8::StaticOrder S; S.init(M, 2 * FF, F.G, bx);
        typedef pg8::EpiSwiglu<false> EP; EP E{ACT, nullptr, FF, SS, 1.0f, 1.0f}; GEMM_RUN(EP, false, g, S, E); if (DUPQ(1)) GEMM_RUN(EP, false, g, S, E); } SEAM(1);
    if (IN(2)) { pg8::Gemm g{ACT, (const bf16*)(ws + WS_WD1), M, D, FF}; pg8::StaticOrder S; S.init(M, D, F.G, bx);
        typedef pg8::EpiResid<0, false, false> EP; EP E{args.in[I_X], nullptr, nullptr, HB, SS + M, 0.5f, nullptr, nullptr}; GEMM_RUN(EP, false, g, S, E);
        if (DUPQ(2)) { EP E2{args.in[I_X], nullptr, nullptr, HB, DUMMY, 0.5f, nullptr, nullptr}; GEMM_RUN(EP, false, g, S, E2); } } SEAM(2);
    if (IN(3)) { pg8::Gemm g{HB, (const bf16*)(ws + WS_WIN), M, INW, D}; pg8::StaticOrder S; S.init(M, INW, F.G, bx);
        pg8::EpiWin E{Qb, Kb, Vb, CUb, BGb, KMS, SS + M}; GEMM_RUN(pg8::EpiWin, false, g, S, E);
        if (DUPQ(3)) { pg8::EpiWin E2{Qb, Kb, Vb, CUb, BGb, (float*)DUMMY, SS + M}; GEMM_RUN(pg8::EpiWin, false, g, S, E2); } } SEAM(3);
    if (IN(4)) for (int rep = 0; rep < (DUPQ(4) ? 2 : 1); ++rep) {
        for (int u = F.vcu; u < BATCH * NH * 8; u += F.G) { const int b = u >> 6, h = (u >> 3) & 7, p = u & 7;
#pragma unroll 1
            for (int half = 0; half < 2; ++half) { const int qb = half ? 15 - p : p; const size_t r0 = (size_t)b * SEQ + (size_t)qb * 256;
                att::attn_body<true, 1024, 1024, 2048, MOBA_SDEPTH, bf16>(Qb + r0 * 1024 + h * 128, Kb + (size_t)b * SEQ * 1024 + h * 128, Vb + (size_t)b * SEQ * 1024 + h * 128, MIXED + r0 * 2048 + h * 128,
                                                       256 * (qb + 1), (att::lptr)(F.lds + RING_OFF), qb, KMS + ((size_t)b * 16 * 8 + h) * 128, 8 * 128, (rep ? DUMMY : SS + 2 * M) + r0); } } }
    if (IN(5)) { p5_conv(F, args); if (DUPQ(5)) p5_conv(F, args); } SEAM(5);
    if (IN(6)) { pg8::Gemm g{MIXED, (const bf16*)(ws + WS_WOUT), M, D, D}; pg8::StaticOrder S; S.init(M, D, F.G, bx);
        typedef pg8::EpiResid<16, true, false> EP; EP E{nullptr, HB, nullptr, HB, SS + 3 * M, 1.0f, SS + 2 * M, F7 ? HB8 : nullptr}; GEMM_RUN(EP, false, g, S, E);
        if (DUPQ(6)) { EP E2{nullptr, HB, nullptr, HB, DUMMY, 0.0f, SS + 2 * M, F7 ? HB8 : nullptr}; GEMM_RUN(EP, false, g, S, E2); } } SEAM(6);
    if (IN(7)) for (int rep = 0; rep < (DUPQ(7) ? 2 : 1); ++rep) {
        { pg8::Gemm g{F7 ? (const bf16*)HB8 : HB, (const bf16*)(ws + WS_WQ), M, XW, D}; pg8::StaticOrder S; S.init(M, XW, F.G, bx);
          pg8::EpiScaleBf16 E{QX, XW, SS + 3 * M, F7 ? WSC : 1.0f}; GEMM_RUN(pg8::EpiScaleBf16, F7, g, S, E); }
        { pg8::Gemm g{(const bf16*)(ws + WS_MEMN), (const bf16*)(ws + WS_WKV), BATCH * MEML, 1024, D}; pg8::StaticOrder S; S.init(BATCH * MEML, 1024, F.G, (bx + F.G - 128) % F.G);
          pg8::EpiScaleBf16 E{KVX, 1024, nullptr, 1.0f}; GEMM_RUN(pg8::EpiScaleBf16, false, g, S, E); } } SEAM(7);
    if (IN(8)) for (int rep = 0; rep < (DUPQ(8) ? 2 : 1); ++rep) {
        for (int u = F.vcu; u < BATCH * XH * 16; u += F.G) { const int b = u >> 6, h = (u >> 4) & 3, qb = u & 15; const size_t r0 = (size_t)b * SEQ + (size_t)qb * 256;
            if constexpr (F9) att::attn_body<false, 512, 1024, 512, 2, unsigned char>(QX + r0 * 512 + h * 128, KVX + (size_t)b * MEML * 1024 + h * 128, KVX + (size_t)b * MEML * 1024 + 512 + h * 128, OX8 + r0 * 512 + h * 128,
                                                  MEML, (att::lptr)(F.lds + RING_OFF), 0, nullptr, 0, nullptr);
            else att::attn_body<false, 512, 1024, 512, 2, bf16>(QX + r0 * 512 + h * 128, KVX + (size_t)b * MEML * 1024 + h * 128, KVX + (size_t)b * MEML * 1024 + 512 + h * 128, OX + r0 * 512 + h * 128,
                                                  MEML, (att::lptr)(F.lds + RING_OFF), 0, nullptr, 0, nullptr); } } SEAM(8);
    if (IN(9)) { pg8::Gemm g{F9 ? (const bf16*)OX8 : OX, (const bf16*)(ws + WS_WO), M, D, XW}; pg8::StaticOrder S; S.init(M, D, F.G, bx);
        typedef pg8::EpiResid<0, true, false> EP; EP E{nullptr, HB, nullptr, HB, SS + 4 * M, F9 ? WSC / 16.0f : 1.0f, nullptr, F10 ? HB8 : nullptr}; GEMM_RUN(EP, F9, g, S, E);
        if (DUPQ(9)) { EP E2{nullptr, HB, nullptr, HB, DUMMY, 0.0f, nullptr, F10 ? HB8 : nullptr}; GEMM_RUN(EP, F9, g, S, E2); } } SEAM(9);
    if (IN(10)) { pg8::Gemm g{F10 ? (const bf16*)HB8 : HB, (const bf16*)(ws + WS_WGU2), M, 2 * FF, D}; pg8::StaticOrder S; S.init(M, 2 * FF, F.G, bx);
        typedef pg8::EpiSwiglu<F11> EP; EP E{ACT, ACT8, FF, SS + 4 * M, F10 ? WSC : 1.0f, 4.0f}; GEMM_RUN(EP, F10, g, S, E); if (DUPQ(10)) GEMM_RUN(EP, F10, g, S, E); } SEAM(10);
    if (IN(11)) { pg8::Gemm g{F11 ? (const bf16*)ACT8 : ACT, (const bf16*)(ws + WS_WD2), M, D, FF}; pg8::StaticOrder S; S.init(M, D, F.G, bx);
        typedef pg8::EpiResid<0, true, true> EP; EP E{nullptr, HB, args.out, nullptr, SS + 5 * M, F11 ? 0.5f * WSC / 4.0f : 0.5f, nullptr, nullptr}; GEMM_RUN(EP, F11, g, S, E);
        if (DUPQ(11)) { EP E2{nullptr, HB, args.out, nullptr, DUMMY, F11 ? 0.5f * WSC / 4.0f : 0.5f, nullptr, nullptr}; GEMM_RUN(EP, F11, g, S, E2); } } SEAM(11);
    if (IN(12)) { p12_final(F, args); }
#undef GEMM_RUN
#undef DUPQ
#undef IN
#undef SEAM
}

extern "C" void kernel_launch(void* const* d_in, const int* in_sizes, int n_in, void* d_out, int out_size, void* d_ws, size_t ws_size, hipStream_t stream) {
    static int grid = 0;
    if (grid == 0) {
        if (n_in != 22 || in_sizes[0] != M * D || out_size != M * D || ws_size < WS_END) { fprintf(stderr, "kernel_launch: shape mismatch (n_in %d, in0 %d, out %d, ws %zu; need ws >= %zu); nothing launched\n", n_in, n_in > 0 ? in_sizes[0] : -1, out_size, ws_size, (size_t)WS_END); grid = -1; return; }
        int dev = 0, cus = 0, per_cu = 0;
        if (hipGetDevice(&dev) != hipSuccess || hipDeviceGetAttribute(&cus, hipDeviceAttributeMultiprocessorCount, dev) != hipSuccess) { grid = -1; return; }
        if (hipFuncSetAttribute((const void*)fwd_kernel, hipFuncAttributeMaxDynamicSharedMemorySize, LDS_BYTES) != hipSuccess) { fprintf(stderr, "kernel_launch: hipFuncSetAttribute failed\n"); grid = -1; return; }
        if (hipOccupancyMaxActiveBlocksPerMultiprocessor(&per_cu, (const void*)fwd_kernel, NWAVES * 64, LDS_BYTES) != hipSuccess || per_cu < 1) { fprintf(stderr, "kernel_launch: occupancy query reports %d workgroups per CU\n", per_cu); }
        (void)hipGetLastError();
        grid = cus;
    }
    if (grid < 0) return;
    if (hipMemsetAsync((char*)d_ws + WS_CTL, 0, CTL_ZERO_BYTES, stream) != hipSuccess) { fprintf(stderr, "kernel_launch: hipMemsetAsync failed\n"); return; }
    Args a{};
    for (int i = 0; i < 22; ++i) a.in[i] = (const float*)d_in[i];
    a.out = (float*)d_out; a.ws = (unsigned char*)d_ws;
    unsigned char* ws = (unsigned char*)d_ws; pg8::u64_t* SS = (pg8::u64_t*)(ws + WS_CTL + CTL_SS); float* KMS = (float*)(ws + WS_CTL + CTL_KMS); float* out = (float*)d_out;
    bf16* HB = (bf16*)(ws + WS_HB); bf16* ACT = (bf16*)(ws + WS_ACT); bf16* MIXED = (bf16*)(ws + WS_MIXED);
    bf16* Qb = (bf16*)(ws + WS_Q); bf16* Kb = (bf16*)(ws + WS_K); bf16* Vb = (bf16*)(ws + WS_V); bf16* CUb = (bf16*)(ws + WS_CU); bf16* BGb = (bf16*)(ws + WS_BG);
    bf16* QX = (bf16*)(ws + WS_QX); bf16* OX = (bf16*)(ws + WS_OX); bf16* KVX = (bf16*)(ws + WS_KVX);
    (void)SS; (void)KMS; (void)out; (void)HB; (void)ACT; (void)MIXED; (void)Qb; (void)Kb; (void)Vb; (void)CUb; (void)BGb; (void)QX; (void)OX; (void)KVX;
#if ONE_LAUNCH
    a.ph_lo = 0; a.ph_hi = NPH;
    hipLaunchKernelGGL(fwd_kernel, dim3(grid), dim3(NWAVES * 64), LDS_BYTES, stream, a);
#else
    for (int ph = 0; ph < NPH; ++ph) {
        if ((FAST_MASK >> ph) & 1) { a.ph_lo = ph; a.ph_hi = ph + 1; hipLaunchKernelGGL(fwd_kernel, dim3(grid), dim3(NWAVES * 64), LDS_BYTES, stream, a); continue; }
        switch (ph) {
        case 1: hipLaunchKernelGGL((nv::gemm<nv::FSwiglu>), dim3(FF / 64, M / 64), dim3(256), 0, stream, HB, (const bf16*)(ws + WS_WGU1), D, nv::FSwiglu{ACT, SS}); break;
        case 2: hipLaunchKernelGGL((nv::gemm<nv::FResid<0, false, false>>), dim3(D / 64, M / 64), dim3(256), 0, stream, ACT, (const bf16*)(ws + WS_WD1), FF, nv::FResid<0, false, false>{a.in[I_X], nullptr, nullptr, HB, SS + M, 0.5f, nullptr}); break;
        case 3: hipLaunchKernelGGL((nv::gemm<nv::FWin>), dim3(5120 / 64, M / 64), dim3(256), 0, stream, HB, (const bf16*)(ws + WS_WIN), D, nv::FWin{Qb, Kb, Vb, CUb, BGb, SS + M});
                hipLaunchKernelGGL(nv::kmean, dim3(BATCH * 16 * 8 * 128 / 256), dim3(256), 0, stream, Kb, KMS); break;
        case 4: hipLaunchKernelGGL(nv::moba, dim3(M * NH / 4), dim3(256), 0, stream, Qb, Kb, Vb, KMS, MIXED, SS + 2 * M); break;
        case 6: hipLaunchKernelGGL((nv::gemm<nv::FResid<1024, true, false>>), dim3(D / 64, M / 64), dim3(256), 0, stream, MIXED, (const bf16*)(ws + WS_WOUT), D, nv::FResid<1024, true, false>{nullptr, HB, nullptr, HB, SS + 3 * M, 1.0f, SS + 2 * M}); break;
        case 7: hipLaunchKernelGGL((nv::gemm<nv::FScale>), dim3(XW / 64, M / 64), dim3(256), 0, stream, HB, (const bf16*)(ws + WS_WQ), D, nv::FScale{QX, XW, SS + 3 * M});
                hipLaunchKernelGGL((nv::gemm<nv::FScale>), dim3(1024 / 64, BATCH * MEML / 64), dim3(256), 0, stream, (const bf16*)(ws + WS_MEMN), (const bf16*)(ws + WS_WKV), D, nv::FScale{KVX, 1024, nullptr}); break;
        case 8: hipLaunchKernelGGL(nv::xattn, dim3(M * XH / 4), dim3(256), 0, stream, QX, KVX, OX); break;
        case 9: hipLaunchKernelGGL((nv::gemm<nv::FResid<0, true, false>>), dim3(D / 64, M / 64), dim3(256), 0, stream, OX, (const bf16*)(ws + WS_WO), XW, nv::FResid<0, true, false>{nullptr, HB, nullptr, HB, SS + 4 * M, 1.0f, nullptr}); break;
        case 10: hipLaunchKernelGGL((nv::gemm<nv::FSwiglu>), dim3(FF / 64, M / 64), dim3(256), 0, stream, HB, (const bf16*)(ws + WS_WGU2), D, nv::FSwiglu{ACT, SS + 4 * M}); break;
        case 11: hipLaunchKernelGGL((nv::gemm<nv::FResid<0, true, true>>), dim3(D / 64, M / 64), dim3(256), 0, stream, ACT, (const bf16*)(ws + WS_WD2), FF, nv::FResid<0, true, true>{nullptr, HB, out, nullptr, SS + 5 * M, 0.5f, nullptr}); break;
        default: break;
        }
    }
#endif
    const hipError_t le = hipPeekAtLastError();
    if (le != hipSuccess) fprintf(stderr, "kernel_launch: launch failed: %s\n", hipGetErrorName(le));
}
```

```cpp
#define ONE_LAUNCH 1
#define FAST_MASK 0x1fff
#define USE_FP8 0xE80
#include <hip/hip_runtime.h>
#include <cstdio>
#include <cstdint>
namespace pg8 {
#define PG8_LAS __attribute__((address_space(3)))
typedef unsigned short bf16_t;
typedef short bf16x8 __attribute__((ext_vector_type(8)));
typedef float f32x4 __attribute__((ext_vector_type(4)));
typedef unsigned u32x4 __attribute__((ext_vector_type(4)));
typedef int i32x4 __attribute__((ext_vector_type(4)));
typedef int i32x8 __attribute__((ext_vector_type(8)));
typedef unsigned u32x2 __attribute__((ext_vector_type(2)));
constexpr int BM = 256, BK = 64, HALF = 128, HTB = HALF * BK * 2  , STAGE_BYTES = 8 * HTB, NXCD = 8, WGM = 8;

__host__ __device__ __forceinline__ int lds_byte(int r, int c) { const int st = (r >> 4) * 2 + (c >> 5), rr = r & 15, cc = c & 31, ob = rr * 64 + cc * 2; return st * 1024 + (ob ^ (((ob >> 9) & 1) << 5)); }
__host__ __device__ __forceinline__ void stage_rc(int b, int& R, int& C) { const int st = b / 1024, sb = b % 1024, swz = sb ^ (((sb >> 9) & 1) << 5); R = (st >> 1) * 16 + swz / 64; C = (st & 1) * 32 + (swz % 64) / 2; }
__host__ __device__ __forceinline__ int perm32(int rho) { const int n = rho >> 4, i = rho & 15; return 8 * (i >> 2) + 4 * n + (i & 3); }

struct Unit { int pm, pn; };
struct Gemm { const bf16_t* A; const bf16_t* Bt; int M, N, K; };

struct StaticOrder {
    int nM, nN, nwg, G, c;
    __host__ __device__ void init(int M, int N, int G_, int c_) { nM = M / BM; nN = N / BM; nwg = nM * nN; G = G_; c = c_; }
    __host__ __device__ bool next(int i, Unit& u) const {
        const long L = (long)i * G + c; if (L >= nwg) return false;
        int wgid = (int)L; { const int q = nwg / NXCD, r = nwg % NXCD, xcd = wgid % NXCD, off = wgid / NXCD; wgid = (xcd < r ? xcd * (q + 1) : r * (q + 1) + (xcd - r) * q) + off; }
        const int nig = WGM * nN, gid = wgid / nig, fm = gid * WGM, gsz = (nM - fm) < WGM ? (nM - fm) : WGM;
        u.pm = fm + ((wgid % nig) % gsz); u.pn = (wgid % nig) / gsz; return true;
    }
    __device__ __forceinline__ void a_ready(const Unit&) const {}
    __device__ __forceinline__ void done(const Unit&) const {}
};

__device__ __forceinline__ unsigned cvt_pk_bf16(float lo, float hi) { unsigned r; asm volatile("v_cvt_pk_bf16_f32 %0, %1, %2" : "=v"(r) : "v"(lo), "v"(hi)); return r; }
__device__ __forceinline__ u32x4 pack8(const f32x4 v0, const f32x4 v1) { u32x4 w; w.x = cvt_pk_bf16(v0[0], v0[1]); w.y = cvt_pk_bf16(v0[2], v0[3]); w.z = cvt_pk_bf16(v1[0], v1[1]); w.w = cvt_pk_bf16(v1[2], v1[3]); return w; }
constexpr float RMS_EPS = 1e-6f;
typedef unsigned long long u64_t;
__device__ __forceinline__ float ss_val(const u64_t* ss, int row) { return (float)ss[row] * (1.0f / 65536.0f); }
__device__ __forceinline__ void ss_add(u64_t* ss, int row, float sq) { atomicAdd(ss + row, (u64_t)(unsigned)(sq * 65536.0f + 0.5f)); }
__device__ __forceinline__ float clamp_f8(float x) { return __builtin_amdgcn_fmed3f(x, -448.0f, 448.0f); }
__device__ __forceinline__ u32x2 pack8_f8(const f32x4 v0, const f32x4 v1) { int a = __builtin_amdgcn_cvt_pk_fp8_f32(clamp_f8(v0[0]), clamp_f8(v0[1]), 0, false); a = __builtin_amdgcn_cvt_pk_fp8_f32(clamp_f8(v0[2]), clamp_f8(v0[3]), a, true);
    int b = __builtin_amdgcn_cvt_pk_fp8_f32(clamp_f8(v1[0]), clamp_f8(v1[1]), 0, false); b = __builtin_amdgcn_cvt_pk_fp8_f32(clamp_f8(v1[2]), clamp_f8(v1[3]), b, true); u32x2 w; w.x = (unsigned)a; w.y = (unsigned)b; return w; }
__device__ __forceinline__ float silu_mul(float g, float u) { return g * u * __builtin_amdgcn_rcpf(1.0f + __builtin_amdgcn_exp2f(-1.4426950408889634f * g)); }

template <bool F8OUT> struct EpiSwiglu {
    static constexpr bool PERM = true, AFTER_DRAIN = false; static constexpr int MIDT = 0;
    bf16_t* O; unsigned char* O8; int ldo; const u64_t* ss; float asc, osc;
    __device__ __forceinline__ void mid(f32x4 (&)[2][2][4][2], const Unit&, int, int) const {}
    __device__ __forceinline__ void operator()(const f32x4 (&acc)[2][2][4][2], const Unit& u, int wr, int wc, int fr_, int fq_) const {
        int fr = fr_, fq = fq_; asm volatile("" : "+v"(fr), "+v"(fq));
        const int row0 = u.pm * BM + wr * 64 + fr, col0 = u.pn * HALF + wc * 32 + 8 * fq;
#pragma unroll
        for (int ai = 0; ai < 2; ++ai)
#pragma unroll
            for (int m = 0; m < 4; ++m) { const int row = row0 + ai * HALF + m * 16; const float rs = asc * rsqrtf(ss_val(ss, row) * (1.0f / 2048.0f) + RMS_EPS);
                f32x4 o0, o1;
#pragma unroll
                for (int j = 0; j < 4; ++j) { o0[j] = silu_mul(acc[ai][0][m][0][j] * rs, acc[ai][1][m][0][j] * rs); o1[j] = silu_mul(acc[ai][0][m][1][j] * rs, acc[ai][1][m][1][j] * rs); }
                if constexpr (F8OUT) *(u32x2*)(O8 + (size_t)row * ldo + col0) = pack8_f8(o0 * osc, o1 * osc);
                else *(u32x4*)(O + (size_t)row * ldo + col0) = pack8(o0, o1); }
    }
};
template <int MIDT_, bool RBF, bool OF32> struct EpiResid {
    static constexpr bool PERM = true, AFTER_DRAIN = false; static constexpr int MIDT = MIDT_;
    const float* R; const bf16_t* RB; float* H; bf16_t* HB; u64_t* ssn; float alpha; const u64_t* midss; unsigned char* HB8;
    __device__ __forceinline__ void mid(f32x4 (&acc)[2][2][4][2], const Unit& u, int wr, int fr) const {
        const int row0 = u.pm * BM + wr * 64 + fr;
#pragma unroll
        for (int ai = 0; ai < 2; ++ai)
#pragma unroll
            for (int m = 0; m < 4; ++m) { const float s = rsqrtf(ss_val(midss, row0 + ai * HALF + m * 16) * (1.0f / 1024.0f) + RMS_EPS);
#pragma unroll
                for (int bj = 0; bj < 2; ++bj)
#pragma unroll
                    for (int n = 0; n < 2; ++n) acc[ai][bj][m][n] = acc[ai][bj][m][n] * s; }
    }
    __device__ __forceinline__ void operator()(const f32x4 (&acc)[2][2][4][2], const Unit& u, int wr, int wc, int fr_, int fq_) const {
        int fr = fr_, fq = fq_; asm volatile("" : "+v"(fr), "+v"(fq));
        const int row0 = u.pm * BM + wr * 64 + fr, col0 = u.pn * BM + wc * 32 + 8 * fq;
#pragma unroll
        for (int ai = 0; ai < 2; ++ai)
#pragma unroll
            for (int m = 0; m < 4; ++m) { const int row = row0 + ai * HALF + m * 16; const size_t off = (size_t)row * 2048 + col0; float sq = 0.f;
#pragma unroll
                for (int bj = 0; bj < 2; ++bj) { f32x4 r0, r1;
                    if constexpr (RBF) { const u32x4 w = *(const u32x4*)(RB + off + bj * HALF);
                        r0 = (f32x4){__uint_as_float(w.x << 16), __uint_as_float(w.x & 0xffff0000u), __uint_as_float(w.y << 16), __uint_as_float(w.y & 0xffff0000u)};
                        r1 = (f32x4){__uint_as_float(w.z << 16), __uint_as_float(w.z & 0xffff0000u), __uint_as_float(w.w << 16), __uint_as_float(w.w & 0xffff0000u)}; }
                    else { r0 = *(const f32x4*)(R + off + bj * HALF); r1 = *(const f32x4*)(R + off + bj * HALF + 4); }
                    const f32x4 h0 = r0 + acc[ai][bj][m][0] * alpha, h1 = r1 + acc[ai][bj][m][1] * alpha;
                    if constexpr (OF32) { *(f32x4*)(H + off + bj * HALF) = h0; *(f32x4*)(H + off + bj * HALF + 4) = h1; }
                    else { *(u32x4*)(HB + off + bj * HALF) = pack8(h0, h1); if (HB8) *(u32x2*)(HB8 + off + bj * HALF) = pack8_f8(h0, h1); }
                    sq += (h0[0] * h0[0] + h0[1] * h0[1]) + (h0[2] * h0[2] + h0[3] * h0[3]) + (h1[0] * h1[0] + h1[1] * h1[1]) + (h1[2] * h1[2] + h1[3] * h1[3]); }
                sq += __shfl_xor(sq, 16); sq += __shfl_xor(sq, 32);
                if (fq == 0) ss_add(ssn, row, sq);
                asm volatile("" ::: "memory"); }
    }
};
struct EpiWin {
    static constexpr bool PERM = true, AFTER_DRAIN = false; static constexpr int MIDT = 0;
    bf16_t *Q, *K, *V, *CU, *BG; float* kms; const u64_t* ss;
    __device__ __forceinline__ void mid(f32x4 (&)[2][2][4][2], const Unit&, int, int) const {}
    __device__ __forceinline__ void operator()(const f32x4 (&acc)[2][2][4][2], const Unit& u, int wr, int wc, int fr_, int fq_) const {
        int fr = fr_, fq = fq_; asm volatile("" : "+v"(fr), "+v"(fq));
        const int row0 = u.pm * BM + wr * 64 + fr, pn = u.pn;
        if (pn >= 12 && pn < 20) {
            const int col0 = (pn - 12) * HALF + wc * 32 + 8 * fq;
#pragma unroll
            for (int ai = 0; ai < 2; ++ai)
#pragma unroll
                for (int m = 0; m < 4; ++m) { const int row = row0 + ai * HALF + m * 16; float rs = rsqrtf(ss_val(ss, row) * (1.0f / 2048.0f) + RMS_EPS); rs = rs * rs;
                    const f32x4 o0 = acc[ai][0][m][0] * acc[ai][1][m][0] * rs, o1 = acc[ai][0][m][1] * acc[ai][1][m][1] * rs;
                    *(u32x4*)(CU + (size_t)row * 1024 + col0) = pack8(o0, o1); }
        } else {
            bf16_t* base = pn < 4 ? Q : pn < 8 ? K : pn < 12 ? V : BG; const int colt = (pn & 3) * BM, col0 = colt + wc * 32 + 8 * fq; const bool isk = (pn >= 4 && pn < 8);
            float rsv[2][4];
#pragma unroll
            for (int ai = 0; ai < 2; ++ai)
#pragma unroll
                for (int m = 0; m < 4; ++m) rsv[ai][m] = rsqrtf(ss_val(ss, row0 + ai * HALF + m * 16) * (1.0f / 2048.0f) + RMS_EPS);
#pragma unroll
            for (int ai = 0; ai < 2; ++ai)
#pragma unroll
                for (int m = 0; m < 4; ++m) { const int row = row0 + ai * HALF + m * 16;
#pragma unroll
                    for (int bj = 0; bj < 2; ++bj) *(u32x4*)(base + (size_t)row * 1024 + col0 + bj * HALF) = pack8(acc[ai][bj][m][0] * rsv[ai][m], acc[ai][bj][m][1] * rsv[ai][m]); }
            if (isk) {
#pragma unroll
                for (int bj = 0; bj < 2; ++bj)
#pragma unroll
                    for (int n = 0; n < 2; ++n) { f32x4 c = (f32x4){0.f, 0.f, 0.f, 0.f};
#pragma unroll
                        for (int ai = 0; ai < 2; ++ai)
#pragma unroll
                            for (int m = 0; m < 4; ++m) { float r2 = rsv[ai][m]; asm volatile("" : "+v"(r2)); c += acc[ai][bj][m][n] * r2; }
#pragma unroll
                        for (int j = 0; j < 4; ++j) { float v = c[j]; v += __shfl_xor(v, 1); v += __shfl_xor(v, 2); v += __shfl_xor(v, 4); v += __shfl_xor(v, 8);
                            const int col = col0 + bj * HALF + 4 * n + j;
                            if (fr == 0) unsafeAtomicAdd(kms + ((size_t)u.pm * 8 + (col >> 7)) * 128 + (col & 127), v); }
                        asm volatile("" ::: "memory"); }
            }
        }
    }
};
struct EpiScaleBf16 {
    static constexpr bool PERM = true, AFTER_DRAIN = false; static constexpr int MIDT = 0;
    bf16_t* O; int ldo; const u64_t* ss; float asc;
    __device__ __forceinline__ void mid(f32x4 (&)[2][2][4][2], const Unit&, int, int) const {}
    __device__ __forceinline__ void operator()(const f32x4 (&acc)[2][2][4][2], const Unit& u, int wr, int wc, int fr_, int fq_) const {
        int fr = fr_, fq = fq_; asm volatile("" : "+v"(fr), "+v"(fq));
        const int row0 = u.pm * BM + wr * 64 + fr, col0 = u.pn * BM + wc * 32 + 8 * fq;
#pragma unroll
        for (int ai = 0; ai < 2; ++ai)
#pragma unroll
            for (int m = 0; m < 4; ++m) { const int row = row0 + ai * HALF + m * 16; const float rs = asc * (ss ? rsqrtf(ss_val(ss, row) * (1.0f / 2048.0f) + RMS_EPS) : 1.0f);
#pragma unroll
                for (int bj = 0; bj < 2; ++bj) *(u32x4*)(O + (size_t)row * ldo + col0 + bj * HALF) = pack8(acc[ai][bj][m][0] * rs, acc[ai][bj][m][1] * rs); }
    }
};

template <class Epi, class Sched, bool ALIGN_EPI = false, bool SP2 = false, bool FP8 = false>
__device__ __forceinline__ void gemm_phase(PG8_LAS unsigned char* lds, const Gemm g, const Sched& S, const Epi& E) {
    int tid_ = threadIdx.x; asm volatile("" : "+v"(tid_));
    const int tid = tid_, wid = __builtin_amdgcn_readfirstlane(tid >> 6), lane = tid & 63, wr = wid >> 2, wc = wid & 3, fr = lane & 15, fq = lane >> 4;
    const int KB = FP8 ? g.K : g.K * 2, nt = KB / (BK * 2);
    unsigned voffA[2], voffB[2];
#pragma unroll
    for (int i = 0; i < 2; ++i) { int R, C; stage_rc(tid * 16 + i * 8192, R, C); const int Rb = Epi::PERM ? ((R & ~31) + perm32(R & 31)) : R;
        voffA[i] = (unsigned)(R * KB + C * 2); voffB[i] = (unsigned)(Rb * KB + C * 2); }
    const size_t kstep = (size_t)(BK * 2);
    const size_t hstep = (size_t)HALF * KB;
    const size_t tstep = 2 * hstep;
    const unsigned ldsw = (unsigned)wid * 1024u;
    const int aoff = lds_byte(wr * 64 + fr, fq * 8), boff = lds_byte(wc * 32 + fr, fq * 8);
#define PG8_SA(b, h) (((b) * 2 + (h)) * HTB)
#define PG8_SB(b, h) ((4 + (b) * 2 + (h)) * HTB)
#define PG8_STAGE(bufoff, gbase, voff) do { _Pragma("unroll") for (int _i = 0; _i < 2; ++_i) \
        __builtin_amdgcn_global_load_lds((const unsigned*)((const char*)(gbase) + (voff)[_i]), (PG8_LAS unsigned*)(lds + (bufoff) + ldsw + _i * 8192), 16, 0, 0); } while (0)
#define PG8_LDA(dst, b, h) do { _Pragma("unroll") for (int m = 0; m < 4; ++m) _Pragma("unroll") for (int k = 0; k < 2; ++k) dst[m][k] = *(const PG8_LAS bf16x8*)(lds + PG8_SA(b, h) + aoff + m * 2048 + k * 1024); } while (0)
#define PG8_LDB(dst, b, h) do { _Pragma("unroll") for (int n = 0; n < 2; ++n) _Pragma("unroll") for (int k = 0; k < 2; ++k) dst[n][k] = *(const PG8_LAS bf16x8*)(lds + PG8_SB(b, h) + boff + n * 2048 + k * 1024); } while (0)
#define PG8_CAT(x) __builtin_shufflevector(__builtin_bit_cast(i32x4, (x)[0]), __builtin_bit_cast(i32x4, (x)[1]), 0, 1, 2, 3, 4, 5, 6, 7)
#define PG8_MMA(ai, bj, At, Bt) do { __builtin_amdgcn_s_setprio(1); _Pragma("unroll") for (int m = 0; m < 4; ++m) _Pragma("unroll") for (int n = 0; n < 2; ++n) { \
        if constexpr (FP8) { const i32x8 b8_ = PG8_CAT(Bt[n]), a8_ = PG8_CAT(At[m]); asm volatile("v_mfma_f32_16x16x128_f8f6f4 %0, %1, %2, %0" : "+v"(acc[ai][bj][m][n]) : "v"(b8_), "v"(a8_)); }   \
        else { _Pragma("unroll") for (int k = 0; k < 2; ++k) acc[ai][bj][m][n] = __builtin_amdgcn_mfma_f32_16x16x32_bf16(Bt[n][k], At[m][k], acc[ai][bj][m][n], 0, 0, 0); } } __builtin_amdgcn_s_setprio(0); } while (0)
#define PG8_WAIT_V(n) asm volatile("s_waitcnt vmcnt(" #n ")" ::: "memory")
#define PG8_WAIT_L(n) asm volatile("s_waitcnt lgkmcnt(" #n ")" ::: "memory")
#define PG8_BAR __builtin_amdgcn_s_barrier()
#define PG8_SCHED __builtin_amdgcn_sched_barrier(0)
    Unit cur, nxt; int ui = 0;
    if (!S.next(0, cur)) return;
    f32x4 acc[2][2][4][2];
#pragma unroll
    for (int a = 0; a < 2; ++a)
#pragma unroll
        for (int b = 0; b < 2; ++b)
#pragma unroll
            for (int m = 0; m < 4; ++m)
#pragma unroll
                for (int n = 0; n < 2; ++n) acc[a][b][m][n] = (f32x4){0.f, 0.f, 0.f, 0.f};
    bf16x8 At[4][2], B0[2][2], B1[2][2];
    const char* cA = (const char*)g.A + (size_t)cur.pm * tstep; const char* cB = (const char*)g.Bt + (size_t)cur.pn * tstep;
    S.a_ready(cur);
    if constexpr (SP2) {
        PG8_STAGE(PG8_SB(0, 0), cB, voffB); PG8_STAGE(PG8_SB(0, 1), cB + hstep, voffB); PG8_STAGE(PG8_SA(0, 0), cA, voffA); PG8_STAGE(PG8_SA(0, 1), cA + hstep, voffA);
        if (wr == 1) PG8_BAR;
        PG8_WAIT_V(2); PG8_BAR;
        PG8_STAGE(PG8_SB(1, 0), cB + kstep, voffB); PG8_STAGE(PG8_SA(1, 0), cA + kstep, voffA); PG8_STAGE(PG8_SB(1, 1), cB + hstep + kstep, voffB);
        PG8_WAIT_V(6); PG8_BAR;
    } else {
        PG8_STAGE(PG8_SB(0, 0), cB, voffB); PG8_STAGE(PG8_SA(0, 0), cA, voffA); PG8_STAGE(PG8_SB(0, 1), cB + hstep, voffB); PG8_STAGE(PG8_SA(0, 1), cA + hstep, voffA);
        if (wr == 1) PG8_BAR;
        PG8_WAIT_V(4); PG8_BAR;
        PG8_STAGE(PG8_SB(1, 0), cB + kstep, voffB); PG8_STAGE(PG8_SA(1, 0), cA + kstep, voffA); PG8_STAGE(PG8_SB(1, 1), cB + hstep + kstep, voffB);
        PG8_WAIT_V(6); PG8_BAR;
    }
    for (;;) {
        const bool has_next = S.next(ui + 1, nxt);
        const char* nA = has_next ? (const char*)g.A + (size_t)nxt.pm * tstep : cA; const char* nB = has_next ? (const char*)g.Bt + (size_t)nxt.pn * tstep : cB;
        for (int t = 0; t < nt; t += 2) {
            if constexpr (Epi::MIDT > 0) { if (t == Epi::MIDT) E.mid(acc, cur, wr, fr); }
            const bool last = (t == nt - 2);
            const char* a1 = cA + (size_t)(t + 1) * kstep;
            const char* a2 = last ? nA : cA + (size_t)(t + 2) * kstep; const char* b2 = last ? nB : cB + (size_t)(t + 2) * kstep;
            const char* a3 = a2 + kstep; const char* b3 = b2 + kstep;
            if (last && has_next) S.a_ready(nxt);
            if constexpr (SP2) {
            PG8_LDB(B0, 0, 0); PG8_LDB(B1, 0, 1); PG8_SCHED; PG8_LDA(At, 0, 0); PG8_STAGE(PG8_SA(1, 1), a1 + hstep, voffA);
            PG8_WAIT_V(8); PG8_WAIT_L(0); PG8_BAR; PG8_MMA(0, 0, At, B0); PG8_MMA(0, 1, At, B1); PG8_BAR; PG8_SCHED;
            PG8_LDA(At, 0, 1); PG8_STAGE(PG8_SB(0, 0), b2, voffB); PG8_STAGE(PG8_SB(0, 1), b2 + hstep, voffB); PG8_STAGE(PG8_SA(0, 0), a2, voffA);
            PG8_WAIT_V(8); PG8_WAIT_L(0); PG8_BAR; PG8_MMA(1, 0, At, B0); PG8_MMA(1, 1, At, B1); PG8_BAR; PG8_SCHED;
            PG8_LDB(B0, 1, 0); PG8_LDB(B1, 1, 1); PG8_SCHED; PG8_LDA(At, 1, 0); PG8_STAGE(PG8_SA(0, 1), a2 + hstep, voffA);
            PG8_WAIT_V(8); PG8_WAIT_L(0); PG8_BAR; PG8_MMA(0, 0, At, B0); PG8_MMA(0, 1, At, B1); PG8_BAR; PG8_SCHED;
            PG8_LDA(At, 1, 1); PG8_STAGE(PG8_SB(1, 0), b3, voffB); PG8_STAGE(PG8_SB(1, 1), b3 + hstep, voffB); PG8_STAGE(PG8_SA(1, 0), a3, voffA);
            PG8_WAIT_V(8); PG8_WAIT_L(0); PG8_BAR; PG8_MMA(1, 0, At, B0); PG8_MMA(1, 1, At, B1); PG8_BAR; PG8_SCHED;
            } else {
            PG8_LDB(B0, 0, 0); PG8_SCHED; PG8_LDA(At, 0, 0); PG8_STAGE(PG8_SA(1, 1), a1 + hstep, voffA);
            PG8_WAIT_L(8); PG8_BAR; PG8_WAIT_L(0); PG8_MMA(0, 0, At, B0); PG8_BAR; PG8_SCHED;
            PG8_LDB(B1, 0, 1); PG8_STAGE(PG8_SB(0, 0), b2, voffB);
            PG8_BAR; PG8_WAIT_L(0); PG8_MMA(0, 1, At, B1); PG8_BAR;
            PG8_LDA(At, 0, 1); PG8_STAGE(PG8_SA(0, 0), a2, voffA);
            PG8_BAR; PG8_WAIT_L(0); PG8_MMA(1, 0, At, B0); PG8_BAR; PG8_SCHED;
            PG8_STAGE(PG8_SB(0, 1), b2 + hstep, voffB);
            PG8_WAIT_V(6); PG8_BAR; PG8_MMA(1, 1, At, B1); PG8_BAR;
            PG8_LDB(B0, 1, 0); PG8_SCHED; PG8_LDA(At, 1, 0); PG8_STAGE(PG8_SA(0, 1), a2 + hstep, voffA);
            PG8_WAIT_L(8); PG8_BAR; PG8_WAIT_L(0); PG8_MMA(0, 0, At, B0); PG8_BAR; PG8_SCHED;
            PG8_LDB(B1, 1, 1); PG8_STAGE(PG8_SB(1, 0), b3, voffB);
            PG8_BAR; PG8_WAIT_L(0); PG8_MMA(0, 1, At, B1); PG8_BAR;
            PG8_LDA(At, 1, 1); PG8_STAGE(PG8_SA(1, 0), a3, voffA);
            PG8_BAR; PG8_WAIT_L(0); PG8_MMA(1, 0, At, B0); PG8_BAR; PG8_SCHED;
            PG8_STAGE(PG8_SB(1, 1), b3 + hstep, voffB);
            PG8_WAIT_V(6); PG8_BAR; PG8_MMA(1, 1, At, B1); PG8_BAR;
            }
        }
        if constexpr (FP8) {
            asm volatile("s_nop 15\n\ts_nop 15" ::: "memory");
#pragma unroll
            for (int a = 0; a < 2; ++a)
#pragma unroll
                for (int b = 0; b < 2; ++b)
#pragma unroll
                    for (int m = 0; m < 4; ++m)
#pragma unroll
                        for (int n = 0; n < 2; ++n) asm volatile("" : "+v"(acc[a][b][m][n]));
        }
        if constexpr (ALIGN_EPI) { if (wr == 0) PG8_BAR; }
        if constexpr (!Epi::AFTER_DRAIN) { E(acc, cur, wr, wc, fr, fq); S.done(cur); }
        if (!has_next) break;
#pragma unroll
        for (int a = 0; a < 2; ++a)
#pragma unroll
            for (int b = 0; b < 2; ++b)
#pragma unroll
                for (int m = 0; m < 4; ++m)
#pragma unroll
                    for (int n = 0; n < 2; ++n) acc[a][b][m][n] = (f32x4){0.f, 0.f, 0.f, 0.f};
        cur = nxt; cA = nA; cB = nB; ++ui;
        if constexpr (ALIGN_EPI) { if (wr == 1) PG8_BAR; }
    }
    PG8_WAIT_V(0);
    if constexpr (!ALIGN_EPI) { if (wr == 0) PG8_BAR; }
    PG8_BAR;
    if constexpr (Epi::AFTER_DRAIN) { E.fused(acc, cur, wr, wc, fr, fq, lds, wid, lane); S.done(cur); }
#undef PG8_SA
#undef PG8_SB
#undef PG8_STAGE
#undef PG8_LDA
#undef PG8_LDB
#undef PG8_MMA
#undef PG8_CAT
#undef PG8_WAIT_V
#undef PG8_WAIT_L
#undef PG8_BAR
#undef PG8_SCHED
}
}

#define PG8_SP2 true
#define PG8_ALIGN true
namespace att {
typedef unsigned short bf16;
using bf16x8 = __attribute__((ext_vector_type(8))) short;
using s16x4  = __attribute__((ext_vector_type(4))) short;
using f32x16 = __attribute__((ext_vector_type(16))) float;
using u32x4  = __attribute__((ext_vector_type(4))) unsigned;
#define ATT_LAS __attribute__((address_space(3)))
typedef ATT_LAS char* lptr;
constexpr int   D = 128, NW = 8, QBLK = 32, KVBLK = 64;
constexpr float SCALE = 0.088388347648318440f;
constexpr float THR = 8.f;
constexpr int SHM_V = KVBLK * D * 2, SHM_K = KVBLK * D * 2, SHM_ATTN = 2 * SHM_V + 2 * SHM_K + NW * 64 * 4;
#define KSWZ(row, colB) ((row) * 256 + ((colB) ^ (((row) & 7) << 4)))
#define SBAR() __builtin_amdgcn_sched_barrier(0)
__device__ __forceinline__ int crow(int r, int hi) { return (r & 3) + 8 * (r >> 2) + 4 * hi; }
__device__ __forceinline__ unsigned cvtpk(float lo, float hi) { unsigned r; asm volatile("v_cvt_pk_bf16_f32 %0, %1, %2" : "=v"(r) : "v"(lo), "v"(hi)); return r; }
__device__ __forceinline__ void partialSM(f32x16& p0, f32x16& p1, float& m_reg, float& mn, float& alpha) {
  constexpr float C = SCALE * 1.4426950408889634f;
  float pmax = p0[0];
#pragma unroll
  for (int r = 1; r < 16; ++r) pmax = fmaxf(pmax, p0[r]);
#pragma unroll
  for (int r = 0; r < 16; ++r) pmax = fmaxf(pmax, p1[r]);
  { auto rr = __builtin_amdgcn_permlane32_swap(__float_as_uint(pmax), __float_as_uint(pmax), false, false);
    pmax = fmaxf(__uint_as_float(rr[0]), __uint_as_float(rr[1])); }
  if (__builtin_expect(__all(pmax - m_reg <= THR / SCALE), 1)) { mn = m_reg; alpha = 1.f; }
  else { mn = fmaxf(m_reg, pmax); alpha = __builtin_amdgcn_exp2f((m_reg - mn) * C); m_reg = mn; }
  float mnC = -mn * C;
#pragma unroll
  for (int r = 0; r < 16; ++r) p0[r] = fmaf(p0[r], C, mnC);
#pragma unroll
  for (int r = 0; r < 16; ++r) p1[r] = fmaf(p1[r], C, mnC);
#pragma unroll
  for (int r = 0; r < 16; ++r) p0[r] = __builtin_amdgcn_exp2f(p0[r]);
}
__device__ __forceinline__ void finishSM(f32x16& p0, f32x16& p1, float alpha, float& l_reg, bf16x8& pa0, bf16x8& pa1, bf16x8& pa2, bf16x8& pa3) {
#pragma unroll
  for (int r = 0; r < 16; ++r) p1[r] = __builtin_amdgcn_exp2f(p1[r]);
  float ps = 0;
#pragma unroll
  for (int r = 0; r < 16; ++r) ps += p0[r];
#pragma unroll
  for (int r = 0; r < 16; ++r) ps += p1[r];
  { auto rr = __builtin_amdgcn_permlane32_swap(__float_as_uint(ps), __float_as_uint(ps), false, false);
    ps = __uint_as_float(rr[0]) + __uint_as_float(rr[1]); }
  l_reg = l_reg * alpha + ps;
#define PK4(P, BASE, OUT) do { unsigned a0 = cvtpk(P[BASE + 0], P[BASE + 1]), a1 = cvtpk(P[BASE + 2], P[BASE + 3]);   \
    unsigned b0 = cvtpk(P[BASE + 4], P[BASE + 5]), b1 = cvtpk(P[BASE + 6], P[BASE + 7]);                              \
    auto r0 = __builtin_amdgcn_permlane32_swap(a0, b0, false, false); auto r1 = __builtin_amdgcn_permlane32_swap(a1, b1, false, false); \
    u32x4 w = {r0[0], r1[0], r0[1], r1[1]}; OUT = *reinterpret_cast<bf16x8*>(&w); } while (0)
  PK4(p0, 0, pa0); PK4(p0, 8, pa1); PK4(p1, 0, pa2); PK4(p1, 8, pa3);
#undef PK4
}
__device__ __forceinline__ void qkt(f32x16& p0, f32x16& p1, lptr Ks, const bf16x8* qr, int r32, int hi) {
  p0 = f32x16{}; p1 = f32x16{};
#pragma unroll
  for (int d0 = 0; d0 < 8; ++d0) { int cb = (d0 * 16 + hi * 8) * 2;
    bf16x8 b0 = *reinterpret_cast<const ATT_LAS bf16x8*>(Ks + KSWZ(r32, cb));
    bf16x8 b1 = *reinterpret_cast<const ATT_LAS bf16x8*>(Ks + KSWZ(32 + r32, cb));
    p0 = __builtin_amdgcn_mfma_f32_32x32x16_bf16(b0, qr[d0], p0, 0, 0, 0);
    p1 = __builtin_amdgcn_mfma_f32_32x32x16_bf16(b1, qr[d0], p1, 0, 0, 0); }
}
__device__ __forceinline__ int v_st(int k, int c) { const int kk = (k & ~0xC) | ((k & 4) << 1) | ((k & 8) >> 1); return ((kk >> 3) * 4 + (c >> 5)) * 512 + ((kk & 7) * 32 + (c & 31)) * 2; }
__device__ __forceinline__ int v_rd_base(int lane) { return ((lane & 3) << 3) | (((lane >> 2) & 3) << 6) | (((lane >> 4) & 1) << 5) | (((lane >> 5) & 1) << 8); }
constexpr int v_rd_off(int d0, int ks, int half) { return d0 * 512 + ks * 4096 + half * 2048; }
template <int OFF> __device__ __forceinline__ s16x4 tr_read(int vb) {
  s16x4 r; asm volatile("ds_read_b64_tr_b16 %0, %1 offset:%2" : "=&v"(r) : "v"(vb), "i"(OFF) : "memory"); return r;
}
template <int D0> __device__ __forceinline__ void pv_one(f32x16& od, int vb, bf16x8 pa0, bf16x8 pa1, bf16x8 pa2, bf16x8 pa3) {
  const s16x4 l0 = tr_read<v_rd_off(D0, 0, 0)>(vb), h0 = tr_read<v_rd_off(D0, 0, 1)>(vb), l1 = tr_read<v_rd_off(D0, 1, 0)>(vb), h1 = tr_read<v_rd_off(D0, 1, 1)>(vb);
  const s16x4 l2 = tr_read<v_rd_off(D0, 2, 0)>(vb), h2 = tr_read<v_rd_off(D0, 2, 1)>(vb), l3 = tr_read<v_rd_off(D0, 3, 0)>(vb), h3 = tr_read<v_rd_off(D0, 3, 1)>(vb);
  asm volatile("s_waitcnt lgkmcnt(0)" ::: "memory"); SBAR();
#define PK(L, H) (bf16x8){L[0], L[1], L[2], L[3], H[0], H[1], H[2], H[3]}
  od = __builtin_amdgcn_mfma_f32_32x32x16_bf16(pa0, PK(l0, h0), od, 0, 0, 0);
  od = __builtin_amdgcn_mfma_f32_32x32x16_bf16(pa1, PK(l1, h1), od, 0, 0, 0);
  od = __builtin_amdgcn_mfma_f32_32x32x16_bf16(pa2, PK(l2, h2), od, 0, 0, 0);
  od = __builtin_amdgcn_mfma_f32_32x32x16_bf16(pa3, PK(l3, h3), od, 0, 0, 0);
#undef PK
}
__device__ __forceinline__ void pv_d0(f32x16* o, int vb, bf16x8 pa0, bf16x8 pa1, bf16x8 pa2, bf16x8 pa3) {
  pv_one<0>(o[0], vb, pa0, pa1, pa2, pa3); pv_one<1>(o[1], vb, pa0, pa1, pa2, pa3); pv_one<2>(o[2], vb, pa0, pa1, pa2, pa3); pv_one<3>(o[3], vb, pa0, pa1, pa2, pa3);
}
__device__ __forceinline__ void moba_mask(f32x16& p0, f32x16& p1, int tile, int qb, unsigned sel, int qi, int w0, int hi) {
  const float NINF = -__builtin_inff();
  const int jb = tile >> 2;
  if (jb < qb) {
    const bool ok = ((sel >> jb) & 1u) != 0u;
    if (!__all(ok)) {
#pragma unroll
      for (int r = 0; r < 16; ++r) { p0[r] = ok ? p0[r] : NINF; p1[r] = ok ? p1[r] : NINF; }
    }
  } else {
    const int k0 = (tile & 3) * 64;
    if (k0 + 63 > w0) {
      int lim = qi - k0 - 4 * hi; asm volatile("" : "+v"(lim));
#pragma unroll
      for (int r = 0; r < 16; ++r) { const int kc = (r & 3) + 8 * (r >> 2); p0[r] = (kc <= lim) ? p0[r] : NINF; p1[r] = (kc + 32 <= lim) ? p1[r] : NINF; }
    }
  }
}

template <bool MOBA, int LDQ, int LDK, int LDO, int SDEPTH, typename TO>
__device__ __forceinline__ void attn_body(const bf16* __restrict__ Qb, const bf16* __restrict__ Kh, const bf16* __restrict__ Vh, TO* __restrict__ Ob, int seq, lptr lds,
                                          int qb, const float* __restrict__ kms, int kms_stride, unsigned long long* __restrict__ ssq) {
  int tid_ = threadIdx.x; asm volatile("" : "+v"(tid_));
  const int tid = tid_, wid = tid >> 6, lane = tid & 63, r32 = lane & 31, hi = lane >> 5;
  lptr V_lds = lds; lptr K_lds = lds + 2 * SHM_V;
  ATT_LAS float* ws = (ATT_LAS float*)(lds + 2 * SHM_V + 2 * SHM_K) + wid * 64; ATT_LAS float* li_l = ws; ATT_LAS float* al_l = ws + 32;
  float m_reg = -1e30f, l_reg = 0; f32x16 o[4] = {}; bf16x8 qr[8];
  unsigned qoff = (unsigned)((wid * QBLK + r32) * LDQ + hi * 8); asm volatile("" : "+v"(qoff));
  const bf16* Qw = Qb + qoff;
#pragma unroll
  for (int d0 = 0; d0 < 8; ++d0) qr[d0] = *reinterpret_cast<const bf16x8*>(Qw + d0 * 16);
  const int sr = tid >> 4, sc = (tid & 15) * 8, vst0 = v_st(sr, sc), vst1 = v_st(32 + sr, sc);
  const int vb0 = (int)(uintptr_t)V_lds + v_rd_base(lane);
  struct { bf16x8 vs0, vs1, ks0, ks1; } sr_[SDEPTH];
  const unsigned so0 = (unsigned)(sr * LDK + sc), so1 = (unsigned)((32 + sr) * LDK + sc);
#define SLOAD(i, k0) do { const bf16* Vt_ = Vh + (long)(k0) * LDK; const bf16* Kt_ = Kh + (long)(k0) * LDK; \
    sr_[i].vs0 = *reinterpret_cast<const bf16x8*>(Vt_ + so0); sr_[i].vs1 = *reinterpret_cast<const bf16x8*>(Vt_ + so1); \
    sr_[i].ks0 = *reinterpret_cast<const bf16x8*>(Kt_ + so0); sr_[i].ks1 = *reinterpret_cast<const bf16x8*>(Kt_ + so1); } while (0)
#define SWRITE(b, i) do { *(ATT_LAS bf16x8*)(V_lds + (b) * SHM_V + vst0) = sr_[i].vs0;          \
    *(ATT_LAS bf16x8*)(V_lds + (b) * SHM_V + vst1) = sr_[i].vs1; int kc = sc * 2;               \
    *(ATT_LAS bf16x8*)(K_lds + (b) * SHM_K + KSWZ(sr, kc)) = sr_[i].ks0;                       \
    *(ATT_LAS bf16x8*)(K_lds + (b) * SHM_K + KSWZ(32 + sr, kc)) = sr_[i].ks1; } while (0)
#define SWAIT() do { if constexpr (SDEPTH == 2) asm volatile("s_waitcnt vmcnt(4)" ::: "memory"); else asm volatile("s_waitcnt vmcnt(0)" ::: "memory"); } while (0)
#define RESC(a) do { if (__any((a) < 1.f)) { if (hi == 0) al_l[r32] = (a); asm volatile("s_waitcnt lgkmcnt(0)" ::: "memory"); \
    _Pragma("unroll") for (int d = 0; d < 4; ++d) _Pragma("unroll") for (int r = 0; r < 16; ++r) o[d][r] *= al_l[crow(r, hi)]; } } while (0)
  f32x16 pA0, pA1, pB0, pB1; float mnA, mnB, alA, alB; bf16x8 pa0, pa1, pa2, pa3; const int NT = seq / KVBLK;
  constexpr int SE = 0, SO = SDEPTH - 1;
  unsigned sel = 0u; const int qi = wid * QBLK + r32, w0 = wid * QBLK;
  SLOAD(SE, 0);
  if constexpr (MOBA) {
    { const int j = sr & 15; const float* src = kms + (size_t)j * kms_stride + sc; const float4 x0 = *reinterpret_cast<const float4*>(src), x1 = *reinterpret_cast<const float4*>(src + 4);
      const float xv[8] = {x0.x, x0.y, x0.z, x0.w, x1.x, x1.y, x1.z, x1.w}; unsigned w[4];
#pragma unroll
      for (int e = 0; e < 4; ++e) { const unsigned h2 = cvtpk(xv[2 * e], xv[2 * e + 1]); const float f0 = __uint_as_float(h2 << 16), f1 = __uint_as_float(h2 & 0xffff0000u);
        const unsigned l2 = cvtpk(xv[2 * e] - f0, xv[2 * e + 1] - f1); w[e] = (sr < 16) ? h2 : l2; }
      u32x4 wv = {w[0], w[1], w[2], w[3]}; *(ATT_LAS u32x4*)(K_lds + KSWZ(sr, sc * 2)) = wv; }
    __syncthreads();
    f32x16 g = f32x16{};
#pragma unroll
    for (int d0 = 0; d0 < 8; ++d0) { const int cb = (d0 * 16 + hi * 8) * 2; const bf16x8 b0 = *reinterpret_cast<const ATT_LAS bf16x8*>(K_lds + KSWZ(r32, cb));
      g = __builtin_amdgcn_mfma_f32_32x32x16_bf16(b0, qr[d0], g, 0, 0, 0); }
    float G[16];
#pragma unroll
    for (int r = 0; r < 8; ++r) { const float own = g[r] + g[r + 8]; const float oth = __shfl_xor(own, 32); const int lb = (r & 3) + 8 * (r >> 2);
      G[lb] = hi ? oth : own; G[lb + 4] = hi ? own : oth; }
    const float NINF = -__builtin_inff();
#pragma unroll
    for (int j = 0; j < 16; ++j) G[j] = (j < qb) ? G[j] : NINF;
#pragma unroll
    for (int it = 0; it < 3; ++it) { float mx = NINF; int mi = -1;
#pragma unroll
      for (int j = 0; j < 16; ++j) { const bool gt = G[j] > mx; mx = gt ? G[j] : mx; mi = gt ? j : mi; }
      if (mi >= 0) sel |= 1u << mi;
#pragma unroll
      for (int j = 0; j < 16; ++j) G[j] = (j == mi) ? NINF : G[j]; }
    __syncthreads();
  }
  asm volatile("s_waitcnt vmcnt(0)" ::: "memory"); SWRITE(0, SE); __syncthreads();
  qkt(pA0, pA1, K_lds, qr, r32, hi);
  if constexpr (MOBA) moba_mask(pA0, pA1, 0, qb, sel, qi, w0, hi);
  partialSM(pA0, pA1, m_reg, mnA, alA);
  SLOAD(SO, KVBLK); if constexpr (SDEPTH == 2) { if (2 < NT) SLOAD(SE, 2 * KVBLK); }
  SWAIT(); SWRITE(1, SO); __syncthreads();
  for (int j = 1; j + 1 < NT; j += 2) {
    SBAR(); qkt(pB0, pB1, K_lds + SHM_K, qr, r32, hi);
    finishSM(pA0, pA1, alA, l_reg, pa0, pa1, pa2, pa3); SBAR();
    SLOAD(SO, (j + SDEPTH) * KVBLK); SBAR();
    pv_d0(o, vb0, pa0, pa1, pa2, pa3);
    if constexpr (MOBA) moba_mask(pB0, pB1, j, qb, sel, qi, w0, hi);
    partialSM(pB0, pB1, m_reg, mnB, alB);
    __syncthreads(); SWAIT(); SWRITE(0, SE);
    RESC(alB); __syncthreads();
    SBAR(); qkt(pA0, pA1, K_lds, qr, r32, hi);
    finishSM(pB0, pB1, alB, l_reg, pa0, pa1, pa2, pa3); SBAR();
    if (SDEPTH == 1 || j + 3 < NT) SLOAD(SE, (j + 1 + SDEPTH) * KVBLK); SBAR();
    pv_d0(o, vb0 + SHM_V, pa0, pa1, pa2, pa3);
    if constexpr (MOBA) moba_mask(pA0, pA1, j + 1, qb, sel, qi, w0, hi);
    partialSM(pA0, pA1, m_reg, mnA, alA);
    __syncthreads(); SWAIT(); SWRITE(1, SO);
    RESC(alA); __syncthreads();
  }
  SBAR(); qkt(pB0, pB1, K_lds + SHM_K, qr, r32, hi);
  finishSM(pA0, pA1, alA, l_reg, pa0, pa1, pa2, pa3); SBAR();
  pv_d0(o, vb0, pa0, pa1, pa2, pa3);
  if constexpr (MOBA) moba_mask(pB0, pB1, NT - 1, qb, sel, qi, w0, hi);
  partialSM(pB0, pB1, m_reg, mnB, alB);
  __syncthreads(); RESC(alB);
  finishSM(pB0, pB1, alB, l_reg, pa0, pa1, pa2, pa3); SBAR();
  pv_d0(o, vb0 + SHM_V, pa0, pa1, pa2, pa3);
  if (hi == 0) li_l[r32] = l_reg; asm volatile("s_waitcnt lgkmcnt(0)" ::: "memory");
  float rli[16];
#pragma unroll
  for (int r = 0; r < 16; ++r) rli[r] = __builtin_amdgcn_rcpf(li_l[crow(r, hi)]);
  int ohi = hi * 4, ocol = r32; asm volatile("" : "+v"(ohi), "+v"(ocol));
  TO* Ow = Ob + (long)(wid * QBLK) * LDO;
#pragma unroll
  for (int r = 0; r < 16; ++r) { const int orow = (r & 3) + 8 * (r >> 2) + ohi; float sq = 0.f;
#pragma unroll
    for (int d0 = 0; d0 < 4; ++d0) { const float v = o[d0][r] * rli[r]; sq += v * v; if constexpr (sizeof(TO) == 2) Ow[(unsigned)(orow * LDO + d0 * 32 + ocol)] = (TO)(cvtpk(v, v) & 0xffffu);
      else Ow[(unsigned)(orow * LDO + d0 * 32 + ocol)] = (TO)(__builtin_amdgcn_cvt_pk_fp8_f32(__builtin_amdgcn_fmed3f(v * 16.0f, -448.0f, 448.0f), 0.0f, 0, false) & 0xff); }
    if constexpr (MOBA) { sq += __shfl_xor(sq, 1); sq += __shfl_xor(sq, 2); sq += __shfl_xor(sq, 4); sq += __shfl_xor(sq, 8); sq += __shfl_xor(sq, 16);
      if (ocol == 0) pg8::ss_add(ssq, wid * QBLK + orow, sq); } }
  __syncthreads();
#undef SLOAD
#undef SWRITE
#undef SWAIT
#undef RESC
}
#undef KSWZ
#undef SBAR
}

constexpr int NWAVES = 8;
constexpr int BATCH = 4, SEQ = 4096, D = 2048, M = BATCH * SEQ, FF = 5632, AW = 1024, CW = 1024, INW = 6144, MEML = 256, XW = 512, NH = 8, XH = 4, NBLK = 16;
constexpr int NPH = 13;
#ifndef FAST_MASK
#define FAST_MASK 0x1fff
#endif
#ifndef ONE_LAUNCH
#define ONE_LAUNCH 1
#endif
constexpr size_t MiB = 1u << 20, KiB = 1u << 10;
constexpr size_t WS_CTL = 0, CTL_ZERO_BYTES = 1536 * KiB;
constexpr size_t CTL_BAR = 64 * KiB, BAR_STRIDE = 16 * KiB;
constexpr size_t CTL_SS = 320 * KiB;
constexpr size_t CTL_KMS = 1088 * KiB;
constexpr size_t WS_WGU1 = 2 * MiB, WS_WD1 = 46 * MiB, WS_WGU2 = 68 * MiB, WS_WD2 = 112 * MiB, WS_WIN = 134 * MiB, WS_WOUT = 158 * MiB, WS_WQ = 166 * MiB, WS_WKV = 168 * MiB, WS_WO = 172 * MiB;
constexpr size_t WS_MEMN = 174 * MiB, WS_KVX = 178 * MiB, WS_HB = 180 * MiB, WS_MIXED = 244 * MiB, WS_ACT = 308 * MiB;
constexpr size_t WS_Q = 308 * MiB, WS_K = 340 * MiB, WS_V = 372 * MiB, WS_CU = 404 * MiB, WS_BG = 436 * MiB;
constexpr size_t WS_QX = 308 * MiB, WS_OX = 324 * MiB;
constexpr size_t WS_HB8 = 340 * MiB, WS_ACT8 = 396 * MiB, WS_OX8 = 324 * MiB;
constexpr size_t WS_DUMMY = 484 * MiB;
constexpr size_t WS_END = 486 * MiB;
static_assert(WS_ACT + (size_t)M * FF * 2 <= WS_END && WS_BG + (size_t)M * 1024 * 2 <= WS_END && CTL_KMS + BATCH * 16 * 8 * 128 * 4 <= CTL_ZERO_BYTES && CTL_SS + 6 * M * 8 <= CTL_KMS && CTL_ZERO_BYTES <= WS_WGU1, "d_ws map");
constexpr int RING_OFF = 0, RING_BYTES = 131072;
constexpr int LDSCTL_OFF = RING_BYTES, MISC_OFF = LDSCTL_OFF + 320;
constexpr int LDS_BYTES = 147456;
static_assert(MISC_OFF + 128 <= LDS_BYTES && att::SHM_ATTN <= RING_BYTES, "LDS map");

#define GAS __attribute__((address_space(1)))
#define LAS __attribute__((address_space(3)))
typedef unsigned short bf16;
typedef unsigned v4u __attribute__((ext_vector_type(4)));
typedef unsigned v2u __attribute__((ext_vector_type(2)));
typedef float f32x4 __attribute__((ext_vector_type(4)));
typedef short bf16x8 __attribute__((ext_vector_type(8)));
typedef GAS unsigned gu32;
#define RLX_AGENT __ATOMIC_RELAXED, __HIP_MEMORY_SCOPE_AGENT
#define LDS_WAIT() asm volatile("s_waitcnt lgkmcnt(0)" ::: "memory")
#define VM_WAIT() asm volatile("s_waitcnt vmcnt(0)" ::: "memory")
__device__ __forceinline__ unsigned pk2(float lo, float hi) { return pg8::cvt_pk_bf16(lo, hi); }
__device__ __forceinline__ float bflo(unsigned w) { return __uint_as_float(w << 16); }
__device__ __forceinline__ float bfhi(unsigned w) { return __uint_as_float(w & 0xffff0000u); }
__device__ __forceinline__ float wave_sum(float v) {
#pragma unroll
    for (int o = 1; o < 64; o <<= 1) v += __shfl_xor(v, o);
    return v;
}
#define XB_TMO      128
#define XB_XCNT(j)  (256  + 64 * (j))
#define XB_XSUB(j)  (1280 + 64 * (j))
#define XB_XGEN(j)  (2304 + 64 * (j))
#define XB_TOP      3328
#define XB_TOPGEN   3392
#define XCD_BAR_WORDS 3456
#define XB_SPIN_CAP (1u << 18)

__device__ __forceinline__ unsigned xb_ld(unsigned* p)              { return __hip_atomic_load(p, __ATOMIC_RELAXED, __HIP_MEMORY_SCOPE_AGENT); }
__device__ __forceinline__ unsigned xb_add(unsigned* p, unsigned v) { return __hip_atomic_fetch_add(p, v, __ATOMIC_RELAXED, __HIP_MEMORY_SCOPE_AGENT); }
__device__ __forceinline__ unsigned xb_xcc_id() { return (unsigned)__builtin_amdgcn_s_getreg((3 << 11) | 20) & 0xFu; }
#define XB_SPIN(cond, bar) do { unsigned _sp = 0; while (cond) { __builtin_amdgcn_s_sleep(1); \
    if ((++_sp & 255u) == 0u) { if (xb_ld(&(bar)[XB_TMO])) break; if (_sp > XB_SPIN_CAP) { atomicAdd(&(bar)[XB_TMO], 1u); break; } } } } while (0)

struct XcdBarrier {
    unsigned* bar; unsigned x;
    volatile LAS unsigned* st;
};

__device__ __forceinline__ XcdBarrier xcd_barrier_post(unsigned* bar, volatile LAS unsigned* st) {
    XcdBarrier b; b.bar = bar; b.x = xb_xcc_id(); b.st = st;
    if (threadIdx.x == 0) (void)xb_add(&bar[XB_XCNT(b.x)], 1u);
    return b;
}
__device__ __forceinline__ void xcd_barrier_complete(unsigned* bar, unsigned x, unsigned& nloc, unsigned& nx) {
    const unsigned G = gridDim.x * gridDim.y * gridDim.z;
    unsigned sum, cnt, mine, sp = 0u;
    for (;;) {
        sum = 0u; cnt = 0u; mine = 0u;
#pragma unroll
        for (unsigned j = 0; j < 16; ++j) { const unsigned c = xb_ld(&bar[XB_XCNT(j)]); sum += c; cnt += (c > 0u) ? 1u : 0u; mine = (j == x) ? c : mine; }
        if (sum == G) break;
        __builtin_amdgcn_s_sleep(1);
        if ((++sp & 255u) == 0u) { if (xb_ld(&bar[XB_TMO])) break; if (sp > XB_SPIN_CAP) { atomicAdd(&bar[XB_TMO], 1u); break; } }
    }
    nloc = mine > 0u ? mine : 1u; nx = cnt > 0u ? cnt : 1u;
}

__device__ __forceinline__ void xcd_barrier(const XcdBarrier& b) {
    asm volatile("s_waitcnt vmcnt(0)" ::: "memory");
    __syncthreads();
    if (threadIdx.x == 0) {
        unsigned* bar = b.bar;
        __builtin_amdgcn_s_waitcnt(0);
        unsigned nloc = b.st[0], nx = b.st[1];
        if (nloc == 0u) { xcd_barrier_complete(bar, b.x, nloc, nx); b.st[0] = nloc; b.st[1] = nx; }
        const unsigned old = xb_add(&bar[XB_XSUB(b.x)], 1u);
        const unsigned gen = old / nloc;
        if (old + 1u == (gen + 1u) * nloc) {
            __builtin_amdgcn_fence(__ATOMIC_RELEASE, "agent");
            asm volatile("s_waitcnt vmcnt(0)" ::: "memory");
            const unsigned og = xb_add(&bar[XB_TOP], 1u);
            const unsigned tg = og / nx;
            if (og + 1u == (tg + 1u) * nx) xb_add(&bar[XB_TOPGEN], 1u);
            else XB_SPIN(xb_ld(&bar[XB_TOPGEN]) == tg, bar);
            __builtin_amdgcn_fence(__ATOMIC_ACQUIRE, "agent");
            xb_add(&bar[XB_XGEN(b.x)], 1u);
            asm volatile("s_waitcnt vmcnt(0)" ::: "memory");
        } else {
            XB_SPIN(xb_ld(&bar[XB_XGEN(b.x)]) == gen, bar);
            __builtin_amdgcn_fence(__ATOMIC_ACQUIRE, "agent");
            asm volatile("s_waitcnt vmcnt(0)" ::: "memory");
        }
    }
    __syncthreads();
}

namespace nv {
typedef float f32x4 __attribute__((ext_vector_type(4)));
typedef short bf16x8 __attribute__((ext_vector_type(8)));
constexpr float EPS = 1e-6f;
template <class F> __global__ __launch_bounds__(256) void gemm(const bf16* __restrict__ A, const bf16* __restrict__ Bt, int K, F f) {
    const int wave = threadIdx.x >> 6, lane = threadIdx.x & 63;
    const int row0 = blockIdx.y * 64 + wave * 16, col0 = blockIdx.x * 64;
    f32x4 acc[4], acc2[4];
#pragma unroll
    for (int c = 0; c < 4; ++c) { acc[c] = (f32x4){0.f, 0.f, 0.f, 0.f}; acc2[c] = (f32x4){0.f, 0.f, 0.f, 0.f}; }
    const bf16* ap = A + (size_t)(row0 + (lane & 15)) * K + 8 * (lane >> 4);
    const bf16* bp[4]; const bf16* bp2[4];
#pragma unroll
    for (int c = 0; c < 4; ++c) { const int col = col0 + 16 * c + (lane & 15); bp[c] = Bt + (size_t)f.brow(col) * K + 8 * (lane >> 4); bp2[c] = Bt + (size_t)f.brow2(col) * K + 8 * (lane >> 4); }
    for (int k0 = 0; k0 < K; k0 += 32) {
        if (F::MIDK > 0 && k0 == F::MIDK) {
#pragma unroll
            for (int j = 0; j < 4; ++j) { const float s = f.midscale(row0 + (lane >> 4) * 4 + j);
#pragma unroll
                for (int c = 0; c < 4; ++c) acc[c][j] *= s; }
        }
        const bf16x8 a = *(const bf16x8*)(ap + k0);
#pragma unroll
        for (int c = 0; c < 4; ++c) { const bf16x8 b = *(const bf16x8*)(bp[c] + k0); acc[c] = __builtin_amdgcn_mfma_f32_16x16x32_bf16(a, b, acc[c], 0, 0, 0);
            if (F::DUAL) { const bf16x8 b2 = *(const bf16x8*)(bp2[c] + k0); acc2[c] = __builtin_amdgcn_mfma_f32_16x16x32_bf16(a, b2, acc2[c], 0, 0, 0); } }
    }
#pragma unroll
    for (int j = 0; j < 4; ++j) { const int row = row0 + (lane >> 4) * 4 + j; float sq = 0.f;
#pragma unroll
        for (int c = 0; c < 4; ++c) { const float h = f.store(row, col0 + 16 * c + (lane & 15), acc[c][j], acc2[c][j]); sq += h * h; }
        if (F::ROWSS) { sq += __shfl_xor(sq, 1); sq += __shfl_xor(sq, 2); sq += __shfl_xor(sq, 4); sq += __shfl_xor(sq, 8); if ((lane & 15) == 0) f.addss(row, sq); } }
}
__device__ __forceinline__ bf16 tobf(float v) { return (bf16)(pg8::cvt_pk_bf16(v, v) & 0xffffu); }
struct FSwiglu { static constexpr bool DUAL = true, ROWSS = false; static constexpr int MIDK = 0; bf16* O; const pg8::u64_t* ss;
    __device__ int brow(int col) const { return (col >> 7) * 256 + (col & 127); } __device__ int brow2(int col) const { return brow(col) + 128; } __device__ float midscale(int) const { return 1.f; } __device__ void addss(int, float) const {}
    __device__ float store(int row, int col, float a, float a2) const { const float rs = rsqrtf(pg8::ss_val(ss, row) * (1.0f / 2048.0f) + EPS), g = a * rs, u = a2 * rs; O[(size_t)row * FF + col] = tobf(g / (1.0f + __expf(-g)) * u); return 0.f; } };
template <int MIDK_, bool RBF, bool OF32> struct FResid { static constexpr bool DUAL = false, ROWSS = true; static constexpr int MIDK = MIDK_; const float* R; const bf16* RB; float* H; bf16* HB; pg8::u64_t* ssn; float alpha; const pg8::u64_t* midss;
    __device__ int brow(int col) const { return col; } __device__ int brow2(int col) const { return col; } __device__ float midscale(int row) const { return rsqrtf(pg8::ss_val(midss, row) * (1.0f / 1024.0f) + EPS); }
    __device__ void addss(int row, float s) const { pg8::ss_add(ssn, row, s); }
    __device__ float store(int row, int col, float a, float) const { const size_t o = (size_t)row * 2048 + col; const float r = RBF ? __uint_as_float((unsigned)RB[o] << 16) : R[o]; const float h = r + alpha * a; if (OF32) H[o] = h; else HB[o] = tobf(h); return h; } };
struct FWin { static constexpr bool DUAL = true, ROWSS = false; static constexpr int MIDK = 0; bf16 *Q, *K, *V, *CU, *BG; const pg8::u64_t* ss;
    __device__ int brow(int col) const { if (col < 3072) return col; if (col < 4096) { const int j = col - 3072; return 3072 + (j >> 7) * 256 + (j & 127); } return 5120 + (col - 4096); }
    __device__ int brow2(int col) const { return (col >= 3072 && col < 4096) ? brow(col) + 128 : brow(col); } __device__ float midscale(int) const { return 1.f; } __device__ void addss(int, float) const {}
    __device__ float store(int row, int col, float a, float a2) const { const float rs = rsqrtf(pg8::ss_val(ss, row) * (1.0f / 2048.0f) + EPS); const size_t o = (size_t)row * 1024 + (col & 1023);
        if (col < 1024) Q[o] = tobf(a * rs); else if (col < 2048) K[o] = tobf(a * rs); else if (col < 3072) V[o] = tobf(a * rs); else if (col < 4096) CU[o] = tobf((a * rs) * (a2 * rs)); else BG[o] = tobf(a * rs); return 0.f; } };
struct FScale { static constexpr bool DUAL = false, ROWSS = false; static constexpr int MIDK = 0; bf16* O; int ldo; const pg8::u64_t* ss;
    __device__ int brow(int col) const { return col; } __device__ int brow2(int col) const { return col; } __device__ float midscale(int) const { return 1.f; } __device__ void addss(int, float) const {}
    __device__ float store(int row, int col, float a, float) const { const float rs = ss ? rsqrtf(pg8::ss_val(ss, row) * (1.0f / 2048.0f) + EPS) : 1.0f; O[(size_t)row * ldo + col] = tobf(a * rs); return 0.f; } };
__global__ __launch_bounds__(256) void kmean(const bf16* __restrict__ K, float* __restrict__ kms) {
    const int i = blockIdx.x * 256 + threadIdx.x; const int d = i & 127, h = (i >> 7) & 7, bb = i >> 10;
    float s = 0.f; for (int r = 0; r < 256; ++r) s += __uint_as_float((unsigned)K[((size_t)bb * 256 + r) * 1024 + h * 128 + d] << 16);
    kms[i] = s;
}
__global__ __launch_bounds__(256) void moba(const bf16* __restrict__ Q, const bf16* __restrict__ K, const bf16* __restrict__ V, const float* __restrict__ kms, bf16* __restrict__ AO, pg8::u64_t* __restrict__ ssA) {
    const int wave = threadIdx.x >> 6, lane = threadIdx.x & 63; const int idx = blockIdx.x * 4 + wave; const int h = idx & 7, row = idx >> 3, b = row >> 12, t = row & 4095, qb = t >> 8;
    const unsigned qw = *(const unsigned*)(Q + (size_t)row * 1024 + h * 128 + 2 * lane); const float q0 = bflo(qw), q1 = bfhi(qw);
    unsigned sel = 0u;
    { float g[16];
#pragma unroll
      for (int j = 0; j < 16; ++j) { const float* km = kms + ((size_t)(b * 16 + j) * 8 + h) * 128 + 2 * lane; const float p = wave_sum(q0 * km[0] + q1 * km[1]); g[j] = (j < qb) ? p : -__builtin_inff(); }
#pragma unroll
      for (int it = 0; it < 3; ++it) { float mx = -__builtin_inff(); int mi = -1;
#pragma unroll
        for (int j = 0; j < 16; ++j) { const bool gt = g[j] > mx; mx = gt ? g[j] : mx; mi = gt ? j : mi; }
        if (mi >= 0) sel |= 1u << mi;
#pragma unroll
        for (int j = 0; j < 16; ++j) g[j] = (j == mi) ? -__builtin_inff() : g[j]; } }
    sel |= 1u << qb;
    float m = -1e30f, l = 0.f, o0 = 0.f, o1 = 0.f;
    for (int jb = 0; jb <= qb; ++jb) { if (!((sel >> jb) & 1u)) continue;
        const int nk = (jb < qb) ? 256 : (t & 255) + 1;
        for (int kk = 0; kk < nk; ++kk) { const size_t ko = ((size_t)b * 4096 + jb * 256 + kk) * 1024 + h * 128 + 2 * lane;
            const unsigned kw = *(const unsigned*)(K + ko), vw = *(const unsigned*)(V + ko);
            const float s = wave_sum(q0 * bflo(kw) + q1 * bfhi(kw)) * 0.088388347648318440f;
            const float mn = fmaxf(m, s), a = __expf(m - mn), p = __expf(s - mn);
            l = l * a + p; o0 = o0 * a + p * bflo(vw); o1 = o1 * a + p * bfhi(vw); m = mn; } }
    const float il = 1.0f / l; o0 *= il; o1 *= il;
    *(unsigned*)(AO + (size_t)row * 2048 + h * 128 + 2 * lane) = pk2(o0, o1);
    const float sq = wave_sum(o0 * o0 + o1 * o1); if (lane == 0) pg8::ss_add(ssA, row, sq);
}
__global__ __launch_bounds__(256) void xattn(const bf16* __restrict__ QX, const bf16* __restrict__ KVX, bf16* __restrict__ OX) {
    const int wave = threadIdx.x >> 6, lane = threadIdx.x & 63; const int idx = blockIdx.x * 4 + wave; const int h = idx & 3, row = idx >> 2, b = row >> 12;
    const unsigned qw = *(const unsigned*)(QX + (size_t)row * 512 + h * 128 + 2 * lane); const float q0 = bflo(qw), q1 = bfhi(qw);
    float m = -1e30f, l = 0.f, o0 = 0.f, o1 = 0.f;
    for (int kk = 0; kk < 256; ++kk) { const size_t ko = ((size_t)b * 256 + kk) * 1024 + h * 128 + 2 * lane;
        const unsigned kw = *(const unsigned*)(KVX + ko), vw = *(const unsigned*)(KVX + ko + 512);
        const float s = wave_sum(q0 * bflo(kw) + q1 * bfhi(kw)) * 0.088388347648318440f;
        const float mn = fmaxf(m, s), a = __expf(m - mn), p = __expf(s - mn);
        l = l * a + p; o0 = o0 * a + p * bflo(vw); o1 = o1 * a + p * bfhi(vw); m = mn; }
    const float il = 1.0f / l;
    *(unsigned*)(OX + (size_t)row * 512 + h * 128 + 2 * lane) = pk2(o0 * il, o1 * il);
}
}


#ifndef USE_FP8
#define USE_FP8 0xE80
#endif
struct Frame {
    LAS unsigned char* lds;
    volatile LAS unsigned* MISC;
    int tid, lane, wave;
    int vcu, G;
};
struct Args { const float* in[22]; float* out; unsigned char* ws; int ph_lo, ph_hi; };
enum { I_X = 0, I_MEM, I_F1N, I_F1G, I_F1U, I_F1D, I_MIXN, I_WIN, I_CONVW, I_AON, I_CON, I_WOUT, I_XN, I_MEMNRM, I_XQ, I_XKV, I_XO, I_F2N, I_F2G, I_F2U, I_F2D, I_FINAL };

__device__ __forceinline__ void p0_transpose_item(const float* W, int pitch, const float* gain, bf16* WT, int dstK, int dkoff, int drow0, int k0, LAS float* scr, int lane, int f8) {
    float v[32];
    const float* wp = W + (size_t)(k0 + (lane >> 5)) * pitch + (lane & 31);
#pragma unroll
    for (int i = 0; i < 32; ++i) v[i] = wp[(size_t)(2 * i) * pitch];
    const int c = lane & 7;
    f32x4 g0 = (f32x4){1.f, 1.f, 1.f, 1.f}, g1 = g0;
    if (gain) { g0 = *(const GAS f32x4*)(gain + k0 + 8 * c); g1 = *(const GAS f32x4*)(gain + k0 + 8 * c + 4); }
#pragma unroll
    for (int i = 0; i < 32; ++i) scr[(2 * i + (lane >> 5)) * 33 + (lane & 31)] = v[i];
    LDS_WAIT(); asm volatile("" ::: "memory");
#pragma unroll
    for (int j = 0; j < 4; ++j) { const int n = (lane >> 3) + 8 * j; const LAS float* s = scr + (8 * c) * 33 + n;
        const f32x4 x0 = (f32x4){s[0 * 33], s[1 * 33], s[2 * 33], s[3 * 33]} * g0, x1 = (f32x4){s[4 * 33], s[5 * 33], s[6 * 33], s[7 * 33]} * g1;
        if (f8) { const pg8::u32x2 o = pg8::pack8_f8(x0 * 64.0f, x1 * 64.0f); *(GAS v2u*)((unsigned char*)WT + (size_t)(drow0 + n) * dstK + dkoff + k0 + 8 * c) = (v2u){o.x, o.y}; }
        else { v4u o; o.x = pk2(x0[0], x0[1]); o.y = pk2(x0[2], x0[3]); o.z = pk2(x1[0], x1[1]); o.w = pk2(x1[2], x1[3]); *(GAS v4u*)(WT + (size_t)(drow0 + n) * dstK + dkoff + k0 + 8 * c) = o; } }
    LDS_WAIT(); asm volatile("" ::: "memory");
}
__device__ __forceinline__ void p0_prologue(Frame& F_, const Args& a) {
    Frame F = F_; asm volatile("" : "+v"(F.lane));
    LAS float* scr = (LAS float*)(F.lds + RING_OFF + F.wave * 16384);
    const int gw = F.vcu * NWAVES + F.wave, NGW = F.G * NWAVES;
    unsigned char* ws = a.ws;
    constexpr int I_FF = (D / 64) * (FF / 32), I_FD = (FF / 64) * (D / 32), I_IN = (D / 64) * (1024 / 32), I_OUT = (1024 / 64) * (D / 32), I_XQn = (D / 64) * (XW / 32), I_XKVn = (D / 64) * (1024 / 32), I_XOn = (XW / 64) * (D / 32);
    constexpr int NITEMS = 4 * I_FF + 2 * I_FD + 6 * I_IN + 2 * I_OUT + I_XQn + I_XKVn + I_XOn;
    for (int it = gw; it < NITEMS; it += NGW) {
        int r = it; const float* src = nullptr; const float* gain = nullptr; bf16* dst = nullptr; int pitch = 0, ncols = 0, dstK = 0, dkoff = 0, rowoff = 0, mode = 0, f8 = 0; bool hit = false; constexpr int F8Q = (USE_FP8 >> 7) & 1, F8O = (USE_FP8 >> 9) & 1, F8G = (USE_FP8 >> 10) & 1, F8D = (USE_FP8 >> 11) & 1;
#define JOB(cnt, SRC, PITCH, NCOLS, GAIN, DST, DSTK, DKOFF, ROWOFF, MODE, F8J) if (!hit) { if (r < (cnt)) { hit = true; f8 = (F8J); src = (SRC); pitch = (PITCH); ncols = (NCOLS); gain = (GAIN); dst = (bf16*)(ws + (DST)); dstK = (DSTK); dkoff = (DKOFF); rowoff = (ROWOFF); mode = (MODE); } else r -= (cnt); }
        JOB(I_FF, a.in[I_F1G], FF, FF, a.in[I_F1N], WS_WGU1, D, 0, 0, 1, 0)
        JOB(I_FF, a.in[I_F1U], FF, FF, a.in[I_F1N], WS_WGU1, D, 0, 0, 2, 0)
        JOB(I_FD, a.in[I_F1D], D, D, nullptr, WS_WD1, FF, 0, 0, 0, 0)
        JOB(I_FF, a.in[I_F2G], FF, FF, a.in[I_F2N], WS_WGU2, D, 0, 0, 1, F8G)
        JOB(I_FF, a.in[I_F2U], FF, FF, a.in[I_F2N], WS_WGU2, D, 0, 0, 2, F8G)
        JOB(I_FD, a.in[I_F2D], D, D, nullptr, WS_WD2, FF, 0, 0, 0, F8D)
        JOB(I_IN, a.in[I_WIN] + 0, INW, 1024, a.in[I_MIXN], WS_WIN, D, 0, 0, 0, 0)
        JOB(I_IN, a.in[I_WIN] + 1024, INW, 1024, a.in[I_MIXN], WS_WIN, D, 0, 1024, 0, 0)
        JOB(I_IN, a.in[I_WIN] + 2048, INW, 1024, a.in[I_MIXN], WS_WIN, D, 0, 2048, 0, 0)
        JOB(I_IN, a.in[I_WIN] + 3072, INW, 1024, a.in[I_MIXN], WS_WIN, D, 0, 3072, 1, 0)
        JOB(I_IN, a.in[I_WIN] + 5120, INW, 1024, a.in[I_MIXN], WS_WIN, D, 0, 3072, 2, 0)
        JOB(I_IN, a.in[I_WIN] + 4096, INW, 1024, a.in[I_MIXN], WS_WIN, D, 0, 5120, 0, 0)
        JOB(I_OUT, a.in[I_WOUT], D, D, a.in[I_AON], WS_WOUT, D, 0, 0, 0, 0)
        JOB(I_OUT, a.in[I_WOUT] + (size_t)1024 * D, D, D, a.in[I_CON], WS_WOUT, D, 1024, 0, 0, 0)
        JOB(I_XQn, a.in[I_XQ], XW, XW, a.in[I_XN], WS_WQ, D, 0, 0, 0, F8Q)
        JOB(I_XKVn, a.in[I_XKV], 1024, 1024, nullptr, WS_WKV, D, 0, 0, 0, 0)
        JOB(I_XOn, a.in[I_XO], D, D, nullptr, WS_WO, XW, 0, 0, 0, F8O)
#undef JOB
        const int nblk = ncols / 32, kb = r / nblk, nb = r % nblk, k0 = 64 * kb, n0 = 32 * nb;
        const int drow0 = rowoff + (mode ? (n0 >> 7) * 256 + (n0 & 127) + (mode == 2 ? 128 : 0) : n0);
        p0_transpose_item(src + n0, pitch, gain, dst, dstK, dkoff, drow0, k0, scr, F.lane, f8);
    }
    { bf16* HB = (bf16*)(ws + WS_HB); pg8::u64_t* ss0 = (pg8::u64_t*)(ws + WS_CTL + CTL_SS);
      for (int m = gw; m < M; m += NGW) { const GAS f32x4* xr = (const GAS f32x4*)(a.in[I_X] + (size_t)m * D) + F.lane; GAS v2u* o8 = (GAS v2u*)(HB + (size_t)m * D) + F.lane; float s = 0.f;
#pragma unroll
          for (int j = 0; j < 8; ++j) { const f32x4 v = xr[64 * j]; s += (v.x * v.x + v.y * v.y) + (v.z * v.z + v.w * v.w); v2u w; w.x = pk2(v.x, v.y); w.y = pk2(v.z, v.w); o8[64 * j] = w; }
          s = wave_sum(s); if (F.lane == 0) ss0[m] = (pg8::u64_t)(s * 65536.0f + 0.5f); } }
    { bf16* MN = (bf16*)(ws + WS_MEMN); const float* gm = a.in[I_MEMNRM];
      for (int m = gw; m < BATCH * MEML; m += NGW) { const GAS f32x4* xr = (const GAS f32x4*)(a.in[I_MEM] + (size_t)m * D) + F.lane; GAS v2u* o8 = (GAS v2u*)(MN + (size_t)m * D) + F.lane; f32x4 v[8]; float s = 0.f;
#pragma unroll
          for (int j = 0; j < 8; ++j) { v[j] = xr[64 * j]; s += (v[j].x * v[j].x + v[j].y * v[j].y) + (v[j].z * v[j].z + v[j].w * v[j].w); }
          const float rs = rsqrtf(wave_sum(s) * (1.0f / D) + 1e-6f);
#pragma unroll
          for (int j = 0; j < 8; ++j) { const f32x4 g = *((const GAS f32x4*)gm + F.lane + 64 * j); v2u w; w.x = pk2(v[j].x * rs * g.x, v[j].y * rs * g.y); w.y = pk2(v[j].z * rs * g.z, v[j].w * rs * g.w); o8[64 * j] = w; } } }
}
__device__ __forceinline__ void p5_conv(Frame& F_, const Args& a) {
    Frame F = F_; asm volatile("" : "+v"(F.lane));
    const int gw = F.vcu * NWAVES + F.wave, NGW = F.G * NWAVES; unsigned char* ws = a.ws;
    const bf16* CU = (const bf16*)(ws + WS_CU); const bf16* BG = (const bf16*)(ws + WS_BG); bf16* MX = (bf16*)(ws + WS_MIXED); const float* cw = a.in[I_CONVW];
    for (int m = gw; m < M; m += NGW) { const int t = m & (SEQ - 1); float y[16]; float s = 0.f;
#pragma unroll
        for (int gsel = 0; gsel < 2; ++gsel) { const int ch = gsel * 512 + F.lane * 8;
            const v4u c0 = *(const GAS v4u*)(CU + (size_t)m * 1024 + ch); v4u c1 = (v4u){0u, 0u, 0u, 0u}, c2 = (v4u){0u, 0u, 0u, 0u};
            if (t >= 1) c1 = *(const GAS v4u*)(CU + (size_t)(m - 1) * 1024 + ch);
            if (t >= 2) c2 = *(const GAS v4u*)(CU + (size_t)(m - 2) * 1024 + ch);
            const v4u bg = *(const GAS v4u*)(BG + (size_t)m * 1024 + ch);
            const f32x4 w0a = *(const GAS f32x4*)(cw + ch), w0b = *(const GAS f32x4*)(cw + ch + 4), w1a = *(const GAS f32x4*)(cw + 1024 + ch), w1b = *(const GAS f32x4*)(cw + 1024 + ch + 4), w2a = *(const GAS f32x4*)(cw + 2048 + ch), w2b = *(const GAS f32x4*)(cw + 2048 + ch + 4);
#pragma unroll
            for (int e = 0; e < 4; ++e) { const unsigned x0 = c0[e], x1 = c1[e], x2 = c2[e], bw = bg[e];
                const float wl0 = e < 2 ? w0a[2 * e] : w0b[2 * e - 4], wh0 = e < 2 ? w0a[2 * e + 1] : w0b[2 * e - 3];
                const float wl1 = e < 2 ? w1a[2 * e] : w1b[2 * e - 4], wh1 = e < 2 ? w1a[2 * e + 1] : w1b[2 * e - 3];
                const float wl2 = e < 2 ? w2a[2 * e] : w2b[2 * e - 4], wh2 = e < 2 ? w2a[2 * e + 1] : w2b[2 * e - 3];
                const float lo = bflo(bw) * (wl0 * bflo(x2) + wl1 * bflo(x1) + wl2 * bflo(x0)), hi = bfhi(bw) * (wh0 * bfhi(x2) + wh1 * bfhi(x1) + wh2 * bfhi(x0));
                y[gsel * 8 + 2 * e] = lo; y[gsel * 8 + 2 * e + 1] = hi; s += lo * lo + hi * hi; } }
        const float rs = rsqrtf(wave_sum(s) * (1.0f / 1024.0f) + 1e-6f);
#pragma unroll
        for (int gsel = 0; gsel < 2; ++gsel) { v4u o; o.x = pk2(y[gsel * 8 + 0] * rs, y[gsel * 8 + 1] * rs); o.y = pk2(y[gsel * 8 + 2] * rs, y[gsel * 8 + 3] * rs); o.z = pk2(y[gsel * 8 + 4] * rs, y[gsel * 8 + 5] * rs); o.w = pk2(y[gsel * 8 + 6] * rs, y[gsel * 8 + 7] * rs);
            *(GAS v4u*)(MX + (size_t)m * 2048 + 1024 + gsel * 512 + F.lane * 8) = o; } }
}
__device__ __forceinline__ void p12_final(Frame& F_, const Args& a) {
    Frame F = F_; asm volatile("" : "+v"(F.lane));
    const int gw = F.vcu * NWAVES + F.wave, NGW = F.G * NWAVES; const pg8::u64_t* ss4 = (const pg8::u64_t*)(a.ws + WS_CTL + CTL_SS) + 5 * M; const float* gf = a.in[I_FINAL];
    for (int m = gw; m < M; m += NGW) { GAS f32x4* xr = (GAS f32x4*)(a.out + (size_t)m * D) + F.lane; const float rs = rsqrtf(pg8::ss_val(ss4, m) * (1.0f / D) + 1e-6f);
#pragma unroll
        for (int j = 0; j < 8; ++j) { const f32x4 v = xr[64 * j]; const f32x4 g = *((const GAS f32x4*)gf + F.lane + 64 * j); xr[64 * j] = v * g * rs; } }
}

#ifndef DUP_MASK
#define DUP_MASK 0
#endif
#ifndef MOBA_SDEPTH
#define MOBA_SDEPTH 1
#endif
__global__ void __launch_bounds__(NWAVES * 64, 2) fwd_kernel(Args args) {
    extern __shared__ __attribute__((aligned(16))) unsigned char lds[];
    Frame F;
    F.lds = (LAS unsigned char*)lds;
    F.MISC = (volatile LAS unsigned*)(F.lds + MISC_OFF);
    F.tid = threadIdx.x; F.lane = F.tid & 63; F.wave = __builtin_amdgcn_readfirstlane(F.tid >> 6);
    F.G = gridDim.x; { const int bx = blockIdx.x; F.vcu = (F.G % 8 == 0) ? (bx % 8) * (F.G / 8) + bx / 8 : bx; }
    unsigned char* ws = args.ws;
    for (int u = F.tid; u < (LDS_BYTES - LDSCTL_OFF) / 4; u += NWAVES * 64) ((LAS unsigned*)(F.lds + LDSCTL_OFF))[u] = 0u;
    __syncthreads();
    const int lo = args.ph_lo, hi = args.ph_hi; const bool multi = (hi - lo) > 1;
    XcdBarrier bar; bar.bar = (unsigned*)(ws + WS_CTL + CTL_BAR + (size_t)lo * BAR_STRIDE); bar.x = 0; bar.st = nullptr;
    if (multi) bar = xcd_barrier_post((unsigned*)(ws + WS_CTL + CTL_BAR + (size_t)lo * BAR_STRIDE), F.MISC + 8);
#ifndef PH_ENABLE
#define PH_ENABLE 0x1fff
#endif
#define IN(k) ((((PH_ENABLE) >> (k)) & 1) && lo <= (k) && (k) < hi)
#define SEAM(k) do { if (IN(k) && IN((k) + 1)) xcd_barrier(bar); } while (0)
    pg8::u64_t* SS = (pg8::u64_t*)(ws + WS_CTL + CTL_SS);
    float* KMS = (float*)(ws + WS_CTL + CTL_KMS);
    bf16* HB = (bf16*)(ws + WS_HB); bf16* ACT = (bf16*)(ws + WS_ACT); bf16* MIXED = (bf16*)(ws + WS_MIXED);
    bf16* Qb = (bf16*)(ws + WS_Q); bf16* Kb = (bf16*)(ws + WS_K); bf16* Vb = (bf16*)(ws + WS_V); bf16* CUb = (bf16*)(ws + WS_CU); bf16* BGb = (bf16*)(ws + WS_BG);
    bf16* QX = (bf16*)(ws + WS_QX); bf16* OX = (bf16*)(ws + WS_OX); bf16* KVX = (bf16*)(ws + WS_KVX);
    const int bx = (int)blockIdx.x;

#ifndef F8_SP2
#define F8_SP2 PG8_SP2
#endif
#ifndef F8_ALIGN
#define F8_ALIGN PG8_ALIGN
#endif
#define GEMM_RUN(EPI, FP8FLAG, G_, S_, E_) pg8::gemm_phase<EPI, pg8::StaticOrder, (FP8FLAG) ? F8_ALIGN : PG8_ALIGN, (FP8FLAG) ? F8_SP2 : PG8_SP2, FP8FLAG>(F.lds + RING_OFF, G_, S_, E_)
#define DUPQ(k) (((DUP_MASK) >> (k)) & 1)
    pg8::u64_t* DUMMY = (pg8::u64_t*)(ws + WS_DUMMY);
    unsigned char* HB8 = ws + WS_HB8; unsigned char* ACT8 = ws + WS_ACT8; unsigned char* OX8 = ws + WS_OX8;
    constexpr bool F7 = ((USE_FP8 >> 7) & 1) != 0, F9 = ((USE_FP8 >> 9) & 1) != 0, F10 = ((USE_FP8 >> 10) & 1) != 0, F11 = ((USE_FP8 >> 11) & 1) != 0;
    constexpr float WSC = 1.0f / 64.0f;
    if (IN(0)) { p0_prologue(F, args); if (DUPQ(0)) p0_prologue(F, args); } SEAM(0);
    if (IN(1)) { pg8::Gemm g{HB, (const bf16*)(ws + WS_WGU1), M, 2 * FF, D}; pg8::StaticOrder S; S.init(M, 2 * FF, F.G, bx);
        typedef pg8::EpiSwiglu<false> EP; EP E{ACT, nullptr, FF, SS, 1.0f, 1.0f}; GEMM_RUN(EP, false, g, S, E); if (DUPQ(1)) GEMM_RUN(EP, false, g, S, E); } SEAM(1);
    if (IN(2)) { pg8::Gemm g{ACT, (const bf16*)(ws + WS_WD1), M, D, FF}; pg8::StaticOrder S; S.init(M, D, F.G, bx);
        typedef pg8::EpiResid<0, false, false> EP; EP E{args.in[I_X], nullptr, nullptr, HB, SS + M, 0.5f, nullptr, nullptr}; GEMM_RUN(EP, false, g, S, E);
        if (DUPQ(2)) { EP E2{args.in[I_X], nullptr, nullptr, HB, DUMMY, 0.5f, nullptr, nullptr}; GEMM_RUN(EP, false, g, S, E2); } } SEAM(2);
    if (IN(3)) { pg8::Gemm g{HB, (const bf16*)(ws + WS_WIN), M, INW, D}; pg8::StaticOrder S; S.init(M, INW, F.G, bx);
        pg8::EpiWin E{Qb, Kb, Vb, CUb, BGb, KMS, SS + M}; GEMM_RUN(pg8::EpiWin, false, g, S, E);
        if (DUPQ(3)) { pg8::EpiWin E2{Qb, Kb, Vb, CUb, BGb, (float*)DUMMY, SS + M}; GEMM_RUN(pg8::EpiWin, false, g, S, E2); } } SEAM(3);
    if (IN(4)) for (int rep = 0; rep < (DUPQ(4) ? 2 : 1); ++rep) {
        for (int u = F.vcu; u < BATCH * NH * 8; u += F.G) { const int b = u >> 6, h = (u >> 3) & 7, p = u & 7;
#pragma unroll 1
            for (int half = 0; half < 2; ++half) { const int qb = half ? 15 - p : p; const size_t r0 = (size_t)b * SEQ + (size_t)qb * 256;
                att::attn_body<true, 1024, 1024, 2048, MOBA_SDEPTH, bf16>(Qb + r0 * 1024 + h * 128, Kb + (size_t)b * SEQ * 1024 + h * 128, Vb + (size_t)b * SEQ * 1024 + h * 128, MIXED + r0 * 2048 + h * 128,
                                                       256 * (qb + 1), (att::lptr)(F.lds + RING_OFF), qb, KMS + ((size_t)b * 16 * 8 + h) * 128, 8 * 128, (rep ? DUMMY : SS + 2 * M) + r0); } } }
    if (IN(5)) { p5_conv(F, args); if (DUPQ(5)) p5_conv(F, args); } SEAM(5);
    if (IN(6)) { pg8::Gemm g{MIXED, (const bf16*)(ws + WS_WOUT), M, D, D}; pg8::StaticOrder S; S.init(M, D, F.G, bx);
        typedef pg8::EpiResid<16, true, false> EP; EP E{nullptr, HB, nullptr, HB, SS + 3 * M, 1.0f, SS + 2 * M, F7 ? HB8 : nullptr}; GEMM_RUN(EP, false, g, S, E);
        if (DUPQ(6)) { EP E2{nullptr, HB, nullptr, HB, DUMMY, 0.0f, SS + 2 * M, F7 ? HB8 : nullptr}; GEMM_RUN(EP, false, g, S, E2); } } SEAM(6);
    if (IN(7)) for (int rep = 0; rep < (DUPQ(7) ? 2 : 1); ++rep) {
        { pg8::Gemm g{F7 ? (const bf16*)HB8 : HB, (const bf16*)(ws + WS_WQ), M, XW, D}; pg8::StaticOrder S; S.init(M, XW, F.G, bx);
          pg8::EpiScaleBf16 E{QX, XW, SS + 3 * M, F7 ? WSC : 1.0f}; GEMM_RUN(pg8::EpiScaleBf16, F7, g, S, E); }
        { pg8::Gemm g{(const bf16*)(ws + WS_MEMN), (const bf16*)(ws + WS_WKV), BATCH * MEML, 1024, D}; pg8::StaticOrder S; S.init(BATCH * MEML, 1024, F.G, (bx + F.G - 128) % F.G);
          pg8::EpiScaleBf16 E{KVX, 1024, nullptr, 1.0f}; GEMM_RUN(pg8::EpiScaleBf16, false, g, S, E); } } SEAM(7);
    if (IN(8)) for (int rep = 0; rep < (DUPQ(8) ? 2 : 1); ++rep) {
        for (int u = F.vcu; u < BATCH * XH * 16; u += F.G) { const int b = u >> 6, h = (u >> 4) & 3, qb = u & 15; const size_t r0 = (size_t)b * SEQ + (size_t)qb * 256;
            if constexpr (F9) att::attn_body<false, 512, 1024, 512, 2, unsigned char>(QX + r0 * 512 + h * 128, KVX + (size_t)b * MEML * 1024 + h * 128, KVX + (size_t)b * MEML * 1024 + 512 + h * 128, OX8 + r0 * 512 + h * 128,
                                                  MEML, (att::lptr)(F.lds + RING_OFF), 0, nullptr, 0, nullptr);
            else att::attn_body<false, 512, 1024, 512, 2, bf16>(QX + r0 * 512 + h * 128, KVX + (size_t)b * MEML * 1024 + h * 128, KVX + (size_t)b * MEML * 1024 + 512 + h * 128, OX + r0 * 512 + h * 128,
                                                  MEML, (att::lptr)(F.lds + RING_OFF), 0, nullptr, 0, nullptr); } } SEAM(8);
    if (IN(9)) { pg8::Gemm g{F9 ? (const bf16*)OX8 : OX, (const bf16*)(ws + WS_WO), M, D, XW}; pg8::StaticOrder S; S.init(M, D, F.G, bx);
        typedef pg8::EpiResid<0, true, false> EP; EP E{nullptr, HB, nullptr, HB, SS + 4 * M, F9 ? WSC / 16.0f : 1.0f, nullptr, F10 ? HB8 : nullptr}; GEMM_RUN(EP, F9, g, S, E);
        if (DUPQ(9)) { EP E2{nullptr, HB, nullptr, HB, DUMMY, 0.0f, nullptr, F10 ? HB8 : nullptr}; GEMM_RUN(EP, F9, g, S, E2); } } SEAM(9);
    if (IN(10)) { pg8::Gemm g{F10 ? (const bf16*)HB8 : HB, (const bf16*)(ws + WS_WGU2), M, 2 * FF, D}; pg8::StaticOrder S; S.init(M, 2 * FF, F.G, bx);
        typedef pg8::EpiSwiglu<F11> EP; EP E{ACT, ACT8, FF, SS + 4 * M, F10 ? WSC : 1.0f, 4.0f}; GEMM_RUN(EP, F10, g, S, E); if (DUPQ(10)) GEMM_RUN(EP, F10, g, S, E); } SEAM(10);
    if (IN(11)) { pg8::Gemm g{F11 ? (const bf16*)ACT8 : ACT, (const bf16*)(ws + WS_WD2), M, D, FF}; pg8::StaticOrder S; S.init(M, D, F.G, bx);
        typedef pg8::EpiResid<0, true, true> EP; EP E{nullptr, HB, args.out, nullptr, SS + 5 * M, F11 ? 0.5f * WSC / 4.0f : 0.5f, nullptr, nullptr}; GEMM_RUN(EP, F11, g, S, E);
        if (DUPQ(11)) { EP E2{nullptr, HB, args.out, nullptr, DUMMY, F11 ? 0.5f * WSC / 4.0f : 0.5f, nullptr, nullptr}; GEMM_RUN(EP, F11, g, S, E2); } } SEAM(11);
    if (IN(12)) { p12_final(F, args); }
#undef GEMM_RUN
#undef DUPQ
#undef IN
#undef SEAM
}

extern "C" void kernel_launch(void* const* d_in, const int* in_sizes, int n_in, void* d_out, int out_size, void* d_ws, size_t ws_size, hipStream_t stream) {
    static int grid = 0;
    if (grid == 0) {
        if (n_in != 22 || in_sizes[0] != M * D || out_size != M * D || ws_size < WS_END) { fprintf(stderr, "kernel_launch: shape mismatch (n_in %d, in0 %d, out %d, ws %zu; need ws >= %zu); nothing launched\n", n_in, n_in > 0 ? in_sizes[0] : -1, out_size, ws_size, (size_t)WS_END); grid = -1; return; }
        int dev = 0, cus = 0, per_cu = 0;
        if (hipGetDevice(&dev) != hipSuccess || hipDeviceGetAttribute(&cus, hipDeviceAttributeMultiprocessorCount, dev) != hipSuccess) { grid = -1; return; }
        if (hipFuncSetAttribute((const void*)fwd_kernel, hipFuncAttributeMaxDynamicSharedMemorySize, LDS_BYTES) != hipSuccess) { fprintf(stderr, "kernel_launch: hipFuncSetAttribute failed\n"); grid = -1; return; }
        if (hipOccupancyMaxActiveBlocksPerMultiprocessor(&per_cu, (const void*)fwd_kernel, NWAVES * 64, LDS_BYTES) != hipSuccess || per_cu < 1) { fprintf(stderr, "kernel_launch: occupancy query reports %d workgroups per CU\n", per_cu); }
        (void)hipGetLastError();
        grid = cus;
    }
    if (grid < 0) return;
    if (hipMemsetAsync((char*)d_ws + WS_CTL, 0, CTL_ZERO_BYTES, stream) != hipSuccess) { fprintf(stderr, "kernel_launch: hipMemsetAsync failed\n"); return; }
    Args a{};
    for (int i = 0; i < 22; ++i) a.in[i] = (const float*)d_in[i];
    a.out = (float*)d_out; a.ws = (unsigned char*)d_ws;
    unsigned char* ws = (unsigned char*)d_ws; pg8::u64_t* SS = (pg8::u64_t*)(ws + WS_CTL + CTL_SS); float* KMS = (float*)(ws + WS_CTL + CTL_KMS); float* out = (float*)d_out;
    bf16* HB = (bf16*)(ws + WS_HB); bf16* ACT = (bf16*)(ws + WS_ACT); bf16* MIXED = (bf16*)(ws + WS_MIXED);
    bf16* Qb = (bf16*)(ws + WS_Q); bf16* Kb = (bf16*)(ws + WS_K); bf16* Vb = (bf16*)(ws + WS_V); bf16* CUb = (bf16*)(ws + WS_CU); bf16* BGb = (bf16*)(ws + WS_BG);
    bf16* QX = (bf16*)(ws + WS_QX); bf16* OX = (bf16*)(ws + WS_OX); bf16* KVX = (bf16*)(ws + WS_KVX);
    (void)SS; (void)KMS; (void)out; (void)HB; (void)ACT; (void)MIXED; (void)Qb; (void)Kb; (void)Vb; (void)CUb; (void)BGb; (void)QX; (void)OX; (void)KVX;
#if ONE_LAUNCH
    a.ph_lo = 0; a.ph_hi = NPH;
    hipLaunchKernelGGL(fwd_kernel, dim3(grid), dim3(NWAVES * 64), LDS_BYTES, stream, a);
#else
    for (int ph = 0; ph < NPH; ++ph) {
        if ((FAST_MASK >> ph) & 1) { a.ph_lo = ph; a.ph_hi = ph + 1; hipLaunchKernelGGL(fwd_kernel, dim3(grid), dim3(NWAVES * 64), LDS_BYTES, stream, a); continue; }
        switch (ph) {
        case 1: hipLaunchKernelGGL((nv::gemm<nv::FSwiglu>), dim3(FF / 64, M / 64), dim3(256), 0, stream, HB, (const bf16*)(ws + WS_WGU1), D, nv::FSwiglu{ACT, SS}); break;
        case 2: hipLaunchKernelGGL((nv::gemm<nv::FResid<0, false, false>>), dim3(D / 64, M / 64), dim3(256), 0, stream, ACT, (const bf16*)(ws + WS_WD1), FF, nv::FResid<0, false, false>{a.in[I_X], nullptr, nullptr, HB, SS + M, 0.5f, nullptr}); break;
        case 3: hipLaunchKernelGGL((nv::gemm<nv::FWin>), dim3(5120 / 64, M / 64), dim3(256), 0, stream, HB, (const bf16*)(ws + WS_WIN), D, nv::FWin{Qb, Kb, Vb, CUb, BGb, SS + M});
                hipLaunchKernelGGL(nv::kmean, dim3(BATCH * 16 * 8 * 128 / 256), dim3(256), 0, stream, Kb, KMS); break;
        case 4: hipLaunchKernelGGL(nv::moba, dim3(M * NH / 4), dim3(256), 0, stream, Qb, Kb, Vb, KMS, MIXED, SS + 2 * M); break;
        case 6: hipLaunchKernelGGL((nv::gemm<nv::FResid<1024, true, false>>), dim3(D / 64, M / 64), dim3(256), 0, stream, MIXED, (const bf16*)(ws + WS_WOUT), D, nv::FResid<1024, true, false>{nullptr, HB, nullptr, HB, SS + 3 * M, 1.0f, SS + 2 * M}); break;
        case 7: hipLaunchKernelGGL((nv::gemm<nv::FScale>), dim3(XW / 64, M / 64), dim3(256), 0, stream, HB, (const bf16*)(ws + WS_WQ), D, nv::FScale{QX, XW, SS + 3 * M});
                hipLaunchKernelGGL((nv::gemm<nv::FScale>), dim3(1024 / 64, BATCH * MEML / 64), dim3(256), 0, stream, (const bf16*)(ws + WS_MEMN), (const bf16*)(ws + WS_WKV), D, nv::FScale{KVX, 1024, nullptr}); break;
        case 8: hipLaunchKernelGGL(nv::xattn, dim3(M * XH / 4), dim3(256), 0, stream, QX, KVX, OX); break;
        case 9: hipLaunchKernelGGL((nv::gemm<nv::FResid<0, true, false>>), dim3(D / 64, M / 64), dim3(256), 0, stream, OX, (const bf16*)(ws + WS_WO), XW, nv::FResid<0, true, false>{nullptr, HB, nullptr, HB, SS + 4 * M, 1.0f, nullptr}); break;
        case 10: hipLaunchKernelGGL((nv::gemm<nv::FSwiglu>), dim3(FF / 64, M / 64), dim3(256), 0, stream, HB, (const bf16*)(ws + WS_WGU2), D, nv::FSwiglu{ACT, SS + 4 * M}); break;
        case 11: hipLaunchKernelGGL((nv::gemm<nv::FResid<0, true, true>>), dim3(D / 64, M / 64), dim3(256), 0, stream, ACT, (const bf16*)(ws + WS_WD2), FF, nv::FResid<0, true, true>{nullptr, HB, out, nullptr, SS + 5 * M, 0.5f, nullptr}); break;
        default: break;
        }
    }
#endif
    const hipError_t le = hipPeekAtLastError();
    if (le != hipSuccess) fprintf(stderr, "kernel_launch: launch failed: %s\n", hipGetErrorName(le));
}
```

```cpp
#define ONE_LAUNCH 1
#define FAST_MASK 0x1fff
#define USE_FP8 0xEC0
#include <hip/hip_runtime.h>
#include <cstdio>
#include <cstdint>
namespace pg8 {
#define PG8_LAS __attribute__((address_space(3)))
typedef unsigned short bf16_t;
typedef short bf16x8 __attribute__((ext_vector_type(8)));
typedef float f32x4 __attribute__((ext_vector_type(4)));
typedef unsigned u32x4 __attribute__((ext_vector_type(4)));
typedef int i32x4 __attribute__((ext_vector_type(4)));
typedef int i32x8 __attribute__((ext_vector_type(8)));
typedef unsigned u32x2 __attribute__((ext_vector_type(2)));
constexpr int BM = 256, BK = 64, HALF = 128, HTB = HALF * BK * 2  , STAGE_BYTES = 8 * HTB, NXCD = 8, WGM = 8;

__host__ __device__ __forceinline__ int lds_byte(int r, int c) { const int st = (r >> 4) * 2 + (c >> 5), rr = r & 15, cc = c & 31, ob = rr * 64 + cc * 2; return st * 1024 + (ob ^ (((ob >> 9) & 1) << 5)); }
__host__ __device__ __forceinline__ void stage_rc(int b, int& R, int& C) { const int st = b / 1024, sb = b % 1024, swz = sb ^ (((sb >> 9) & 1) << 5); R = (st >> 1) * 16 + swz / 64; C = (st & 1) * 32 + (swz % 64) / 2; }
__host__ __device__ __forceinline__ int perm32(int rho) { const int n = rho >> 4, i = rho & 15; return 8 * (i >> 2) + 4 * n + (i & 3); }

struct Unit { int pm, pn; };
struct Gemm { const bf16_t* A; const bf16_t* Bt; int M, N, K; };

struct StaticOrder {
    int nM, nN, nwg, G, c;
    __host__ __device__ void init(int M, int N, int G_, int c_) { nM = M / BM; nN = N / BM; nwg = nM * nN; G = G_; c = c_; }
    __host__ __device__ bool next(int i, Unit& u) const {
        const long L = (long)i * G + c; if (L >= nwg) return false;
        int wgid = (int)L; { const int q = nwg / NXCD, r = nwg % NXCD, xcd = wgid % NXCD, off = wgid / NXCD; wgid = (xcd < r ? xcd * (q + 1) : r * (q + 1) + (xcd - r) * q) + off; }
        const int nig = WGM * nN, gid = wgid / nig, fm = gid * WGM, gsz = (nM - fm) < WGM ? (nM - fm) : WGM;
        u.pm = fm + ((wgid % nig) % gsz); u.pn = (wgid % nig) / gsz; return true;
    }
    __device__ __forceinline__ void a_ready(const Unit&) const {}
    __device__ __forceinline__ void done(const Unit&) const {}
};

__device__ __forceinline__ unsigned cvt_pk_bf16(float lo, float hi) { unsigned r; asm volatile("v_cvt_pk_bf16_f32 %0, %1, %2" : "=v"(r) : "v"(lo), "v"(hi)); return r; }
__device__ __forceinline__ u32x4 pack8(const f32x4 v0, const f32x4 v1) { u32x4 w; w.x = cvt_pk_bf16(v0[0], v0[1]); w.y = cvt_pk_bf16(v0[2], v0[3]); w.z = cvt_pk_bf16(v1[0], v1[1]); w.w = cvt_pk_bf16(v1[2], v1[3]); return w; }
constexpr float RMS_EPS = 1e-6f;
typedef unsigned long long u64_t;
__device__ __forceinline__ float ss_val(const u64_t* ss, int row) { return (float)ss[row] * (1.0f / 65536.0f); }
__device__ __forceinline__ void ss_add(u64_t* ss, int row, float sq) { atomicAdd(ss + row, (u64_t)(unsigned)(sq * 65536.0f + 0.5f)); }
__device__ __forceinline__ float clamp_f8(float x) { return __builtin_amdgcn_fmed3f(x, -448.0f, 448.0f); }
__device__ __forceinline__ u32x2 pack8_f8(const f32x4 v0, const f32x4 v1) { int a = __builtin_amdgcn_cvt_pk_fp8_f32(clamp_f8(v0[0]), clamp_f8(v0[1]), 0, false); a = __builtin_amdgcn_cvt_pk_fp8_f32(clamp_f8(v0[2]), clamp_f8(v0[3]), a, true);
    int b = __builtin_amdgcn_cvt_pk_fp8_f32(clamp_f8(v1[0]), clamp_f8(v1[1]), 0, false); b = __builtin_amdgcn_cvt_pk_fp8_f32(clamp_f8(v1[2]), clamp_f8(v1[3]), b, true); u32x2 w; w.x = (unsigned)a; w.y = (unsigned)b; return w; }
__device__ __forceinline__ float silu_mul(float g, float u) { return g * u * __builtin_amdgcn_rcpf(1.0f + __builtin_amdgcn_exp2f(-1.4426950408889634f * g)); }

template <bool F8OUT> struct EpiSwiglu {
    static constexpr bool PERM = true, AFTER_DRAIN = false; static constexpr int MIDT = 0;
    bf16_t* O; unsigned char* O8; int ldo; const u64_t* ss; float asc, osc;
    __device__ __forceinline__ void mid(f32x4 (&)[2][2][4][2], const Unit&, int, int) const {}
    __device__ __forceinline__ void operator()(const f32x4 (&acc)[2][2][4][2], const Unit& u, int wr, int wc, int fr_, int fq_) const {
        int fr = fr_, fq = fq_; asm volatile("" : "+v"(fr), "+v"(fq));
        const int row0 = u.pm * BM + wr * 64 + fr, col0 = u.pn * HALF + wc * 32 + 8 * fq;
#pragma unroll
        for (int ai = 0; ai < 2; ++ai)
#pragma unroll
            for (int m = 0; m < 4; ++m) { const int row = row0 + ai * HALF + m * 16; const float rs = asc * rsqrtf(ss_val(ss, row) * (1.0f / 2048.0f) + RMS_EPS);
                f32x4 o0, o1;
#pragma unroll
                for (int j = 0; j < 4; ++j) { o0[j] = silu_mul(acc[ai][0][m][0][j] * rs, acc[ai][1][m][0][j] * rs); o1[j] = silu_mul(acc[ai][0][m][1][j] * rs, acc[ai][1][m][1][j] * rs); }
                if constexpr (F8OUT) *(u32x2*)(O8 + (size_t)row * ldo + col0) = pack8_f8(o0 * osc, o1 * osc);
                else *(u32x4*)(O + (size_t)row * ldo + col0) = pack8(o0, o1); }
    }
};
template <int MIDT_, bool RBF, bool OF32> struct EpiResid {
    static constexpr bool PERM = true, AFTER_DRAIN = false; static constexpr int MIDT = MIDT_;
    const float* R; const bf16_t* RB; float* H; bf16_t* HB; u64_t* ssn; float alpha; const u64_t* midss; unsigned char* HB8; float midmul;
    __device__ __forceinline__ void mid(f32x4 (&acc)[2][2][4][2], const Unit& u, int wr, int fr) const {
        const int row0 = u.pm * BM + wr * 64 + fr;
#pragma unroll
        for (int ai = 0; ai < 2; ++ai)
#pragma unroll
            for (int m = 0; m < 4; ++m) { const float s = midmul * rsqrtf(ss_val(midss, row0 + ai * HALF + m * 16) * (1.0f / 1024.0f) + RMS_EPS);
#pragma unroll
                for (int bj = 0; bj < 2; ++bj)
#pragma unroll
                    for (int n = 0; n < 2; ++n) acc[ai][bj][m][n] = acc[ai][bj][m][n] * s; }
    }
    __device__ __forceinline__ void operator()(const f32x4 (&acc)[2][2][4][2], const Unit& u, int wr, int wc, int fr_, int fq_) const {
        int fr = fr_, fq = fq_; asm volatile("" : "+v"(fr), "+v"(fq));
        const int row0 = u.pm * BM + wr * 64 + fr, col0 = u.pn * BM + wc * 32 + 8 * fq;
#pragma unroll
        for (int ai = 0; ai < 2; ++ai)
#pragma unroll
            for (int m = 0; m < 4; ++m) { const int row = row0 + ai * HALF + m * 16; const size_t off = (size_t)row * 2048 + col0; float sq = 0.f;
#pragma unroll
                for (int bj = 0; bj < 2; ++bj) { f32x4 r0, r1;
                    if constexpr (RBF) { const u32x4 w = *(const u32x4*)(RB + off + bj * HALF);
                        r0 = (f32x4){__uint_as_float(w.x << 16), __uint_as_float(w.x & 0xffff0000u), __uint_as_float(w.y << 16), __uint_as_float(w.y & 0xffff0000u)};
                        r1 = (f32x4){__uint_as_float(w.z << 16), __uint_as_float(w.z & 0xffff0000u), __uint_as_float(w.w << 16), __uint_as_float(w.w & 0xffff0000u)}; }
                    else { r0 = *(const f32x4*)(R + off + bj * HALF); r1 = *(const f32x4*)(R + off + bj * HALF + 4); }
                    const f32x4 h0 = r0 + acc[ai][bj][m][0] * alpha, h1 = r1 + acc[ai][bj][m][1] * alpha;
                    if constexpr (OF32) { *(f32x4*)(H + off + bj * HALF) = h0; *(f32x4*)(H + off + bj * HALF + 4) = h1; }
                    else { *(u32x4*)(HB + off + bj * HALF) = pack8(h0, h1); if (HB8) *(u32x2*)(HB8 + off + bj * HALF) = pack8_f8(h0, h1); }
                    sq += (h0[0] * h0[0] + h0[1] * h0[1]) + (h0[2] * h0[2] + h0[3] * h0[3]) + (h1[0] * h1[0] + h1[1] * h1[1]) + (h1[2] * h1[2] + h1[3] * h1[3]); }
                sq += __shfl_xor(sq, 16); sq += __shfl_xor(sq, 32);
                if (fq == 0) ss_add(ssn, row, sq);
                asm volatile("" ::: "memory"); }
    }
};
struct EpiWin {
    static constexpr bool PERM = true, AFTER_DRAIN = false; static constexpr int MIDT = 0;
    bf16_t *Q, *K, *V, *CU, *BG; float* kms; const u64_t* ss;
    __device__ __forceinline__ void mid(f32x4 (&)[2][2][4][2], const Unit&, int, int) const {}
    __device__ __forceinline__ void operator()(const f32x4 (&acc)[2][2][4][2], const Unit& u, int wr, int wc, int fr_, int fq_) const {
        int fr = fr_, fq = fq_; asm volatile("" : "+v"(fr), "+v"(fq));
        const int row0 = u.pm * BM + wr * 64 + fr, pn = u.pn;
        if (pn >= 12 && pn < 20) {
            const int col0 = (pn - 12) * HALF + wc * 32 + 8 * fq;
#pragma unroll
            for (int ai = 0; ai < 2; ++ai)
#pragma unroll
                for (int m = 0; m < 4; ++m) { const int row = row0 + ai * HALF + m * 16; float rs = rsqrtf(ss_val(ss, row) * (1.0f / 2048.0f) + RMS_EPS); rs = rs * rs;
                    const f32x4 o0 = acc[ai][0][m][0] * acc[ai][1][m][0] * rs, o1 = acc[ai][0][m][1] * acc[ai][1][m][1] * rs;
                    *(u32x4*)(CU + (size_t)row * 1024 + col0) = pack8(o0, o1); }
        } else {
            bf16_t* base = pn < 4 ? Q : pn < 8 ? K : pn < 12 ? V : BG; const int colt = (pn & 3) * BM, col0 = colt + wc * 32 + 8 * fq; const bool isk = (pn >= 4 && pn < 8);
            float rsv[2][4];
#pragma unroll
            for (int ai = 0; ai < 2; ++ai)
#pragma unroll
                for (int m = 0; m < 4; ++m) rsv[ai][m] = rsqrtf(ss_val(ss, row0 + ai * HALF + m * 16) * (1.0f / 2048.0f) + RMS_EPS);
#pragma unroll
            for (int ai = 0; ai < 2; ++ai)
#pragma unroll
                for (int m = 0; m < 4; ++m) { const int row = row0 + ai * HALF + m * 16;
#pragma unroll
                    for (int bj = 0; bj < 2; ++bj) *(u32x4*)(base + (size_t)row * 1024 + col0 + bj * HALF) = pack8(acc[ai][bj][m][0] * rsv[ai][m], acc[ai][bj][m][1] * rsv[ai][m]); }
            if (isk) {
#pragma unroll
                for (int bj = 0; bj < 2; ++bj)
#pragma unroll
                    for (int n = 0; n < 2; ++n) { f32x4 c = (f32x4){0.f, 0.f, 0.f, 0.f};
#pragma unroll
                        for (int ai = 0; ai < 2; ++ai)
#pragma unroll
                            for (int m = 0; m < 4; ++m) { float r2 = rsv[ai][m]; asm volatile("" : "+v"(r2)); c += acc[ai][bj][m][n] * r2; }
#pragma unroll
                        for (int j = 0; j < 4; ++j) { float v = c[j]; v += __shfl_xor(v, 1); v += __shfl_xor(v, 2); v += __shfl_xor(v, 4); v += __shfl_xor(v, 8);
                            const int col = col0 + bj * HALF + 4 * n + j;
                            if (fr == 0) unsafeAtomicAdd(kms + ((size_t)u.pm * 8 + (col >> 7)) * 128 + (col & 127), v); }
                        asm volatile("" ::: "memory"); }
            }
        }
    }
};
struct EpiScaleBf16 {
    static constexpr bool PERM = true, AFTER_DRAIN = false; static constexpr int MIDT = 0;
    bf16_t* O; int ldo; const u64_t* ss; float asc;
    __device__ __forceinline__ void mid(f32x4 (&)[2][2][4][2], const Unit&, int, int) const {}
    __device__ __forceinline__ void operator()(const f32x4 (&acc)[2][2][4][2], const Unit& u, int wr, int wc, int fr_, int fq_) const {
        int fr = fr_, fq = fq_; asm volatile("" : "+v"(fr), "+v"(fq));
        const int row0 = u.pm * BM + wr * 64 + fr, col0 = u.pn * BM + wc * 32 + 8 * fq;
#pragma unroll
        for (int ai = 0; ai < 2; ++ai)
#pragma unroll
            for (int m = 0; m < 4; ++m) { const int row = row0 + ai * HALF + m * 16; const float rs = asc * (ss ? rsqrtf(ss_val(ss, row) * (1.0f / 2048.0f) + RMS_EPS) : 1.0f);
#pragma unroll
                for (int bj = 0; bj < 2; ++bj) *(u32x4*)(O + (size_t)row * ldo + col0 + bj * HALF) = pack8(acc[ai][bj][m][0] * rs, acc[ai][bj][m][1] * rs); }
    }
};

template <class Epi, class Sched, bool ALIGN_EPI = false, bool SP2 = false, bool FP8 = false>
__device__ __forceinline__ void gemm_phase(PG8_LAS unsigned char* lds, const Gemm g, const Sched& S, const Epi& E) {
    int tid_ = threadIdx.x; asm volatile("" : "+v"(tid_));
    const int tid = tid_, wid = __builtin_amdgcn_readfirstlane(tid >> 6), lane = tid & 63, wr = wid >> 2, wc = wid & 3, fr = lane & 15, fq = lane >> 4;
    const int KB = FP8 ? g.K : g.K * 2, nt = KB / (BK * 2);
    unsigned voffA[2], voffB[2];
#pragma unroll
    for (int i = 0; i < 2; ++i) { int R, C; stage_rc(tid * 16 + i * 8192, R, C); const int Rb = Epi::PERM ? ((R & ~31) + perm32(R & 31)) : R;
        voffA[i] = (unsigned)(R * KB + C * 2); voffB[i] = (unsigned)(Rb * KB + C * 2); }
    const size_t kstep = (size_t)(BK * 2);
    const size_t hstep = (size_t)HALF * KB;
    const size_t tstep = 2 * hstep;
    const unsigned ldsw = (unsigned)wid * 1024u;
    const int aoff = lds_byte(wr * 64 + fr, fq * 8), boff = lds_byte(wc * 32 + fr, fq * 8);
#define PG8_SA(b, h) (((b) * 2 + (h)) * HTB)
#define PG8_SB(b, h) ((4 + (b) * 2 + (h)) * HTB)
#define PG8_STAGE(bufoff, gbase, voff) do { _Pragma("unroll") for (int _i = 0; _i < 2; ++_i) \
        __builtin_amdgcn_global_load_lds((const unsigned*)((const char*)(gbase) + (voff)[_i]), (PG8_LAS unsigned*)(lds + (bufoff) + ldsw + _i * 8192), 16, 0, 0); } while (0)
#define PG8_LDA(dst, b, h) do { _Pragma("unroll") for (int m = 0; m < 4; ++m) _Pragma("unroll") for (int k = 0; k < 2; ++k) dst[m][k] = *(const PG8_LAS bf16x8*)(lds + PG8_SA(b, h) + aoff + m * 2048 + k * 1024); } while (0)
#define PG8_LDB(dst, b, h) do { _Pragma("unroll") for (int n = 0; n < 2; ++n) _Pragma("unroll") for (int k = 0; k < 2; ++k) dst[n][k] = *(const PG8_LAS bf16x8*)(lds + PG8_SB(b, h) + boff + n * 2048 + k * 1024); } while (0)
#define PG8_CAT(x) __builtin_shufflevector(__builtin_bit_cast(i32x4, (x)[0]), __builtin_bit_cast(i32x4, (x)[1]), 0, 1, 2, 3, 4, 5, 6, 7)
#define PG8_MMA(ai, bj, At, Bt) do { __builtin_amdgcn_s_setprio(1); _Pragma("unroll") for (int m = 0; m < 4; ++m) _Pragma("unroll") for (int n = 0; n < 2; ++n) { \
        if constexpr (FP8) { const i32x8 b8_ = PG8_CAT(Bt[n]), a8_ = PG8_CAT(At[m]); asm volatile("v_mfma_f32_16x16x128_f8f6f4 %0, %1, %2, %0" : "+v"(acc[ai][bj][m][n]) : "v"(b8_), "v"(a8_)); }   \
        else { _Pragma("unroll") for (int k = 0; k < 2; ++k) acc[ai][bj][m][n] = __builtin_amdgcn_mfma_f32_16x16x32_bf16(Bt[n][k], At[m][k], acc[ai][bj][m][n], 0, 0, 0); } } __builtin_amdgcn_s_setprio(0); } while (0)
#define PG8_WAIT_V(n) asm volatile("s_waitcnt vmcnt(" #n ")" ::: "memory")
#define PG8_WAIT_L(n) asm volatile("s_waitcnt lgkmcnt(" #n ")" ::: "memory")
#define PG8_BAR __builtin_amdgcn_s_barrier()
#define PG8_SCHED __builtin_amdgcn_sched_barrier(0)
    Unit cur, nxt; int ui = 0;
    if (!S.next(0, cur)) return;
    f32x4 acc[2][2][4][2];
#pragma unroll
    for (int a = 0; a < 2; ++a)
#pragma unroll
        for (int b = 0; b < 2; ++b)
#pragma unroll
            for (int m = 0; m < 4; ++m)
#pragma unroll
                for (int n = 0; n < 2; ++n) acc[a][b][m][n] = (f32x4){0.f, 0.f, 0.f, 0.f};
    bf16x8 At[4][2], B0[2][2], B1[2][2];
    const char* cA = (const char*)g.A + (size_t)cur.pm * tstep; const char* cB = (const char*)g.Bt + (size_t)cur.pn * tstep;
    S.a_ready(cur);
    if constexpr (SP2) {
        PG8_STAGE(PG8_SB(0, 0), cB, voffB); PG8_STAGE(PG8_SB(0, 1), cB + hstep, voffB); PG8_STAGE(PG8_SA(0, 0), cA, voffA); PG8_STAGE(PG8_SA(0, 1), cA + hstep, voffA);
        if (wr == 1) PG8_BAR;
        PG8_WAIT_V(2); PG8_BAR;
        PG8_STAGE(PG8_SB(1, 0), cB + kstep, voffB); PG8_STAGE(PG8_SA(1, 0), cA + kstep, voffA); PG8_STAGE(PG8_SB(1, 1), cB + hstep + kstep, voffB);
        PG8_WAIT_V(6); PG8_BAR;
    } else {
        PG8_STAGE(PG8_SB(0, 0), cB, voffB); PG8_STAGE(PG8_SA(0, 0), cA, voffA); PG8_STAGE(PG8_SB(0, 1), cB + hstep, voffB); PG8_STAGE(PG8_SA(0, 1), cA + hstep, voffA);
        if (wr == 1) PG8_BAR;
        PG8_WAIT_V(4); PG8_BAR;
        PG8_STAGE(PG8_SB(1, 0), cB + kstep, voffB); PG8_STAGE(PG8_SA(1, 0), cA + kstep, voffA); PG8_STAGE(PG8_SB(1, 1), cB + hstep + kstep, voffB);
        PG8_WAIT_V(6); PG8_BAR;
    }
    for (;;) {
        const bool has_next = S.next(ui + 1, nxt);
        const char* nA = has_next ? (const char*)g.A + (size_t)nxt.pm * tstep : cA; const char* nB = has_next ? (const char*)g.Bt + (size_t)nxt.pn * tstep : cB;
        for (int t = 0; t < nt; t += 2) {
            if constexpr (Epi::MIDT > 0) { if (t == Epi::MIDT) {
                if constexpr (FP8) { asm volatile("s_nop 15\n\ts_nop 15" ::: "memory");
#pragma unroll
                    for (int a = 0; a < 2; ++a)
#pragma unroll
                        for (int b = 0; b < 2; ++b)
#pragma unroll
                            for (int m = 0; m < 4; ++m)
#pragma unroll
                                for (int n = 0; n < 2; ++n) asm volatile("" : "+v"(acc[a][b][m][n])); }
                E.mid(acc, cur, wr, fr); } }
            const bool last = (t == nt - 2);
            const char* a1 = cA + (size_t)(t + 1) * kstep;
            const char* a2 = last ? nA : cA + (size_t)(t + 2) * kstep; const char* b2 = last ? nB : cB + (size_t)(t + 2) * kstep;
            const char* a3 = a2 + kstep; const char* b3 = b2 + kstep;
            if (last && has_next) S.a_ready(nxt);
            if constexpr (SP2) {
            PG8_LDB(B0, 0, 0); PG8_LDB(B1, 0, 1); PG8_SCHED; PG8_LDA(At, 0, 0); PG8_STAGE(PG8_SA(1, 1), a1 + hstep, voffA);
            PG8_WAIT_V(8); PG8_WAIT_L(0); PG8_BAR; PG8_MMA(0, 0, At, B0); PG8_MMA(0, 1, At, B1); PG8_BAR; PG8_SCHED;
            PG8_LDA(At, 0, 1); PG8_STAGE(PG8_SB(0, 0), b2, voffB); PG8_STAGE(PG8_SB(0, 1), b2 + hstep, voffB); PG8_STAGE(PG8_SA(0, 0), a2, voffA);
            PG8_WAIT_V(8); PG8_WAIT_L(0); PG8_BAR; PG8_MMA(1, 0, At, B0); PG8_MMA(1, 1, At, B1); PG8_BAR; PG8_SCHED;
            PG8_LDB(B0, 1, 0); PG8_LDB(B1, 1, 1); PG8_SCHED; PG8_LDA(At, 1, 0); PG8_STAGE(PG8_SA(0, 1), a2 + hstep, voffA);
            PG8_WAIT_V(8); PG8_WAIT_L(0); PG8_BAR; PG8_MMA(0, 0, At, B0); PG8_MMA(0, 1, At, B1); PG8_BAR; PG8_SCHED;
            PG8_LDA(At, 1, 1); PG8_STAGE(PG8_SB(1, 0), b3, voffB); PG8_STAGE(PG8_SB(1, 1), b3 + hstep, voffB); PG8_STAGE(PG8_SA(1, 0), a3, voffA);
            PG8_WAIT_V(8); PG8_WAIT_L(0); PG8_BAR; PG8_MMA(1, 0, At, B0); PG8_MMA(1, 1, At, B1); PG8_BAR; PG8_SCHED;
            } else {
            PG8_LDB(B0, 0, 0); PG8_SCHED; PG8_LDA(At, 0, 0); PG8_STAGE(PG8_SA(1, 1), a1 + hstep, voffA);
            PG8_WAIT_L(8); PG8_BAR; PG8_WAIT_L(0); PG8_MMA(0, 0, At, B0); PG8_BAR; PG8_SCHED;
            PG8_LDB(B1, 0, 1); PG8_STAGE(PG8_SB(0, 0), b2, voffB);
            PG8_BAR; PG8_WAIT_L(0); PG8_MMA(0, 1, At, B1); PG8_BAR;
            PG8_LDA(At, 0, 1); PG8_STAGE(PG8_SA(0, 0), a2, voffA);
            PG8_BAR; PG8_WAIT_L(0); PG8_MMA(1, 0, At, B0); PG8_BAR; PG8_SCHED;
            PG8_STAGE(PG8_SB(0, 1), b2 + hstep, voffB);
            PG8_WAIT_V(6); PG8_BAR; PG8_MMA(1, 1, At, B1); PG8_BAR;
            PG8_LDB(B0, 1, 0); PG8_SCHED; PG8_LDA(At, 1, 0); PG8_STAGE(PG8_SA(0, 1), a2 + hstep, voffA);
            PG8_WAIT_L(8); PG8_BAR; PG8_WAIT_L(0); PG8_MMA(0, 0, At, B0); PG8_BAR; PG8_SCHED;
            PG8_LDB(B1, 1, 1); PG8_STAGE(PG8_SB(1, 0), b3, voffB);
            PG8_BAR; PG8_WAIT_L(0); PG8_MMA(0, 1, At, B1); PG8_BAR;
            PG8_LDA(At, 1, 1); PG8_STAGE(PG8_SA(1, 0), a3, voffA);
            PG8_BAR; PG8_WAIT_L(0); PG8_MMA(1, 0, At, B0); PG8_BAR; PG8_SCHED;
            PG8_STAGE(PG8_SB(1, 1), b3 + hstep, voffB);
            PG8_WAIT_V(6); PG8_BAR; PG8_MMA(1, 1, At, B1); PG8_BAR;
            }
        }
        if constexpr (FP8) {
            asm volatile("s_nop 15\n\ts_nop 15" ::: "memory");
#pragma unroll
            for (int a = 0; a < 2; ++a)
#pragma unroll
                for (int b = 0; b < 2; ++b)
#pragma unroll
                    for (int m = 0; m < 4; ++m)
#pragma unroll
                        for (int n = 0; n < 2; ++n) asm volatile("" : "+v"(acc[a][b][m][n]));
        }
        if constexpr (ALIGN_EPI) { if (wr == 0) PG8_BAR; }
        if constexpr (!Epi::AFTER_DRAIN) { E(acc, cur, wr, wc, fr, fq); S.done(cur); }
        if (!has_next) break;
#pragma unroll
        for (int a = 0; a < 2; ++a)
#pragma unroll
            for (int b = 0; b < 2; ++b)
#pragma unroll
                for (int m = 0; m < 4; ++m)
#pragma unroll
                    for (int n = 0; n < 2; ++n) acc[a][b][m][n] = (f32x4){0.f, 0.f, 0.f, 0.f};
        cur = nxt; cA = nA; cB = nB; ++ui;
        if constexpr (ALIGN_EPI) { if (wr == 1) PG8_BAR; }
    }
    PG8_WAIT_V(0);
    if constexpr (!ALIGN_EPI) { if (wr == 0) PG8_BAR; }
    PG8_BAR;
    if constexpr (Epi::AFTER_DRAIN) { E.fused(acc, cur, wr, wc, fr, fq, lds, wid, lane); S.done(cur); }
#undef PG8_SA
#undef PG8_SB
#undef PG8_STAGE
#undef PG8_LDA
#undef PG8_LDB
#undef PG8_MMA
#undef PG8_CAT
#undef PG8_WAIT_V
#undef PG8_WAIT_L
#undef PG8_BAR
#undef PG8_SCHED
}
}

#define PG8_SP2 true
#define PG8_ALIGN true
namespace att {
typedef unsigned short bf16;
using bf16x8 = __attribute__((ext_vector_type(8))) short;
using s16x4  = __attribute__((ext_vector_type(4))) short;
using f32x16 = __attribute__((ext_vector_type(16))) float;
using u32x4  = __attribute__((ext_vector_type(4))) unsigned;
#define ATT_LAS __attribute__((address_space(3)))
typedef ATT_LAS char* lptr;
constexpr int   D = 128, NW = 8, QBLK = 32, KVBLK = 64;
constexpr float SCALE = 0.088388347648318440f;
constexpr float THR = 8.f;
constexpr int SHM_V = KVBLK * D * 2, SHM_K = KVBLK * D * 2, SHM_ATTN = 2 * SHM_V + 2 * SHM_K + NW * 64 * 4;
#define KSWZ(row, colB) ((row) * 256 + ((colB) ^ (((row) & 7) << 4)))
#define SBAR() __builtin_amdgcn_sched_barrier(0)
__device__ __forceinline__ int crow(int r, int hi) { return (r & 3) + 8 * (r >> 2) + 4 * hi; }
__device__ __forceinline__ unsigned cvtpk(float lo, float hi) { unsigned r; asm volatile("v_cvt_pk_bf16_f32 %0, %1, %2" : "=v"(r) : "v"(lo), "v"(hi)); return r; }
__device__ __forceinline__ void partialSM(f32x16& p0, f32x16& p1, float& m_reg, float& mn, float& alpha) {
  constexpr float C = SCALE * 1.4426950408889634f;
  float pmax = p0[0];
#pragma unroll
  for (int r = 1; r < 16; ++r) pmax = fmaxf(pmax, p0[r]);
#pragma unroll
  for (int r = 0; r < 16; ++r) pmax = fmaxf(pmax, p1[r]);
  { auto rr = __builtin_amdgcn_permlane32_swap(__float_as_uint(pmax), __float_as_uint(pmax), false, false);
    pmax = fmaxf(__uint_as_float(rr[0]), __uint_as_float(rr[1])); }
  if (__builtin_expect(__all(pmax - m_reg <= THR / SCALE), 1)) { mn = m_reg; alpha = 1.f; }
  else { mn = fmaxf(m_reg, pmax); alpha = __builtin_amdgcn_exp2f((m_reg - mn) * C); m_reg = mn; }
  float mnC = -mn * C;
#pragma unroll
  for (int r = 0; r < 16; ++r) p0[r] = fmaf(p0[r], C, mnC);
#pragma unroll
  for (int r = 0; r < 16; ++r) p1[r] = fmaf(p1[r], C, mnC);
#pragma unroll
  for (int r = 0; r < 16; ++r) p0[r] = __builtin_amdgcn_exp2f(p0[r]);
}
__device__ __forceinline__ void finishSM(f32x16& p0, f32x16& p1, float alpha, float& l_reg, bf16x8& pa0, bf16x8& pa1, bf16x8& pa2, bf16x8& pa3) {
#pragma unroll
  for (int r = 0; r < 16; ++r) p1[r] = __builtin_amdgcn_exp2f(p1[r]);
  float ps = 0;
#pragma unroll
  for (int r = 0; r < 16; ++r) ps += p0[r];
#pragma unroll
  for (int r = 0; r < 16; ++r) ps += p1[r];
  { auto rr = __builtin_amdgcn_permlane32_swap(__float_as_uint(ps), __float_as_uint(ps), false, false);
    ps = __uint_as_float(rr[0]) + __uint_as_float(rr[1]); }
  l_reg = l_reg * alpha + ps;
#define PK4(P, BASE, OUT) do { unsigned a0 = cvtpk(P[BASE + 0], P[BASE + 1]), a1 = cvtpk(P[BASE + 2], P[BASE + 3]);   \
    unsigned b0 = cvtpk(P[BASE + 4], P[BASE + 5]), b1 = cvtpk(P[BASE + 6], P[BASE + 7]);                              \
    auto r0 = __builtin_amdgcn_permlane32_swap(a0, b0, false, false); auto r1 = __builtin_amdgcn_permlane32_swap(a1, b1, false, false); \
    u32x4 w = {r0[0], r1[0], r0[1], r1[1]}; OUT = *reinterpret_cast<bf16x8*>(&w); } while (0)
  PK4(p0, 0, pa0); PK4(p0, 8, pa1); PK4(p1, 0, pa2); PK4(p1, 8, pa3);
#undef PK4
}
__device__ __forceinline__ void qkt(f32x16& p0, f32x16& p1, lptr Ks, const bf16x8* qr, int r32, int hi) {
  p0 = f32x16{}; p1 = f32x16{};
#pragma unroll
  for (int d0 = 0; d0 < 8; ++d0) { int cb = (d0 * 16 + hi * 8) * 2;
    bf16x8 b0 = *reinterpret_cast<const ATT_LAS bf16x8*>(Ks + KSWZ(r32, cb));
    bf16x8 b1 = *reinterpret_cast<const ATT_LAS bf16x8*>(Ks + KSWZ(32 + r32, cb));
    p0 = __builtin_amdgcn_mfma_f32_32x32x16_bf16(b0, qr[d0], p0, 0, 0, 0);
    p1 = __builtin_amdgcn_mfma_f32_32x32x16_bf16(b1, qr[d0], p1, 0, 0, 0); }
}
__device__ __forceinline__ int v_st(int k, int c) { const int kk = (k & ~0xC) | ((k & 4) << 1) | ((k & 8) >> 1); return ((kk >> 3) * 4 + (c >> 5)) * 512 + ((kk & 7) * 32 + (c & 31)) * 2; }
__device__ __forceinline__ int v_rd_base(int lane) { return ((lane & 3) << 3) | (((lane >> 2) & 3) << 6) | (((lane >> 4) & 1) << 5) | (((lane >> 5) & 1) << 8); }
constexpr int v_rd_off(int d0, int ks, int half) { return d0 * 512 + ks * 4096 + half * 2048; }
template <int OFF> __device__ __forceinline__ s16x4 tr_read(int vb) {
  s16x4 r; asm volatile("ds_read_b64_tr_b16 %0, %1 offset:%2" : "=&v"(r) : "v"(vb), "i"(OFF) : "memory"); return r;
}
template <int D0> __device__ __forceinline__ void pv_one(f32x16& od, int vb, bf16x8 pa0, bf16x8 pa1, bf16x8 pa2, bf16x8 pa3) {
  const s16x4 l0 = tr_read<v_rd_off(D0, 0, 0)>(vb), h0 = tr_read<v_rd_off(D0, 0, 1)>(vb), l1 = tr_read<v_rd_off(D0, 1, 0)>(vb), h1 = tr_read<v_rd_off(D0, 1, 1)>(vb);
  const s16x4 l2 = tr_read<v_rd_off(D0, 2, 0)>(vb), h2 = tr_read<v_rd_off(D0, 2, 1)>(vb), l3 = tr_read<v_rd_off(D0, 3, 0)>(vb), h3 = tr_read<v_rd_off(D0, 3, 1)>(vb);
  asm volatile("s_waitcnt lgkmcnt(0)" ::: "memory"); SBAR();
#define PK(L, H) (bf16x8){L[0], L[1], L[2], L[3], H[0], H[1], H[2], H[3]}
  od = __builtin_amdgcn_mfma_f32_32x32x16_bf16(pa0, PK(l0, h0), od, 0, 0, 0);
  od = __builtin_amdgcn_mfma_f32_32x32x16_bf16(pa1, PK(l1, h1), od, 0, 0, 0);
  od = __builtin_amdgcn_mfma_f32_32x32x16_bf16(pa2, PK(l2, h2), od, 0, 0, 0);
  od = __builtin_amdgcn_mfma_f32_32x32x16_bf16(pa3, PK(l3, h3), od, 0, 0, 0);
#undef PK
}
__device__ __forceinline__ void pv_d0(f32x16* o, int vb, bf16x8 pa0, bf16x8 pa1, bf16x8 pa2, bf16x8 pa3) {
  pv_one<0>(o[0], vb, pa0, pa1, pa2, pa3); pv_one<1>(o[1], vb, pa0, pa1, pa2, pa3); pv_one<2>(o[2], vb, pa0, pa1, pa2, pa3); pv_one<3>(o[3], vb, pa0, pa1, pa2, pa3);
}
__device__ __forceinline__ void moba_mask(f32x16& p0, f32x16& p1, int tile, int qb, unsigned sel, int qi, int w0, int hi) {
  const float NINF = -__builtin_inff();
  const int jb = tile >> 2;
  if (jb < qb) {
    const bool ok = ((sel >> jb) & 1u) != 0u;
    if (!__all(ok)) {
#pragma unroll
      for (int r = 0; r < 16; ++r) { p0[r] = ok ? p0[r] : NINF; p1[r] = ok ? p1[r] : NINF; }
    }
  } else {
    const int k0 = (tile & 3) * 64;
    if (k0 + 63 > w0) {
      int lim = qi - k0 - 4 * hi; asm volatile("" : "+v"(lim));
#pragma unroll
      for (int r = 0; r < 16; ++r) { const int kc = (r & 3) + 8 * (r >> 2); p0[r] = (kc <= lim) ? p0[r] : NINF; p1[r] = (kc + 32 <= lim) ? p1[r] : NINF; }
    }
  }
}

template <bool MOBA, int LDQ, int LDK, int LDO, int SDEPTH, typename TO, int OSC>
__device__ __forceinline__ void attn_body(const bf16* __restrict__ Qb, const bf16* __restrict__ Kh, const bf16* __restrict__ Vh, TO* __restrict__ Ob, int seq, lptr lds,
                                          int qb, const float* __restrict__ kms, int kms_stride, unsigned long long* __restrict__ ssq) {
  int tid_ = threadIdx.x; asm volatile("" : "+v"(tid_));
  const int tid = tid_, wid = tid >> 6, lane = tid & 63, r32 = lane & 31, hi = lane >> 5;
  lptr V_lds = lds; lptr K_lds = lds + 2 * SHM_V;
  ATT_LAS float* ws = (ATT_LAS float*)(lds + 2 * SHM_V + 2 * SHM_K) + wid * 64; ATT_LAS float* li_l = ws; ATT_LAS float* al_l = ws + 32;
  float m_reg = -1e30f, l_reg = 0; f32x16 o[4] = {}; bf16x8 qr[8];
  unsigned qoff = (unsigned)((wid * QBLK + r32) * LDQ + hi * 8); asm volatile("" : "+v"(qoff));
  const bf16* Qw = Qb + qoff;
#pragma unroll
  for (int d0 = 0; d0 < 8; ++d0) qr[d0] = *reinterpret_cast<const bf16x8*>(Qw + d0 * 16);
  const int sr = tid >> 4, sc = (tid & 15) * 8, vst0 = v_st(sr, sc), vst1 = v_st(32 + sr, sc);
  const int vb0 = (int)(uintptr_t)V_lds + v_rd_base(lane);
  struct { bf16x8 vs0, vs1, ks0, ks1; } sr_[SDEPTH];
  const unsigned so0 = (unsigned)(sr * LDK + sc), so1 = (unsigned)((32 + sr) * LDK + sc);
#define SLOAD(i, k0) do { const bf16* Vt_ = Vh + (long)(k0) * LDK; const bf16* Kt_ = Kh + (long)(k0) * LDK; \
    sr_[i].vs0 = *reinterpret_cast<const bf16x8*>(Vt_ + so0); sr_[i].vs1 = *reinterpret_cast<const bf16x8*>(Vt_ + so1); \
    sr_[i].ks0 = *reinterpret_cast<const bf16x8*>(Kt_ + so0); sr_[i].ks1 = *reinterpret_cast<const bf16x8*>(Kt_ + so1); } while (0)
#define SWRITE(b, i) do { *(ATT_LAS bf16x8*)(V_lds + (b) * SHM_V + vst0) = sr_[i].vs0;          \
    *(ATT_LAS bf16x8*)(V_lds + (b) * SHM_V + vst1) = sr_[i].vs1; int kc = sc * 2;               \
    *(ATT_LAS bf16x8*)(K_lds + (b) * SHM_K + KSWZ(sr, kc)) = sr_[i].ks0;                       \
    *(ATT_LAS bf16x8*)(K_lds + (b) * SHM_K + KSWZ(32 + sr, kc)) = sr_[i].ks1; } while (0)
#define SWAIT() do { if constexpr (SDEPTH == 2) asm volatile("s_waitcnt vmcnt(4)" ::: "memory"); else asm volatile("s_waitcnt vmcnt(0)" ::: "memory"); } while (0)
#define RESC(a) do { if (__any((a) < 1.f)) { if (hi == 0) al_l[r32] = (a); asm volatile("s_waitcnt lgkmcnt(0)" ::: "memory"); \
    _Pragma("unroll") for (int d = 0; d < 4; ++d) _Pragma("unroll") for (int r = 0; r < 16; ++r) o[d][r] *= al_l[crow(r, hi)]; } } while (0)
  f32x16 pA0, pA1, pB0, pB1; float mnA, mnB, alA, alB; bf16x8 pa0, pa1, pa2, pa3; const int NT = seq / KVBLK;
  constexpr int SE = 0, SO = SDEPTH - 1;
  unsigned sel = 0u; const int qi = wid * QBLK + r32, w0 = wid * QBLK;
  SLOAD(SE, 0);
  if constexpr (MOBA) {
    { const int j = sr & 15; const float* src = kms + (size_t)j * kms_stride + sc; const float4 x0 = *reinterpret_cast<const float4*>(src), x1 = *reinterpret_cast<const float4*>(src + 4);
      const float xv[8] = {x0.x, x0.y, x0.z, x0.w, x1.x, x1.y, x1.z, x1.w}; unsigned w[4];
#pragma unroll
      for (int e = 0; e < 4; ++e) { const unsigned h2 = cvtpk(xv[2 * e], xv[2 * e + 1]); const float f0 = __uint_as_float(h2 << 16), f1 = __uint_as_float(h2 & 0xffff0000u);
        const unsigned l2 = cvtpk(xv[2 * e] - f0, xv[2 * e + 1] - f1); w[e] = (sr < 16) ? h2 : l2; }
      u32x4 wv = {w[0], w[1], w[2], w[3]}; *(ATT_LAS u32x4*)(K_lds + KSWZ(sr, sc * 2)) = wv; }
    __syncthreads();
    f32x16 g = f32x16{};
#pragma unroll
    for (int d0 = 0; d0 < 8; ++d0) { const int cb = (d0 * 16 + hi * 8) * 2; const bf16x8 b0 = *reinterpret_cast<const ATT_LAS bf16x8*>(K_lds + KSWZ(r32, cb));
      g = __builtin_amdgcn_mfma_f32_32x32x16_bf16(b0, qr[d0], g, 0, 0, 0); }
    float G[16];
#pragma unroll
    for (int r = 0; r < 8; ++r) { const float own = g[r] + g[r + 8]; const float oth = __shfl_xor(own, 32); const int lb = (r & 3) + 8 * (r >> 2);
      G[lb] = hi ? oth : own; G[lb + 4] = hi ? own : oth; }
    const float NINF = -__builtin_inff();
#pragma unroll
    for (int j = 0; j < 16; ++j) G[j] = (j < qb) ? G[j] : NINF;
#pragma unroll
    for (int it = 0; it < 3; ++it) { float mx = NINF; int mi = -1;
#pragma unroll
      for (int j = 0; j < 16; ++j) { const bool gt = G[j] > mx; mx = gt ? G[j] : mx; mi = gt ? j : mi; }
      if (mi >= 0) sel |= 1u << mi;
#pragma unroll
      for (int j = 0; j < 16; ++j) G[j] = (j == mi) ? NINF : G[j]; }
    __syncthreads();
  }
  asm volatile("s_waitcnt vmcnt(0)" ::: "memory"); SWRITE(0, SE); __syncthreads();
  qkt(pA0, pA1, K_lds, qr, r32, hi);
  if constexpr (MOBA) moba_mask(pA0, pA1, 0, qb, sel, qi, w0, hi);
  partialSM(pA0, pA1, m_reg, mnA, alA);
  SLOAD(SO, KVBLK); if constexpr (SDEPTH == 2) { if (2 < NT) SLOAD(SE, 2 * KVBLK); }
  SWAIT(); SWRITE(1, SO); __syncthreads();
  for (int j = 1; j + 1 < NT; j += 2) {
    SBAR(); qkt(pB0, pB1, K_lds + SHM_K, qr, r32, hi);
    finishSM(pA0, pA1, alA, l_reg, pa0, pa1, pa2, pa3); SBAR();
    SLOAD(SO, (j + SDEPTH) * KVBLK); SBAR();
    pv_d0(o, vb0, pa0, pa1, pa2, pa3);
    if constexpr (MOBA) moba_mask(pB0, pB1, j, qb, sel, qi, w0, hi);
    partialSM(pB0, pB1, m_reg, mnB, alB);
    __syncthreads(); SWAIT(); SWRITE(0, SE);
    RESC(alB); __syncthreads();
    SBAR(); qkt(pA0, pA1, K_lds, qr, r32, hi);
    finishSM(pB0, pB1, alB, l_reg, pa0, pa1, pa2, pa3); SBAR();
    if (SDEPTH == 1 || j + 3 < NT) SLOAD(SE, (j + 1 + SDEPTH) * KVBLK); SBAR();
    pv_d0(o, vb0 + SHM_V, pa0, pa1, pa2, pa3);
    if constexpr (MOBA) moba_mask(pA0, pA1, j + 1, qb, sel, qi, w0, hi);
    partialSM(pA0, pA1, m_reg, mnA, alA);
    __syncthreads(); SWAIT(); SWRITE(1, SO);
    RESC(alA); __syncthreads();
  }
  SBAR(); qkt(pB0, pB1, K_lds + SHM_K, qr, r32, hi);
  finishSM(pA0, pA1, alA, l_reg, pa0, pa1, pa2, pa3); SBAR();
  pv_d0(o, vb0, pa0, pa1, pa2, pa3);
  if constexpr (MOBA) moba_mask(pB0, pB1, NT - 1, qb, sel, qi, w0, hi);
  partialSM(pB0, pB1, m_reg, mnB, alB);
  __syncthreads(); RESC(alB);
  finishSM(pB0, pB1, alB, l_reg, pa0, pa1, pa2, pa3); SBAR();
  pv_d0(o, vb0 + SHM_V, pa0, pa1, pa2, pa3);
  if (hi == 0) li_l[r32] = l_reg; asm volatile("s_waitcnt lgkmcnt(0)" ::: "memory");
  float rli[16];
#pragma unroll
  for (int r = 0; r < 16; ++r) rli[r] = __builtin_amdgcn_rcpf(li_l[crow(r, hi)]);
  int ohi = hi * 4, ocol = r32; asm volatile("" : "+v"(ohi), "+v"(ocol));
  TO* Ow = Ob + (long)(wid * QBLK) * LDO;
#pragma unroll
  for (int r = 0; r < 16; ++r) { const int orow = (r & 3) + 8 * (r >> 2) + ohi; float sq = 0.f;
#pragma unroll
    for (int d0 = 0; d0 < 4; ++d0) { const float v = o[d0][r] * rli[r]; sq += v * v; if constexpr (sizeof(TO) == 2) Ow[(unsigned)(orow * LDO + d0 * 32 + ocol)] = (TO)(cvtpk(v, v) & 0xffffu);
      else Ow[(unsigned)(orow * LDO + d0 * 32 + ocol)] = (TO)(__builtin_amdgcn_cvt_pk_fp8_f32(__builtin_amdgcn_fmed3f(v * (float)OSC, -448.0f, 448.0f), 0.0f, 0, false) & 0xff); }
    if constexpr (MOBA) { sq += __shfl_xor(sq, 1); sq += __shfl_xor(sq, 2); sq += __shfl_xor(sq, 4); sq += __shfl_xor(sq, 8); sq += __shfl_xor(sq, 16);
      if (ocol == 0) pg8::ss_add(ssq, wid * QBLK + orow, sq); } }
  __syncthreads();
#undef SLOAD
#undef SWRITE
#undef SWAIT
#undef RESC
}
#undef KSWZ
#undef SBAR
}

constexpr int NWAVES = 8;
constexpr int BATCH = 4, SEQ = 4096, D = 2048, M = BATCH * SEQ, FF = 5632, AW = 1024, CW = 1024, INW = 6144, MEML = 256, XW = 512, NH = 8, XH = 4, NBLK = 16;
constexpr int NPH = 13;
#ifndef FAST_MASK
#define FAST_MASK 0x1fff
#endif
#ifndef ONE_LAUNCH
#define ONE_LAUNCH 1
#endif
constexpr size_t MiB = 1u << 20, KiB = 1u << 10;
constexpr size_t WS_CTL = 0, CTL_ZERO_BYTES = 1536 * KiB;
constexpr size_t CTL_BAR = 64 * KiB, BAR_STRIDE = 16 * KiB;
constexpr size_t CTL_SS = 320 * KiB;
constexpr size_t CTL_KMS = 1088 * KiB;
constexpr size_t WS_WGU1 = 2 * MiB, WS_WD1 = 46 * MiB, WS_WGU2 = 68 * MiB, WS_WD2 = 112 * MiB, WS_WIN = 134 * MiB, WS_WOUT = 158 * MiB, WS_WQ = 166 * MiB, WS_WKV = 168 * MiB, WS_WO = 172 * MiB;
constexpr size_t WS_MEMN = 174 * MiB, WS_KVX = 178 * MiB, WS_HB = 180 * MiB, WS_MIXED = 244 * MiB, WS_ACT = 308 * MiB;
constexpr size_t WS_Q = 308 * MiB, WS_K = 340 * MiB, WS_V = 372 * MiB, WS_CU = 404 * MiB, WS_BG = 436 * MiB;
constexpr size_t WS_QX = 308 * MiB, WS_OX = 324 * MiB;
constexpr size_t WS_HB8 = 340 * MiB, WS_ACT8 = 396 * MiB, WS_OX8 = 324 * MiB;
constexpr size_t WS_DUMMY = 484 * MiB;
constexpr size_t WS_END = 486 * MiB;
static_assert(WS_ACT + (size_t)M * FF * 2 <= WS_END && WS_BG + (size_t)M * 1024 * 2 <= WS_END && CTL_KMS + BATCH * 16 * 8 * 128 * 4 <= CTL_ZERO_BYTES && CTL_SS + 6 * M * 8 <= CTL_KMS && CTL_ZERO_BYTES <= WS_WGU1, "d_ws map");
constexpr int RING_OFF = 0, RING_BYTES = 131072;
constexpr int LDSCTL_OFF = RING_BYTES, MISC_OFF = LDSCTL_OFF + 320;
constexpr int LDS_BYTES = 147456;
static_assert(MISC_OFF + 128 <= LDS_BYTES && att::SHM_ATTN <= RING_BYTES, "LDS map");

#define GAS __attribute__((address_space(1)))
#define LAS __attribute__((address_space(3)))
typedef unsigned short bf16;
typedef unsigned v4u __attribute__((ext_vector_type(4)));
typedef unsigned v2u __attribute__((ext_vector_type(2)));
typedef float f32x4 __attribute__((ext_vector_type(4)));
typedef short bf16x8 __attribute__((ext_vector_type(8)));
typedef GAS unsigned gu32;
#define RLX_AGENT __ATOMIC_RELAXED, __HIP_MEMORY_SCOPE_AGENT
#define LDS_WAIT() asm volatile("s_waitcnt lgkmcnt(0)" ::: "memory")
#define VM_WAIT() asm volatile("s_waitcnt vmcnt(0)" ::: "memory")
__device__ __forceinline__ unsigned pk2(float lo, float hi) { return pg8::cvt_pk_bf16(lo, hi); }
__device__ __forceinline__ float bflo(unsigned w) { return __uint_as_float(w << 16); }
__device__ __forceinline__ float bfhi(unsigned w) { return __uint_as_float(w & 0xffff0000u); }
__device__ __forceinline__ float wave_sum(float v) {
#pragma unroll
    for (int o = 1; o < 64; o <<= 1) v += __shfl_xor(v, o);
    return v;
}
#define XB_TMO      128
#define XB_XCNT(j)  (256  + 64 * (j))
#define XB_XSUB(j)  (1280 + 64 * (j))
#define XB_XGEN(j)  (2304 + 64 * (j))
#define XB_TOP      3328
#define XB_TOPGEN   3392
#define XCD_BAR_WORDS 3456
#define XB_SPIN_CAP (1u << 18)

__device__ __forceinline__ unsigned xb_ld(unsigned* p)              { return __hip_atomic_load(p, __ATOMIC_RELAXED, __HIP_MEMORY_SCOPE_AGENT); }
__device__ __forceinline__ unsigned xb_add(unsigned* p, unsigned v) { return __hip_atomic_fetch_add(p, v, __ATOMIC_RELAXED, __HIP_MEMORY_SCOPE_AGENT); }
__device__ __forceinline__ unsigned xb_xcc_id() { return (unsigned)__builtin_amdgcn_s_getreg((3 << 11) | 20) & 0xFu; }
#define XB_SPIN(cond, bar) do { unsigned _sp = 0; while (cond) { __builtin_amdgcn_s_sleep(1); \
    if ((++_sp & 255u) == 0u) { if (xb_ld(&(bar)[XB_TMO])) break; if (_sp > XB_SPIN_CAP) { atomicAdd(&(bar)[XB_TMO], 1u); break; } } } } while (0)

struct XcdBarrier {
    unsigned* bar; unsigned x;
    volatile LAS unsigned* st;
};

__device__ __forceinline__ XcdBarrier xcd_barrier_post(unsigned* bar, volatile LAS unsigned* st) {
    XcdBarrier b; b.bar = bar; b.x = xb_xcc_id(); b.st = st;
    if (threadIdx.x == 0) (void)xb_add(&bar[XB_XCNT(b.x)], 1u);
    return b;
}
__device__ __forceinline__ void xcd_barrier_complete(unsigned* bar, unsigned x, unsigned& nloc, unsigned& nx) {
    const unsigned G = gridDim.x * gridDim.y * gridDim.z;
    unsigned sum, cnt, mine, sp = 0u;
    for (;;) {
        sum = 0u; cnt = 0u; mine = 0u;
#pragma unroll
        for (unsigned j = 0; j < 16; ++j) { const unsigned c = xb_ld(&bar[XB_XCNT(j)]); sum += c; cnt += (c > 0u) ? 1u : 0u; mine = (j == x) ? c : mine; }
        if (sum == G) break;
        __builtin_amdgcn_s_sleep(1);
        if ((++sp & 255u) == 0u) { if (xb_ld(&bar[XB_TMO])) break; if (sp > XB_SPIN_CAP) { atomicAdd(&bar[XB_TMO], 1u); break; } }
    }
    nloc = mine > 0u ? mine : 1u; nx = cnt > 0u ? cnt : 1u;
}

__device__ __forceinline__ void xcd_barrier(const XcdBarrier& b) {
    asm volatile("s_waitcnt vmcnt(0)" ::: "memory");
    __syncthreads();
    if (threadIdx.x == 0) {
        unsigned* bar = b.bar;
        __builtin_amdgcn_s_waitcnt(0);
        unsigned nloc = b.st[0], nx = b.st[1];
        if (nloc == 0u) { xcd_barrier_complete(bar, b.x, nloc, nx); b.st[0] = nloc; b.st[1] = nx; }
        const unsigned old = xb_add(&bar[XB_XSUB(b.x)], 1u);
        const unsigned gen = old / nloc;
        if (old + 1u == (gen + 1u) * nloc) {
            __builtin_amdgcn_fence(__ATOMIC_RELEASE, "agent");
            asm volatile("s_waitcnt vmcnt(0)" ::: "memory");
            const unsigned og = xb_add(&bar[XB_TOP], 1u);
            const unsigned tg = og / nx;
            if (og + 1u == (tg + 1u) * nx) xb_add(&bar[XB_TOPGEN], 1u);
            else XB_SPIN(xb_ld(&bar[XB_TOPGEN]) == tg, bar);
            __builtin_amdgcn_fence(__ATOMIC_ACQUIRE, "agent");
            xb_add(&bar[XB_XGEN(b.x)], 1u);
            asm volatile("s_waitcnt vmcnt(0)" ::: "memory");
        } else {
            XB_SPIN(xb_ld(&bar[XB_XGEN(b.x)]) == gen, bar);
            __builtin_amdgcn_fence(__ATOMIC_ACQUIRE, "agent");
            asm volatile("s_waitcnt vmcnt(0)" ::: "memory");
        }
    }
    __syncthreads();
}

namespace nv {
typedef float f32x4 __attribute__((ext_vector_type(4)));
typedef short bf16x8 __attribute__((ext_vector_type(8)));
constexpr float EPS = 1e-6f;
template <class F> __global__ __launch_bounds__(256) void gemm(const bf16* __restrict__ A, const bf16* __restrict__ Bt, int K, F f) {
    const int wave = threadIdx.x >> 6, lane = threadIdx.x & 63;
    const int row0 = blockIdx.y * 64 + wave * 16, col0 = blockIdx.x * 64;
    f32x4 acc[4], acc2[4];
#pragma unroll
    for (int c = 0; c < 4; ++c) { acc[c] = (f32x4){0.f, 0.f, 0.f, 0.f}; acc2[c] = (f32x4){0.f, 0.f, 0.f, 0.f}; }
    const bf16* ap = A + (size_t)(row0 + (lane & 15)) * K + 8 * (lane >> 4);
    const bf16* bp[4]; const bf16* bp2[4];
#pragma unroll
    for (int c = 0; c < 4; ++c) { const int col = col0 + 16 * c + (lane & 15); bp[c] = Bt + (size_t)f.brow(col) * K + 8 * (lane >> 4); bp2[c] = Bt + (size_t)f.brow2(col) * K + 8 * (lane >> 4); }
    for (int k0 = 0; k0 < K; k0 += 32) {
        if (F::MIDK > 0 && k0 == F::MIDK) {
#pragma unroll
            for (int j = 0; j < 4; ++j) { const float s = f.midscale(row0 + (lane >> 4) * 4 + j);
#pragma unroll
                for (int c = 0; c < 4; ++c) acc[c][j] *= s; }
        }
        const bf16x8 a = *(const bf16x8*)(ap + k0);
#pragma unroll
        for (int c = 0; c < 4; ++c) { const bf16x8 b = *(const bf16x8*)(bp[c] + k0); acc[c] = __builtin_amdgcn_mfma_f32_16x16x32_bf16(a, b, acc[c], 0, 0, 0);
            if (F::DUAL) { const bf16x8 b2 = *(const bf16x8*)(bp2[c] + k0); acc2[c] = __builtin_amdgcn_mfma_f32_16x16x32_bf16(a, b2, acc2[c], 0, 0, 0); } }
    }
#pragma unroll
    for (int j = 0; j < 4; ++j) { const int row = row0 + (lane >> 4) * 4 + j; float sq = 0.f;
#pragma unroll
        for (int c = 0; c < 4; ++c) { const float h = f.store(row, col0 + 16 * c + (lane & 15), acc[c][j], acc2[c][j]); sq += h * h; }
        if (F::ROWSS) { sq += __shfl_xor(sq, 1); sq += __shfl_xor(sq, 2); sq += __shfl_xor(sq, 4); sq += __shfl_xor(sq, 8); if ((lane & 15) == 0) f.addss(row, sq); } }
}
__device__ __forceinline__ bf16 tobf(float v) { return (bf16)(pg8::cvt_pk_bf16(v, v) & 0xffffu); }
struct FSwiglu { static constexpr bool DUAL = true, ROWSS = false; static constexpr int MIDK = 0; bf16* O; const pg8::u64_t* ss;
    __device__ int brow(int col) const { return (col >> 7) * 256 + (col & 127); } __device__ int brow2(int col) const { return brow(col) + 128; } __device__ float midscale(int) const { return 1.f; } __device__ void addss(int, float) const {}
    __device__ float store(int row, int col, float a, float a2) const { const float rs = rsqrtf(pg8::ss_val(ss, row) * (1.0f / 2048.0f) + EPS), g = a * rs, u = a2 * rs; O[(size_t)row * FF + col] = tobf(g / (1.0f + __expf(-g)) * u); return 0.f; } };
template <int MIDK_, bool RBF, bool OF32> struct FResid { static constexpr bool DUAL = false, ROWSS = true; static constexpr int MIDK = MIDK_; const float* R; const bf16* RB; float* H; bf16* HB; pg8::u64_t* ssn; float alpha; const pg8::u64_t* midss;
    __device__ int brow(int col) const { return col; } __device__ int brow2(int col) const { return col; } __device__ float midscale(int row) const { return rsqrtf(pg8::ss_val(midss, row) * (1.0f / 1024.0f) + EPS); }
    __device__ void addss(int row, float s) const { pg8::ss_add(ssn, row, s); }
    __device__ float store(int row, int col, float a, float) const { const size_t o = (size_t)row * 2048 + col; const float r = RBF ? __uint_as_float((unsigned)RB[o] << 16) : R[o]; const float h = r + alpha * a; if (OF32) H[o] = h; else HB[o] = tobf(h); return h; } };
struct FWin { static constexpr bool DUAL = true, ROWSS = false; static constexpr int MIDK = 0; bf16 *Q, *K, *V, *CU, *BG; const pg8::u64_t* ss;
    __device__ int brow(int col) const { if (col < 3072) return col; if (col < 4096) { const int j = col - 3072; return 3072 + (j >> 7) * 256 + (j & 127); } return 5120 + (col - 4096); }
    __device__ int brow2(int col) const { return (col >= 3072 && col < 4096) ? brow(col) + 128 : brow(col); } __device__ float midscale(int) const { return 1.f; } __device__ void addss(int, float) const {}
    __device__ float store(int row, int col, float a, float a2) const { const float rs = rsqrtf(pg8::ss_val(ss, row) * (1.0f / 2048.0f) + EPS); const size_t o = (size_t)row * 1024 + (col & 1023);
        if (col < 1024) Q[o] = tobf(a * rs); else if (col < 2048) K[o] = tobf(a * rs); else if (col < 3072) V[o] = tobf(a * rs); else if (col < 4096) CU[o] = tobf((a * rs) * (a2 * rs)); else BG[o] = tobf(a * rs); return 0.f; } };
struct FScale { static constexpr bool DUAL = false, ROWSS = false; static constexpr int MIDK = 0; bf16* O; int ldo; const pg8::u64_t* ss;
    __device__ int brow(int col) const { return col; } __device__ int brow2(int col) const { return col; } __device__ float midscale(int) const { return 1.f; } __device__ void addss(int, float) const {}
    __device__ float store(int row, int col, float a, float) const { const float rs = ss ? rsqrtf(pg8::ss_val(ss, row) * (1.0f / 2048.0f) + EPS) : 1.0f; O[(size_t)row * ldo + col] = tobf(a * rs); return 0.f; } };
__global__ __launch_bounds__(256) void kmean(const bf16* __restrict__ K, float* __restrict__ kms) {
    const int i = blockIdx.x * 256 + threadIdx.x; const int d = i & 127, h = (i >> 7) & 7, bb = i >> 10;
    float s = 0.f; for (int r = 0; r < 256; ++r) s += __uint_as_float((unsigned)K[((size_t)bb * 256 + r) * 1024 + h * 128 + d] << 16);
    kms[i] = s;
}
__global__ __launch_bounds__(256) void moba(const bf16* __restrict__ Q, const bf16* __restrict__ K, const bf16* __restrict__ V, const float* __restrict__ kms, bf16* __restrict__ AO, pg8::u64_t* __restrict__ ssA) {
    const int wave = threadIdx.x >> 6, lane = threadIdx.x & 63; const int idx = blockIdx.x * 4 + wave; const int h = idx & 7, row = idx >> 3, b = row >> 12, t = row & 4095, qb = t >> 8;
    const unsigned qw = *(const unsigned*)(Q + (size_t)row * 1024 + h * 128 + 2 * lane); const float q0 = bflo(qw), q1 = bfhi(qw);
    unsigned sel = 0u;
    { float g[16];
#pragma unroll
      for (int j = 0; j < 16; ++j) { const float* km = kms + ((size_t)(b * 16 + j) * 8 + h) * 128 + 2 * lane; const float p = wave_sum(q0 * km[0] + q1 * km[1]); g[j] = (j < qb) ? p : -__builtin_inff(); }
#pragma unroll
      for (int it = 0; it < 3; ++it) { float mx = -__builtin_inff(); int mi = -1;
#pragma unroll
        for (int j = 0; j < 16; ++j) { const bool gt = g[j] > mx; mx = gt ? g[j] : mx; mi = gt ? j : mi; }
        if (mi >= 0) sel |= 1u << mi;
#pragma unroll
        for (int j = 0; j < 16; ++j) g[j] = (j == mi) ? -__builtin_inff() : g[j]; } }
    sel |= 1u << qb;
    float m = -1e30f, l = 0.f, o0 = 0.f, o1 = 0.f;
    for (int jb = 0; jb <= qb; ++jb) { if (!((sel >> jb) & 1u)) continue;
        const int nk = (jb < qb) ? 256 : (t & 255) + 1;
        for (int kk = 0; kk < nk; ++kk) { const size_t ko = ((size_t)b * 4096 + jb * 256 + kk) * 1024 + h * 128 + 2 * lane;
            const unsigned kw = *(const unsigned*)(K + ko), vw = *(const unsigned*)(V + ko);
            const float s = wave_sum(q0 * bflo(kw) + q1 * bfhi(kw)) * 0.088388347648318440f;
            const float mn = fmaxf(m, s), a = __expf(m - mn), p = __expf(s - mn);
            l = l * a + p; o0 = o0 * a + p * bflo(vw); o1 = o1 * a + p * bfhi(vw); m = mn; } }
    const float il = 1.0f / l; o0 *= il; o1 *= il;
    *(unsigned*)(AO + (size_t)row * 2048 + h * 128 + 2 * lane) = pk2(o0, o1);
    const float sq = wave_sum(o0 * o0 + o1 * o1); if (lane == 0) pg8::ss_add(ssA, row, sq);
}
__global__ __launch_bounds__(256) void xattn(const bf16* __restrict__ QX, const bf16* __restrict__ KVX, bf16* __restrict__ OX) {
    const int wave = threadIdx.x >> 6, lane = threadIdx.x & 63; const int idx = blockIdx.x * 4 + wave; const int h = idx & 3, row = idx >> 2, b = row >> 12;
    const unsigned qw = *(const unsigned*)(QX + (size_t)row * 512 + h * 128 + 2 * lane); const float q0 = bflo(qw), q1 = bfhi(qw);
    float m = -1e30f, l = 0.f, o0 = 0.f, o1 = 0.f;
    for (int kk = 0; kk < 256; ++kk) { const size_t ko = ((size_t)b * 256 + kk) * 1024 + h * 128 + 2 * lane;
        const unsigned kw = *(const unsigned*)(KVX + ko), vw = *(const unsigned*)(KVX + ko + 512);
        const float s = wave_sum(q0 * bflo(kw) + q1 * bfhi(kw)) * 0.088388347648318440f;
        const float mn = fmaxf(m, s), a = __expf(m - mn), p = __expf(s - mn);
        l = l * a + p; o0 = o0 * a + p * bflo(vw); o1 = o1 * a + p * bfhi(vw); m = mn; }
    const float il = 1.0f / l;
    *(unsigned*)(OX + (size_t)row * 512 + h * 128 + 2 * lane) = pk2(o0 * il, o1 * il);
}
}


#ifndef USE_FP8
#define USE_FP8 0xE80
#endif
struct Frame {
    LAS unsigned char* lds;
    volatile LAS unsigned* MISC;
    int tid, lane, wave;
    int vcu, G;
};
struct Args { const float* in[22]; float* out; unsigned char* ws; int ph_lo, ph_hi; };
enum { I_X = 0, I_MEM, I_F1N, I_F1G, I_F1U, I_F1D, I_MIXN, I_WIN, I_CONVW, I_AON, I_CON, I_WOUT, I_XN, I_MEMNRM, I_XQ, I_XKV, I_XO, I_F2N, I_F2G, I_F2U, I_F2D, I_FINAL };

__device__ __forceinline__ void p0_transpose_item(const float* W, int pitch, const float* gain, bf16* WT, int dstK, int dkoff, int drow0, int k0, LAS float* scr, int lane, int f8) {
    float v[32];
    const float* wp = W + (size_t)(k0 + (lane >> 5)) * pitch + (lane & 31);
#pragma unroll
    for (int i = 0; i < 32; ++i) v[i] = wp[(size_t)(2 * i) * pitch];
    const int c = lane & 7;
    f32x4 g0 = (f32x4){1.f, 1.f, 1.f, 1.f}, g1 = g0;
    if (gain) { g0 = *(const GAS f32x4*)(gain + k0 + 8 * c); g1 = *(const GAS f32x4*)(gain + k0 + 8 * c + 4); }
#pragma unroll
    for (int i = 0; i < 32; ++i) scr[(2 * i + (lane >> 5)) * 33 + (lane & 31)] = v[i];
    LDS_WAIT(); asm volatile("" ::: "memory");
#pragma unroll
    for (int j = 0; j < 4; ++j) { const int n = (lane >> 3) + 8 * j; const LAS float* s = scr + (8 * c) * 33 + n;
        const f32x4 x0 = (f32x4){s[0 * 33], s[1 * 33], s[2 * 33], s[3 * 33]} * g0, x1 = (f32x4){s[4 * 33], s[5 * 33], s[6 * 33], s[7 * 33]} * g1;
        if (f8) { const pg8::u32x2 o = pg8::pack8_f8(x0 * 64.0f, x1 * 64.0f); *(GAS v2u*)((unsigned char*)WT + (size_t)(drow0 + n) * dstK + dkoff + k0 + 8 * c) = (v2u){o.x, o.y}; }
        else { v4u o; o.x = pk2(x0[0], x0[1]); o.y = pk2(x0[2], x0[3]); o.z = pk2(x1[0], x1[1]); o.w = pk2(x1[2], x1[3]); *(GAS v4u*)(WT + (size_t)(drow0 + n) * dstK + dkoff + k0 + 8 * c) = o; } }
    LDS_WAIT(); asm volatile("" ::: "memory");
}
__device__ __forceinline__ void p0_prologue(Frame& F_, const Args& a) {
    Frame F = F_; asm volatile("" : "+v"(F.lane));
    LAS float* scr = (LAS float*)(F.lds + RING_OFF + F.wave * 16384);
    const int gw = F.vcu * NWAVES + F.wave, NGW = F.G * NWAVES;
    unsigned char* ws = a.ws;
    constexpr int I_FF = (D / 64) * (FF / 32), I_FD = (FF / 64) * (D / 32), I_IN = (D / 64) * (1024 / 32), I_OUT = (1024 / 64) * (D / 32), I_XQn = (D / 64) * (XW / 32), I_XKVn = (D / 64) * (1024 / 32), I_XOn = (XW / 64) * (D / 32);
    constexpr int NITEMS = 4 * I_FF + 2 * I_FD + 6 * I_IN + 2 * I_OUT + I_XQn + I_XKVn + I_XOn;
    for (int it = gw; it < NITEMS; it += NGW) {
        int r = it; const float* src = nullptr; const float* gain = nullptr; bf16* dst = nullptr; int pitch = 0, ncols = 0, dstK = 0, dkoff = 0, rowoff = 0, mode = 0, f8 = 0; bool hit = false; constexpr int F8M = (USE_FP8 >> 6) & 1, F8Q = (USE_FP8 >> 7) & 1, F8O = (USE_FP8 >> 9) & 1, F8G = (USE_FP8 >> 10) & 1, F8D = (USE_FP8 >> 11) & 1;
#define JOB(cnt, SRC, PITCH, NCOLS, GAIN, DST, DSTK, DKOFF, ROWOFF, MODE, F8J) if (!hit) { if (r < (cnt)) { hit = true; f8 = (F8J); src = (SRC); pitch = (PITCH); ncols = (NCOLS); gain = (GAIN); dst = (bf16*)(ws + (DST)); dstK = (DSTK); dkoff = (DKOFF); rowoff = (ROWOFF); mode = (MODE); } else r -= (cnt); }
        JOB(I_FF, a.in[I_F1G], FF, FF, a.in[I_F1N], WS_WGU1, D, 0, 0, 1, 0)
        JOB(I_FF, a.in[I_F1U], FF, FF, a.in[I_F1N], WS_WGU1, D, 0, 0, 2, 0)
        JOB(I_FD, a.in[I_F1D], D, D, nullptr, WS_WD1, FF, 0, 0, 0, 0)
        JOB(I_FF, a.in[I_F2G], FF, FF, a.in[I_F2N], WS_WGU2, D, 0, 0, 1, F8G)
        JOB(I_FF, a.in[I_F2U], FF, FF, a.in[I_F2N], WS_WGU2, D, 0, 0, 2, F8G)
        JOB(I_FD, a.in[I_F2D], D, D, nullptr, WS_WD2, FF, 0, 0, 0, F8D)
        JOB(I_IN, a.in[I_WIN] + 0, INW, 1024, a.in[I_MIXN], WS_WIN, D, 0, 0, 0, 0)
        JOB(I_IN, a.in[I_WIN] + 1024, INW, 1024, a.in[I_MIXN], WS_WIN, D, 0, 1024, 0, 0)
        JOB(I_IN, a.in[I_WIN] + 2048, INW, 1024, a.in[I_MIXN], WS_WIN, D, 0, 2048, 0, 0)
        JOB(I_IN, a.in[I_WIN] + 3072, INW, 1024, a.in[I_MIXN], WS_WIN, D, 0, 3072, 1, 0)
        JOB(I_IN, a.in[I_WIN] + 5120, INW, 1024, a.in[I_MIXN], WS_WIN, D, 0, 3072, 2, 0)
        JOB(I_IN, a.in[I_WIN] + 4096, INW, 1024, a.in[I_MIXN], WS_WIN, D, 0, 5120, 0, 0)
        JOB(I_OUT, a.in[I_WOUT], D, D, a.in[I_AON], WS_WOUT, D, 0, 0, 0, F8M)
        JOB(I_OUT, a.in[I_WOUT] + (size_t)1024 * D, D, D, a.in[I_CON], WS_WOUT, D, 1024, 0, 0, F8M)
        JOB(I_XQn, a.in[I_XQ], XW, XW, a.in[I_XN], WS_WQ, D, 0, 0, 0, F8Q)
        JOB(I_XKVn, a.in[I_XKV], 1024, 1024, nullptr, WS_WKV, D, 0, 0, 0, 0)
        JOB(I_XOn, a.in[I_XO], D, D, nullptr, WS_WO, XW, 0, 0, 0, F8O)
#undef JOB
        const int nblk = ncols / 32, kb = r / nblk, nb = r % nblk, k0 = 64 * kb, n0 = 32 * nb;
        const int drow0 = rowoff + (mode ? (n0 >> 7) * 256 + (n0 & 127) + (mode == 2 ? 128 : 0) : n0);
        p0_transpose_item(src + n0, pitch, gain, dst, dstK, dkoff, drow0, k0, scr, F.lane, f8);
    }
    { bf16* HB = (bf16*)(ws + WS_HB); pg8::u64_t* ss0 = (pg8::u64_t*)(ws + WS_CTL + CTL_SS);
      for (int m = gw; m < M; m += NGW) { const GAS f32x4* xr = (const GAS f32x4*)(a.in[I_X] + (size_t)m * D) + F.lane; GAS v2u* o8 = (GAS v2u*)(HB + (size_t)m * D) + F.lane; float s = 0.f;
#pragma unroll
          for (int j = 0; j < 8; ++j) { const f32x4 v = xr[64 * j]; s += (v.x * v.x + v.y * v.y) + (v.z * v.z + v.w * v.w); v2u w; w.x = pk2(v.x, v.y); w.y = pk2(v.z, v.w); o8[64 * j] = w; }
          s = wave_sum(s); if (F.lane == 0) ss0[m] = (pg8::u64_t)(s * 65536.0f + 0.5f); } }
    { bf16* MN = (bf16*)(ws + WS_MEMN); const float* gm = a.in[I_MEMNRM];
      for (int m = gw; m < BATCH * MEML; m += NGW) { const GAS f32x4* xr = (const GAS f32x4*)(a.in[I_MEM] + (size_t)m * D) + F.lane; GAS v2u* o8 = (GAS v2u*)(MN + (size_t)m * D) + F.lane; f32x4 v[8]; float s = 0.f;
#pragma unroll
          for (int j = 0; j < 8; ++j) { v[j] = xr[64 * j]; s += (v[j].x * v[j].x + v[j].y * v[j].y) + (v[j].z * v[j].z + v[j].w * v[j].w); }
          const float rs = rsqrtf(wave_sum(s) * (1.0f / D) + 1e-6f);
#pragma unroll
          for (int j = 0; j < 8; ++j) { const f32x4 g = *((const GAS f32x4*)gm + F.lane + 64 * j); v2u w; w.x = pk2(v[j].x * rs * g.x, v[j].y * rs * g.y); w.y = pk2(v[j].z * rs * g.z, v[j].w * rs * g.w); o8[64 * j] = w; } } }
}
__device__ __forceinline__ void p5_conv(Frame& F_, const Args& a) {
    Frame F = F_; asm volatile("" : "+v"(F.lane));
    const int gw = F.vcu * NWAVES + F.wave, NGW = F.G * NWAVES; unsigned char* ws = a.ws;
    const bf16* CU = (const bf16*)(ws + WS_CU); const bf16* BG = (const bf16*)(ws + WS_BG); bf16* MX = (bf16*)(ws + WS_MIXED); const float* cw = a.in[I_CONVW];
    for (int m = gw; m < M; m += NGW) { const int t = m & (SEQ - 1); float y[16]; float s = 0.f;
#pragma unroll
        for (int gsel = 0; gsel < 2; ++gsel) { const int ch = gsel * 512 + F.lane * 8;
            const v4u c0 = *(const GAS v4u*)(CU + (size_t)m * 1024 + ch); v4u c1 = (v4u){0u, 0u, 0u, 0u}, c2 = (v4u){0u, 0u, 0u, 0u};
            if (t >= 1) c1 = *(const GAS v4u*)(CU + (size_t)(m - 1) * 1024 + ch);
            if (t >= 2) c2 = *(const GAS v4u*)(CU + (size_t)(m - 2) * 1024 + ch);
            const v4u bg = *(const GAS v4u*)(BG + (size_t)m * 1024 + ch);
            const f32x4 w0a = *(const GAS f32x4*)(cw + ch), w0b = *(const GAS f32x4*)(cw + ch + 4), w1a = *(const GAS f32x4*)(cw + 1024 + ch), w1b = *(const GAS f32x4*)(cw + 1024 + ch + 4), w2a = *(const GAS f32x4*)(cw + 2048 + ch), w2b = *(const GAS f32x4*)(cw + 2048 + ch + 4);
#pragma unroll
            for (int e = 0; e < 4; ++e) { const unsigned x0 = c0[e], x1 = c1[e], x2 = c2[e], bw = bg[e];
                const float wl0 = e < 2 ? w0a[2 * e] : w0b[2 * e - 4], wh0 = e < 2 ? w0a[2 * e + 1] : w0b[2 * e - 3];
                const float wl1 = e < 2 ? w1a[2 * e] : w1b[2 * e - 4], wh1 = e < 2 ? w1a[2 * e + 1] : w1b[2 * e - 3];
                const float wl2 = e < 2 ? w2a[2 * e] : w2b[2 * e - 4], wh2 = e < 2 ? w2a[2 * e + 1] : w2b[2 * e - 3];
                const float lo = bflo(bw) * (wl0 * bflo(x2) + wl1 * bflo(x1) + wl2 * bflo(x0)), hi = bfhi(bw) * (wh0 * bfhi(x2) + wh1 * bfhi(x1) + wh2 * bfhi(x0));
                y[gsel * 8 + 2 * e] = lo; y[gsel * 8 + 2 * e + 1] = hi; s += lo * lo + hi * hi; } }
        const float rs = rsqrtf(wave_sum(s) * (1.0f / 1024.0f) + 1e-6f);
#pragma unroll
        for (int gsel = 0; gsel < 2; ++gsel) {
            if constexpr (((USE_FP8 >> 6) & 1) != 0) { const pg8::u32x2 o = pg8::pack8_f8((f32x4){y[gsel * 8 + 0], y[gsel * 8 + 1], y[gsel * 8 + 2], y[gsel * 8 + 3]} * rs, (f32x4){y[gsel * 8 + 4], y[gsel * 8 + 5], y[gsel * 8 + 6], y[gsel * 8 + 7]} * rs);
                *(GAS v2u*)((unsigned char*)MX + (size_t)m * 2048 + 1024 + gsel * 512 + F.lane * 8) = (v2u){o.x, o.y}; }
            else { v4u o; o.x = pk2(y[gsel * 8 + 0] * rs, y[gsel * 8 + 1] * rs); o.y = pk2(y[gsel * 8 + 2] * rs, y[gsel * 8 + 3] * rs); o.z = pk2(y[gsel * 8 + 4] * rs, y[gsel * 8 + 5] * rs); o.w = pk2(y[gsel * 8 + 6] * rs, y[gsel * 8 + 7] * rs);
                *(GAS v4u*)(MX + (size_t)m * 2048 + 1024 + gsel * 512 + F.lane * 8) = o; } } }
}
__device__ __forceinline__ void p12_final(Frame& F_, const Args& a) {
    Frame F = F_; asm volatile("" : "+v"(F.lane));
    const int gw = F.vcu * NWAVES + F.wave, NGW = F.G * NWAVES; const pg8::u64_t* ss4 = (const pg8::u64_t*)(a.ws + WS_CTL + CTL_SS) + 5 * M; const float* gf = a.in[I_FINAL];
    for (int m = gw; m < M; m += NGW) { GAS f32x4* xr = (GAS f32x4*)(a.out + (size_t)m * D) + F.lane; const float rs = rsqrtf(pg8::ss_val(ss4, m) * (1.0f / D) + 1e-6f);
#pragma unroll
        for (int j = 0; j < 8; ++j) { const f32x4 v = xr[64 * j]; const f32x4 g = *((const GAS f32x4*)gf + F.lane + 64 * j); xr[64 * j] = v * g * rs; } }
}

#ifndef DUP_MASK
#define DUP_MASK 0
#endif
#ifndef MOBA_SDEPTH
#define MOBA_SDEPTH 1
#endif
__global__ void __launch_bounds__(NWAVES * 64, 2) fwd_kernel(Args args) {
    extern __shared__ __attribute__((aligned(16))) unsigned char lds[];
    Frame F;
    F.lds = (LAS unsigned char*)lds;
    F.MISC = (volatile LAS unsigned*)(F.lds + MISC_OFF);
    F.tid = threadIdx.x; F.lane = F.tid & 63; F.wave = __builtin_amdgcn_readfirstlane(F.tid >> 6);
    F.G = gridDim.x; { const int bx = blockIdx.x; F.vcu = (F.G % 8 == 0) ? (bx % 8) * (F.G / 8) + bx / 8 : bx; }
    unsigned char* ws = args.ws;
    for (int u = F.tid; u < (LDS_BYTES - LDSCTL_OFF) / 4; u += NWAVES * 64) ((LAS unsigned*)(F.lds + LDSCTL_OFF))[u] = 0u;
    __syncthreads();
    const int lo = args.ph_lo, hi = args.ph_hi; const bool multi = (hi - lo) > 1;
    XcdBarrier bar; bar.bar = (unsigned*)(ws + WS_CTL + CTL_BAR + (size_t)lo * BAR_STRIDE); bar.x = 0; bar.st = nullptr;
    if (multi) bar = xcd_barrier_post((unsigned*)(ws + WS_CTL + CTL_BAR + (size_t)lo * BAR_STRIDE), F.MISC + 8);
#ifndef PH_ENABLE
#define PH_ENABLE 0x1fff
#endif
#define IN(k) ((((PH_ENABLE) >> (k)) & 1) && lo <= (k) && (k) < hi)
#define SEAM(k) do { if (IN(k) && IN((k) + 1)) xcd_barrier(bar); } while (0)
    pg8::u64_t* SS = (pg8::u64_t*)(ws + WS_CTL + CTL_SS);
    float* KMS = (float*)(ws + WS_CTL + CTL_KMS);
    bf16* HB = (bf16*)(ws + WS_HB); bf16* ACT = (bf16*)(ws + WS_ACT); bf16* MIXED = (bf16*)(ws + WS_MIXED);
    bf16* Qb = (bf16*)(ws + WS_Q); bf16* Kb = (bf16*)(ws + WS_K); bf16* Vb = (bf16*)(ws + WS_V); bf16* CUb = (bf16*)(ws + WS_CU); bf16* BGb = (bf16*)(ws + WS_BG);
    bf16* QX = (bf16*)(ws + WS_QX); bf16* OX = (bf16*)(ws + WS_OX); bf16* KVX = (bf16*)(ws + WS_KVX);
    const int bx = (int)blockIdx.x;

#ifndef F8_SP2
#define F8_SP2 PG8_SP2
#endif
#ifndef F8_ALIGN
#define F8_ALIGN PG8_ALIGN
#endif
#define GEMM_RUN(EPI, FP8FLAG, G_, S_, E_) pg8::gemm_phase<EPI, pg8::StaticOrder, (FP8FLAG) ? F8_ALIGN : PG8_ALIGN, (FP8FLAG) ? F8_SP2 : PG8_SP2, FP8FLAG>(F.lds + RING_OFF, G_, S_, E_)
#define DUPQ(k) (((DUP_MASK) >> (k)) & 1)
    pg8::u64_t* DUMMY = (pg8::u64_t*)(ws + WS_DUMMY);
    unsigned char* MIXED8 = ws + WS_MIXED; unsigned char* HB8 = ws + WS_HB8; unsigned char* ACT8 = ws + WS_ACT8; unsigned char* OX8 = ws + WS_OX8;
    constexpr bool F6 = ((USE_FP8 >> 6) & 1) != 0, F7 = ((USE_FP8 >> 7) & 1) != 0, F9 = ((USE_FP8 >> 9) & 1) != 0, F10 = ((USE_FP8 >> 10) & 1) != 0, F11 = ((USE_FP8 >> 11) & 1) != 0;
    constexpr float WSC = 1.0f / 64.0f;
    if (IN(0)) { p0_prologue(F, args); if (DUPQ(0)) p0_prologue(F, args); } SEAM(0);
    if (IN(1)) { pg8::Gemm g{HB, (const bf16*)(ws + WS_WGU1), M, 2 * FF, D}; pg8::StaticOrder S; S.init(M, 2 * FF, F.G, bx);
        typedef pg8::EpiSwiglu<false> EP; EP E{ACT, nullptr, FF, SS, 1.0f, 1.0f}; GEMM_RUN(EP, false, g, S, E); if (DUPQ(1)) GEMM_RUN(EP, false, g, S, E); } SEAM(1);
    if (IN(2)) { pg8::Gemm g{ACT, (const bf16*)(ws + WS_WD1), M, D, FF}; pg8::StaticOrder S; S.init(M, D, F.G, bx);
        typedef pg8::EpiResid<0, false, false> EP; EP E{args.in[I_X], nullptr, nullptr, HB, SS + M, 0.5f, nullptr, nullptr, 1.0f}; GEMM_RUN(EP, false, g, S, E);
        if (DUPQ(2)) { EP E2{args.in[I_X], nullptr, nullptr, HB, DUMMY, 0.5f, nullptr, nullptr, 1.0f}; GEMM_RUN(EP, false, g, S, E2); } } SEAM(2);
    if (IN(3)) { pg8::Gemm g{HB, (const bf16*)(ws + WS_WIN), M, INW, D}; pg8::StaticOrder S; S.init(M, INW, F.G, bx);
        pg8::EpiWin E{Qb, Kb, Vb, CUb, BGb, KMS, SS + M}; GEMM_RUN(pg8::EpiWin, false, g, S, E);
        if (DUPQ(3)) { pg8::EpiWin E2{Qb, Kb, Vb, CUb, BGb, (float*)DUMMY, SS + M}; GEMM_RUN(pg8::EpiWin, false, g, S, E2); } } SEAM(3);
    if (IN(4)) for (int rep = 0; rep < (DUPQ(4) ? 2 : 1); ++rep) {
        for (int u = F.vcu; u < BATCH * NH * 8; u += F.G) { const int b = u >> 6, h = (u >> 3) & 7, p = u & 7;
#pragma unroll 1
            for (int half = 0; half < 2; ++half) { const int qb = half ? 15 - p : p; const size_t r0 = (size_t)b * SEQ + (size_t)qb * 256;
                if constexpr (F6) att::attn_body<true, 1024, 1024, 2048, MOBA_SDEPTH, unsigned char, 32>(Qb + r0 * 1024 + h * 128, Kb + (size_t)b * SEQ * 1024 + h * 128, Vb + (size_t)b * SEQ * 1024 + h * 128, MIXED8 + r0 * 2048 + h * 128,
                                                       256 * (qb + 1), (att::lptr)(F.lds + RING_OFF), qb, KMS + ((size_t)b * 16 * 8 + h) * 128, 8 * 128, (rep ? DUMMY : SS + 2 * M) + r0);
                else att::attn_body<true, 1024, 1024, 2048, MOBA_SDEPTH, bf16, 1>(Qb + r0 * 1024 + h * 128, Kb + (size_t)b * SEQ * 1024 + h * 128, Vb + (size_t)b * SEQ * 1024 + h * 128, MIXED + r0 * 2048 + h * 128,
                                                       256 * (qb + 1), (att::lptr)(F.lds + RING_OFF), qb, KMS + ((size_t)b * 16 * 8 + h) * 128, 8 * 128, (rep ? DUMMY : SS + 2 * M) + r0); } } }
    if (IN(5)) { p5_conv(F, args); if (DUPQ(5)) p5_conv(F, args); } SEAM(5);
    if (IN(6)) { pg8::Gemm g{F6 ? (const bf16*)MIXED8 : MIXED, (const bf16*)(ws + WS_WOUT), M, D, D}; pg8::StaticOrder S; S.init(M, D, F.G, bx);
        typedef pg8::EpiResid<F6 ? 8 : 16, true, false> EP; EP E{nullptr, HB, nullptr, HB, SS + 3 * M, F6 ? WSC : 1.0f, SS + 2 * M, F7 ? HB8 : nullptr, F6 ? 1.0f / 32.0f : 1.0f}; GEMM_RUN(EP, F6, g, S, E);
        if (DUPQ(6)) { EP E2{nullptr, HB, nullptr, HB, DUMMY, 0.0f, SS + 2 * M, F7 ? HB8 : nullptr, F6 ? 1.0f / 32.0f : 1.0f}; GEMM_RUN(EP, F6, g, S, E2); } } SEAM(6);
    if (IN(7)) for (int rep = 0; rep < (DUPQ(7) ? 2 : 1); ++rep) {
        { pg8::Gemm g{F7 ? (const bf16*)HB8 : HB, (const bf16*)(ws + WS_WQ), M, XW, D}; pg8::StaticOrder S; S.init(M, XW, F.G, bx);
          pg8::EpiScaleBf16 E{QX, XW, SS + 3 * M, F7 ? WSC : 1.0f}; GEMM_RUN(pg8::EpiScaleBf16, F7, g, S, E); }
        { pg8::Gemm g{(const bf16*)(ws + WS_MEMN), (const bf16*)(ws + WS_WKV), BATCH * MEML, 1024, D}; pg8::StaticOrder S; S.init(BATCH * MEML, 1024, F.G, (bx + F.G - 128) % F.G);
          pg8::EpiScaleBf16 E{KVX, 1024, nullptr, 1.0f}; GEMM_RUN(pg8::EpiScaleBf16, false, g, S, E); } } SEAM(7);
    if (IN(8)) for (int rep = 0; rep < (DUPQ(8) ? 2 : 1); ++rep) {
        for (int u = F.vcu; u < BATCH * XH * 16; u += F.G) { const int b = u >> 6, h = (u >> 4) & 3, qb = u & 15; const size_t r0 = (size_t)b * SEQ + (size_t)qb * 256;
            if constexpr (F9) att::attn_body<false, 512, 1024, 512, 2, unsigned char, 16>(QX + r0 * 512 + h * 128, KVX + (size_t)b * MEML * 1024 + h * 128, KVX + (size_t)b * MEML * 1024 + 512 + h * 128, OX8 + r0 * 512 + h * 128,
                                                  MEML, (att::lptr)(F.lds + RING_OFF), 0, nullptr, 0, nullptr);
            else att::attn_body<false, 512, 1024, 512, 2, bf16, 1>(QX + r0 * 512 + h * 128, KVX + (size_t)b * MEML * 1024 + h * 128, KVX + (size_t)b * MEML * 1024 + 512 + h * 128, OX + r0 * 512 + h * 128,
                                                  MEML, (att::lptr)(F.lds + RING_OFF), 0, nullptr, 0, nullptr); } } SEAM(8);
    if (IN(9)) { pg8::Gemm g{F9 ? (const bf16*)OX8 : OX, (const bf16*)(ws + WS_WO), M, D, XW}; pg8::StaticOrder S; S.init(M, D, F.G, bx);
        typedef pg8::EpiResid<0, true, false> EP; EP E{nullptr, HB, nullptr, HB, SS + 4 * M, F9 ? WSC / 16.0f : 1.0f, nullptr, F10 ? HB8 : nullptr, 1.0f}; GEMM_RUN(EP, F9, g, S, E);
        if (DUPQ(9)) { EP E2{nullptr, HB, nullptr, HB, DUMMY, 0.0f, nullptr, F10 ? HB8 : nullptr, 1.0f}; GEMM_RUN(EP, F9, g, S, E2); } } SEAM(9);
    if (IN(10)) { pg8::Gemm g{F10 ? (const bf16*)HB8 : HB, (const bf16*)(ws + WS_WGU2), M, 2 * FF, D}; pg8::StaticOrder S; S.init(M, 2 * FF, F.G, bx);
        typedef pg8::EpiSwiglu<F11> EP; EP E{ACT, ACT8, FF, SS + 4 * M, F10 ? WSC : 1.0f, 4.0f}; GEMM_RUN(EP, F10, g, S, E); if (DUPQ(10)) GEMM_RUN(EP, F10, g, S, E); } SEAM(10);
    if (IN(11)) { pg8::Gemm g{F11 ? (const bf16*)ACT8 : ACT, (const bf16*)(ws + WS_WD2), M, D, FF}; pg8::StaticOrder S; S.init(M, D, F.G, bx);
        typedef pg8::EpiResid<0, true, true> EP; EP E{nullptr, HB, args.out, nullptr, SS + 5 * M, F11 ? 0.5f * WSC / 4.0f : 0.5f, nullptr, nullptr, 1.0f}; GEMM_RUN(EP, F11, g, S, E);
        if (DUPQ(11)) { EP E2{nullptr, HB, args.out, nullptr, DUMMY, F11 ? 0.5f * WSC / 4.0f : 0.5f, nullptr, nullptr, 1.0f}; GEMM_RUN(EP, F11, g, S, E2); } } SEAM(11);
    if (IN(12)) { p12_final(F, args); }
#undef GEMM_RUN
#undef DUPQ
#undef IN
#undef SEAM
}

extern "C" void kernel_launch(void* const* d_in, const int* in_sizes, int n_in, void* d_out, int out_size, void* d_ws, size_t ws_size, hipStream_t stream) {
    static int grid = 0;
    if (grid == 0) {
        if (n_in != 22 || in_sizes[0] != M * D || out_size != M * D || ws_size < WS_END) { fprintf(stderr, "kernel_launch: shape mismatch (n_in %d, in0 %d, out %d, ws %zu; need ws >= %zu); nothing launched\n", n_in, n_in > 0 ? in_sizes[0] : -1, out_size, ws_size, (size_t)WS_END); grid = -1; return; }
        int dev = 0, cus = 0, per_cu = 0;
        if (hipGetDevice(&dev) != hipSuccess || hipDeviceGetAttribute(&cus, hipDeviceAttributeMultiprocessorCount, dev) != hipSuccess) { grid = -1; return; }
        if (hipFuncSetAttribute((const void*)fwd_kernel, hipFuncAttributeMaxDynamicSharedMemorySize, LDS_BYTES) != hipSuccess) { fprintf(stderr, "kernel_launch: hipFuncSetAttribute failed\n"); grid = -1; return; }
        if (hipOccupancyMaxActiveBlocksPerMultiprocessor(&per_cu, (const void*)fwd_kernel, NWAVES * 64, LDS_BYTES) != hipSuccess || per_cu < 1) { fprintf(stderr, "kernel_launch: occupancy query reports %d workgroups per CU\n", per_cu); }
        (void)hipGetLastError();
        grid = cus;
    }
    if (grid < 0) return;
    if (hipMemsetAsync((char*)d_ws + WS_CTL, 0, CTL_ZERO_BYTES, stream) != hipSuccess) { fprintf(stderr, "kernel_launch: hipMemsetAsync failed\n"); return; }
    Args a{};
    for (int i = 0; i < 22; ++i) a.in[i] = (const float*)d_in[i];
    a.out = (float*)d_out; a.ws = (unsigned char*)d_ws;
    unsigned char* ws = (unsigned char*)d_ws; pg8::u64_t* SS = (pg8::u64_t*)(ws + WS_CTL + CTL_SS); float* KMS = (float*)(ws + WS_CTL + CTL_KMS); float* out = (float*)d_out;
    bf16* HB = (bf16*)(ws + WS_HB); bf16* ACT = (bf16*)(ws + WS_ACT); bf16* MIXED = (bf16*)(ws + WS_MIXED);
    bf16* Qb = (bf16*)(ws + WS_Q); bf16* Kb = (bf16*)(ws + WS_K); bf16* Vb = (bf16*)(ws + WS_V); bf16* CUb = (bf16*)(ws + WS_CU); bf16* BGb = (bf16*)(ws + WS_BG);
    bf16* QX = (bf16*)(ws + WS_QX); bf16* OX = (bf16*)(ws + WS_OX); bf16* KVX = (bf16*)(ws + WS_KVX);
    (void)SS; (void)KMS; (void)out; (void)HB; (void)ACT; (void)MIXED; (void)Qb; (void)Kb; (void)Vb; (void)CUb; (void)BGb; (void)QX; (void)OX; (void)KVX;
#if ONE_LAUNCH
    a.ph_lo = 0; a.ph_hi = NPH;
    hipLaunchKernelGGL(fwd_kernel, dim3(grid), dim3(NWAVES * 64), LDS_BYTES, stream, a);
#else
    for (int ph = 0; ph < NPH; ++ph) {
        if ((FAST_MASK >> ph) & 1) { a.ph_lo = ph; a.ph_hi = ph + 1; hipLaunchKernelGGL(fwd_kernel, dim3(grid), dim3(NWAVES * 64), LDS_BYTES, stream, a); continue; }
        switch (ph) {
        case 1: hipLaunchKernelGGL((nv::gemm<nv::FSwiglu>), dim3(FF / 64, M / 64), dim3(256), 0, stream, HB, (const bf16*)(ws + WS_WGU1), D, nv::FSwiglu{ACT, SS}); break;
        case 2: hipLaunchKernelGGL((nv::gemm<nv::FResid<0, false, false>>), dim3(D / 64, M / 64), dim3(256), 0, stream, ACT, (const bf16*)(ws + WS_WD1), FF, nv::FResid<0, false, false>{a.in[I_X], nullptr, nullptr, HB, SS + M, 0.5f, nullptr}); break;
        case 3: hipLaunchKernelGGL((nv::gemm<nv::FWin>), dim3(5120 / 64, M / 64), dim3(256), 0, stream, HB, (const bf16*)(ws + WS_WIN), D, nv::FWin{Qb, Kb, Vb, CUb, BGb, SS + M});
                hipLaunchKernelGGL(nv::kmean, dim3(BATCH * 16 * 8 * 128 / 256), dim3(256), 0, stream, Kb, KMS); break;
        case 4: hipLaunchKernelGGL(nv::moba, dim3(M * NH / 4), dim3(256), 0, stream, Qb, Kb, Vb, KMS, MIXED, SS + 2 * M); break;
        case 6: hipLaunchKernelGGL((nv::gemm<nv::FResid<1024, true, false>>), dim3(D / 64, M / 64), dim3(256), 0, stream, MIXED, (const bf16*)(ws + WS_WOUT), D, nv::FResid<1024, true, false>{nullptr, HB, nullptr, HB, SS + 3 * M, 1.0f, SS + 2 * M}); break;
        case 7: hipLaunchKernelGGL((nv::gemm<nv::FScale>), dim3(XW / 64, M / 64), dim3(256), 0, stream, HB, (const bf16*)(ws + WS_WQ), D, nv::FScale{QX, XW, SS + 3 * M});
                hipLaunchKernelGGL((nv::gemm<nv::FScale>), dim3(1024 / 64, BATCH * MEML / 64), dim3(256), 0, stream, (const bf16*)(ws + WS_MEMN), (const bf16*)(ws + WS_WKV), D, nv::FScale{KVX, 1024, nullptr}); break;
        case 8: hipLaunchKernelGGL(nv::xattn, dim3(M * XH / 4), dim3(256), 0, stream, QX, KVX, OX); break;
        case 9: hipLaunchKernelGGL((nv::gemm<nv::FResid<0, true, false>>), dim3(D / 64, M / 64), dim3(256), 0, stream, OX, (const bf16*)(ws + WS_WO), XW, nv::FResid<0, true, false>{nullptr, HB, nullptr, HB, SS + 4 * M, 1.0f, nullptr}); break;
        case 10: hipLaunchKernelGGL((nv::gemm<nv::FSwiglu>), dim3(FF / 64, M / 64), dim3(256), 0, stream, HB, (const bf16*)(ws + WS_WGU2), D, nv::FSwiglu{ACT, SS + 4 * M}); break;
        case 11: hipLaunchKernelGGL((nv::gemm<nv::FResid<0, true, true>>), dim3(D / 64, M / 64), dim3(256), 0, stream, ACT, (const bf16*)(ws + WS_WD2), FF, nv::FResid<0, true, true>{nullptr, HB, out, nullptr, SS + 5 * M, 0.5f, nullptr}); break;
        default: break;
        }
    }
#endif
    const hipError_t le = hipPeekAtLastError();
    if (le != hipSuccess) fprintf(stderr, "kernel_launch: launch failed: %s\n", hipGetErrorName(le));
}
```

```cpp
#define ONE_LAUNCH 1
#define FAST_MASK 0x1fff
#define USE_FP8 0xEC0
#include <hip/hip_runtime.h>
#include <cstdio>
#include <cstdint>
namespace pg8 {
#define PG8_LAS __attribute__((address_space(3)))
typedef unsigned short bf16_t;
typedef short bf16x8 __attribute__((ext_vector_type(8)));
typedef float f32x4 __attribute__((ext_vector_type(4)));
typedef unsigned u32x4 __attribute__((ext_vector_type(4)));
typedef int i32x4 __attribute__((ext_vector_type(4)));
typedef int i32x8 __attribute__((ext_vector_type(8)));
typedef unsigned u32x2 __attribute__((ext_vector_type(2)));
constexpr int BM = 256, BK = 64, HALF = 128, HTB = HALF * BK * 2  , STAGE_BYTES = 8 * HTB, NXCD = 8, WGM = 8;

__host__ __device__ __forceinline__ int lds_byte(int r, int c) { const int st = (r >> 4) * 2 + (c >> 5), rr = r & 15, cc = c & 31, ob = rr * 64 + cc * 2; return st * 1024 + (ob ^ (((ob >> 9) & 1) << 5)); }
__host__ __device__ __forceinline__ void stage_rc(int b, int& R, int& C) { const int st = b / 1024, sb = b % 1024, swz = sb ^ (((sb >> 9) & 1) << 5); R = (st >> 1) * 16 + swz / 64; C = (st & 1) * 32 + (swz % 64) / 2; }
__host__ __device__ __forceinline__ int perm32(int rho) { const int n = rho >> 4, i = rho & 15; return 8 * (i >> 2) + 4 * n + (i & 3); }

struct Unit { int pm, pn; };
struct Gemm { const bf16_t* A; const bf16_t* Bt; int M, N, K; };

struct StaticOrder {
    int nM, nN, nwg, G, c;
    __host__ __device__ void init(int M, int N, int G_, int c_) { nM = M / BM; nN = N / BM; nwg = nM * nN; G = G_; c = c_; }
    __host__ __device__ bool next(int i, Unit& u) const {
        const long L = (long)i * G + c; if (L >= nwg) return false;
        int wgid = (int)L; { const int q = nwg / NXCD, r = nwg % NXCD, xcd = wgid % NXCD, off = wgid / NXCD; wgid = (xcd < r ? xcd * (q + 1) : r * (q + 1) + (xcd - r) * q) + off; }
        const int nig = WGM * nN, gid = wgid / nig, fm = gid * WGM, gsz = (nM - fm) < WGM ? (nM - fm) : WGM;
        u.pm = fm + ((wgid % nig) % gsz); u.pn = (wgid % nig) / gsz; return true;
    }
    __device__ __forceinline__ void a_ready(const Unit&) const {}
    __device__ __forceinline__ void done(const Unit&) const {}
};

__device__ __forceinline__ unsigned cvt_pk_bf16(float lo, float hi) { unsigned r; asm volatile("v_cvt_pk_bf16_f32 %0, %1, %2" : "=v"(r) : "v"(lo), "v"(hi)); return r; }
__device__ __forceinline__ u32x4 pack8(const f32x4 v0, const f32x4 v1) { u32x4 w; w.x = cvt_pk_bf16(v0[0], v0[1]); w.y = cvt_pk_bf16(v0[2], v0[3]); w.z = cvt_pk_bf16(v1[0], v1[1]); w.w = cvt_pk_bf16(v1[2], v1[3]); return w; }
constexpr float RMS_EPS = 1e-6f;
typedef unsigned long long u64_t;
__device__ __forceinline__ float ss_val(const u64_t* ss, int row) { return (float)ss[row] * (1.0f / 65536.0f); }
__device__ __forceinline__ void ss_add(u64_t* ss, int row, float sq) { atomicAdd(ss + row, (u64_t)(unsigned)(sq * 65536.0f + 0.5f)); }
__device__ __forceinline__ float clamp_f8(float x) { return __builtin_amdgcn_fmed3f(x, -448.0f, 448.0f); }
__device__ __forceinline__ u32x2 pack8_f8(const f32x4 v0, const f32x4 v1) { int a = __builtin_amdgcn_cvt_pk_fp8_f32(clamp_f8(v0[0]), clamp_f8(v0[1]), 0, false); a = __builtin_amdgcn_cvt_pk_fp8_f32(clamp_f8(v0[2]), clamp_f8(v0[3]), a, true);
    int b = __builtin_amdgcn_cvt_pk_fp8_f32(clamp_f8(v1[0]), clamp_f8(v1[1]), 0, false); b = __builtin_amdgcn_cvt_pk_fp8_f32(clamp_f8(v1[2]), clamp_f8(v1[3]), b, true); u32x2 w; w.x = (unsigned)a; w.y = (unsigned)b; return w; }
__device__ __forceinline__ float silu_mul(float g, float u) { return g * u * __builtin_amdgcn_rcpf(1.0f + __builtin_amdgcn_exp2f(-1.4426950408889634f * g)); }

template <bool F8OUT> struct EpiSwiglu {
    static constexpr bool PERM = true, AFTER_DRAIN = false; static constexpr int MIDT = 0;
    bf16_t* O; unsigned char* O8; int ldo; const u64_t* ss; float asc, osc;
    __device__ __forceinline__ void mid(f32x4 (&)[2][2][4][2], const Unit&, int, int) const {}
    __device__ __forceinline__ void operator()(const f32x4 (&acc)[2][2][4][2], const Unit& u, int wr, int wc, int fr_, int fq_) const {
        int fr = fr_, fq = fq_; asm volatile("" : "+v"(fr), "+v"(fq));
        const int row0 = u.pm * BM + wr * 64 + fr, col0 = u.pn * HALF + wc * 32 + 8 * fq;
#pragma unroll
        for (int ai = 0; ai < 2; ++ai)
#pragma unroll
            for (int m = 0; m < 4; ++m) { const int row = row0 + ai * HALF + m * 16; const float rs = asc * rsqrtf(ss_val(ss, row) * (1.0f / 2048.0f) + RMS_EPS);
                f32x4 o0, o1;
#pragma unroll
                for (int j = 0; j < 4; ++j) { o0[j] = silu_mul(acc[ai][0][m][0][j] * rs, acc[ai][1][m][0][j] * rs); o1[j] = silu_mul(acc[ai][0][m][1][j] * rs, acc[ai][1][m][1][j] * rs); }
                if constexpr (F8OUT) *(u32x2*)(O8 + (size_t)row * ldo + col0) = pack8_f8(o0 * osc, o1 * osc);
                else *(u32x4*)(O + (size_t)row * ldo + col0) = pack8(o0, o1); }
    }
};
template <int MIDT_, bool RBF, bool OF32> struct EpiResid {
    static constexpr bool PERM = true, AFTER_DRAIN = false; static constexpr int MIDT = MIDT_;
    const float* R; const bf16_t* RB; float* H; bf16_t* HB; u64_t* ssn; float alpha; const u64_t* midss; unsigned char* HB8; float midmul;
    __device__ __forceinline__ void mid(f32x4 (&acc)[2][2][4][2], const Unit& u, int wr, int fr) const {
        const int row0 = u.pm * BM + wr * 64 + fr;
#pragma unroll
        for (int ai = 0; ai < 2; ++ai)
#pragma unroll
            for (int m = 0; m < 4; ++m) { const float s = midmul * rsqrtf(ss_val(midss, row0 + ai * HALF + m * 16) * (1.0f / 1024.0f) + RMS_EPS);
#pragma unroll
                for (int bj = 0; bj < 2; ++bj)
#pragma unroll
                    for (int n = 0; n < 2; ++n) acc[ai][bj][m][n] = acc[ai][bj][m][n] * s; }
    }
    __device__ __forceinline__ void operator()(const f32x4 (&acc)[2][2][4][2], const Unit& u, int wr, int wc, int fr_, int fq_) const {
        int fr = fr_, fq = fq_; asm volatile("" : "+v"(fr), "+v"(fq));
        const int row0 = u.pm * BM + wr * 64 + fr, col0 = u.pn * BM + wc * 32 + 8 * fq;
#pragma unroll
        for (int ai = 0; ai < 2; ++ai)
#pragma unroll
            for (int m = 0; m < 4; ++m) { const int row = row0 + ai * HALF + m * 16; const size_t off = (size_t)row * 2048 + col0; float sq = 0.f;
#pragma unroll
                for (int bj = 0; bj < 2; ++bj) { f32x4 r0, r1;
                    if constexpr (RBF) { const u32x4 w = *(const u32x4*)(RB + off + bj * HALF);
                        r0 = (f32x4){__uint_as_float(w.x << 16), __uint_as_float(w.x & 0xffff0000u), __uint_as_float(w.y << 16), __uint_as_float(w.y & 0xffff0000u)};
                        r1 = (f32x4){__uint_as_float(w.z << 16), __uint_as_float(w.z & 0xffff0000u), __uint_as_float(w.w << 16), __uint_as_float(w.w & 0xffff0000u)}; }
                    else { r0 = *(const f32x4*)(R + off + bj * HALF); r1 = *(const f32x4*)(R + off + bj * HALF + 4); }
                    const f32x4 h0 = r0 + acc[ai][bj][m][0] * alpha, h1 = r1 + acc[ai][bj][m][1] * alpha;
                    if constexpr (OF32) { *(f32x4*)(H + off + bj * HALF) = h0; *(f32x4*)(H + off + bj * HALF + 4) = h1; }
                    else { *(u32x4*)(HB + off + bj * HALF) = pack8(h0, h1); if (HB8) *(u32x2*)(HB8 + off + bj * HALF) = pack8_f8(h0, h1); }
                    sq += (h0[0] * h0[0] + h0[1] * h0[1]) + (h0[2] * h0[2] + h0[3] * h0[3]) + (h1[0] * h1[0] + h1[1] * h1[1]) + (h1[2] * h1[2] + h1[3] * h1[3]); }
                sq += __shfl_xor(sq, 16); sq += __shfl_xor(sq, 32);
                if (fq == 0) ss_add(ssn, row, sq);
                asm volatile("" ::: "memory"); }
    }
};
struct EpiWin {
    static constexpr bool PERM = true, AFTER_DRAIN = false; static constexpr int MIDT = 0;
    bf16_t *Q, *K, *V, *CU, *BG; float* kms; const u64_t* ss;
    __device__ __forceinline__ void mid(f32x4 (&)[2][2][4][2], const Unit&, int, int) const {}
    __device__ __forceinline__ void operator()(const f32x4 (&acc)[2][2][4][2], const Unit& u, int wr, int wc, int fr_, int fq_) const {
        int fr = fr_, fq = fq_; asm volatile("" : "+v"(fr), "+v"(fq));
        const int row0 = u.pm * BM + wr * 64 + fr, pn = u.pn;
        if (pn >= 12 && pn < 20) {
            const int col0 = (pn - 12) * HALF + wc * 32 + 8 * fq;
#pragma unroll
            for (int ai = 0; ai < 2; ++ai)
#pragma unroll
                for (int m = 0; m < 4; ++m) { const int row = row0 + ai * HALF + m * 16; float rs = rsqrtf(ss_val(ss, row) * (1.0f / 2048.0f) + RMS_EPS); rs = rs * rs;
                    const f32x4 o0 = acc[ai][0][m][0] * acc[ai][1][m][0] * rs, o1 = acc[ai][0][m][1] * acc[ai][1][m][1] * rs;
                    *(u32x4*)(CU + (size_t)row * 1024 + col0) = pack8(o0, o1); }
        } else {
            bf16_t* base = pn < 4 ? Q : pn < 8 ? K : pn < 12 ? V : BG; const int colt = (pn & 3) * BM, col0 = colt + wc * 32 + 8 * fq; const bool isk = (pn >= 4 && pn < 8);
            float rsv[2][4];
#pragma unroll
            for (int ai = 0; ai < 2; ++ai)
#pragma unroll
                for (int m = 0; m < 4; ++m) rsv[ai][m] = rsqrtf(ss_val(ss, row0 + ai * HALF + m * 16) * (1.0f / 2048.0f) + RMS_EPS);
#pragma unroll
            for (int ai = 0; ai < 2; ++ai)
#pragma unroll
                for (int m = 0; m < 4; ++m) { const int row = row0 + ai * HALF + m * 16;
#pragma unroll
                    for (int bj = 0; bj < 2; ++bj) *(u32x4*)(base + (size_t)row * 1024 + col0 + bj * HALF) = pack8(acc[ai][bj][m][0] * rsv[ai][m], acc[ai][bj][m][1] * rsv[ai][m]); }
            if (isk) {
#pragma unroll
                for (int bj = 0; bj < 2; ++bj)
#pragma unroll
                    for (int n = 0; n < 2; ++n) { f32x4 c = (f32x4){0.f, 0.f, 0.f, 0.f};
#pragma unroll
                        for (int ai = 0; ai < 2; ++ai)
#pragma unroll
                            for (int m = 0; m < 4; ++m) { float r2 = rsv[ai][m]; asm volatile("" : "+v"(r2)); c += acc[ai][bj][m][n] * r2; }
#pragma unroll
                        for (int j = 0; j < 4; ++j) { float v = c[j]; v += __shfl_xor(v, 1); v += __shfl_xor(v, 2); v += __shfl_xor(v, 4); v += __shfl_xor(v, 8);
                            const int col = col0 + bj * HALF + 4 * n + j;
                            if (fr == 0) unsafeAtomicAdd(kms + ((size_t)u.pm * 8 + (col >> 7)) * 128 + (col & 127), v); }
                        asm volatile("" ::: "memory"); }
            }
        }
    }
};
struct EpiScaleBf16 {
    static constexpr bool PERM = true, AFTER_DRAIN = false; static constexpr int MIDT = 0;
    bf16_t* O; int ldo; const u64_t* ss; float asc;
    __device__ __forceinline__ void mid(f32x4 (&)[2][2][4][2], const Unit&, int, int) const {}
    __device__ __forceinline__ void operator()(const f32x4 (&acc)[2][2][4][2], const Unit& u, int wr, int wc, int fr_, int fq_) const {
        int fr = fr_, fq = fq_; asm volatile("" : "+v"(fr), "+v"(fq));
        const int row0 = u.pm * BM + wr * 64 + fr, col0 = u.pn * BM + wc * 32 + 8 * fq;
#pragma unroll
        for (int ai = 0; ai < 2; ++ai)
#pragma unroll
            for (int m = 0; m < 4; ++m) { const int row = row0 + ai * HALF + m * 16; const float rs = asc * (ss ? rsqrtf(ss_val(ss, row) * (1.0f / 2048.0f) + RMS_EPS) : 1.0f);
#pragma unroll
                for (int bj = 0; bj < 2; ++bj) *(u32x4*)(O + (size_t)row * ldo + col0 + bj * HALF) = pack8(acc[ai][bj][m][0] * rs, acc[ai][bj][m][1] * rs); }
    }
};

template <class Epi, class Sched, bool ALIGN_EPI = false, bool SP2 = false, bool FP8 = false>
__device__ __forceinline__ void gemm_phase(PG8_LAS unsigned char* lds, const Gemm g, const Sched& S, const Epi& E) {
    int tid_ = threadIdx.x; asm volatile("" : "+v"(tid_));
    const int tid = tid_, wid = __builtin_amdgcn_readfirstlane(tid >> 6), lane = tid & 63, wr = wid >> 2, wc = wid & 3, fr = lane & 15, fq = lane >> 4;
    const int KB = FP8 ? g.K : g.K * 2, nt = KB / (BK * 2);
    unsigned voffA[2], voffB[2];
#pragma unroll
    for (int i = 0; i < 2; ++i) { int R, C; stage_rc(tid * 16 + i * 8192, R, C); const int Rb = Epi::PERM ? ((R & ~31) + perm32(R & 31)) : R;
        voffA[i] = (unsigned)(R * KB + C * 2); voffB[i] = (unsigned)(Rb * KB + C * 2); }
    const size_t kstep = (size_t)(BK * 2);
    const size_t hstep = (size_t)HALF * KB;
    const size_t tstep = 2 * hstep;
    const unsigned ldsw = (unsigned)wid * 1024u;
    const int aoff = lds_byte(wr * 64 + fr, fq * 8), boff = lds_byte(wc * 32 + fr, fq * 8);
#define PG8_SA(b, h) (((b) * 2 + (h)) * HTB)
#define PG8_SB(b, h) ((4 + (b) * 2 + (h)) * HTB)
#define PG8_STAGE(bufoff, gbase, voff) do { _Pragma("unroll") for (int _i = 0; _i < 2; ++_i) \
        __builtin_amdgcn_global_load_lds((const unsigned*)((const char*)(gbase) + (voff)[_i]), (PG8_LAS unsigned*)(lds + (bufoff) + ldsw + _i * 8192), 16, 0, 0); } while (0)
#define PG8_LDA(dst, b, h) do { _Pragma("unroll") for (int m = 0; m < 4; ++m) _Pragma("unroll") for (int k = 0; k < 2; ++k) dst[m][k] = *(const PG8_LAS bf16x8*)(lds + PG8_SA(b, h) + aoff + m * 2048 + k * 1024); } while (0)
#define PG8_LDB(dst, b, h) do { _Pragma("unroll") for (int n = 0; n < 2; ++n) _Pragma("unroll") for (int k = 0; k < 2; ++k) dst[n][k] = *(const PG8_LAS bf16x8*)(lds + PG8_SB(b, h) + boff + n * 2048 + k * 1024); } while (0)
#define PG8_CAT(x) __builtin_shufflevector(__builtin_bit_cast(i32x4, (x)[0]), __builtin_bit_cast(i32x4, (x)[1]), 0, 1, 2, 3, 4, 5, 6, 7)
#define PG8_MMA(ai, bj, At, Bt) do { __builtin_amdgcn_s_setprio(1); _Pragma("unroll") for (int m = 0; m < 4; ++m) _Pragma("unroll") for (int n = 0; n < 2; ++n) { \
        if constexpr (FP8) { const i32x8 b8_ = PG8_CAT(Bt[n]), a8_ = PG8_CAT(At[m]); asm volatile("v_mfma_f32_16x16x128_f8f6f4 %0, %1, %2, %0" : "+v"(acc[ai][bj][m][n]) : "v"(b8_), "v"(a8_)); }   \
        else { _Pragma("unroll") for (int k = 0; k < 2; ++k) acc[ai][bj][m][n] = __builtin_amdgcn_mfma_f32_16x16x32_bf16(Bt[n][k], At[m][k], acc[ai][bj][m][n], 0, 0, 0); } } __builtin_amdgcn_s_setprio(0); } while (0)
#define PG8_WAIT_V(n) asm volatile("s_waitcnt vmcnt(" #n ")" ::: "memory")
#define PG8_WAIT_L(n) asm volatile("s_waitcnt lgkmcnt(" #n ")" ::: "memory")
#define PG8_BAR __builtin_amdgcn_s_barrier()
#define PG8_SCHED __builtin_amdgcn_sched_barrier(0)
    Unit cur, nxt; int ui = 0;
    if (!S.next(0, cur)) return;
    f32x4 acc[2][2][4][2];
#pragma unroll
    for (int a = 0; a < 2; ++a)
#pragma unroll
        for (int b = 0; b < 2; ++b)
#pragma unroll
            for (int m = 0; m < 4; ++m)
#pragma unroll
                for (int n = 0; n < 2; ++n) acc[a][b][m][n] = (f32x4){0.f, 0.f, 0.f, 0.f};
    bf16x8 At[4][2], B0[2][2], B1[2][2];
    const char* cA = (const char*)g.A + (size_t)cur.pm * tstep; const char* cB = (const char*)g.Bt + (size_t)cur.pn * tstep;
    S.a_ready(cur);
    if constexpr (SP2) {
        PG8_STAGE(PG8_SB(0, 0), cB, voffB); PG8_STAGE(PG8_SB(0, 1), cB + hstep, voffB); PG8_STAGE(PG8_SA(0, 0), cA, voffA); PG8_STAGE(PG8_SA(0, 1), cA + hstep, voffA);
        if (wr == 1) PG8_BAR;
        PG8_WAIT_V(2); PG8_BAR;
        PG8_STAGE(PG8_SB(1, 0), cB + kstep, voffB); PG8_STAGE(PG8_SA(1, 0), cA + kstep, voffA); PG8_STAGE(PG8_SB(1, 1), cB + hstep + kstep, voffB);
        PG8_WAIT_V(6); PG8_BAR;
    } else {
        PG8_STAGE(PG8_SB(0, 0), cB, voffB); PG8_STAGE(PG8_SA(0, 0), cA, voffA); PG8_STAGE(PG8_SB(0, 1), cB + hstep, voffB); PG8_STAGE(PG8_SA(0, 1), cA + hstep, voffA);
        if (wr == 1) PG8_BAR;
        PG8_WAIT_V(4); PG8_BAR;
        PG8_STAGE(PG8_SB(1, 0), cB + kstep, voffB); PG8_STAGE(PG8_SA(1, 0), cA + kstep, voffA); PG8_STAGE(PG8_SB(1, 1), cB + hstep + kstep, voffB);
        PG8_WAIT_V(6); PG8_BAR;
    }
    for (;;) {
        const bool has_next = S.next(ui + 1, nxt);
        const char* nA = has_next ? (const char*)g.A + (size_t)nxt.pm * tstep : cA; const char* nB = has_next ? (const char*)g.Bt + (size_t)nxt.pn * tstep : cB;
        for (int t = 0; t < nt; t += 2) {
            if constexpr (Epi::MIDT > 0) { if (t == Epi::MIDT) {
                if constexpr (FP8) { asm volatile("s_nop 15\n\ts_nop 15" ::: "memory");
#pragma unroll
                    for (int a = 0; a < 2; ++a)
#pragma unroll
                        for (int b = 0; b < 2; ++b)
#pragma unroll
                            for (int m = 0; m < 4; ++m)
#pragma unroll
                                for (int n = 0; n < 2; ++n) asm volatile("" : "+v"(acc[a][b][m][n])); }
                E.mid(acc, cur, wr, fr); } }
            const bool last = (t == nt - 2);
            const char* a1 = cA + (size_t)(t + 1) * kstep;
            const char* a2 = last ? nA : cA + (size_t)(t + 2) * kstep; const char* b2 = last ? nB : cB + (size_t)(t + 2) * kstep;
            const char* a3 = a2 + kstep; const char* b3 = b2 + kstep;
            if (last && has_next) S.a_ready(nxt);
            if constexpr (SP2) {
            PG8_LDB(B0, 0, 0); PG8_LDB(B1, 0, 1); PG8_SCHED; PG8_LDA(At, 0, 0); PG8_STAGE(PG8_SA(1, 1), a1 + hstep, voffA);
            PG8_WAIT_V(8); PG8_WAIT_L(0); PG8_BAR; PG8_MMA(0, 0, At, B0); PG8_MMA(0, 1, At, B1); PG8_BAR; PG8_SCHED;
            PG8_LDA(At, 0, 1); PG8_STAGE(PG8_SB(0, 0), b2, voffB); PG8_STAGE(PG8_SB(0, 1), b2 + hstep, voffB); PG8_STAGE(PG8_SA(0, 0), a2, voffA);
            PG8_WAIT_V(8); PG8_WAIT_L(0); PG8_BAR; PG8_MMA(1, 0, At, B0); PG8_MMA(1, 1, At, B1); PG8_BAR; PG8_SCHED;
            PG8_LDB(B0, 1, 0); PG8_LDB(B1, 1, 1); PG8_SCHED; PG8_LDA(At, 1, 0); PG8_STAGE(PG8_SA(0, 1), a2 + hstep, voffA);
            PG8_WAIT_V(8); PG8_WAIT_L(0); PG8_BAR; PG8_MMA(0, 0, At, B0); PG8_MMA(0, 1, At, B1); PG8_BAR; PG8_SCHED;
            PG8_LDA(At, 1, 1); PG8_STAGE(PG8_SB(1, 0), b3, voffB); PG8_STAGE(PG8_SB(1, 1), b3 + hstep, voffB); PG8_STAGE(PG8_SA(1, 0), a3, voffA);
            PG8_WAIT_V(8); PG8_WAIT_L(0); PG8_BAR; PG8_MMA(1, 0, At, B0); PG8_MMA(1, 1, At, B1); PG8_BAR; PG8_SCHED;
            } else {
            PG8_LDB(B0, 0, 0); PG8_SCHED; PG8_LDA(At, 0, 0); PG8_STAGE(PG8_SA(1, 1), a1 + hstep, voffA);
            PG8_WAIT_L(8); PG8_BAR; PG8_WAIT_L(0); PG8_MMA(0, 0, At, B0); PG8_BAR; PG8_SCHED;
            PG8_LDB(B1, 0, 1); PG8_STAGE(PG8_SB(0, 0), b2, voffB);
            PG8_BAR; PG8_WAIT_L(0); PG8_MMA(0, 1, At, B1); PG8_BAR;
            PG8_LDA(At, 0, 1); PG8_STAGE(PG8_SA(0, 0), a2, voffA);
            PG8_BAR; PG8_WAIT_L(0); PG8_MMA(1, 0, At, B0); PG8_BAR; PG8_SCHED;
            PG8_STAGE(PG8_SB(0, 1), b2 + hstep, voffB);
            PG8_WAIT_V(6); PG8_BAR; PG8_MMA(1, 1, At, B1); PG8_BAR;
            PG8_LDB(B0, 1, 0); PG8_SCHED; PG8_LDA(At, 1, 0); PG8_STAGE(PG8_SA(0, 1), a2 + hstep, voffA);
            PG8_WAIT_L(8); PG8_BAR; PG8_WAIT_L(0); PG8_MMA(0, 0, At, B0); PG8_BAR; PG8_SCHED;
            PG8_LDB(B1, 1, 1); PG8_STAGE(PG8_SB(1, 0), b3, voffB);
            PG8_BAR; PG8_WAIT_L(0); PG8_MMA(0, 1, At, B1); PG8_BAR;
            PG8_LDA(At, 1, 1); PG8_STAGE(PG8_SA(1, 0), a3, voffA);
            PG8_BAR; PG8_WAIT_L(0); PG8_MMA(1, 0, At, B0); PG8_BAR; PG8_SCHED;
            PG8_STAGE(PG8_SB(1, 1), b3 + hstep, voffB);
            PG8_WAIT_V(6); PG8_BAR; PG8_MMA(1, 1, At, B1); PG8_BAR;
            }
        }
        if constexpr (FP8) {
            asm volatile("s_nop 15\n\ts_nop 15" ::: "memory");
#pragma unroll
            for (int a = 0; a < 2; ++a)
#pragma unroll
                for (int b = 0; b < 2; ++b)
#pragma unroll
                    for (int m = 0; m < 4; ++m)
#pragma unroll
                        for (int n = 0; n < 2; ++n) asm volatile("" : "+v"(acc[a][b][m][n]));
        }
        if constexpr (ALIGN_EPI) { if (wr == 0) PG8_BAR; }
        if constexpr (!Epi::AFTER_DRAIN) { E(acc, cur, wr, wc, fr, fq); S.done(cur); }
        if (!has_next) break;
#pragma unroll
        for (int a = 0; a < 2; ++a)
#pragma unroll
            for (int b = 0; b < 2; ++b)
#pragma unroll
                for (int m = 0; m < 4; ++m)
#pragma unroll
                    for (int n = 0; n < 2; ++n) acc[a][b][m][n] = (f32x4){0.f, 0.f, 0.f, 0.f};
        cur = nxt; cA = nA; cB = nB; ++ui;
        if constexpr (ALIGN_EPI) { if (wr == 1) PG8_BAR; }
    }
    PG8_WAIT_V(0);
    if constexpr (!ALIGN_EPI) { if (wr == 0) PG8_BAR; }
    PG8_BAR;
    if constexpr (Epi::AFTER_DRAIN) { E.fused(acc, cur, wr, wc, fr, fq, lds, wid, lane); S.done(cur); }
#undef PG8_SA
#undef PG8_SB
#undef PG8_STAGE
#undef PG8_LDA
#undef PG8_LDB
#undef PG8_MMA
#undef PG8_CAT
#undef PG8_WAIT_V
#undef PG8_WAIT_L
#undef PG8_BAR
#undef PG8_SCHED
}
}

#define PG8_SP2 true
#define PG8_ALIGN true
namespace att {
typedef unsigned short bf16;
using bf16x8 = __attribute__((ext_vector_type(8))) short;
using s16x4  = __attribute__((ext_vector_type(4))) short;
using f32x16 = __attribute__((ext_vector_type(16))) float;
using u32x4  = __attribute__((ext_vector_type(4))) unsigned;
#define ATT_LAS __attribute__((address_space(3)))
typedef ATT_LAS char* lptr;
constexpr int   D = 128, NW = 8, QBLK = 32, KVBLK = 64;
constexpr float SCALE = 0.088388347648318440f;
constexpr float THR = 8.f;
constexpr int SHM_V = KVBLK * D * 2, SHM_K = KVBLK * D * 2, SHM_ATTN = 2 * SHM_V + 2 * SHM_K + NW * 64 * 4;
#define KSWZ(row, colB) ((row) * 256 + ((colB) ^ (((row) & 7) << 4)))
#define SBAR() __builtin_amdgcn_sched_barrier(0)
__device__ __forceinline__ int crow(int r, int hi) { return (r & 3) + 8 * (r >> 2) + 4 * hi; }
__device__ __forceinline__ unsigned cvtpk(float lo, float hi) { unsigned r; asm volatile("v_cvt_pk_bf16_f32 %0, %1, %2" : "=v"(r) : "v"(lo), "v"(hi)); return r; }
__device__ __forceinline__ void partialSM(f32x16& p0, f32x16& p1, float& m_reg, float& mn, float& alpha) {
  constexpr float C = SCALE * 1.4426950408889634f;
  float pmax = p0[0];
#pragma unroll
  for (int r = 1; r < 16; ++r) pmax = fmaxf(pmax, p0[r]);
#pragma unroll
  for (int r = 0; r < 16; ++r) pmax = fmaxf(pmax, p1[r]);
  { auto rr = __builtin_amdgcn_permlane32_swap(__float_as_uint(pmax), __float_as_uint(pmax), false, false);
    pmax = fmaxf(__uint_as_float(rr[0]), __uint_as_float(rr[1])); }
  if (__builtin_expect(__all(pmax - m_reg <= THR / SCALE), 1)) { mn = m_reg; alpha = 1.f; }
  else { mn = fmaxf(m_reg, pmax); alpha = __builtin_amdgcn_exp2f((m_reg - mn) * C); m_reg = mn; }
  float mnC = -mn * C;
#pragma unroll
  for (int r = 0; r < 16; ++r) p0[r] = fmaf(p0[r], C, mnC);
#pragma unroll
  for (int r = 0; r < 16; ++r) p1[r] = fmaf(p1[r], C, mnC);
#pragma unroll
  for (int r = 0; r < 16; ++r) p0[r] = __builtin_amdgcn_exp2f(p0[r]);
}
__device__ __forceinline__ void finishSM(f32x16& p0, f32x16& p1, float alpha, float& l_reg, bf16x8& pa0, bf16x8& pa1, bf16x8& pa2, bf16x8& pa3) {
#pragma unroll
  for (int r = 0; r < 16; ++r) p1[r] = __builtin_amdgcn_exp2f(p1[r]);
  float ps = 0;
#pragma unroll
  for (int r = 0; r < 16; ++r) ps += p0[r];
#pragma unroll
  for (int r = 0; r < 16; ++r) ps += p1[r];
  { auto rr = __builtin_amdgcn_permlane32_swap(__float_as_uint(ps), __float_as_uint(ps), false, false);
    ps = __uint_as_float(rr[0]) + __uint_as_float(rr[1]); }
  l_reg = l_reg * alpha + ps;
#define PK4(P, BASE, OUT) do { unsigned a0 = cvtpk(P[BASE + 0], P[BASE + 1]), a1 = cvtpk(P[BASE + 2], P[BASE + 3]);   \
    unsigned b0 = cvtpk(P[BASE + 4], P[BASE + 5]), b1 = cvtpk(P[BASE + 6], P[BASE + 7]);                              \
    auto r0 = __builtin_amdgcn_permlane32_swap(a0, b0, false, false); auto r1 = __builtin_amdgcn_permlane32_swap(a1, b1, false, false); \
    u32x4 w = {r0[0], r1[0], r0[1], r1[1]}; OUT = *reinterpret_cast<bf16x8*>(&w); } while (0)
  PK4(p0, 0, pa0); PK4(p0, 8, pa1); PK4(p1, 0, pa2); PK4(p1, 8, pa3);
#undef PK4
}
__device__ __forceinline__ void qkt(f32x16& p0, f32x16& p1, lptr Ks, const bf16x8* qr, int r32, int hi) {
  p0 = f32x16{}; p1 = f32x16{};
#pragma unroll
  for (int d0 = 0; d0 < 8; ++d0) { int cb = (d0 * 16 + hi * 8) * 2;
    bf16x8 b0 = *reinterpret_cast<const ATT_LAS bf16x8*>(Ks + KSWZ(r32, cb));
    bf16x8 b1 = *reinterpret_cast<const ATT_LAS bf16x8*>(Ks + KSWZ(32 + r32, cb));
    p0 = __builtin_amdgcn_mfma_f32_32x32x16_bf16(b0, qr[d0], p0, 0, 0, 0);
    p1 = __builtin_amdgcn_mfma_f32_32x32x16_bf16(b1, qr[d0], p1, 0, 0, 0); }
}
__device__ __forceinline__ int v_st(int k, int c) { const int kk = (k & ~0xC) | ((k & 4) << 1) | ((k & 8) >> 1); return ((kk >> 3) * 4 + (c >> 5)) * 512 + ((kk & 7) * 32 + (c & 31)) * 2; }
__device__ __forceinline__ int v_rd_base(int lane) { return ((lane & 3) << 3) | (((lane >> 2) & 3) << 6) | (((lane >> 4) & 1) << 5) | (((lane >> 5) & 1) << 8); }
constexpr int v_rd_off(int d0, int ks, int half) { return d0 * 512 + ks * 4096 + half * 2048; }
template <int OFF> __device__ __forceinline__ s16x4 tr_read(int vb) {
  s16x4 r; asm volatile("ds_read_b64_tr_b16 %0, %1 offset:%2" : "=&v"(r) : "v"(vb), "i"(OFF) : "memory"); return r;
}
template <int D0> __device__ __forceinline__ void pv_one(f32x16& od, int vb, bf16x8 pa0, bf16x8 pa1, bf16x8 pa2, bf16x8 pa3) {
  const s16x4 l0 = tr_read<v_rd_off(D0, 0, 0)>(vb), h0 = tr_read<v_rd_off(D0, 0, 1)>(vb), l1 = tr_read<v_rd_off(D0, 1, 0)>(vb), h1 = tr_read<v_rd_off(D0, 1, 1)>(vb);
  const s16x4 l2 = tr_read<v_rd_off(D0, 2, 0)>(vb), h2 = tr_read<v_rd_off(D0, 2, 1)>(vb), l3 = tr_read<v_rd_off(D0, 3, 0)>(vb), h3 = tr_read<v_rd_off(D0, 3, 1)>(vb);
  asm volatile("s_waitcnt lgkmcnt(0)" ::: "memory"); SBAR();
#define PK(L, H) (bf16x8){L[0], L[1], L[2], L[3], H[0], H[1], H[2], H[3]}
  od = __builtin_amdgcn_mfma_f32_32x32x16_bf16(pa0, PK(l0, h0), od, 0, 0, 0);
  od = __builtin_amdgcn_mfma_f32_32x32x16_bf16(pa1, PK(l1, h1), od, 0, 0, 0);
  od = __builtin_amdgcn_mfma_f32_32x32x16_bf16(pa2, PK(l2, h2), od, 0, 0, 0);
  od = __builtin_amdgcn_mfma_f32_32x32x16_bf16(pa3, PK(l3, h3), od, 0, 0, 0);
#undef PK
}
__device__ __forceinline__ void pv_d0(f32x16* o, int vb, bf16x8 pa0, bf16x8 pa1, bf16x8 pa2, bf16x8 pa3) {
  pv_one<0>(o[0], vb, pa0, pa1, pa2, pa3); pv_one<1>(o[1], vb, pa0, pa1, pa2, pa3); pv_one<2>(o[2], vb, pa0, pa1, pa2, pa3); pv_one<3>(o[3], vb, pa0, pa1, pa2, pa3);
}
__device__ __forceinline__ void moba_mask(f32x16& p0, f32x16& p1, int tile, int qb, unsigned sel, int qi, int w0, int hi) {
  const float NINF = -__builtin_inff();
  const int jb = tile >> 2;
  if (jb < qb) {
    const bool ok = ((sel >> jb) & 1u) != 0u;
    if (!__all(ok)) {
#pragma unroll
      for (int r = 0; r < 16; ++r) { p0[r] = ok ? p0[r] : NINF; p1[r] = ok ? p1[r] : NINF; }
    }
  } else {
    const int k0 = (tile & 3) * 64;
    if (k0 + 63 > w0) {
      int lim = qi - k0 - 4 * hi; asm volatile("" : "+v"(lim));
#pragma unroll
      for (int r = 0; r < 16; ++r) { const int kc = (r & 3) + 8 * (r >> 2); p0[r] = (kc <= lim) ? p0[r] : NINF; p1[r] = (kc + 32 <= lim) ? p1[r] : NINF; }
    }
  }
}

template <bool MOBA, int LDQ, int LDK, int LDO, int SDEPTH, typename TO, int OSC>
__device__ __forceinline__ void attn_body(const bf16* __restrict__ Qb, const bf16* __restrict__ Kh, const bf16* __restrict__ Vh, TO* __restrict__ Ob, int seq, lptr lds,
                                          int qb, const float* __restrict__ kms, int kms_stride, unsigned long long* __restrict__ ssq) {
  int tid_ = threadIdx.x; asm volatile("" : "+v"(tid_));
  const int tid = tid_, wid = tid >> 6, lane = tid & 63, r32 = lane & 31, hi = lane >> 5;
  lptr V_lds = lds; lptr K_lds = lds + 2 * SHM_V;
  ATT_LAS float* ws = (ATT_LAS float*)(lds + 2 * SHM_V + 2 * SHM_K) + wid * 64; ATT_LAS float* li_l = ws; ATT_LAS float* al_l = ws + 32;
  float m_reg = -1e30f, l_reg = 0; f32x16 o[4] = {}; bf16x8 qr[8];
  unsigned qoff = (unsigned)((wid * QBLK + r32) * LDQ + hi * 8); asm volatile("" : "+v"(qoff));
  const bf16* Qw = Qb + qoff;
#pragma unroll
  for (int d0 = 0; d0 < 8; ++d0) qr[d0] = *reinterpret_cast<const bf16x8*>(Qw + d0 * 16);
  const int sr = tid >> 4, sc = (tid & 15) * 8, vst0 = v_st(sr, sc), vst1 = v_st(32 + sr, sc);
  const int vb0 = (int)(uintptr_t)V_lds + v_rd_base(lane);
  struct { bf16x8 vs0, vs1, ks0, ks1; } sr_[SDEPTH];
  const unsigned so0 = (unsigned)(sr * LDK + sc), so1 = (unsigned)((32 + sr) * LDK + sc);
#define SLOAD(i, k0) do { const bf16* Vt_ = Vh + (long)(k0) * LDK; const bf16* Kt_ = Kh + (long)(k0) * LDK; \
    sr_[i].vs0 = *reinterpret_cast<const bf16x8*>(Vt_ + so0); sr_[i].vs1 = *reinterpret_cast<const bf16x8*>(Vt_ + so1); \
    sr_[i].ks0 = *reinterpret_cast<const bf16x8*>(Kt_ + so0); sr_[i].ks1 = *reinterpret_cast<const bf16x8*>(Kt_ + so1); } while (0)
#define SWRITE(b, i) do { *(ATT_LAS bf16x8*)(V_lds + (b) * SHM_V + vst0) = sr_[i].vs0;          \
    *(ATT_LAS bf16x8*)(V_lds + (b) * SHM_V + vst1) = sr_[i].vs1; int kc = sc * 2;               \
    *(ATT_LAS bf16x8*)(K_lds + (b) * SHM_K + KSWZ(sr, kc)) = sr_[i].ks0;                       \
    *(ATT_LAS bf16x8*)(K_lds + (b) * SHM_K + KSWZ(32 + sr, kc)) = sr_[i].ks1; } while (0)
#define SWAIT() do { if constexpr (SDEPTH == 2) asm volatile("s_waitcnt vmcnt(4)" ::: "memory"); else asm volatile("s_waitcnt vmcnt(0)" ::: "memory"); } while (0)
#define RESC(a) do { if (__any((a) < 1.f)) { if (hi == 0) al_l[r32] = (a); asm volatile("s_waitcnt lgkmcnt(0)" ::: "memory"); \
    _Pragma("unroll") for (int d = 0; d < 4; ++d) _Pragma("unroll") for (int r = 0; r < 16; ++r) o[d][r] *= al_l[crow(r, hi)]; } } while (0)
  f32x16 pA0, pA1, pB0, pB1; float mnA, mnB, alA, alB; bf16x8 pa0, pa1, pa2, pa3; const int NT = seq / KVBLK;
  constexpr int SE = 0, SO = SDEPTH - 1;
  unsigned sel = 0u; const int qi = wid * QBLK + r32, w0 = wid * QBLK;
  SLOAD(SE, 0);
  if constexpr (MOBA) {
    { const int j = sr & 15; const float* src = kms + (size_t)j * kms_stride + sc; const float4 x0 = *reinterpret_cast<const float4*>(src), x1 = *reinterpret_cast<const float4*>(src + 4);
      const float xv[8] = {x0.x, x0.y, x0.z, x0.w, x1.x, x1.y, x1.z, x1.w}; unsigned w[4];
#pragma unroll
      for (int e = 0; e < 4; ++e) { const unsigned h2 = cvtpk(xv[2 * e], xv[2 * e + 1]); const float f0 = __uint_as_float(h2 << 16), f1 = __uint_as_float(h2 & 0xffff0000u);
        const unsigned l2 = cvtpk(xv[2 * e] - f0, xv[2 * e + 1] - f1); w[e] = (sr < 16) ? h2 : l2; }
      u32x4 wv = {w[0], w[1], w[2], w[3]}; *(ATT_LAS u32x4*)(K_lds + KSWZ(sr, sc * 2)) = wv; }
    __syncthreads();
    f32x16 g = f32x16{};
#pragma unroll
    for (int d0 = 0; d0 < 8; ++d0) { const int cb = (d0 * 16 + hi * 8) * 2; const bf16x8 b0 = *reinterpret_cast<const ATT_LAS bf16x8*>(K_lds + KSWZ(r32, cb));
      g = __builtin_amdgcn_mfma_f32_32x32x16_bf16(b0, qr[d0], g, 0, 0, 0); }
    float G[16];
#pragma unroll
    for (int r = 0; r < 8; ++r) { const float own = g[r] + g[r + 8]; const float oth = __shfl_xor(own, 32); const int lb = (r & 3) + 8 * (r >> 2);
      G[lb] = hi ? oth : own; G[lb + 4] = hi ? own : oth; }
    const float NINF = -__builtin_inff();
#pragma unroll
    for (int j = 0; j < 16; ++j) G[j] = (j < qb) ? G[j] : NINF;
#pragma unroll
    for (int it = 0; it < 3; ++it) { float mx = NINF; int mi = -1;
#pragma unroll
      for (int j = 0; j < 16; ++j) { const bool gt = G[j] > mx; mx = gt ? G[j] : mx; mi = gt ? j : mi; }
      if (mi >= 0) sel |= 1u << mi;
#pragma unroll
      for (int j = 0; j < 16; ++j) G[j] = (j == mi) ? NINF : G[j]; }
    __syncthreads();
  }
  asm volatile("s_waitcnt vmcnt(0)" ::: "memory"); SWRITE(0, SE); __syncthreads();
  qkt(pA0, pA1, K_lds, qr, r32, hi);
  if constexpr (MOBA) moba_mask(pA0, pA1, 0, qb, sel, qi, w0, hi);
  partialSM(pA0, pA1, m_reg, mnA, alA);
  SLOAD(SO, KVBLK); if constexpr (SDEPTH == 2) { if (2 < NT) SLOAD(SE, 2 * KVBLK); }
  SWAIT(); SWRITE(1, SO); __syncthreads();
  for (int j = 1; j + 1 < NT; j += 2) {
    SBAR(); qkt(pB0, pB1, K_lds + SHM_K, qr, r32, hi);
    finishSM(pA0, pA1, alA, l_reg, pa0, pa1, pa2, pa3); SBAR();
    SLOAD(SO, (j + SDEPTH) * KVBLK); SBAR();
    pv_d0(o, vb0, pa0, pa1, pa2, pa3);
    if constexpr (MOBA) moba_mask(pB0, pB1, j, qb, sel, qi, w0, hi);
    partialSM(pB0, pB1, m_reg, mnB, alB);
    __syncthreads(); SWAIT(); SWRITE(0, SE);
    RESC(alB); __syncthreads();
    SBAR(); qkt(pA0, pA1, K_lds, qr, r32, hi);
    finishSM(pB0, pB1, alB, l_reg, pa0, pa1, pa2, pa3); SBAR();
    if (SDEPTH == 1 || j + 3 < NT) SLOAD(SE, (j + 1 + SDEPTH) * KVBLK); SBAR();
    pv_d0(o, vb0 + SHM_V, pa0, pa1, pa2, pa3);
    if constexpr (MOBA) moba_mask(pA0, pA1, j + 1, qb, sel, qi, w0, hi);
    partialSM(pA0, pA1, m_reg, mnA, alA);
    __syncthreads(); SWAIT(); SWRITE(1, SO);
    RESC(alA); __syncthreads();
  }
  SBAR(); qkt(pB0, pB1, K_lds + SHM_K, qr, r32, hi);
  finishSM(pA0, pA1, alA, l_reg, pa0, pa1, pa2, pa3); SBAR();
  pv_d0(o, vb0, pa0, pa1, pa2, pa3);
  if constexpr (MOBA) moba_mask(pB0, pB1, NT - 1, qb, sel, qi, w0, hi);
  partialSM(pB0, pB1, m_reg, mnB, alB);
  __syncthreads(); RESC(alB);
  finishSM(pB0, pB1, alB, l_reg, pa0, pa1, pa2, pa3); SBAR();
  pv_d0(o, vb0 + SHM_V, pa0, pa1, pa2, pa3);
  if (hi == 0) li_l[r32] = l_reg; asm volatile("s_waitcnt lgkmcnt(0)" ::: "memory");
  float rli[16];
#pragma unroll
  for (int r = 0; r < 16; ++r) rli[r] = __builtin_amdgcn_rcpf(li_l[crow(r, hi)]);
  int ohi = hi * 4, ocol = r32; asm volatile("" : "+v"(ohi), "+v"(ocol));
  TO* Ow = Ob + (long)(wid * QBLK) * LDO;
#pragma unroll
  for (int r = 0; r < 16; ++r) { const int orow = (r & 3) + 8 * (r >> 2) + ohi; float sq = 0.f;
#pragma unroll
    for (int d0 = 0; d0 < 4; ++d0) { const float v = o[d0][r] * rli[r]; sq += v * v; if constexpr (sizeof(TO) == 2) Ow[(unsigned)(orow * LDO + d0 * 32 + ocol)] = (TO)(cvtpk(v, v) & 0xffffu);
      else Ow[(unsigned)(orow * LDO + d0 * 32 + ocol)] = (TO)(__builtin_amdgcn_cvt_pk_fp8_f32(__builtin_amdgcn_fmed3f(v * (float)OSC, -448.0f, 448.0f), 0.0f, 0, false) & 0xff); }
    if constexpr (MOBA) { sq += __shfl_xor(sq, 1); sq += __shfl_xor(sq, 2); sq += __shfl_xor(sq, 4); sq += __shfl_xor(sq, 8); sq += __shfl_xor(sq, 16);
      if (ocol == 0) pg8::ss_add(ssq, wid * QBLK + orow, sq); } }
  __syncthreads();
#undef SLOAD
#undef SWRITE
#undef SWAIT
#undef RESC
}
#undef KSWZ
#undef SBAR
}

constexpr int NWAVES = 8;
constexpr int BATCH = 4, SEQ = 4096, D = 2048, M = BATCH * SEQ, FF = 5632, AW = 1024, CW = 1024, INW = 6144, MEML = 256, XW = 512, NH = 8, XH = 4, NBLK = 16;
constexpr int NPH = 13;
#ifndef FAST_MASK
#define FAST_MASK 0x1fff
#endif
#ifndef ONE_LAUNCH
#define ONE_LAUNCH 1
#endif
constexpr size_t MiB = 1u << 20, KiB = 1u << 10;
constexpr size_t WS_CTL = 0, CTL_ZERO_BYTES = 1536 * KiB;
constexpr size_t CTL_BAR = 64 * KiB, BAR_STRIDE = 16 * KiB;
constexpr size_t CTL_SS = 320 * KiB;
constexpr size_t CTL_KMS = 1088 * KiB;
constexpr size_t WS_WGU1 = 2 * MiB, WS_WD1 = 46 * MiB, WS_WGU2 = 68 * MiB, WS_WD2 = 112 * MiB, WS_WIN = 134 * MiB, WS_WOUT = 158 * MiB, WS_WQ = 166 * MiB, WS_WKV = 168 * MiB, WS_WO = 172 * MiB;
constexpr size_t WS_MEMN = 174 * MiB, WS_KVX = 178 * MiB, WS_HB = 180 * MiB, WS_MIXED = 244 * MiB, WS_ACT = 308 * MiB;
constexpr size_t WS_Q = 308 * MiB, WS_K = 340 * MiB, WS_V = 372 * MiB, WS_CU = 404 * MiB, WS_BG = 436 * MiB;
constexpr size_t WS_QX = 308 * MiB, WS_OX = 324 * MiB;
constexpr size_t WS_HB8 = 340 * MiB, WS_ACT8 = 396 * MiB, WS_OX8 = 324 * MiB;
constexpr size_t WS_DUMMY = 484 * MiB;
constexpr size_t WS_END = 486 * MiB;
static_assert(WS_ACT + (size_t)M * FF * 2 <= WS_END && WS_BG + (size_t)M * 1024 * 2 <= WS_END && CTL_KMS + BATCH * 16 * 8 * 128 * 4 <= CTL_ZERO_BYTES && CTL_SS + 6 * M * 8 <= CTL_KMS && CTL_ZERO_BYTES <= WS_WGU1, "d_ws map");
constexpr int RING_OFF = 0, RING_BYTES = 131072;
constexpr int LDSCTL_OFF = RING_BYTES, MISC_OFF = LDSCTL_OFF + 320;
constexpr int LDS_BYTES = 147456;
static_assert(MISC_OFF + 128 <= LDS_BYTES && att::SHM_ATTN <= RING_BYTES, "LDS map");

#define GAS __attribute__((address_space(1)))
#define LAS __attribute__((address_space(3)))
typedef unsigned short bf16;
typedef unsigned v4u __attribute__((ext_vector_type(4)));
typedef unsigned v2u __attribute__((ext_vector_type(2)));
typedef float f32x4 __attribute__((ext_vector_type(4)));
typedef short bf16x8 __attribute__((ext_vector_type(8)));
typedef GAS unsigned gu32;
#define RLX_AGENT __ATOMIC_RELAXED, __HIP_MEMORY_SCOPE_AGENT
#define LDS_WAIT() asm volatile("s_waitcnt lgkmcnt(0)" ::: "memory")
#define VM_WAIT() asm volatile("s_waitcnt vmcnt(0)" ::: "memory")
__device__ __forceinline__ unsigned pk2(float lo, float hi) { return pg8::cvt_pk_bf16(lo, hi); }
__device__ __forceinline__ float bflo(unsigned w) { return __uint_as_float(w << 16); }
__device__ __forceinline__ float bfhi(unsigned w) { return __uint_as_float(w & 0xffff0000u); }
__device__ __forceinline__ float wave_sum(float v) {
#pragma unroll
    for (int o = 1; o < 64; o <<= 1) v += __shfl_xor(v, o);
    return v;
}
#define XB_TMO      128
#define XB_XCNT(j)  (256  + 64 * (j))
#define XB_XSUB(j)  (1280 + 64 * (j))
#define XB_XGEN(j)  (2304 + 64 * (j))
#define XB_TOP      3328
#define XB_TOPGEN   3392
#define XCD_BAR_WORDS 3456
#define XB_SPIN_CAP (1u << 18)

__device__ __forceinline__ unsigned xb_ld(unsigned* p)              { return __hip_atomic_load(p, __ATOMIC_RELAXED, __HIP_MEMORY_SCOPE_AGENT); }
__device__ __forceinline__ unsigned xb_add(unsigned* p, unsigned v) { return __hip_atomic_fetch_add(p, v, __ATOMIC_RELAXED, __HIP_MEMORY_SCOPE_AGENT); }
__device__ __forceinline__ unsigned xb_xcc_id() { return (unsigned)__builtin_amdgcn_s_getreg((3 << 11) | 20) & 0xFu; }
#define XB_SPIN(cond, bar) do { unsigned _sp = 0; while (cond) { __builtin_amdgcn_s_sleep(1); \
    if ((++_sp & 255u) == 0u) { if (xb_ld(&(bar)[XB_TMO])) break; if (_sp > XB_SPIN_CAP) { atomicAdd(&(bar)[XB_TMO], 1u); break; } } } } while (0)

struct XcdBarrier {
    unsigned* bar; unsigned x;
    volatile LAS unsigned* st;
};

__device__ __forceinline__ XcdBarrier xcd_barrier_post(unsigned* bar, volatile LAS unsigned* st) {
    XcdBarrier b; b.bar = bar; b.x = xb_xcc_id(); b.st = st;
    if (threadIdx.x == 0) (void)xb_add(&bar[XB_XCNT(b.x)], 1u);
    return b;
}
__device__ __forceinline__ void xcd_barrier_complete(unsigned* bar, unsigned x, unsigned& nloc, unsigned& nx) {
    const unsigned G = gridDim.x * gridDim.y * gridDim.z;
    unsigned sum, cnt, mine, sp = 0u;
    for (;;) {
        sum = 0u; cnt = 0u; mine = 0u;
#pragma unroll
        for (unsigned j = 0; j < 16; ++j) { const unsigned c = xb_ld(&bar[XB_XCNT(j)]); sum += c; cnt += (c > 0u) ? 1u : 0u; mine = (j == x) ? c : mine; }
        if (sum == G) break;
        __builtin_amdgcn_s_sleep(1);
        if ((++sp & 255u) == 0u) { if (xb_ld(&bar[XB_TMO])) break; if (sp > XB_SPIN_CAP) { atomicAdd(&bar[XB_TMO], 1u); break; } }
    }
    nloc = mine > 0u ? mine : 1u; nx = cnt > 0u ? cnt : 1u;
}

__device__ __forceinline__ void xcd_barrier(const XcdBarrier& b) {
    asm volatile("s_waitcnt vmcnt(0)" ::: "memory");
    __syncthreads();
    if (threadIdx.x == 0) {
        unsigned* bar = b.bar;
        __builtin_amdgcn_s_waitcnt(0);
        unsigned nloc = b.st[0], nx = b.st[1];
        if (nloc == 0u) { xcd_barrier_complete(bar, b.x, nloc, nx); b.st[0] = nloc; b.st[1] = nx; }
        const unsigned old = xb_add(&bar[XB_XSUB(b.x)], 1u);
        const unsigned gen = old / nloc;
        if (old + 1u == (gen + 1u) * nloc) {
            __builtin_amdgcn_fence(__ATOMIC_RELEASE, "agent");
            asm volatile("s_waitcnt vmcnt(0)" ::: "memory");
            const unsigned og = xb_add(&bar[XB_TOP], 1u);
            const unsigned tg = og / nx;
            if (og + 1u == (tg + 1u) * nx) xb_add(&bar[XB_TOPGEN], 1u);
            else XB_SPIN(xb_ld(&bar[XB_TOPGEN]) == tg, bar);
            __builtin_amdgcn_fence(__ATOMIC_ACQUIRE, "agent");
            xb_add(&bar[XB_XGEN(b.x)], 1u);
            asm volatile("s_waitcnt vmcnt(0)" ::: "memory");
        } else {
            XB_SPIN(xb_ld(&bar[XB_XGEN(b.x)]) == gen, bar);
            __builtin_amdgcn_fence(__ATOMIC_ACQUIRE, "agent");
            asm volatile("s_waitcnt vmcnt(0)" ::: "memory");
        }
    }
    __syncthreads();
}

namespace nv {
typedef float f32x4 __attribute__((ext_vector_type(4)));
typedef short bf16x8 __attribute__((ext_vector_type(8)));
constexpr float EPS = 1e-6f;
template <class F> __global__ __launch_bounds__(256) void gemm(const bf16* __restrict__ A, const bf16* __restrict__ Bt, int K, F f) {
    const int wave = threadIdx.x >> 6, lane = threadIdx.x & 63;
    const int row0 = blockIdx.y * 64 + wave * 16, col0 = blockIdx.x * 64;
    f32x4 acc[4], acc2[4];
#pragma unroll
    for (int c = 0; c < 4; ++c) { acc[c] = (f32x4){0.f, 0.f, 0.f, 0.f}; acc2[c] = (f32x4){0.f, 0.f, 0.f, 0.f}; }
    const bf16* ap = A + (size_t)(row0 + (lane & 15)) * K + 8 * (lane >> 4);
    const bf16* bp[4]; const bf16* bp2[4];
#pragma unroll
    for (int c = 0; c < 4; ++c) { const int col = col0 + 16 * c + (lane & 15); bp[c] = Bt + (size_t)f.brow(col) * K + 8 * (lane >> 4); bp2[c] = Bt + (size_t)f.brow2(col) * K + 8 * (lane >> 4); }
    for (int k0 = 0; k0 < K; k0 += 32) {
        if (F::MIDK > 0 && k0 == F::MIDK) {
#pragma unroll
            for (int j = 0; j < 4; ++j) { const float s = f.midscale(row0 + (lane >> 4) * 4 + j);
#pragma unroll
                for (int c = 0; c < 4; ++c) acc[c][j] *= s; }
        }
        const bf16x8 a = *(const bf16x8*)(ap + k0);
#pragma unroll
        for (int c = 0; c < 4; ++c) { const bf16x8 b = *(const bf16x8*)(bp[c] + k0); acc[c] = __builtin_amdgcn_mfma_f32_16x16x32_bf16(a, b, acc[c], 0, 0, 0);
            if (F::DUAL) { const bf16x8 b2 = *(const bf16x8*)(bp2[c] + k0); acc2[c] = __builtin_amdgcn_mfma_f32_16x16x32_bf16(a, b2, acc2[c], 0, 0, 0); } }
    }
#pragma unroll
    for (int j = 0; j < 4; ++j) { const int row = row0 + (lane >> 4) * 4 + j; float sq = 0.f;
#pragma unroll
        for (int c = 0; c < 4; ++c) { const float h = f.store(row, col0 + 16 * c + (lane & 15), acc[c][j], acc2[c][j]); sq += h * h; }
        if (F::ROWSS) { sq += __shfl_xor(sq, 1); sq += __shfl_xor(sq, 2); sq += __shfl_xor(sq, 4); sq += __shfl_xor(sq, 8); if ((lane & 15) == 0) f.addss(row, sq); } }
}
__device__ __forceinline__ bf16 tobf(float v) { return (bf16)(pg8::cvt_pk_bf16(v, v) & 0xffffu); }
struct FSwiglu { static constexpr bool DUAL = true, ROWSS = false; static constexpr int MIDK = 0; bf16* O; const pg8::u64_t* ss;
    __device__ int brow(int col) const { return (col >> 7) * 256 + (col & 127); } __device__ int brow2(int col) const { return brow(col) + 128; } __device__ float midscale(int) const { return 1.f; } __device__ void addss(int, float) const {}
    __device__ float store(int row, int col, float a, float a2) const { const float rs = rsqrtf(pg8::ss_val(ss, row) * (1.0f / 2048.0f) + EPS), g = a * rs, u = a2 * rs; O[(size_t)row * FF + col] = tobf(g / (1.0f + __expf(-g)) * u); return 0.f; } };
template <int MIDK_, bool RBF, bool OF32> struct FResid { static constexpr bool DUAL = false, ROWSS = true; static constexpr int MIDK = MIDK_; const float* R; const bf16* RB; float* H; bf16* HB; pg8::u64_t* ssn; float alpha; const pg8::u64_t* midss;
    __device__ int brow(int col) const { return col; } __device__ int brow2(int col) const { return col; } __device__ float midscale(int row) const { return rsqrtf(pg8::ss_val(midss, row) * (1.0f / 1024.0f) + EPS); }
    __device__ void addss(int row, float s) const { pg8::ss_add(ssn, row, s); }
    __device__ float store(int row, int col, float a, float) const { const size_t o = (size_t)row * 2048 + col; const float r = RBF ? __uint_as_float((unsigned)RB[o] << 16) : R[o]; const float h = r + alpha * a; if (OF32) H[o] = h; else HB[o] = tobf(h); return h; } };
struct FWin { static constexpr bool DUAL = true, ROWSS = false; static constexpr int MIDK = 0; bf16 *Q, *K, *V, *CU, *BG; const pg8::u64_t* ss;
    __device__ int brow(int col) const { if (col < 3072) return col; if (col < 4096) { const int j = col - 3072; return 3072 + (j >> 7) * 256 + (j & 127); } return 5120 + (col - 4096); }
    __device__ int brow2(int col) const { return (col >= 3072 && col < 4096) ? brow(col) + 128 : brow(col); } __device__ float midscale(int) const { return 1.f; } __device__ void addss(int, float) const {}
    __device__ float store(int row, int col, float a, float a2) const { const float rs = rsqrtf(pg8::ss_val(ss, row) * (1.0f / 2048.0f) + EPS); const size_t o = (size_t)row * 1024 + (col & 1023);
        if (col < 1024) Q[o] = tobf(a * rs); else if (col < 2048) K[o] = tobf(a * rs); else if (col < 3072) V[o] = tobf(a * rs); else if (col < 4096) CU[o] = tobf((a * rs) * (a2 * rs)); else BG[o] = tobf(a * rs); return 0.f; } };
struct FScale { static constexpr bool DUAL = false, ROWSS = false; static constexpr int MIDK = 0; bf16* O; int ldo; const pg8::u64_t* ss;
    __device__ int brow(int col) const { return col; } __device__ int brow2(int col) const { return col; } __device__ float midscale(int) const { return 1.f; } __device__ void addss(int, float) const {}
    __device__ float store(int row, int col, float a, float) const { const float rs = ss ? rsqrtf(pg8::ss_val(ss, row) * (1.0f / 2048.0f) + EPS) : 1.0f; O[(size_t)row * ldo + col] = tobf(a * rs); return 0.f; } };
__global__ __launch_bounds__(256) void kmean(const bf16* __restrict__ K, float* __restrict__ kms) {
    const int i = blockIdx.x * 256 + threadIdx.x; const int d = i & 127, h = (i >> 7) & 7, bb = i >> 10;
    float s = 0.f; for (int r = 0; r < 256; ++r) s += __uint_as_float((unsigned)K[((size_t)bb * 256 + r) * 1024 + h * 128 + d] << 16);
    kms[i] = s;
}
__global__ __launch_bounds__(256) void moba(const bf16* __restrict__ Q, const bf16* __restrict__ K, const bf16* __restrict__ V, const float* __restrict__ kms, bf16* __restrict__ AO, pg8::u64_t* __restrict__ ssA) {
    const int wave = threadIdx.x >> 6, lane = threadIdx.x & 63; const int idx = blockIdx.x * 4 + wave; const int h = idx & 7, row = idx >> 3, b = row >> 12, t = row & 4095, qb = t >> 8;
    const unsigned qw = *(const unsigned*)(Q + (size_t)row * 1024 + h * 128 + 2 * lane); const float q0 = bflo(qw), q1 = bfhi(qw);
    unsigned sel = 0u;
    { float g[16];
#pragma unroll
      for (int j = 0; j < 16; ++j) { const float* km = kms + ((size_t)(b * 16 + j) * 8 + h) * 128 + 2 * lane; const float p = wave_sum(q0 * km[0] + q1 * km[1]); g[j] = (j < qb) ? p : -__builtin_inff(); }
#pragma unroll
      for (int it = 0; it < 3; ++it) { float mx = -__builtin_inff(); int mi = -1;
#pragma unroll
        for (int j = 0; j < 16; ++j) { const bool gt = g[j] > mx; mx = gt ? g[j] : mx; mi = gt ? j : mi; }
        if (mi >= 0) sel |= 1u << mi;
#pragma unroll
        for (int j = 0; j < 16; ++j) g[j] = (j == mi) ? -__builtin_inff() : g[j]; } }
    sel |= 1u << qb;
    float m = -1e30f, l = 0.f, o0 = 0.f, o1 = 0.f;
    for (int jb = 0; jb <= qb; ++jb) { if (!((sel >> jb) & 1u)) continue;
        const int nk = (jb < qb) ? 256 : (t & 255) + 1;
        for (int kk = 0; kk < nk; ++kk) { const size_t ko = ((size_t)b * 4096 + jb * 256 + kk) * 1024 + h * 128 + 2 * lane;
            const unsigned kw = *(const unsigned*)(K + ko), vw = *(const unsigned*)(V + ko);
            const float s = wave_sum(q0 * bflo(kw) + q1 * bfhi(kw)) * 0.088388347648318440f;
            const float mn = fmaxf(m, s), a = __expf(m - mn), p = __expf(s - mn);
            l = l * a + p; o0 = o0 * a + p * bflo(vw); o1 = o1 * a + p * bfhi(vw); m = mn; } }
    const float il = 1.0f / l; o0 *= il; o1 *= il;
    *(unsigned*)(AO + (size_t)row * 2048 + h * 128 + 2 * lane) = pk2(o0, o1);
    const float sq = wave_sum(o0 * o0 + o1 * o1); if (lane == 0) pg8::ss_add(ssA, row, sq);
}
__global__ __launch_bounds__(256) void xattn(const bf16* __restrict__ QX, const bf16* __restrict__ KVX, bf16* __restrict__ OX) {
    const int wave = threadIdx.x >> 6, lane = threadIdx.x & 63; const int idx = blockIdx.x * 4 + wave; const int h = idx & 3, row = idx >> 2, b = row >> 12;
    const unsigned qw = *(const unsigned*)(QX + (size_t)row * 512 + h * 128 + 2 * lane); const float q0 = bflo(qw), q1 = bfhi(qw);
    float m = -1e30f, l = 0.f, o0 = 0.f, o1 = 0.f;
    for (int kk = 0; kk < 256; ++kk) { const size_t ko = ((size_t)b * 256 + kk) * 1024 + h * 128 + 2 * lane;
        const unsigned kw = *(const unsigned*)(KVX + ko), vw = *(const unsigned*)(KVX + ko + 512);
        const float s = wave_sum(q0 * bflo(kw) + q1 * bfhi(kw)) * 0.088388347648318440f;
        const float mn = fmaxf(m, s), a = __expf(m - mn), p = __expf(s - mn);
        l = l * a + p; o0 = o0 * a + p * bflo(vw); o1 = o1 * a + p * bfhi(vw); m = mn; }
    const float il = 1.0f / l;
    *(unsigned*)(OX + (size_t)row * 512 + h * 128 + 2 * lane) = pk2(o0 * il, o1 * il);
}
}


#ifndef USE_FP8
#define USE_FP8 0xE80
#endif
struct Frame {
    LAS unsigned char* lds;
    volatile LAS unsigned* MISC;
    int tid, lane, wave;
    int vcu, G;
};
struct Args { const float* in[22]; float* out; unsigned char* ws; int ph_lo, ph_hi; };
enum { I_X = 0, I_MEM, I_F1N, I_F1G, I_F1U, I_F1D, I_MIXN, I_WIN, I_CONVW, I_AON, I_CON, I_WOUT, I_XN, I_MEMNRM, I_XQ, I_XKV, I_XO, I_F2N, I_F2G, I_F2U, I_F2D, I_FINAL };

struct P0Job { const float* src; const float* gain; bf16* dst; int pitch, dstK, dkoff, drow0, k0, f8; };
__device__ __forceinline__ void p0_load(const P0Job& J, int lane, float (&v)[32]) {
    const float* wp = J.src + (size_t)(J.k0 + (lane >> 5)) * J.pitch + (lane & 31);
#pragma unroll
    for (int i = 0; i < 32; ++i) v[i] = wp[(size_t)(2 * i) * J.pitch];
}
__device__ __forceinline__ void p0_store(const P0Job& J, int lane, const float (&v)[32], LAS float* scr) {
    const int c = lane & 7;
    f32x4 g0 = (f32x4){1.f, 1.f, 1.f, 1.f}, g1 = g0;
    if (J.gain) { g0 = *(const GAS f32x4*)(J.gain + J.k0 + 8 * c); g1 = *(const GAS f32x4*)(J.gain + J.k0 + 8 * c + 4); }
#pragma unroll
    for (int i = 0; i < 32; ++i) scr[(2 * i + (lane >> 5)) * 33 + (lane & 31)] = v[i];
    LDS_WAIT(); asm volatile("" ::: "memory");
#pragma unroll
    for (int j = 0; j < 4; ++j) { const int n = (lane >> 3) + 8 * j; const LAS float* s = scr + (8 * c) * 33 + n;
        const f32x4 x0 = (f32x4){s[0 * 33], s[1 * 33], s[2 * 33], s[3 * 33]} * g0, x1 = (f32x4){s[4 * 33], s[5 * 33], s[6 * 33], s[7 * 33]} * g1;
        if (J.f8) { const pg8::u32x2 o = pg8::pack8_f8(x0 * 64.0f, x1 * 64.0f); *(GAS v2u*)((unsigned char*)J.dst + (size_t)(J.drow0 + n) * J.dstK + J.dkoff + J.k0 + 8 * c) = (v2u){o.x, o.y}; }
        else { v4u o; o.x = pk2(x0[0], x0[1]); o.y = pk2(x0[2], x0[3]); o.z = pk2(x1[0], x1[1]); o.w = pk2(x1[2], x1[3]); *(GAS v4u*)(J.dst + (size_t)(J.drow0 + n) * J.dstK + J.dkoff + J.k0 + 8 * c) = o; } }
    LDS_WAIT(); asm volatile("" ::: "memory");
}
constexpr int P0_I_FF = (D / 64) * (FF / 32), P0_I_FD = (FF / 64) * (D / 32), P0_I_IN = (D / 64) * (1024 / 32), P0_I_OUT = (1024 / 64) * (D / 32), P0_I_XQ = (D / 64) * (XW / 32), P0_I_XKV = (D / 64) * (1024 / 32), P0_I_XO = (XW / 64) * (D / 32);
constexpr int P0_NITEMS = 4 * P0_I_FF + 2 * P0_I_FD + 6 * P0_I_IN + 2 * P0_I_OUT + P0_I_XQ + P0_I_XKV + P0_I_XO;
__device__ __forceinline__ P0Job p0_job(const Args& a, int it) {
    unsigned char* ws = a.ws;
    int r = it; const float* src = nullptr; const float* gain = nullptr; bf16* dst = nullptr; int pitch = 0, ncols = 32, dstK = 0, dkoff = 0, rowoff = 0, mode = 0, f8 = 0; bool hit = false;
    constexpr int F8M = (USE_FP8 >> 6) & 1, F8Q = (USE_FP8 >> 7) & 1, F8O = (USE_FP8 >> 9) & 1, F8G = (USE_FP8 >> 10) & 1, F8D = (USE_FP8 >> 11) & 1;
#define JOB(cnt, SRC, PITCH, NCOLS, GAIN, DST, DSTK, DKOFF, ROWOFF, MODE, F8J) if (!hit) { if (r < (cnt)) { hit = true; f8 = (F8J); src = (SRC); pitch = (PITCH); ncols = (NCOLS); gain = (GAIN); dst = (bf16*)(ws + (DST)); dstK = (DSTK); dkoff = (DKOFF); rowoff = (ROWOFF); mode = (MODE); } else r -= (cnt); }
    JOB(P0_I_FF, a.in[I_F1G], FF, FF, a.in[I_F1N], WS_WGU1, D, 0, 0, 1, 0)
    JOB(P0_I_FF, a.in[I_F1U], FF, FF, a.in[I_F1N], WS_WGU1, D, 0, 0, 2, 0)
    JOB(P0_I_FD, a.in[I_F1D], D, D, nullptr, WS_WD1, FF, 0, 0, 0, 0)
    JOB(P0_I_IN, a.in[I_WIN] + 0, INW, 1024, a.in[I_MIXN], WS_WIN, D, 0, 0, 0, 0)
    JOB(P0_I_IN, a.in[I_WIN] + 1024, INW, 1024, a.in[I_MIXN], WS_WIN, D, 0, 1024, 0, 0)
    JOB(P0_I_IN, a.in[I_WIN] + 2048, INW, 1024, a.in[I_MIXN], WS_WIN, D, 0, 2048, 0, 0)
    JOB(P0_I_IN, a.in[I_WIN] + 3072, INW, 1024, a.in[I_MIXN], WS_WIN, D, 0, 3072, 1, 0)
    JOB(P0_I_IN, a.in[I_WIN] + 5120, INW, 1024, a.in[I_MIXN], WS_WIN, D, 0, 3072, 2, 0)
    JOB(P0_I_IN, a.in[I_WIN] + 4096, INW, 1024, a.in[I_MIXN], WS_WIN, D, 0, 5120, 0, 0)
    JOB(P0_I_OUT, a.in[I_WOUT], D, D, a.in[I_AON], WS_WOUT, D, 0, 0, 0, F8M)
    JOB(P0_I_OUT, a.in[I_WOUT] + (size_t)1024 * D, D, D, a.in[I_CON], WS_WOUT, D, 1024, 0, 0, F8M)
    JOB(P0_I_XQ, a.in[I_XQ], XW, XW, a.in[I_XN], WS_WQ, D, 0, 0, 0, F8Q)
    JOB(P0_I_XKV, a.in[I_XKV], 1024, 1024, nullptr, WS_WKV, D, 0, 0, 0, 0)
    JOB(P0_I_XO, a.in[I_XO], D, D, nullptr, WS_WO, XW, 0, 0, 0, F8O)
    JOB(P0_I_FF, a.in[I_F2G], FF, FF, a.in[I_F2N], WS_WGU2, D, 0, 0, 1, F8G)
    JOB(P0_I_FF, a.in[I_F2U], FF, FF, a.in[I_F2N], WS_WGU2, D, 0, 0, 2, F8G)
    JOB(P0_I_FD, a.in[I_F2D], D, D, nullptr, WS_WD2, FF, 0, 0, 0, F8D)
#undef JOB
    const int nblk = ncols / 32, kb = r / nblk, nb = r % nblk, k0 = 64 * kb, n0 = 32 * nb;
    P0Job J; J.src = src + n0; J.gain = gain; J.dst = dst; J.pitch = pitch; J.dstK = dstK; J.dkoff = dkoff; J.k0 = k0; J.f8 = f8;
    J.drow0 = rowoff + (mode ? (n0 >> 7) * 256 + (n0 & 127) + (mode == 2 ? 128 : 0) : n0);
    return J;
}
__device__ __forceinline__ void p0_prologue(Frame& F_, const Args& a) {
    Frame F = F_; asm volatile("" : "+v"(F.lane));
    LAS float* scr = (LAS float*)(F.lds + RING_OFF + F.wave * 16384);
    const int gw = F.vcu * NWAVES + F.wave, NGW = F.G * NWAVES;
    unsigned char* ws = a.ws;
    { float va[32], vb[32]; P0Job Ja, Jb; int it = gw;
      if (it < P0_NITEMS) { Ja = p0_job(a, it); p0_load(Ja, F.lane, va); }
      while (it < P0_NITEMS) {
          const int i2 = it + NGW; if (i2 < P0_NITEMS) { Jb = p0_job(a, i2); p0_load(Jb, F.lane, vb); }
          p0_store(Ja, F.lane, va, scr);
          if (i2 >= P0_NITEMS) break;
          const int i3 = i2 + NGW; if (i3 < P0_NITEMS) { Ja = p0_job(a, i3); p0_load(Ja, F.lane, va); }
          p0_store(Jb, F.lane, vb, scr);
          it = i3; } }
    { bf16* HB = (bf16*)(ws + WS_HB); pg8::u64_t* ss0 = (pg8::u64_t*)(ws + WS_CTL + CTL_SS);
      for (int m = gw; m < M; m += NGW) { const GAS f32x4* xr = (const GAS f32x4*)(a.in[I_X] + (size_t)m * D) + F.lane; GAS v2u* o8 = (GAS v2u*)(HB + (size_t)m * D) + F.lane; float s = 0.f;
#pragma unroll
          for (int j = 0; j < 8; ++j) { const f32x4 v = xr[64 * j]; s += (v.x * v.x + v.y * v.y) + (v.z * v.z + v.w * v.w); v2u w; w.x = pk2(v.x, v.y); w.y = pk2(v.z, v.w); o8[64 * j] = w; }
          s = wave_sum(s); if (F.lane == 0) ss0[m] = (pg8::u64_t)(s * 65536.0f + 0.5f); } }
    { bf16* MN = (bf16*)(ws + WS_MEMN); const float* gm = a.in[I_MEMNRM];
      for (int m = gw; m < BATCH * MEML; m += NGW) { const GAS f32x4* xr = (const GAS f32x4*)(a.in[I_MEM] + (size_t)m * D) + F.lane; GAS v2u* o8 = (GAS v2u*)(MN + (size_t)m * D) + F.lane; f32x4 v[8]; float s = 0.f;
#pragma unroll
          for (int j = 0; j < 8; ++j) { v[j] = xr[64 * j]; s += (v[j].x * v[j].x + v[j].y * v[j].y) + (v[j].z * v[j].z + v[j].w * v[j].w); }
          const float rs = rsqrtf(wave_sum(s) * (1.0f / D) + 1e-6f);
#pragma unroll
          for (int j = 0; j < 8; ++j) { const f32x4 g = *((const GAS f32x4*)gm + F.lane + 64 * j); v2u w; w.x = pk2(v[j].x * rs * g.x, v[j].y * rs * g.y); w.y = pk2(v[j].z * rs * g.z, v[j].w * rs * g.w); o8[64 * j] = w; } } }
}
__device__ __forceinline__ void p5_conv(Frame& F_, const Args& a) {
    Frame F = F_; asm volatile("" : "+v"(F.lane));
    const int gw = F.vcu * NWAVES + F.wave, NGW = F.G * NWAVES; unsigned char* ws = a.ws;
    const bf16* CU = (const bf16*)(ws + WS_CU); const bf16* BG = (const bf16*)(ws + WS_BG); bf16* MX = (bf16*)(ws + WS_MIXED); const float* cw = a.in[I_CONVW];
    for (int m = gw; m < M; m += NGW) { const int t = m & (SEQ - 1); float y[16]; float s = 0.f;
#pragma unroll
        for (int gsel = 0; gsel < 2; ++gsel) { const int ch = gsel * 512 + F.lane * 8;
            const v4u c0 = *(const GAS v4u*)(CU + (size_t)m * 1024 + ch); v4u c1 = (v4u){0u, 0u, 0u, 0u}, c2 = (v4u){0u, 0u, 0u, 0u};
            if (t >= 1) c1 = *(const GAS v4u*)(CU + (size_t)(m - 1) * 1024 + ch);
            if (t >= 2) c2 = *(const GAS v4u*)(CU + (size_t)(m - 2) * 1024 + ch);
            const v4u bg = *(const GAS v4u*)(BG + (size_t)m * 1024 + ch);
            const f32x4 w0a = *(const GAS f32x4*)(cw + ch), w0b = *(const GAS f32x4*)(cw + ch + 4), w1a = *(const GAS f32x4*)(cw + 1024 + ch), w1b = *(const GAS f32x4*)(cw + 1024 + ch + 4), w2a = *(const GAS f32x4*)(cw + 2048 + ch), w2b = *(const GAS f32x4*)(cw + 2048 + ch + 4);
#pragma unroll
            for (int e = 0; e < 4; ++e) { const unsigned x0 = c0[e], x1 = c1[e], x2 = c2[e], bw = bg[e];
                const float wl0 = e < 2 ? w0a[2 * e] : w0b[2 * e - 4], wh0 = e < 2 ? w0a[2 * e + 1] : w0b[2 * e - 3];
                const float wl1 = e < 2 ? w1a[2 * e] : w1b[2 * e - 4], wh1 = e < 2 ? w1a[2 * e + 1] : w1b[2 * e - 3];
                const float wl2 = e < 2 ? w2a[2 * e] : w2b[2 * e - 4], wh2 = e < 2 ? w2a[2 * e + 1] : w2b[2 * e - 3];
                const float lo = bflo(bw) * (wl0 * bflo(x2) + wl1 * bflo(x1) + wl2 * bflo(x0)), hi = bfhi(bw) * (wh0 * bfhi(x2) + wh1 * bfhi(x1) + wh2 * bfhi(x0));
                y[gsel * 8 + 2 * e] = lo; y[gsel * 8 + 2 * e + 1] = hi; s += lo * lo + hi * hi; } }
        const float rs = rsqrtf(wave_sum(s) * (1.0f / 1024.0f) + 1e-6f);
#pragma unroll
        for (int gsel = 0; gsel < 2; ++gsel) {
            if constexpr (((USE_FP8 >> 6) & 1) != 0) { const pg8::u32x2 o = pg8::pack8_f8((f32x4){y[gsel * 8 + 0], y[gsel * 8 + 1], y[gsel * 8 + 2], y[gsel * 8 + 3]} * rs, (f32x4){y[gsel * 8 + 4], y[gsel * 8 + 5], y[gsel * 8 + 6], y[gsel * 8 + 7]} * rs);
                *(GAS v2u*)((unsigned char*)MX + (size_t)m * 2048 + 1024 + gsel * 512 + F.lane * 8) = (v2u){o.x, o.y}; }
            else { v4u o; o.x = pk2(y[gsel * 8 + 0] * rs, y[gsel * 8 + 1] * rs); o.y = pk2(y[gsel * 8 + 2] * rs, y[gsel * 8 + 3] * rs); o.z = pk2(y[gsel * 8 + 4] * rs, y[gsel * 8 + 5] * rs); o.w = pk2(y[gsel * 8 + 6] * rs, y[gsel * 8 + 7] * rs);
                *(GAS v4u*)(MX + (size_t)m * 2048 + 1024 + gsel * 512 + F.lane * 8) = o; } } }
}
__device__ __forceinline__ void p12_final(Frame& F_, const Args& a) {
    Frame F = F_; asm volatile("" : "+v"(F.lane));
    const int gw = F.vcu * NWAVES + F.wave, NGW = F.G * NWAVES; const pg8::u64_t* ss4 = (const pg8::u64_t*)(a.ws + WS_CTL + CTL_SS) + 5 * M; const float* gf = a.in[I_FINAL]; const bf16* HB = (const bf16*)(a.ws + WS_HB);
    for (int m = gw; m < M; m += NGW) { GAS f32x4* xr = (GAS f32x4*)(a.out + (size_t)m * D); const GAS v4u* hr = (const GAS v4u*)(HB + (size_t)m * D) + F.lane; const float rs = rsqrtf(pg8::ss_val(ss4, m) * (1.0f / D) + 1e-6f);
#pragma unroll
        for (int j = 0; j < 4; ++j) { const v4u w = hr[64 * j]; const int c = (F.lane + 64 * j) * 8; const f32x4 g0 = *(const GAS f32x4*)(gf + c), g1 = *(const GAS f32x4*)(gf + c + 4);
            xr[(c >> 2)] = (f32x4){bflo(w.x), bfhi(w.x), bflo(w.y), bfhi(w.y)} * g0 * rs; xr[(c >> 2) + 1] = (f32x4){bflo(w.z), bfhi(w.z), bflo(w.w), bfhi(w.w)} * g1 * rs; } }
}
#ifndef DUP_MASK
#define DUP_MASK 0
#endif
#ifndef MOBA_SDEPTH
#define MOBA_SDEPTH 1
#endif
__global__ void __launch_bounds__(NWAVES * 64, 2) fwd_kernel(Args args) {
    extern __shared__ __attribute__((aligned(16))) unsigned char lds[];
    Frame F;
    F.lds = (LAS unsigned char*)lds;
    F.MISC = (volatile LAS unsigned*)(F.lds + MISC_OFF);
    F.tid = threadIdx.x; F.lane = F.tid & 63; F.wave = __builtin_amdgcn_readfirstlane(F.tid >> 6);
    F.G = gridDim.x; { const int bx = blockIdx.x; F.vcu = (F.G % 8 == 0) ? (bx % 8) * (F.G / 8) + bx / 8 : bx; }
    unsigned char* ws = args.ws;
    for (int u = F.tid; u < (LDS_BYTES - LDSCTL_OFF) / 4; u += NWAVES * 64) ((LAS unsigned*)(F.lds + LDSCTL_OFF))[u] = 0u;
    __syncthreads();
    const int lo = args.ph_lo, hi = args.ph_hi; const bool multi = (hi - lo) > 1;
    XcdBarrier bar; bar.bar = (unsigned*)(ws + WS_CTL + CTL_BAR + (size_t)lo * BAR_STRIDE); bar.x = 0; bar.st = nullptr;
    if (multi) bar = xcd_barrier_post((unsigned*)(ws + WS_CTL + CTL_BAR + (size_t)lo * BAR_STRIDE), F.MISC + 8);
#ifndef PH_ENABLE
#define PH_ENABLE 0x1fff
#endif
#define IN(k) ((((PH_ENABLE) >> (k)) & 1) && lo <= (k) && (k) < hi)
#define SEAM(k) do { if (IN(k) && IN((k) + 1)) xcd_barrier(bar); } while (0)
    pg8::u64_t* SS = (pg8::u64_t*)(ws + WS_CTL + CTL_SS);
    float* KMS = (float*)(ws + WS_CTL + CTL_KMS);
    bf16* HB = (bf16*)(ws + WS_HB); bf16* ACT = (bf16*)(ws + WS_ACT); bf16* MIXED = (bf16*)(ws + WS_MIXED);
    bf16* Qb = (bf16*)(ws + WS_Q); bf16* Kb = (bf16*)(ws + WS_K); bf16* Vb = (bf16*)(ws + WS_V); bf16* CUb = (bf16*)(ws + WS_CU); bf16* BGb = (bf16*)(ws + WS_BG);
    bf16* QX = (bf16*)(ws + WS_QX); bf16* OX = (bf16*)(ws + WS_OX); bf16* KVX = (bf16*)(ws + WS_KVX);
    const int bx = (int)blockIdx.x;

#ifndef F8_SP2
#define F8_SP2 PG8_SP2
#endif
#ifndef F8_ALIGN
#define F8_ALIGN PG8_ALIGN
#endif
#define GEMM_RUN(EPI, FP8FLAG, G_, S_, E_) pg8::gemm_phase<EPI, pg8::StaticOrder, (FP8FLAG) ? F8_ALIGN : PG8_ALIGN, (FP8FLAG) ? F8_SP2 : PG8_SP2, FP8FLAG>(F.lds + RING_OFF, G_, S_, E_)
#define DUPQ(k) (((DUP_MASK) >> (k)) & 1)
    pg8::u64_t* DUMMY = (pg8::u64_t*)(ws + WS_DUMMY);
    unsigned char* MIXED8 = ws + WS_MIXED; unsigned char* HB8 = ws + WS_HB8; unsigned char* ACT8 = ws + WS_ACT8; unsigned char* OX8 = ws + WS_OX8;
    constexpr bool F6 = ((USE_FP8 >> 6) & 1) != 0, F7 = ((USE_FP8 >> 7) & 1) != 0, F9 = ((USE_FP8 >> 9) & 1) != 0, F10 = ((USE_FP8 >> 10) & 1) != 0, F11 = ((USE_FP8 >> 11) & 1) != 0;
    constexpr float WSC = 1.0f / 64.0f;
    if (IN(0)) { p0_prologue(F, args); if (DUPQ(0)) p0_prologue(F, args); } SEAM(0);
    if (IN(1)) { pg8::Gemm g{HB, (const bf16*)(ws + WS_WGU1), M, 2 * FF, D}; pg8::StaticOrder S; S.init(M, 2 * FF, F.G, bx);
        typedef pg8::EpiSwiglu<false> EP; EP E{ACT, nullptr, FF, SS, 1.0f, 1.0f}; GEMM_RUN(EP, false, g, S, E); if (DUPQ(1)) GEMM_RUN(EP, false, g, S, E); } SEAM(1);
    if (IN(2)) { pg8::Gemm g{ACT, (const bf16*)(ws + WS_WD1), M, D, FF}; pg8::StaticOrder S; S.init(M, D, F.G, bx);
        typedef pg8::EpiResid<0, false, false> EP; EP E{args.in[I_X], nullptr, nullptr, HB, SS + M, 0.5f, nullptr, nullptr, 1.0f}; GEMM_RUN(EP, false, g, S, E);
        if (DUPQ(2)) { EP E2{args.in[I_X], nullptr, nullptr, HB, DUMMY, 0.5f, nullptr, nullptr, 1.0f}; GEMM_RUN(EP, false, g, S, E2); } } SEAM(2);
    if (IN(3)) { pg8::Gemm g{HB, (const bf16*)(ws + WS_WIN), M, INW, D}; pg8::StaticOrder S; S.init(M, INW, F.G, bx);
        pg8::EpiWin E{Qb, Kb, Vb, CUb, BGb, KMS, SS + M}; GEMM_RUN(pg8::EpiWin, false, g, S, E);
        if (DUPQ(3)) { pg8::EpiWin E2{Qb, Kb, Vb, CUb, BGb, (float*)DUMMY, SS + M}; GEMM_RUN(pg8::EpiWin, false, g, S, E2); } } SEAM(3);
    if (IN(4)) for (int rep = 0; rep < (DUPQ(4) ? 2 : 1); ++rep) {
        for (int u = F.vcu; u < BATCH * NH * 8; u += F.G) { const int b = u >> 6, h = (u >> 3) & 7, p = u & 7;
#pragma unroll 1
            for (int half = 0; half < 2; ++half) { const int qb = half ? 15 - p : p; const size_t r0 = (size_t)b * SEQ + (size_t)qb * 256;
                if constexpr (F6) att::attn_body<true, 1024, 1024, 2048, MOBA_SDEPTH, unsigned char, 32>(Qb + r0 * 1024 + h * 128, Kb + (size_t)b * SEQ * 1024 + h * 128, Vb + (size_t)b * SEQ * 1024 + h * 128, MIXED8 + r0 * 2048 + h * 128,
                                                       256 * (qb + 1), (att::lptr)(F.lds + RING_OFF), qb, KMS + ((size_t)b * 16 * 8 + h) * 128, 8 * 128, (rep ? DUMMY : SS + 2 * M) + r0);
                else att::attn_body<true, 1024, 1024, 2048, MOBA_SDEPTH, bf16, 1>(Qb + r0 * 1024 + h * 128, Kb + (size_t)b * SEQ * 1024 + h * 128, Vb + (size_t)b * SEQ * 1024 + h * 128, MIXED + r0 * 2048 + h * 128,
                                                       256 * (qb + 1), (att::lptr)(F.lds + RING_OFF), qb, KMS + ((size_t)b * 16 * 8 + h) * 128, 8 * 128, (rep ? DUMMY : SS + 2 * M) + r0); } } }
    if (IN(5)) { p5_conv(F, args); if (DUPQ(5)) p5_conv(F, args); } SEAM(5);
    if (IN(6)) { pg8::Gemm g{F6 ? (const bf16*)MIXED8 : MIXED, (const bf16*)(ws + WS_WOUT), M, D, D}; pg8::StaticOrder S; S.init(M, D, F.G, bx);
        typedef pg8::EpiResid<F6 ? 8 : 16, true, false> EP; EP E{nullptr, HB, nullptr, HB, SS + 3 * M, F6 ? WSC : 1.0f, SS + 2 * M, F7 ? HB8 : nullptr, F6 ? 1.0f / 32.0f : 1.0f}; GEMM_RUN(EP, F6, g, S, E);
        if (DUPQ(6)) { EP E2{nullptr, HB, nullptr, HB, DUMMY, 0.0f, SS + 2 * M, F7 ? HB8 : nullptr, F6 ? 1.0f / 32.0f : 1.0f}; GEMM_RUN(EP, F6, g, S, E2); } } SEAM(6);
    if (IN(7)) for (int rep = 0; rep < (DUPQ(7) ? 2 : 1); ++rep) {
        { pg8::Gemm g{F7 ? (const bf16*)HB8 : HB, (const bf16*)(ws + WS_WQ), M, XW, D}; pg8::StaticOrder S; S.init(M, XW, F.G, bx);
          pg8::EpiScaleBf16 E{QX, XW, SS + 3 * M, F7 ? WSC : 1.0f}; GEMM_RUN(pg8::EpiScaleBf16, F7, g, S, E); }
        { pg8::Gemm g{(const bf16*)(ws + WS_MEMN), (const bf16*)(ws + WS_WKV), BATCH * MEML, 1024, D}; pg8::StaticOrder S; S.init(BATCH * MEML, 1024, F.G, (bx + F.G - 128) % F.G);
          pg8::EpiScaleBf16 E{KVX, 1024, nullptr, 1.0f}; GEMM_RUN(pg8::EpiScaleBf16, false, g, S, E); } } SEAM(7);
    if (IN(8)) for (int rep = 0; rep < (DUPQ(8) ? 2 : 1); ++rep) {
        for (int u = F.vcu; u < BATCH * XH * 16; u += F.G) { const int b = u >> 6, h = (u >> 4) & 3, qb = u & 15; const size_t r0 = (size_t)b * SEQ + (size_t)qb * 256;
            if constexpr (F9) att::attn_body<false, 512, 1024, 512, 2, unsigned char, 16>(QX + r0 * 512 + h * 128, KVX + (size_t)b * MEML * 1024 + h * 128, KVX + (size_t)b * MEML * 1024 + 512 + h * 128, OX8 + r0 * 512 + h * 128,
                                                  MEML, (att::lptr)(F.lds + RING_OFF), 0, nullptr, 0, nullptr);
            else att::attn_body<false, 512, 1024, 512, 2, bf16, 1>(QX + r0 * 512 + h * 128, KVX + (size_t)b * MEML * 1024 + h * 128, KVX + (size_t)b * MEML * 1024 + 512 + h * 128, OX + r0 * 512 + h * 128,
                                                  MEML, (att::lptr)(F.lds + RING_OFF), 0, nullptr, 0, nullptr); } } SEAM(8);
    if (IN(9)) { pg8::Gemm g{F9 ? (const bf16*)OX8 : OX, (const bf16*)(ws + WS_WO), M, D, XW}; pg8::StaticOrder S; S.init(M, D, F.G, bx);
        typedef pg8::EpiResid<0, true, false> EP; EP E{nullptr, HB, nullptr, HB, SS + 4 * M, F9 ? WSC / 16.0f : 1.0f, nullptr, F10 ? HB8 : nullptr, 1.0f}; GEMM_RUN(EP, F9, g, S, E);
        if (DUPQ(9)) { EP E2{nullptr, HB, nullptr, HB, DUMMY, 0.0f, nullptr, F10 ? HB8 : nullptr, 1.0f}; GEMM_RUN(EP, F9, g, S, E2); } } SEAM(9);
    if (IN(10)) { pg8::Gemm g{F10 ? (const bf16*)HB8 : HB, (const bf16*)(ws + WS_WGU2), M, 2 * FF, D}; pg8::StaticOrder S; S.init(M, 2 * FF, F.G, bx);
        typedef pg8::EpiSwiglu<F11> EP; EP E{ACT, ACT8, FF, SS + 4 * M, F10 ? WSC : 1.0f, 4.0f}; GEMM_RUN(EP, F10, g, S, E); if (DUPQ(10)) GEMM_RUN(EP, F10, g, S, E); } SEAM(10);
    if (IN(11)) { pg8::Gemm g{F11 ? (const bf16*)ACT8 : ACT, (const bf16*)(ws + WS_WD2), M, D, FF}; pg8::StaticOrder S; S.init(M, D, F.G, bx);
        typedef pg8::EpiResid<0, true, false> EP; EP E{nullptr, HB, nullptr, HB, SS + 5 * M, F11 ? 0.5f * WSC / 4.0f : 0.5f, nullptr, nullptr, 1.0f}; GEMM_RUN(EP, F11, g, S, E);
        if (DUPQ(11)) { EP E2{nullptr, HB, nullptr, HB, DUMMY, 0.0f, nullptr, nullptr, 1.0f}; GEMM_RUN(EP, F11, g, S, E2); } } SEAM(11);
    if (IN(12)) { p12_final(F, args); }
#undef GEMM_RUN
#undef DUPQ
#undef IN
#undef SEAM
}

extern "C" void kernel_launch(void* const* d_in, const int* in_sizes, int n_in, void* d_out, int out_size, void* d_ws, size_t ws_size, hipStream_t stream) {
    static int grid = 0;
    if (grid == 0) {
        if (n_in != 22 || in_sizes[0] != M * D || out_size != M * D || ws_size < WS_END) { fprintf(stderr, "kernel_launch: shape mismatch (n_in %d, in0 %d, out %d, ws %zu; need ws >= %zu); nothing launched\n", n_in, n_in > 0 ? in_sizes[0] : -1, out_size, ws_size, (size_t)WS_END); grid = -1; return; }
        int dev = 0, cus = 0, per_cu = 0;
        if (hipGetDevice(&dev) != hipSuccess || hipDeviceGetAttribute(&cus, hipDeviceAttributeMultiprocessorCount, dev) != hipSuccess) { grid = -1; return; }
        if (hipFuncSetAttribute((const void*)fwd_kernel, hipFuncAttributeMaxDynamicSharedMemorySize, LDS_BYTES) != hipSuccess) { fprintf(stderr, "kernel_launch: hipFuncSetAttribute failed\n"); grid = -1; return; }
        if (hipOccupancyMaxActiveBlocksPerMultiprocessor(&per_cu, (const void*)fwd_kernel, NWAVES * 64, LDS_BYTES) != hipSuccess || per_cu < 1) { fprintf(stderr, "kernel_launch: occupancy query reports %d workgroups per CU\n", per_cu); }
        (void)hipGetLastError();
        grid = cus;
    }
    if (grid < 0) return;
    if (hipMemsetAsync((char*)d_ws + WS_CTL, 0, CTL_ZERO_BYTES, stream) != hipSuccess) { fprintf(stderr, "kernel_launch: hipMemsetAsync failed\n"); return; }
    Args a{};
    for (int i = 0; i < 22; ++i) a.in[i] = (const float*)d_in[i];
    a.out = (float*)d_out; a.ws = (unsigned char*)d_ws;
    unsigned char* ws = (unsigned char*)d_ws; pg8::u64_t* SS = (pg8::u64_t*)(ws + WS_CTL + CTL_SS); float* KMS = (float*)(ws + WS_CTL + CTL_KMS); float* out = (float*)d_out;
    bf16* HB = (bf16*)(ws + WS_HB); bf16* ACT = (bf16*)(ws + WS_ACT); bf16* MIXED = (bf16*)(ws + WS_MIXED);
    bf16* Qb = (bf16*)(ws + WS_Q); bf16* Kb = (bf16*)(ws + WS_K); bf16* Vb = (bf16*)(ws + WS_V); bf16* CUb = (bf16*)(ws + WS_CU); bf16* BGb = (bf16*)(ws + WS_BG);
    bf16* QX = (bf16*)(ws + WS_QX); bf16* OX = (bf16*)(ws + WS_OX); bf16* KVX = (bf16*)(ws + WS_KVX);
    (void)SS; (void)KMS; (void)out; (void)HB; (void)ACT; (void)MIXED; (void)Qb; (void)Kb; (void)Vb; (void)CUb; (void)BGb; (void)QX; (void)OX; (void)KVX;
#if ONE_LAUNCH
    a.ph_lo = 0; a.ph_hi = NPH;
    hipLaunchKernelGGL(fwd_kernel, dim3(grid), dim3(NWAVES * 64), LDS_BYTES, stream, a);
#else
    for (int ph = 0; ph < NPH; ++ph) {
        if ((FAST_MASK >> ph) & 1) { a.ph_lo = ph; a.ph_hi = ph + 1; hipLaunchKernelGGL(fwd_kernel, dim3(grid), dim3(NWAVES * 64), LDS_BYTES, stream, a); continue; }
        switch (ph) {
        case 1: hipLaunchKernelGGL((nv::gemm<nv::FSwiglu>), dim3(FF / 64, M / 64), dim3(256), 0, stream, HB, (const bf16*)(ws + WS_WGU1), D, nv::FSwiglu{ACT, SS}); break;
        case 2: hipLaunchKernelGGL((nv::gemm<nv::FResid<0, false, false>>), dim3(D / 64, M / 64), dim3(256), 0, stream, ACT, (const bf16*)(ws + WS_WD1), FF, nv::FResid<0, false, false>{a.in[I_X], nullptr, nullptr, HB, SS + M, 0.5f, nullptr}); break;
        case 3: hipLaunchKernelGGL((nv::gemm<nv::FWin>), dim3(5120 / 64, M / 64), dim3(256), 0, stream, HB, (const bf16*)(ws + WS_WIN), D, nv::FWin{Qb, Kb, Vb, CUb, BGb, SS + M});
                hipLaunchKernelGGL(nv::kmean, dim3(BATCH * 16 * 8 * 128 / 256), dim3(256), 0, stream, Kb, KMS); break;
        case 4: hipLaunchKernelGGL(nv::moba, dim3(M * NH / 4), dim3(256), 0, stream, Qb, Kb, Vb, KMS, MIXED, SS + 2 * M); break;
        case 6: hipLaunchKernelGGL((nv::gemm<nv::FResid<1024, true, false>>), dim3(D / 64, M / 64), dim3(256), 0, stream, MIXED, (const bf16*)(ws + WS_WOUT), D, nv::FResid<1024, true, false>{nullptr, HB, nullptr, HB, SS + 3 * M, 1.0f, SS + 2 * M}); break;
        case 7: hipLaunchKernelGGL((nv::gemm<nv::FScale>), dim3(XW / 64, M / 64), dim3(256), 0, stream, HB, (const bf16*)(ws + WS_WQ), D, nv::FScale{QX, XW, SS + 3 * M});
                hipLaunchKernelGGL((nv::gemm<nv::FScale>), dim3(1024 / 64, BATCH * MEML / 64), dim3(256), 0, stream, (const bf16*)(ws + WS_MEMN), (const bf16*)(ws + WS_WKV), D, nv::FScale{KVX, 1024, nullptr}); break;
        case 8: hipLaunchKernelGGL(nv::xattn, dim3(M * XH / 4), dim3(256), 0, stream, QX, KVX, OX); break;
        case 9: hipLaunchKernelGGL((nv::gemm<nv::FResid<0, true, false>>), dim3(D / 64, M / 64), dim3(256), 0, stream, OX, (const bf16*)(ws + WS_WO), XW, nv::FResid<0, true, false>{nullptr, HB, nullptr, HB, SS + 4 * M, 1.0f, nullptr}); break;
        case 10: hipLaunchKernelGGL((nv::gemm<nv::FSwiglu>), dim3(FF / 64, M / 64), dim3(256), 0, stream, HB, (const bf16*)(ws + WS_WGU2), D, nv::FSwiglu{ACT, SS + 4 * M}); break;
        case 11: hipLaunchKernelGGL((nv::gemm<nv::FResid<0, true, false>>), dim3(D / 64, M / 64), dim3(256), 0, stream, ACT, (const bf16*)(ws + WS_WD2), FF, nv::FResid<0, true, false>{nullptr, HB, nullptr, HB, SS + 5 * M, 0.5f, nullptr}); break;
        default: break;
        }
    }
#endif
    const hipError_t le = hipPeekAtLastError();
    if (le != hipSuccess) fprintf(stderr, "kernel_launch: launch failed: %s\n", hipGetErrorName(le));
}
```

```cpp
#define ONE_LAUNCH 1
#define FAST_MASK 0x1fff
#define USE_FP8 0xEC8
#include <hip/hip_runtime.h>
#include <cstdio>
#include <cstdint>
namespace pg8 {
#define PG8_LAS __attribute__((address_space(3)))
typedef unsigned short bf16_t;
typedef short bf16x8 __attribute__((ext_vector_type(8)));
typedef float f32x4 __attribute__((ext_vector_type(4)));
typedef unsigned u32x4 __attribute__((ext_vector_type(4)));
typedef int i32x4 __attribute__((ext_vector_type(4)));
typedef int i32x8 __attribute__((ext_vector_type(8)));
typedef unsigned u32x2 __attribute__((ext_vector_type(2)));
constexpr int BM = 256, BK = 64, HALF = 128, HTB = HALF * BK * 2  , STAGE_BYTES = 8 * HTB, NXCD = 8, WGM = 8;

__host__ __device__ __forceinline__ int lds_byte(int r, int c) { const int st = (r >> 4) * 2 + (c >> 5), rr = r & 15, cc = c & 31, ob = rr * 64 + cc * 2; return st * 1024 + (ob ^ (((ob >> 9) & 1) << 5)); }
__host__ __device__ __forceinline__ void stage_rc(int b, int& R, int& C) { const int st = b / 1024, sb = b % 1024, swz = sb ^ (((sb >> 9) & 1) << 5); R = (st >> 1) * 16 + swz / 64; C = (st & 1) * 32 + (swz % 64) / 2; }
__host__ __device__ __forceinline__ int perm32(int rho) { const int n = rho >> 4, i = rho & 15; return 8 * (i >> 2) + 4 * n + (i & 3); }

struct Unit { int pm, pn; };
struct Gemm { const bf16_t* A; const bf16_t* Bt; int M, N, K; };

struct StaticOrder {
    int nM, nN, nwg, G, c;
    __host__ __device__ void init(int M, int N, int G_, int c_) { nM = M / BM; nN = N / BM; nwg = nM * nN; G = G_; c = c_; }
    __host__ __device__ bool next(int i, Unit& u) const {
        const long L = (long)i * G + c; if (L >= nwg) return false;
        int wgid = (int)L; { const int q = nwg / NXCD, r = nwg % NXCD, xcd = wgid % NXCD, off = wgid / NXCD; wgid = (xcd < r ? xcd * (q + 1) : r * (q + 1) + (xcd - r) * q) + off; }
        const int nig = WGM * nN, gid = wgid / nig, fm = gid * WGM, gsz = (nM - fm) < WGM ? (nM - fm) : WGM;
        u.pm = fm + ((wgid % nig) % gsz); u.pn = (wgid % nig) / gsz; return true;
    }
    __device__ __forceinline__ void a_ready(const Unit&) const {}
    __device__ __forceinline__ void done(const Unit&) const {}
};

__device__ __forceinline__ unsigned cvt_pk_bf16(float lo, float hi) { unsigned r; asm volatile("v_cvt_pk_bf16_f32 %0, %1, %2" : "=v"(r) : "v"(lo), "v"(hi)); return r; }
__device__ __forceinline__ u32x4 pack8(const f32x4 v0, const f32x4 v1) { u32x4 w; w.x = cvt_pk_bf16(v0[0], v0[1]); w.y = cvt_pk_bf16(v0[2], v0[3]); w.z = cvt_pk_bf16(v1[0], v1[1]); w.w = cvt_pk_bf16(v1[2], v1[3]); return w; }
constexpr float RMS_EPS = 1e-6f;
typedef unsigned long long u64_t;
__device__ __forceinline__ float ss_val(const u64_t* ss, int row) { return (float)ss[row] * (1.0f / 65536.0f); }
__device__ __forceinline__ void ss_add(u64_t* ss, int row, float sq) { atomicAdd(ss + row, (u64_t)(unsigned)(sq * 65536.0f + 0.5f)); }
__device__ __forceinline__ float clamp_f8(float x) { return __builtin_amdgcn_fmed3f(x, -448.0f, 448.0f); }
__device__ __forceinline__ u32x2 pack8_f8(const f32x4 v0, const f32x4 v1) { int a = __builtin_amdgcn_cvt_pk_fp8_f32(clamp_f8(v0[0]), clamp_f8(v0[1]), 0, false); a = __builtin_amdgcn_cvt_pk_fp8_f32(clamp_f8(v0[2]), clamp_f8(v0[3]), a, true);
    int b = __builtin_amdgcn_cvt_pk_fp8_f32(clamp_f8(v1[0]), clamp_f8(v1[1]), 0, false); b = __builtin_amdgcn_cvt_pk_fp8_f32(clamp_f8(v1[2]), clamp_f8(v1[3]), b, true); u32x2 w; w.x = (unsigned)a; w.y = (unsigned)b; return w; }
__device__ __forceinline__ float silu_mul(float g, float u) { return g * u * __builtin_amdgcn_rcpf(1.0f + __builtin_amdgcn_exp2f(-1.4426950408889634f * g)); }

template <bool F8OUT> struct EpiSwiglu {
    static constexpr bool PERM = true, AFTER_DRAIN = false; static constexpr int MIDT = 0;
    bf16_t* O; unsigned char* O8; int ldo; const u64_t* ss; float asc, osc;
    __device__ __forceinline__ void mid(f32x4 (&)[2][2][4][2], const Unit&, int, int) const {}
    __device__ __forceinline__ void operator()(const f32x4 (&acc)[2][2][4][2], const Unit& u, int wr, int wc, int fr_, int fq_) const {
        int fr = fr_, fq = fq_; asm volatile("" : "+v"(fr), "+v"(fq));
        const int row0 = u.pm * BM + wr * 64 + fr, col0 = u.pn * HALF + wc * 32 + 8 * fq;
#pragma unroll
        for (int ai = 0; ai < 2; ++ai)
#pragma unroll
            for (int m = 0; m < 4; ++m) { const int row = row0 + ai * HALF + m * 16; const float rs = asc * rsqrtf(ss_val(ss, row) * (1.0f / 2048.0f) + RMS_EPS);
                f32x4 o0, o1;
#pragma unroll
                for (int j = 0; j < 4; ++j) { o0[j] = silu_mul(acc[ai][0][m][0][j] * rs, acc[ai][1][m][0][j] * rs); o1[j] = silu_mul(acc[ai][0][m][1][j] * rs, acc[ai][1][m][1][j] * rs); }
                if constexpr (F8OUT) *(u32x2*)(O8 + (size_t)row * ldo + col0) = pack8_f8(o0 * osc, o1 * osc);
                else *(u32x4*)(O + (size_t)row * ldo + col0) = pack8(o0, o1); }
    }
};
template <int MIDT_, bool RBF, bool OF32> struct EpiResid {
    static constexpr bool PERM = true, AFTER_DRAIN = false; static constexpr int MIDT = MIDT_;
    const float* R; const bf16_t* RB; float* H; bf16_t* HB; u64_t* ssn; float alpha; const u64_t* midss; unsigned char* HB8; float midmul;
    __device__ __forceinline__ void mid(f32x4 (&acc)[2][2][4][2], const Unit& u, int wr, int fr) const {
        const int row0 = u.pm * BM + wr * 64 + fr;
#pragma unroll
        for (int ai = 0; ai < 2; ++ai)
#pragma unroll
            for (int m = 0; m < 4; ++m) { const float s = midmul * rsqrtf(ss_val(midss, row0 + ai * HALF + m * 16) * (1.0f / 1024.0f) + RMS_EPS);
#pragma unroll
                for (int bj = 0; bj < 2; ++bj)
#pragma unroll
                    for (int n = 0; n < 2; ++n) acc[ai][bj][m][n] = acc[ai][bj][m][n] * s; }
    }
    __device__ __forceinline__ void operator()(const f32x4 (&acc)[2][2][4][2], const Unit& u, int wr, int wc, int fr_, int fq_) const {
        int fr = fr_, fq = fq_; asm volatile("" : "+v"(fr), "+v"(fq));
        const int row0 = u.pm * BM + wr * 64 + fr, col0 = u.pn * BM + wc * 32 + 8 * fq;
#pragma unroll
        for (int ai = 0; ai < 2; ++ai)
#pragma unroll
            for (int m = 0; m < 4; ++m) { const int row = row0 + ai * HALF + m * 16; const size_t off = (size_t)row * 2048 + col0; float sq = 0.f;
#pragma unroll
                for (int bj = 0; bj < 2; ++bj) { f32x4 r0, r1;
                    if constexpr (RBF) { const u32x4 w = *(const u32x4*)(RB + off + bj * HALF);
                        r0 = (f32x4){__uint_as_float(w.x << 16), __uint_as_float(w.x & 0xffff0000u), __uint_as_float(w.y << 16), __uint_as_float(w.y & 0xffff0000u)};
                        r1 = (f32x4){__uint_as_float(w.z << 16), __uint_as_float(w.z & 0xffff0000u), __uint_as_float(w.w << 16), __uint_as_float(w.w & 0xffff0000u)}; }
                    else { r0 = *(const f32x4*)(R + off + bj * HALF); r1 = *(const f32x4*)(R + off + bj * HALF + 4); }
                    const f32x4 h0 = r0 + acc[ai][bj][m][0] * alpha, h1 = r1 + acc[ai][bj][m][1] * alpha;
                    if constexpr (OF32) { *(f32x4*)(H + off + bj * HALF) = h0; *(f32x4*)(H + off + bj * HALF + 4) = h1; }
                    else { *(u32x4*)(HB + off + bj * HALF) = pack8(h0, h1); if (HB8) *(u32x2*)(HB8 + off + bj * HALF) = pack8_f8(h0, h1); }
                    sq += (h0[0] * h0[0] + h0[1] * h0[1]) + (h0[2] * h0[2] + h0[3] * h0[3]) + (h1[0] * h1[0] + h1[1] * h1[1]) + (h1[2] * h1[2] + h1[3] * h1[3]); }
                sq += __shfl_xor(sq, 16); sq += __shfl_xor(sq, 32);
                if (fq == 0) ss_add(ssn, row, sq);
                asm volatile("" ::: "memory"); }
    }
};
struct EpiWin {
    static constexpr bool PERM = true, AFTER_DRAIN = false; static constexpr int MIDT = 0;
    bf16_t *Q, *K, *V, *CU, *BG; float* kms; const u64_t* ss; int pn_off; float asc;
    __device__ __forceinline__ void mid(f32x4 (&)[2][2][4][2], const Unit&, int, int) const {}
    __device__ __forceinline__ void operator()(const f32x4 (&acc)[2][2][4][2], const Unit& u, int wr, int wc, int fr_, int fq_) const {
        int fr = fr_, fq = fq_; asm volatile("" : "+v"(fr), "+v"(fq));
        const int row0 = u.pm * BM + wr * 64 + fr, pn = u.pn + pn_off;
        if (pn >= 12 && pn < 20) {
            const int col0 = (pn - 12) * HALF + wc * 32 + 8 * fq;
#pragma unroll
            for (int ai = 0; ai < 2; ++ai)
#pragma unroll
                for (int m = 0; m < 4; ++m) { const int row = row0 + ai * HALF + m * 16; float rs = asc * rsqrtf(ss_val(ss, row) * (1.0f / 2048.0f) + RMS_EPS); rs = rs * rs;
                    const f32x4 o0 = acc[ai][0][m][0] * acc[ai][1][m][0] * rs, o1 = acc[ai][0][m][1] * acc[ai][1][m][1] * rs;
                    *(u32x4*)(CU + (size_t)row * 1024 + col0) = pack8(o0, o1); }
        } else {
            bf16_t* base = pn < 4 ? Q : pn < 8 ? K : pn < 12 ? V : BG; const int colt = (pn & 3) * BM, col0 = colt + wc * 32 + 8 * fq; const bool isk = (pn >= 4 && pn < 8);
            float rsv[2][4];
#pragma unroll
            for (int ai = 0; ai < 2; ++ai)
#pragma unroll
                for (int m = 0; m < 4; ++m) rsv[ai][m] = asc * rsqrtf(ss_val(ss, row0 + ai * HALF + m * 16) * (1.0f / 2048.0f) + RMS_EPS);
#pragma unroll
            for (int ai = 0; ai < 2; ++ai)
#pragma unroll
                for (int m = 0; m < 4; ++m) { const int row = row0 + ai * HALF + m * 16;
#pragma unroll
                    for (int bj = 0; bj < 2; ++bj) *(u32x4*)(base + (size_t)row * 1024 + col0 + bj * HALF) = pack8(acc[ai][bj][m][0] * rsv[ai][m], acc[ai][bj][m][1] * rsv[ai][m]); }
            if (isk) {
#pragma unroll
                for (int bj = 0; bj < 2; ++bj)
#pragma unroll
                    for (int n = 0; n < 2; ++n) { f32x4 c = (f32x4){0.f, 0.f, 0.f, 0.f};
#pragma unroll
                        for (int ai = 0; ai < 2; ++ai)
#pragma unroll
                            for (int m = 0; m < 4; ++m) { float r2 = rsv[ai][m]; asm volatile("" : "+v"(r2)); c += acc[ai][bj][m][n] * r2; }
#pragma unroll
                        for (int j = 0; j < 4; ++j) { float v = c[j]; v += __shfl_xor(v, 1); v += __shfl_xor(v, 2); v += __shfl_xor(v, 4); v += __shfl_xor(v, 8);
                            const int col = col0 + bj * HALF + 4 * n + j;
                            if (fr == 0) unsafeAtomicAdd(kms + ((size_t)u.pm * 8 + (col >> 7)) * 128 + (col & 127), v); }
                        asm volatile("" ::: "memory"); }
            }
        }
    }
};
struct EpiScaleBf16 {
    static constexpr bool PERM = true, AFTER_DRAIN = false; static constexpr int MIDT = 0;
    bf16_t* O; int ldo; const u64_t* ss; float asc;
    __device__ __forceinline__ void mid(f32x4 (&)[2][2][4][2], const Unit&, int, int) const {}
    __device__ __forceinline__ void operator()(const f32x4 (&acc)[2][2][4][2], const Unit& u, int wr, int wc, int fr_, int fq_) const {
        int fr = fr_, fq = fq_; asm volatile("" : "+v"(fr), "+v"(fq));
        const int row0 = u.pm * BM + wr * 64 + fr, col0 = u.pn * BM + wc * 32 + 8 * fq;
#pragma unroll
        for (int ai = 0; ai < 2; ++ai)
#pragma unroll
            for (int m = 0; m < 4; ++m) { const int row = row0 + ai * HALF + m * 16; const float rs = asc * (ss ? rsqrtf(ss_val(ss, row) * (1.0f / 2048.0f) + RMS_EPS) : 1.0f);
#pragma unroll
                for (int bj = 0; bj < 2; ++bj) *(u32x4*)(O + (size_t)row * ldo + col0 + bj * HALF) = pack8(acc[ai][bj][m][0] * rs, acc[ai][bj][m][1] * rs); }
    }
};

template <class Epi, class Sched, bool ALIGN_EPI = false, bool SP2 = false, bool FP8 = false>
__device__ __forceinline__ void gemm_phase(PG8_LAS unsigned char* lds, const Gemm g, const Sched& S, const Epi& E) {
    int tid_ = threadIdx.x; asm volatile("" : "+v"(tid_));
    const int tid = tid_, wid = __builtin_amdgcn_readfirstlane(tid >> 6), lane = tid & 63, wr = wid >> 2, wc = wid & 3, fr = lane & 15, fq = lane >> 4;
    const int KB = FP8 ? g.K : g.K * 2, nt = KB / (BK * 2);
    unsigned voffA[2], voffB[2];
#pragma unroll
    for (int i = 0; i < 2; ++i) { int R, C; stage_rc(tid * 16 + i * 8192, R, C); const int Rb = Epi::PERM ? ((R & ~31) + perm32(R & 31)) : R;
        voffA[i] = (unsigned)(R * KB + C * 2); voffB[i] = (unsigned)(Rb * KB + C * 2); }
    const size_t kstep = (size_t)(BK * 2);
    const size_t hstep = (size_t)HALF * KB;
    const size_t tstep = 2 * hstep;
    const unsigned ldsw = (unsigned)wid * 1024u;
    const int aoff = lds_byte(wr * 64 + fr, fq * 8), boff = lds_byte(wc * 32 + fr, fq * 8);
#define PG8_SA(b, h) (((b) * 2 + (h)) * HTB)
#define PG8_SB(b, h) ((4 + (b) * 2 + (h)) * HTB)
#define PG8_STAGE(bufoff, gbase, voff) do { _Pragma("unroll") for (int _i = 0; _i < 2; ++_i) \
        __builtin_amdgcn_global_load_lds((const unsigned*)((const char*)(gbase) + (voff)[_i]), (PG8_LAS unsigned*)(lds + (bufoff) + ldsw + _i * 8192), 16, 0, 0); } while (0)
#define PG8_LDA(dst, b, h) do { _Pragma("unroll") for (int m = 0; m < 4; ++m) _Pragma("unroll") for (int k = 0; k < 2; ++k) dst[m][k] = *(const PG8_LAS bf16x8*)(lds + PG8_SA(b, h) + aoff + m * 2048 + k * 1024); } while (0)
#define PG8_LDB(dst, b, h) do { _Pragma("unroll") for (int n = 0; n < 2; ++n) _Pragma("unroll") for (int k = 0; k < 2; ++k) dst[n][k] = *(const PG8_LAS bf16x8*)(lds + PG8_SB(b, h) + boff + n * 2048 + k * 1024); } while (0)
#define PG8_CAT(x) __builtin_shufflevector(__builtin_bit_cast(i32x4, (x)[0]), __builtin_bit_cast(i32x4, (x)[1]), 0, 1, 2, 3, 4, 5, 6, 7)
#define PG8_MMA(ai, bj, At, Bt) do { __builtin_amdgcn_s_setprio(1); _Pragma("unroll") for (int m = 0; m < 4; ++m) _Pragma("unroll") for (int n = 0; n < 2; ++n) { \
        if constexpr (FP8) { const i32x8 b8_ = PG8_CAT(Bt[n]), a8_ = PG8_CAT(At[m]); asm volatile("v_mfma_f32_16x16x128_f8f6f4 %0, %1, %2, %0" : "+v"(acc[ai][bj][m][n]) : "v"(b8_), "v"(a8_)); }   \
        else { _Pragma("unroll") for (int k = 0; k < 2; ++k) acc[ai][bj][m][n] = __builtin_amdgcn_mfma_f32_16x16x32_bf16(Bt[n][k], At[m][k], acc[ai][bj][m][n], 0, 0, 0); } } __builtin_amdgcn_s_setprio(0); } while (0)
#define PG8_WAIT_V(n) asm volatile("s_waitcnt vmcnt(" #n ")" ::: "memory")
#define PG8_WAIT_L(n) asm volatile("s_waitcnt lgkmcnt(" #n ")" ::: "memory")
#define PG8_BAR __builtin_amdgcn_s_barrier()
#define PG8_SCHED __builtin_amdgcn_sched_barrier(0)
    Unit cur, nxt; int ui = 0;
    if (!S.next(0, cur)) return;
    f32x4 acc[2][2][4][2];
#pragma unroll
    for (int a = 0; a < 2; ++a)
#pragma unroll
        for (int b = 0; b < 2; ++b)
#pragma unroll
            for (int m = 0; m < 4; ++m)
#pragma unroll
                for (int n = 0; n < 2; ++n) acc[a][b][m][n] = (f32x4){0.f, 0.f, 0.f, 0.f};
    bf16x8 At[4][2], B0[2][2], B1[2][2];
    const char* cA = (const char*)g.A + (size_t)cur.pm * tstep; const char* cB = (const char*)g.Bt + (size_t)cur.pn * tstep;
    S.a_ready(cur);
    if constexpr (SP2) {
        PG8_STAGE(PG8_SB(0, 0), cB, voffB); PG8_STAGE(PG8_SB(0, 1), cB + hstep, voffB); PG8_STAGE(PG8_SA(0, 0), cA, voffA); PG8_STAGE(PG8_SA(0, 1), cA + hstep, voffA);
        if (wr == 1) PG8_BAR;
        PG8_WAIT_V(2); PG8_BAR;
        PG8_STAGE(PG8_SB(1, 0), cB + kstep, voffB); PG8_STAGE(PG8_SA(1, 0), cA + kstep, voffA); PG8_STAGE(PG8_SB(1, 1), cB + hstep + kstep, voffB);
        PG8_WAIT_V(6); PG8_BAR;
    } else {
        PG8_STAGE(PG8_SB(0, 0), cB, voffB); PG8_STAGE(PG8_SA(0, 0), cA, voffA); PG8_STAGE(PG8_SB(0, 1), cB + hstep, voffB); PG8_STAGE(PG8_SA(0, 1), cA + hstep, voffA);
        if (wr == 1) PG8_BAR;
        PG8_WAIT_V(4); PG8_BAR;
        PG8_STAGE(PG8_SB(1, 0), cB + kstep, voffB); PG8_STAGE(PG8_SA(1, 0), cA + kstep, voffA); PG8_STAGE(PG8_SB(1, 1), cB + hstep + kstep, voffB);
        PG8_WAIT_V(6); PG8_BAR;
    }
    for (;;) {
        const bool has_next = S.next(ui + 1, nxt);
        const char* nA = has_next ? (const char*)g.A + (size_t)nxt.pm * tstep : cA; const char* nB = has_next ? (const char*)g.Bt + (size_t)nxt.pn * tstep : cB;
        for (int t = 0; t < nt; t += 2) {
            if constexpr (Epi::MIDT > 0) { if (t == Epi::MIDT) {
                if constexpr (FP8) { asm volatile("s_nop 15\n\ts_nop 15" ::: "memory");
#pragma unroll
                    for (int a = 0; a < 2; ++a)
#pragma unroll
                        for (int b = 0; b < 2; ++b)
#pragma unroll
                            for (int m = 0; m < 4; ++m)
#pragma unroll
                                for (int n = 0; n < 2; ++n) asm volatile("" : "+v"(acc[a][b][m][n])); }
                E.mid(acc, cur, wr, fr); } }
            const bool last = (t == nt - 2);
            const char* a1 = cA + (size_t)(t + 1) * kstep;
            const char* a2 = last ? nA : cA + (size_t)(t + 2) * kstep; const char* b2 = last ? nB : cB + (size_t)(t + 2) * kstep;
            const char* a3 = a2 + kstep; const char* b3 = b2 + kstep;
            if (last && has_next) S.a_ready(nxt);
            if constexpr (SP2) {
            PG8_LDB(B0, 0, 0); PG8_LDB(B1, 0, 1); PG8_SCHED; PG8_LDA(At, 0, 0); PG8_STAGE(PG8_SA(1, 1), a1 + hstep, voffA);
            PG8_WAIT_V(8); PG8_WAIT_L(0); PG8_BAR; PG8_MMA(0, 0, At, B0); PG8_MMA(0, 1, At, B1); PG8_BAR; PG8_SCHED;
            PG8_LDA(At, 0, 1); PG8_STAGE(PG8_SB(0, 0), b2, voffB); PG8_STAGE(PG8_SB(0, 1), b2 + hstep, voffB); PG8_STAGE(PG8_SA(0, 0), a2, voffA);
            PG8_WAIT_V(8); PG8_WAIT_L(0); PG8_BAR; PG8_MMA(1, 0, At, B0); PG8_MMA(1, 1, At, B1); PG8_BAR; PG8_SCHED;
            PG8_LDB(B0, 1, 0); PG8_LDB(B1, 1, 1); PG8_SCHED; PG8_LDA(At, 1, 0); PG8_STAGE(PG8_SA(0, 1), a2 + hstep, voffA);
            PG8_WAIT_V(8); PG8_WAIT_L(0); PG8_BAR; PG8_MMA(0, 0, At, B0); PG8_MMA(0, 1, At, B1); PG8_BAR; PG8_SCHED;
            PG8_LDA(At, 1, 1); PG8_STAGE(PG8_SB(1, 0), b3, voffB); PG8_STAGE(PG8_SB(1, 1), b3 + hstep, voffB); PG8_STAGE(PG8_SA(1, 0), a3, voffA);
            PG8_WAIT_V(8); PG8_WAIT_L(0); PG8_BAR; PG8_MMA(1, 0, At, B0); PG8_MMA(1, 1, At, B1); PG8_BAR; PG8_SCHED;
            } else {
            PG8_LDB(B0, 0, 0); PG8_SCHED; PG8_LDA(At, 0, 0); PG8_STAGE(PG8_SA(1, 1), a1 + hstep, voffA);
            PG8_WAIT_L(8); PG8_BAR; PG8_WAIT_L(0); PG8_MMA(0, 0, At, B0); PG8_BAR; PG8_SCHED;
            PG8_LDB(B1, 0, 1); PG8_STAGE(PG8_SB(0, 0), b2, voffB);
            PG8_BAR; PG8_WAIT_L(0); PG8_MMA(0, 1, At, B1); PG8_BAR;
            PG8_LDA(At, 0, 1); PG8_STAGE(PG8_SA(0, 0), a2, voffA);
            PG8_BAR; PG8_WAIT_L(0); PG8_MMA(1, 0, At, B0); PG8_BAR; PG8_SCHED;
            PG8_STAGE(PG8_SB(0, 1), b2 + hstep, voffB);
            PG8_WAIT_V(6); PG8_BAR; PG8_MMA(1, 1, At, B1); PG8_BAR;
            PG8_LDB(B0, 1, 0); PG8_SCHED; PG8_LDA(At, 1, 0); PG8_STAGE(PG8_SA(0, 1), a2 + hstep, voffA);
            PG8_WAIT_L(8); PG8_BAR; PG8_WAIT_L(0); PG8_MMA(0, 0, At, B0); PG8_BAR; PG8_SCHED;
            PG8_LDB(B1, 1, 1); PG8_STAGE(PG8_SB(1, 0), b3, voffB);
            PG8_BAR; PG8_WAIT_L(0); PG8_MMA(0, 1, At, B1); PG8_BAR;
            PG8_LDA(At, 1, 1); PG8_STAGE(PG8_SA(1, 0), a3, voffA);
            PG8_BAR; PG8_WAIT_L(0); PG8_MMA(1, 0, At, B0); PG8_BAR; PG8_SCHED;
            PG8_STAGE(PG8_SB(1, 1), b3 + hstep, voffB);
            PG8_WAIT_V(6); PG8_BAR; PG8_MMA(1, 1, At, B1); PG8_BAR;
            }
        }
        if constexpr (FP8) {
            asm volatile("s_nop 15\n\ts_nop 15" ::: "memory");
#pragma unroll
            for (int a = 0; a < 2; ++a)
#pragma unroll
                for (int b = 0; b < 2; ++b)
#pragma unroll
                    for (int m = 0; m < 4; ++m)
#pragma unroll
                        for (int n = 0; n < 2; ++n) asm volatile("" : "+v"(acc[a][b][m][n]));
        }
        if constexpr (ALIGN_EPI) { if (wr == 0) PG8_BAR; }
        if constexpr (!Epi::AFTER_DRAIN) { E(acc, cur, wr, wc, fr, fq); S.done(cur); }
        if (!has_next) break;
#pragma unroll
        for (int a = 0; a < 2; ++a)
#pragma unroll
            for (int b = 0; b < 2; ++b)
#pragma unroll
                for (int m = 0; m < 4; ++m)
#pragma unroll
                    for (int n = 0; n < 2; ++n) acc[a][b][m][n] = (f32x4){0.f, 0.f, 0.f, 0.f};
        cur = nxt; cA = nA; cB = nB; ++ui;
        if constexpr (ALIGN_EPI) { if (wr == 1) PG8_BAR; }
    }
    PG8_WAIT_V(0);
    if constexpr (!ALIGN_EPI) { if (wr == 0) PG8_BAR; }
    PG8_BAR;
    if constexpr (Epi::AFTER_DRAIN) { E.fused(acc, cur, wr, wc, fr, fq, lds, wid, lane); S.done(cur); }
#undef PG8_SA
#undef PG8_SB
#undef PG8_STAGE
#undef PG8_LDA
#undef PG8_LDB
#undef PG8_MMA
#undef PG8_CAT
#undef PG8_WAIT_V
#undef PG8_WAIT_L
#undef PG8_BAR
#undef PG8_SCHED
}
}

#define PG8_SP2 true
#define PG8_ALIGN true
namespace att {
typedef unsigned short bf16;
using bf16x8 = __attribute__((ext_vector_type(8))) short;
using s16x4  = __attribute__((ext_vector_type(4))) short;
using f32x16 = __attribute__((ext_vector_type(16))) float;
using u32x4  = __attribute__((ext_vector_type(4))) unsigned;
#define ATT_LAS __attribute__((address_space(3)))
typedef ATT_LAS char* lptr;
constexpr int   D = 128, NW = 8, QBLK = 32, KVBLK = 64;
constexpr float SCALE = 0.088388347648318440f;
constexpr float THR = 8.f;
constexpr int SHM_V = KVBLK * D * 2, SHM_K = KVBLK * D * 2, SHM_ATTN = 2 * SHM_V + 2 * SHM_K + NW * 64 * 4;
#define KSWZ(row, colB) ((row) * 256 + ((colB) ^ (((row) & 7) << 4)))
#define SBAR() __builtin_amdgcn_sched_barrier(0)
__device__ __forceinline__ int crow(int r, int hi) { return (r & 3) + 8 * (r >> 2) + 4 * hi; }
__device__ __forceinline__ unsigned cvtpk(float lo, float hi) { unsigned r; asm volatile("v_cvt_pk_bf16_f32 %0, %1, %2" : "=v"(r) : "v"(lo), "v"(hi)); return r; }
__device__ __forceinline__ void partialSM(f32x16& p0, f32x16& p1, float& m_reg, float& mn, float& alpha) {
  constexpr float C = SCALE * 1.4426950408889634f;
  float pmax = p0[0];
#pragma unroll
  for (int r = 1; r < 16; ++r) pmax = fmaxf(pmax, p0[r]);
#pragma unroll
  for (int r = 0; r < 16; ++r) pmax = fmaxf(pmax, p1[r]);
  { auto rr = __builtin_amdgcn_permlane32_swap(__float_as_uint(pmax), __float_as_uint(pmax), false, false);
    pmax = fmaxf(__uint_as_float(rr[0]), __uint_as_float(rr[1])); }
  if (__builtin_expect(__all(pmax - m_reg <= THR / SCALE), 1)) { mn = m_reg; alpha = 1.f; }
  else { mn = fmaxf(m_reg, pmax); alpha = __builtin_amdgcn_exp2f((m_reg - mn) * C); m_reg = mn; }
  float mnC = -mn * C;
#pragma unroll
  for (int r = 0; r < 16; ++r) p0[r] = fmaf(p0[r], C, mnC);
#pragma unroll
  for (int r = 0; r < 16; ++r) p1[r] = fmaf(p1[r], C, mnC);
#pragma unroll
  for (int r = 0; r < 16; ++r) p0[r] = __builtin_amdgcn_exp2f(p0[r]);
}
__device__ __forceinline__ void finishSM(f32x16& p0, f32x16& p1, float alpha, float& l_reg, bf16x8& pa0, bf16x8& pa1, bf16x8& pa2, bf16x8& pa3) {
#pragma unroll
  for (int r = 0; r < 16; ++r) p1[r] = __builtin_amdgcn_exp2f(p1[r]);
  float ps = 0;
#pragma unroll
  for (int r = 0; r < 16; ++r) ps += p0[r];
#pragma unroll
  for (int r = 0; r < 16; ++r) ps += p1[r];
  { auto rr = __builtin_amdgcn_permlane32_swap(__float_as_uint(ps), __float_as_uint(ps), false, false);
    ps = __uint_as_float(rr[0]) + __uint_as_float(rr[1]); }
  l_reg = l_reg * alpha + ps;
#define PK4(P, BASE, OUT) do { unsigned a0 = cvtpk(P[BASE + 0], P[BASE + 1]), a1 = cvtpk(P[BASE + 2], P[BASE + 3]);   \
    unsigned b0 = cvtpk(P[BASE + 4], P[BASE + 5]), b1 = cvtpk(P[BASE + 6], P[BASE + 7]);                              \
    auto r0 = __builtin_amdgcn_permlane32_swap(a0, b0, false, false); auto r1 = __builtin_amdgcn_permlane32_swap(a1, b1, false, false); \
    u32x4 w = {r0[0], r1[0], r0[1], r1[1]}; OUT = *reinterpret_cast<bf16x8*>(&w); } while (0)
  PK4(p0, 0, pa0); PK4(p0, 8, pa1); PK4(p1, 0, pa2); PK4(p1, 8, pa3);
#undef PK4
}
__device__ __forceinline__ void qkt(f32x16& p0, f32x16& p1, lptr Ks, const bf16x8* qr, int r32, int hi) {
  p0 = f32x16{}; p1 = f32x16{};
#pragma unroll
  for (int d0 = 0; d0 < 8; ++d0) { int cb = (d0 * 16 + hi * 8) * 2;
    bf16x8 b0 = *reinterpret_cast<const ATT_LAS bf16x8*>(Ks + KSWZ(r32, cb));
    bf16x8 b1 = *reinterpret_cast<const ATT_LAS bf16x8*>(Ks + KSWZ(32 + r32, cb));
    p0 = __builtin_amdgcn_mfma_f32_32x32x16_bf16(b0, qr[d0], p0, 0, 0, 0);
    p1 = __builtin_amdgcn_mfma_f32_32x32x16_bf16(b1, qr[d0], p1, 0, 0, 0); }
}
__device__ __forceinline__ int v_st(int k, int c) { const int kk = (k & ~0xC) | ((k & 4) << 1) | ((k & 8) >> 1); return ((kk >> 3) * 4 + (c >> 5)) * 512 + ((kk & 7) * 32 + (c & 31)) * 2; }
__device__ __forceinline__ int v_rd_base(int lane) { return ((lane & 3) << 3) | (((lane >> 2) & 3) << 6) | (((lane >> 4) & 1) << 5) | (((lane >> 5) & 1) << 8); }
constexpr int v_rd_off(int d0, int ks, int half) { return d0 * 512 + ks * 4096 + half * 2048; }
template <int OFF> __device__ __forceinline__ s16x4 tr_read(int vb) {
  s16x4 r; asm volatile("ds_read_b64_tr_b16 %0, %1 offset:%2" : "=&v"(r) : "v"(vb), "i"(OFF) : "memory"); return r;
}
template <int D0> __device__ __forceinline__ void pv_one(f32x16& od, int vb, bf16x8 pa0, bf16x8 pa1, bf16x8 pa2, bf16x8 pa3) {
  const s16x4 l0 = tr_read<v_rd_off(D0, 0, 0)>(vb), h0 = tr_read<v_rd_off(D0, 0, 1)>(vb), l1 = tr_read<v_rd_off(D0, 1, 0)>(vb), h1 = tr_read<v_rd_off(D0, 1, 1)>(vb);
  const s16x4 l2 = tr_read<v_rd_off(D0, 2, 0)>(vb), h2 = tr_read<v_rd_off(D0, 2, 1)>(vb), l3 = tr_read<v_rd_off(D0, 3, 0)>(vb), h3 = tr_read<v_rd_off(D0, 3, 1)>(vb);
  asm volatile("s_waitcnt lgkmcnt(0)" ::: "memory"); SBAR();
#define PK(L, H) (bf16x8){L[0], L[1], L[2], L[3], H[0], H[1], H[2], H[3]}
  od = __builtin_amdgcn_mfma_f32_32x32x16_bf16(pa0, PK(l0, h0), od, 0, 0, 0);
  od = __builtin_amdgcn_mfma_f32_32x32x16_bf16(pa1, PK(l1, h1), od, 0, 0, 0);
  od = __builtin_amdgcn_mfma_f32_32x32x16_bf16(pa2, PK(l2, h2), od, 0, 0, 0);
  od = __builtin_amdgcn_mfma_f32_32x32x16_bf16(pa3, PK(l3, h3), od, 0, 0, 0);
#undef PK
}
__device__ __forceinline__ void pv_d0(f32x16* o, int vb, bf16x8 pa0, bf16x8 pa1, bf16x8 pa2, bf16x8 pa3) {
  pv_one<0>(o[0], vb, pa0, pa1, pa2, pa3); pv_one<1>(o[1], vb, pa0, pa1, pa2, pa3); pv_one<2>(o[2], vb, pa0, pa1, pa2, pa3); pv_one<3>(o[3], vb, pa0, pa1, pa2, pa3);
}
__device__ __forceinline__ void moba_mask(f32x16& p0, f32x16& p1, int tile, int qb, unsigned sel, int qi, int w0, int hi) {
  const float NINF = -__builtin_inff();
  const int jb = tile >> 2;
  if (jb < qb) {
    const bool ok = ((sel >> jb) & 1u) != 0u;
    if (!__all(ok)) {
#pragma unroll
      for (int r = 0; r < 16; ++r) { p0[r] = ok ? p0[r] : NINF; p1[r] = ok ? p1[r] : NINF; }
    }
  } else {
    const int k0 = (tile & 3) * 64;
    if (k0 + 63 > w0) {
      int lim = qi - k0 - 4 * hi; asm volatile("" : "+v"(lim));
#pragma unroll
      for (int r = 0; r < 16; ++r) { const int kc = (r & 3) + 8 * (r >> 2); p0[r] = (kc <= lim) ? p0[r] : NINF; p1[r] = (kc + 32 <= lim) ? p1[r] : NINF; }
    }
  }
}

template <bool MOBA, int LDQ, int LDK, int LDO, int SDEPTH, typename TO, int OSC>
__device__ __forceinline__ void attn_body(const bf16* __restrict__ Qb, const bf16* __restrict__ Kh, const bf16* __restrict__ Vh, TO* __restrict__ Ob, int seq, lptr lds,
                                          int qb, const float* __restrict__ kms, int kms_stride, unsigned long long* __restrict__ ssq) {
  int tid_ = threadIdx.x; asm volatile("" : "+v"(tid_));
  const int tid = tid_, wid = tid >> 6, lane = tid & 63, r32 = lane & 31, hi = lane >> 5;
  lptr V_lds = lds; lptr K_lds = lds + 2 * SHM_V;
  ATT_LAS float* ws = (ATT_LAS float*)(lds + 2 * SHM_V + 2 * SHM_K) + wid * 64; ATT_LAS float* li_l = ws; ATT_LAS float* al_l = ws + 32;
  float m_reg = -1e30f, l_reg = 0; f32x16 o[4] = {}; bf16x8 qr[8];
  unsigned qoff = (unsigned)((wid * QBLK + r32) * LDQ + hi * 8); asm volatile("" : "+v"(qoff));
  const bf16* Qw = Qb + qoff;
#pragma unroll
  for (int d0 = 0; d0 < 8; ++d0) qr[d0] = *reinterpret_cast<const bf16x8*>(Qw + d0 * 16);
  const int sr = tid >> 4, sc = (tid & 15) * 8, vst0 = v_st(sr, sc), vst1 = v_st(32 + sr, sc);
  const int vb0 = (int)(uintptr_t)V_lds + v_rd_base(lane);
  struct { bf16x8 vs0, vs1, ks0, ks1; } sr_[SDEPTH];
  const unsigned so0 = (unsigned)(sr * LDK + sc), so1 = (unsigned)((32 + sr) * LDK + sc);
#define SLOAD(i, k0) do { const bf16* Vt_ = Vh + (long)(k0) * LDK; const bf16* Kt_ = Kh + (long)(k0) * LDK; \
    sr_[i].vs0 = *reinterpret_cast<const bf16x8*>(Vt_ + so0); sr_[i].vs1 = *reinterpret_cast<const bf16x8*>(Vt_ + so1); \
    sr_[i].ks0 = *reinterpret_cast<const bf16x8*>(Kt_ + so0); sr_[i].ks1 = *reinterpret_cast<const bf16x8*>(Kt_ + so1); } while (0)
#define SWRITE(b, i) do { *(ATT_LAS bf16x8*)(V_lds + (b) * SHM_V + vst0) = sr_[i].vs0;          \
    *(ATT_LAS bf16x8*)(V_lds + (b) * SHM_V + vst1) = sr_[i].vs1; int kc = sc * 2;               \
    *(ATT_LAS bf16x8*)(K_lds + (b) * SHM_K + KSWZ(sr, kc)) = sr_[i].ks0;                       \
    *(ATT_LAS bf16x8*)(K_lds + (b) * SHM_K + KSWZ(32 + sr, kc)) = sr_[i].ks1; } while (0)
#define SWAIT() do { if constexpr (SDEPTH == 2) asm volatile("s_waitcnt vmcnt(4)" ::: "memory"); else asm volatile("s_waitcnt vmcnt(0)" ::: "memory"); } while (0)
#define RESC(a) do { if (__any((a) < 1.f)) { if (hi == 0) al_l[r32] = (a); asm volatile("s_waitcnt lgkmcnt(0)" ::: "memory"); \
    _Pragma("unroll") for (int d = 0; d < 4; ++d) _Pragma("unroll") for (int r = 0; r < 16; ++r) o[d][r] *= al_l[crow(r, hi)]; } } while (0)
  f32x16 pA0, pA1, pB0, pB1; float mnA, mnB, alA, alB; bf16x8 pa0, pa1, pa2, pa3; const int NT = seq / KVBLK;
  constexpr int SE = 0, SO = SDEPTH - 1;
  unsigned sel = 0u; const int qi = wid * QBLK + r32, w0 = wid * QBLK;
  SLOAD(SE, 0);
  if constexpr (MOBA) {
    { const int j = sr & 15; const float* src = kms + (size_t)j * kms_stride + sc; const float4 x0 = *reinterpret_cast<const float4*>(src), x1 = *reinterpret_cast<const float4*>(src + 4);
      const float xv[8] = {x0.x, x0.y, x0.z, x0.w, x1.x, x1.y, x1.z, x1.w}; unsigned w[4];
#pragma unroll
      for (int e = 0; e < 4; ++e) { const unsigned h2 = cvtpk(xv[2 * e], xv[2 * e + 1]); const float f0 = __uint_as_float(h2 << 16), f1 = __uint_as_float(h2 & 0xffff0000u);
        const unsigned l2 = cvtpk(xv[2 * e] - f0, xv[2 * e + 1] - f1); w[e] = (sr < 16) ? h2 : l2; }
      u32x4 wv = {w[0], w[1], w[2], w[3]}; *(ATT_LAS u32x4*)(K_lds + KSWZ(sr, sc * 2)) = wv; }
    __syncthreads();
    f32x16 g = f32x16{};
#pragma unroll
    for (int d0 = 0; d0 < 8; ++d0) { const int cb = (d0 * 16 + hi * 8) * 2; const bf16x8 b0 = *reinterpret_cast<const ATT_LAS bf16x8*>(K_lds + KSWZ(r32, cb));
      g = __builtin_amdgcn_mfma_f32_32x32x16_bf16(b0, qr[d0], g, 0, 0, 0); }
    float G[16];
#pragma unroll
    for (int r = 0; r < 8; ++r) { const float own = g[r] + g[r + 8]; const float oth = __shfl_xor(own, 32); const int lb = (r & 3) + 8 * (r >> 2);
      G[lb] = hi ? oth : own; G[lb + 4] = hi ? own : oth; }
    const float NINF = -__builtin_inff();
#pragma unroll
    for (int j = 0; j < 16; ++j) G[j] = (j < qb) ? G[j] : NINF;
#pragma unroll
    for (int it = 0; it < 3; ++it) { float mx = NINF; int mi = -1;
#pragma unroll
      for (int j = 0; j < 16; ++j) { const bool gt = G[j] > mx; mx = gt ? G[j] : mx; mi = gt ? j : mi; }
      if (mi >= 0) sel |= 1u << mi;
#pragma unroll
      for (int j = 0; j < 16; ++j) G[j] = (j == mi) ? NINF : G[j]; }
    __syncthreads();
  }
  asm volatile("s_waitcnt vmcnt(0)" ::: "memory"); SWRITE(0, SE); __syncthreads();
  qkt(pA0, pA1, K_lds, qr, r32, hi);
  if constexpr (MOBA) moba_mask(pA0, pA1, 0, qb, sel, qi, w0, hi);
  partialSM(pA0, pA1, m_reg, mnA, alA);
  SLOAD(SO, KVBLK); if constexpr (SDEPTH == 2) { if (2 < NT) SLOAD(SE, 2 * KVBLK); }
  SWAIT(); SWRITE(1, SO); __syncthreads();
  for (int j = 1; j + 1 < NT; j += 2) {
    SBAR(); qkt(pB0, pB1, K_lds + SHM_K, qr, r32, hi);
    finishSM(pA0, pA1, alA, l_reg, pa0, pa1, pa2, pa3); SBAR();
    SLOAD(SO, (j + SDEPTH) * KVBLK); SBAR();
    pv_d0(o, vb0, pa0, pa1, pa2, pa3);
    if constexpr (MOBA) moba_mask(pB0, pB1, j, qb, sel, qi, w0, hi);
    partialSM(pB0, pB1, m_reg, mnB, alB);
    __syncthreads(); SWAIT(); SWRITE(0, SE);
    RESC(alB); __syncthreads();
    SBAR(); qkt(pA0, pA1, K_lds, qr, r32, hi);
    finishSM(pB0, pB1, alB, l_reg, pa0, pa1, pa2, pa3); SBAR();
    if (SDEPTH == 1 || j + 3 < NT) SLOAD(SE, (j + 1 + SDEPTH) * KVBLK); SBAR();
    pv_d0(o, vb0 + SHM_V, pa0, pa1, pa2, pa3);
    if constexpr (MOBA) moba_mask(pA0, pA1, j + 1, qb, sel, qi, w0, hi);
    partialSM(pA0, pA1, m_reg, mnA, alA);
    __syncthreads(); SWAIT(); SWRITE(1, SO);
    RESC(alA); __syncthreads();
  }
  SBAR(); qkt(pB0, pB1, K_lds + SHM_K, qr, r32, hi);
  finishSM(pA0, pA1, alA, l_reg, pa0, pa1, pa2, pa3); SBAR();
  pv_d0(o, vb0, pa0, pa1, pa2, pa3);
  if constexpr (MOBA) moba_mask(pB0, pB1, NT - 1, qb, sel, qi, w0, hi);
  partialSM(pB0, pB1, m_reg, mnB, alB);
  __syncthreads(); RESC(alB);
  finishSM(pB0, pB1, alB, l_reg, pa0, pa1, pa2, pa3); SBAR();
  pv_d0(o, vb0 + SHM_V, pa0, pa1, pa2, pa3);
  if (hi == 0) li_l[r32] = l_reg; asm volatile("s_waitcnt lgkmcnt(0)" ::: "memory");
  float rli[16];
#pragma unroll
  for (int r = 0; r < 16; ++r) rli[r] = __builtin_amdgcn_rcpf(li_l[crow(r, hi)]);
  int ohi = hi * 4, ocol = r32; asm volatile("" : "+v"(ohi), "+v"(ocol));
  TO* Ow = Ob + (long)(wid * QBLK) * LDO;
#pragma unroll
  for (int r = 0; r < 16; ++r) { const int orow = (r & 3) + 8 * (r >> 2) + ohi; float sq = 0.f;
#pragma unroll
    for (int d0 = 0; d0 < 4; ++d0) { const float v = o[d0][r] * rli[r]; sq += v * v; if constexpr (sizeof(TO) == 2) Ow[(unsigned)(orow * LDO + d0 * 32 + ocol)] = (TO)(cvtpk(v, v) & 0xffffu);
      else Ow[(unsigned)(orow * LDO + d0 * 32 + ocol)] = (TO)(__builtin_amdgcn_cvt_pk_fp8_f32(__builtin_amdgcn_fmed3f(v * (float)OSC, -448.0f, 448.0f), 0.0f, 0, false) & 0xff); }
    if constexpr (MOBA) { sq += __shfl_xor(sq, 1); sq += __shfl_xor(sq, 2); sq += __shfl_xor(sq, 4); sq += __shfl_xor(sq, 8); sq += __shfl_xor(sq, 16);
      if (ocol == 0) pg8::ss_add(ssq, wid * QBLK + orow, sq); } }
  __syncthreads();
#undef SLOAD
#undef SWRITE
#undef SWAIT
#undef RESC
}
#undef KSWZ
#undef SBAR
}

constexpr int NWAVES = 8;
constexpr int BATCH = 4, SEQ = 4096, D = 2048, M = BATCH * SEQ, FF = 5632, AW = 1024, CW = 1024, INW = 6144, MEML = 256, XW = 512, NH = 8, XH = 4, NBLK = 16;
constexpr int NPH = 13;
#ifndef FAST_MASK
#define FAST_MASK 0x1fff
#endif
#ifndef ONE_LAUNCH
#define ONE_LAUNCH 1
#endif
constexpr size_t MiB = 1u << 20, KiB = 1u << 10;
constexpr size_t WS_CTL = 0, CTL_ZERO_BYTES = 1536 * KiB;
constexpr size_t CTL_BAR = 64 * KiB, BAR_STRIDE = 16 * KiB;
constexpr size_t CTL_SS = 320 * KiB;
constexpr size_t CTL_KMS = 1088 * KiB;
constexpr size_t WS_WGU1 = 2 * MiB, WS_WD1 = 46 * MiB, WS_WGU2 = 68 * MiB, WS_WD2 = 112 * MiB, WS_WIN = 134 * MiB, WS_WOUT = 158 * MiB, WS_WQ = 166 * MiB, WS_WKV = 168 * MiB, WS_WO = 172 * MiB;
constexpr size_t WS_MEMN = 174 * MiB, WS_KVX = 178 * MiB, WS_HB = 180 * MiB, WS_MIXED = 244 * MiB, WS_ACT = 308 * MiB;
constexpr size_t WS_Q = 308 * MiB, WS_K = 340 * MiB, WS_V = 372 * MiB, WS_CU = 404 * MiB, WS_BG = 436 * MiB;
constexpr size_t WS_QX = 308 * MiB, WS_OX = 324 * MiB;
constexpr size_t WS_HB8 = 340 * MiB, WS_ACT8 = 396 * MiB, WS_OX8 = 324 * MiB;
constexpr size_t WS_H1F8 = WS_MIXED + 32 * MiB, WS_WIN8 = WS_WIN + 8 * MiB;
constexpr size_t WS_DUMMY = 484 * MiB;
constexpr size_t WS_END = 486 * MiB;
static_assert(WS_ACT + (size_t)M * FF * 2 <= WS_END && WS_BG + (size_t)M * 1024 * 2 <= WS_END && CTL_KMS + BATCH * 16 * 8 * 128 * 4 <= CTL_ZERO_BYTES && CTL_SS + 6 * M * 8 <= CTL_KMS && CTL_ZERO_BYTES <= WS_WGU1, "d_ws map");
constexpr int RING_OFF = 0, RING_BYTES = 131072;
constexpr int LDSCTL_OFF = RING_BYTES, MISC_OFF = LDSCTL_OFF + 320;
constexpr int LDS_BYTES = 147456;
static_assert(MISC_OFF + 128 <= LDS_BYTES && att::SHM_ATTN <= RING_BYTES, "LDS map");

#define GAS __attribute__((address_space(1)))
#define LAS __attribute__((address_space(3)))
typedef unsigned short bf16;
typedef unsigned v4u __attribute__((ext_vector_type(4)));
typedef unsigned v2u __attribute__((ext_vector_type(2)));
typedef float f32x4 __attribute__((ext_vector_type(4)));
typedef short bf16x8 __attribute__((ext_vector_type(8)));
typedef GAS unsigned gu32;
#define RLX_AGENT __ATOMIC_RELAXED, __HIP_MEMORY_SCOPE_AGENT
#define LDS_WAIT() asm volatile("s_waitcnt lgkmcnt(0)" ::: "memory")
#define VM_WAIT() asm volatile("s_waitcnt vmcnt(0)" ::: "memory")
__device__ __forceinline__ unsigned pk2(float lo, float hi) { return pg8::cvt_pk_bf16(lo, hi); }
__device__ __forceinline__ float bflo(unsigned w) { return __uint_as_float(w << 16); }
__device__ __forceinline__ float bfhi(unsigned w) { return __uint_as_float(w & 0xffff0000u); }
__device__ __forceinline__ float wave_sum(float v) {
#pragma unroll
    for (int o = 1; o < 64; o <<= 1) v += __shfl_xor(v, o);
    return v;
}
#define XB_TMO      128
#define XB_XCNT(j)  (256  + 64 * (j))
#define XB_XSUB(j)  (1280 + 64 * (j))
#define XB_XGEN(j)  (2304 + 64 * (j))
#define XB_TOP      3328
#define XB_TOPGEN   3392
#define XCD_BAR_WORDS 3456
#define XB_SPIN_CAP (1u << 18)

__device__ __forceinline__ unsigned xb_ld(unsigned* p)              { return __hip_atomic_load(p, __ATOMIC_RELAXED, __HIP_MEMORY_SCOPE_AGENT); }
__device__ __forceinline__ unsigned xb_add(unsigned* p, unsigned v) { return __hip_atomic_fetch_add(p, v, __ATOMIC_RELAXED, __HIP_MEMORY_SCOPE_AGENT); }
__device__ __forceinline__ unsigned xb_xcc_id() { return (unsigned)__builtin_amdgcn_s_getreg((3 << 11) | 20) & 0xFu; }
#define XB_SPIN(cond, bar) do { unsigned _sp = 0; while (cond) { __builtin_amdgcn_s_sleep(1); \
    if ((++_sp & 255u) == 0u) { if (xb_ld(&(bar)[XB_TMO])) break; if (_sp > XB_SPIN_CAP) { atomicAdd(&(bar)[XB_TMO], 1u); break; } } } } while (0)

struct XcdBarrier {
    unsigned* bar; unsigned x;
    volatile LAS unsigned* st;
};

__device__ __forceinline__ XcdBarrier xcd_barrier_post(unsigned* bar, volatile LAS unsigned* st) {
    XcdBarrier b; b.bar = bar; b.x = xb_xcc_id(); b.st = st;
    if (threadIdx.x == 0) (void)xb_add(&bar[XB_XCNT(b.x)], 1u);
    return b;
}
__device__ __forceinline__ void xcd_barrier_complete(unsigned* bar, unsigned x, unsigned& nloc, unsigned& nx) {
    const unsigned G = gridDim.x * gridDim.y * gridDim.z;
    unsigned sum, cnt, mine, sp = 0u;
    for (;;) {
        sum = 0u; cnt = 0u; mine = 0u;
#pragma unroll
        for (unsigned j = 0; j < 16; ++j) { const unsigned c = xb_ld(&bar[XB_XCNT(j)]); sum += c; cnt += (c > 0u) ? 1u : 0u; mine = (j == x) ? c : mine; }
        if (sum == G) break;
        __builtin_amdgcn_s_sleep(1);
        if ((++sp & 255u) == 0u) { if (xb_ld(&bar[XB_TMO])) break; if (sp > XB_SPIN_CAP) { atomicAdd(&bar[XB_TMO], 1u); break; } }
    }
    nloc = mine > 0u ? mine : 1u; nx = cnt > 0u ? cnt : 1u;
}

__device__ __forceinline__ void xcd_barrier(const XcdBarrier& b) {
    asm volatile("s_waitcnt vmcnt(0)" ::: "memory");
    __syncthreads();
    if (threadIdx.x == 0) {
        unsigned* bar = b.bar;
        __builtin_amdgcn_s_waitcnt(0);
        unsigned nloc = b.st[0], nx = b.st[1];
        if (nloc == 0u) { xcd_barrier_complete(bar, b.x, nloc, nx); b.st[0] = nloc; b.st[1] = nx; }
        const unsigned old = xb_add(&bar[XB_XSUB(b.x)], 1u);
        const unsigned gen = old / nloc;
        if (old + 1u == (gen + 1u) * nloc) {
            __builtin_amdgcn_fence(__ATOMIC_RELEASE, "agent");
            asm volatile("s_waitcnt vmcnt(0)" ::: "memory");
            const unsigned og = xb_add(&bar[XB_TOP], 1u);
            const unsigned tg = og / nx;
            if (og + 1u == (tg + 1u) * nx) xb_add(&bar[XB_TOPGEN], 1u);
            else XB_SPIN(xb_ld(&bar[XB_TOPGEN]) == tg, bar);
            __builtin_amdgcn_fence(__ATOMIC_ACQUIRE, "agent");
            xb_add(&bar[XB_XGEN(b.x)], 1u);
            asm volatile("s_waitcnt vmcnt(0)" ::: "memory");
        } else {
            XB_SPIN(xb_ld(&bar[XB_XGEN(b.x)]) == gen, bar);
            __builtin_amdgcn_fence(__ATOMIC_ACQUIRE, "agent");
            asm volatile("s_waitcnt vmcnt(0)" ::: "memory");
        }
    }
    __syncthreads();
}

namespace nv {
typedef float f32x4 __attribute__((ext_vector_type(4)));
typedef short bf16x8 __attribute__((ext_vector_type(8)));
constexpr float EPS = 1e-6f;
template <class F> __global__ __launch_bounds__(256) void gemm(const bf16* __restrict__ A, const bf16* __restrict__ Bt, int K, F f) {
    const int wave = threadIdx.x >> 6, lane = threadIdx.x & 63;
    const int row0 = blockIdx.y * 64 + wave * 16, col0 = blockIdx.x * 64;
    f32x4 acc[4], acc2[4];
#pragma unroll
    for (int c = 0; c < 4; ++c) { acc[c] = (f32x4){0.f, 0.f, 0.f, 0.f}; acc2[c] = (f32x4){0.f, 0.f, 0.f, 0.f}; }
    const bf16* ap = A + (size_t)(row0 + (lane & 15)) * K + 8 * (lane >> 4);
    const bf16* bp[4]; const bf16* bp2[4];
#pragma unroll
    for (int c = 0; c < 4; ++c) { const int col = col0 + 16 * c + (lane & 15); bp[c] = Bt + (size_t)f.brow(col) * K + 8 * (lane >> 4); bp2[c] = Bt + (size_t)f.brow2(col) * K + 8 * (lane >> 4); }
    for (int k0 = 0; k0 < K; k0 += 32) {
        if (F::MIDK > 0 && k0 == F::MIDK) {
#pragma unroll
            for (int j = 0; j < 4; ++j) { const float s = f.midscale(row0 + (lane >> 4) * 4 + j);
#pragma unroll
                for (int c = 0; c < 4; ++c) acc[c][j] *= s; }
        }
        const bf16x8 a = *(const bf16x8*)(ap + k0);
#pragma unroll
        for (int c = 0; c < 4; ++c) { const bf16x8 b = *(const bf16x8*)(bp[c] + k0); acc[c] = __builtin_amdgcn_mfma_f32_16x16x32_bf16(a, b, acc[c], 0, 0, 0);
            if (F::DUAL) { const bf16x8 b2 = *(const bf16x8*)(bp2[c] + k0); acc2[c] = __builtin_amdgcn_mfma_f32_16x16x32_bf16(a, b2, acc2[c], 0, 0, 0); } }
    }
#pragma unroll
    for (int j = 0; j < 4; ++j) { const int row = row0 + (lane >> 4) * 4 + j; float sq = 0.f;
#pragma unroll
        for (int c = 0; c < 4; ++c) { const float h = f.store(row, col0 + 16 * c + (lane & 15), acc[c][j], acc2[c][j]); sq += h * h; }
        if (F::ROWSS) { sq += __shfl_xor(sq, 1); sq += __shfl_xor(sq, 2); sq += __shfl_xor(sq, 4); sq += __shfl_xor(sq, 8); if ((lane & 15) == 0) f.addss(row, sq); } }
}
__device__ __forceinline__ bf16 tobf(float v) { return (bf16)(pg8::cvt_pk_bf16(v, v) & 0xffffu); }
struct FSwiglu { static constexpr bool DUAL = true, ROWSS = false; static constexpr int MIDK = 0; bf16* O; const pg8::u64_t* ss;
    __device__ int brow(int col) const { return (col >> 7) * 256 + (col & 127); } __device__ int brow2(int col) const { return brow(col) + 128; } __device__ float midscale(int) const { return 1.f; } __device__ void addss(int, float) const {}
    __device__ float store(int row, int col, float a, float a2) const { const float rs = rsqrtf(pg8::ss_val(ss, row) * (1.0f / 2048.0f) + EPS), g = a * rs, u = a2 * rs; O[(size_t)row * FF + col] = tobf(g / (1.0f + __expf(-g)) * u); return 0.f; } };
template <int MIDK_, bool RBF, bool OF32> struct FResid { static constexpr bool DUAL = false, ROWSS = true; static constexpr int MIDK = MIDK_; const float* R; const bf16* RB; float* H; bf16* HB; pg8::u64_t* ssn; float alpha; const pg8::u64_t* midss;
    __device__ int brow(int col) const { return col; } __device__ int brow2(int col) const { return col; } __device__ float midscale(int row) const { return rsqrtf(pg8::ss_val(midss, row) * (1.0f / 1024.0f) + EPS); }
    __device__ void addss(int row, float s) const { pg8::ss_add(ssn, row, s); }
    __device__ float store(int row, int col, float a, float) const { const size_t o = (size_t)row * 2048 + col; const float r = RBF ? __uint_as_float((unsigned)RB[o] << 16) : R[o]; const float h = r + alpha * a; if (OF32) H[o] = h; else HB[o] = tobf(h); return h; } };
struct FWin { static constexpr bool DUAL = true, ROWSS = false; static constexpr int MIDK = 0; bf16 *Q, *K, *V, *CU, *BG; const pg8::u64_t* ss;
    __device__ int brow(int col) const { if (col < 3072) return col; if (col < 4096) { const int j = col - 3072; return 3072 + (j >> 7) * 256 + (j & 127); } return 5120 + (col - 4096); }
    __device__ int brow2(int col) const { return (col >= 3072 && col < 4096) ? brow(col) + 128 : brow(col); } __device__ float midscale(int) const { return 1.f; } __device__ void addss(int, float) const {}
    __device__ float store(int row, int col, float a, float a2) const { const float rs = rsqrtf(pg8::ss_val(ss, row) * (1.0f / 2048.0f) + EPS); const size_t o = (size_t)row * 1024 + (col & 1023);
        if (col < 1024) Q[o] = tobf(a * rs); else if (col < 2048) K[o] = tobf(a * rs); else if (col < 3072) V[o] = tobf(a * rs); else if (col < 4096) CU[o] = tobf((a * rs) * (a2 * rs)); else BG[o] = tobf(a * rs); return 0.f; } };
struct FScale { static constexpr bool DUAL = false, ROWSS = false; static constexpr int MIDK = 0; bf16* O; int ldo; const pg8::u64_t* ss;
    __device__ int brow(int col) const { return col; } __device__ int brow2(int col) const { return col; } __device__ float midscale(int) const { return 1.f; } __device__ void addss(int, float) const {}
    __device__ float store(int row, int col, float a, float) const { const float rs = ss ? rsqrtf(pg8::ss_val(ss, row) * (1.0f / 2048.0f) + EPS) : 1.0f; O[(size_t)row * ldo + col] = tobf(a * rs); return 0.f; } };
__global__ __launch_bounds__(256) void kmean(const bf16* __restrict__ K, float* __restrict__ kms) {
    const int i = blockIdx.x * 256 + threadIdx.x; const int d = i & 127, h = (i >> 7) & 7, bb = i >> 10;
    float s = 0.f; for (int r = 0; r < 256; ++r) s += __uint_as_float((unsigned)K[((size_t)bb * 256 + r) * 1024 + h * 128 + d] << 16);
    kms[i] = s;
}
__global__ __launch_bounds__(256) void moba(const bf16* __restrict__ Q, const bf16* __restrict__ K, const bf16* __restrict__ V, const float* __restrict__ kms, bf16* __restrict__ AO, pg8::u64_t* __restrict__ ssA) {
    const int wave = threadIdx.x >> 6, lane = threadIdx.x & 63; const int idx = blockIdx.x * 4 + wave; const int h = idx & 7, row = idx >> 3, b = row >> 12, t = row & 4095, qb = t >> 8;
    const unsigned qw = *(const unsigned*)(Q + (size_t)row * 1024 + h * 128 + 2 * lane); const float q0 = bflo(qw), q1 = bfhi(qw);
    unsigned sel = 0u;
    { float g[16];
#pragma unroll
      for (int j = 0; j < 16; ++j) { const float* km = kms + ((size_t)(b * 16 + j) * 8 + h) * 128 + 2 * lane; const float p = wave_sum(q0 * km[0] + q1 * km[1]); g[j] = (j < qb) ? p : -__builtin_inff(); }
#pragma unroll
      for (int it = 0; it < 3; ++it) { float mx = -__builtin_inff(); int mi = -1;
#pragma unroll
        for (int j = 0; j < 16; ++j) { const bool gt = g[j] > mx; mx = gt ? g[j] : mx; mi = gt ? j : mi; }
        if (mi >= 0) sel |= 1u << mi;
#pragma unroll
        for (int j = 0; j < 16; ++j) g[j] = (j == mi) ? -__builtin_inff() : g[j]; } }
    sel |= 1u << qb;
    float m = -1e30f, l = 0.f, o0 = 0.f, o1 = 0.f;
    for (int jb = 0; jb <= qb; ++jb) { if (!((sel >> jb) & 1u)) continue;
        const int nk = (jb < qb) ? 256 : (t & 255) + 1;
        for (int kk = 0; kk < nk; ++kk) { const size_t ko = ((size_t)b * 4096 + jb * 256 + kk) * 1024 + h * 128 + 2 * lane;
            const unsigned kw = *(const unsigned*)(K + ko), vw = *(const unsigned*)(V + ko);
            const float s = wave_sum(q0 * bflo(kw) + q1 * bfhi(kw)) * 0.088388347648318440f;
            const float mn = fmaxf(m, s), a = __expf(m - mn), p = __expf(s - mn);
            l = l * a + p; o0 = o0 * a + p * bflo(vw); o1 = o1 * a + p * bfhi(vw); m = mn; } }
    const float il = 1.0f / l; o0 *= il; o1 *= il;
    *(unsigned*)(AO + (size_t)row * 2048 + h * 128 + 2 * lane) = pk2(o0, o1);
    const float sq = wave_sum(o0 * o0 + o1 * o1); if (lane == 0) pg8::ss_add(ssA, row, sq);
}
__global__ __launch_bounds__(256) void xattn(const bf16* __restrict__ QX, const bf16* __restrict__ KVX, bf16* __restrict__ OX) {
    const int wave = threadIdx.x >> 6, lane = threadIdx.x & 63; const int idx = blockIdx.x * 4 + wave; const int h = idx & 3, row = idx >> 2, b = row >> 12;
    const unsigned qw = *(const unsigned*)(QX + (size_t)row * 512 + h * 128 + 2 * lane); const float q0 = bflo(qw), q1 = bfhi(qw);
    float m = -1e30f, l = 0.f, o0 = 0.f, o1 = 0.f;
    for (int kk = 0; kk < 256; ++kk) { const size_t ko = ((size_t)b * 256 + kk) * 1024 + h * 128 + 2 * lane;
        const unsigned kw = *(const unsigned*)(KVX + ko), vw = *(const unsigned*)(KVX + ko + 512);
        const float s = wave_sum(q0 * bflo(kw) + q1 * bfhi(kw)) * 0.088388347648318440f;
        const float mn = fmaxf(m, s), a = __expf(m - mn), p = __expf(s - mn);
        l = l * a + p; o0 = o0 * a + p * bflo(vw); o1 = o1 * a + p * bfhi(vw); m = mn; }
    const float il = 1.0f / l;
    *(unsigned*)(OX + (size_t)row * 512 + h * 128 + 2 * lane) = pk2(o0 * il, o1 * il);
}
}


#ifndef USE_FP8
#define USE_FP8 0xE80
#endif
struct Frame {
    LAS unsigned char* lds;
    volatile LAS unsigned* MISC;
    int tid, lane, wave;
    int vcu, G;
};
struct Args { const float* in[22]; float* out; unsigned char* ws; int ph_lo, ph_hi; };
enum { I_X = 0, I_MEM, I_F1N, I_F1G, I_F1U, I_F1D, I_MIXN, I_WIN, I_CONVW, I_AON, I_CON, I_WOUT, I_XN, I_MEMNRM, I_XQ, I_XKV, I_XO, I_F2N, I_F2G, I_F2U, I_F2D, I_FINAL };

struct P0Job { const float* src; const float* gain; bf16* dst; int pitch, dstK, dkoff, drow0, k0, f8; };
__device__ __forceinline__ void p0_load(const P0Job& J, int lane, float (&v)[32]) {
    const float* wp = J.src + (size_t)(J.k0 + (lane >> 5)) * J.pitch + (lane & 31);
#pragma unroll
    for (int i = 0; i < 32; ++i) v[i] = wp[(size_t)(2 * i) * J.pitch];
}
__device__ __forceinline__ void p0_store(const P0Job& J, int lane, const float (&v)[32], LAS float* scr) {
    const int c = lane & 7;
    f32x4 g0 = (f32x4){1.f, 1.f, 1.f, 1.f}, g1 = g0;
    if (J.gain) { g0 = *(const GAS f32x4*)(J.gain + J.k0 + 8 * c); g1 = *(const GAS f32x4*)(J.gain + J.k0 + 8 * c + 4); }
#pragma unroll
    for (int i = 0; i < 32; ++i) scr[(2 * i + (lane >> 5)) * 33 + (lane & 31)] = v[i];
    LDS_WAIT(); asm volatile("" ::: "memory");
#pragma unroll
    for (int j = 0; j < 4; ++j) { const int n = (lane >> 3) + 8 * j; const LAS float* s = scr + (8 * c) * 33 + n;
        const f32x4 x0 = (f32x4){s[0 * 33], s[1 * 33], s[2 * 33], s[3 * 33]} * g0, x1 = (f32x4){s[4 * 33], s[5 * 33], s[6 * 33], s[7 * 33]} * g1;
        if (J.f8) { const pg8::u32x2 o = pg8::pack8_f8(x0 * 64.0f, x1 * 64.0f); *(GAS v2u*)((unsigned char*)J.dst + (size_t)(J.drow0 + n) * J.dstK + J.dkoff + J.k0 + 8 * c) = (v2u){o.x, o.y}; }
        else { v4u o; o.x = pk2(x0[0], x0[1]); o.y = pk2(x0[2], x0[3]); o.z = pk2(x1[0], x1[1]); o.w = pk2(x1[2], x1[3]); *(GAS v4u*)(J.dst + (size_t)(J.drow0 + n) * J.dstK + J.dkoff + J.k0 + 8 * c) = o; } }
    LDS_WAIT(); asm volatile("" ::: "memory");
}
constexpr int P0_I_FF = (D / 64) * (FF / 32), P0_I_FD = (FF / 64) * (D / 32), P0_I_IN = (D / 64) * (1024 / 32), P0_I_OUT = (1024 / 64) * (D / 32), P0_I_XQ = (D / 64) * (XW / 32), P0_I_XKV = (D / 64) * (1024 / 32), P0_I_XO = (XW / 64) * (D / 32);
constexpr int P0_NITEMS = 4 * P0_I_FF + 2 * P0_I_FD + 6 * P0_I_IN + 2 * P0_I_OUT + P0_I_XQ + P0_I_XKV + P0_I_XO;
__device__ __forceinline__ P0Job p0_job(const Args& a, int it) {
    unsigned char* ws = a.ws;
    int r = it; const float* src = nullptr; const float* gain = nullptr; bf16* dst = nullptr; int pitch = 0, ncols = 32, dstK = 0, dkoff = 0, rowoff = 0, mode = 0, f8 = 0; bool hit = false;
    constexpr int F8I = (USE_FP8 >> 3) & 1, F8M = (USE_FP8 >> 6) & 1, F8Q = (USE_FP8 >> 7) & 1, F8O = (USE_FP8 >> 9) & 1, F8G = (USE_FP8 >> 10) & 1, F8D = (USE_FP8 >> 11) & 1;
#define JOB(cnt, SRC, PITCH, NCOLS, GAIN, DST, DSTK, DKOFF, ROWOFF, MODE, F8J) if (!hit) { if (r < (cnt)) { hit = true; f8 = (F8J); src = (SRC); pitch = (PITCH); ncols = (NCOLS); gain = (GAIN); dst = (bf16*)(ws + (DST)); dstK = (DSTK); dkoff = (DKOFF); rowoff = (ROWOFF); mode = (MODE); } else r -= (cnt); }
    JOB(P0_I_FF, a.in[I_F1G], FF, FF, a.in[I_F1N], WS_WGU1, D, 0, 0, 1, 0)
    JOB(P0_I_FF, a.in[I_F1U], FF, FF, a.in[I_F1N], WS_WGU1, D, 0, 0, 2, 0)
    JOB(P0_I_FD, a.in[I_F1D], D, D, nullptr, WS_WD1, FF, 0, 0, 0, 0)
    JOB(P0_I_IN, a.in[I_WIN] + 0, INW, 1024, a.in[I_MIXN], WS_WIN, D, 0, 0, 0, 0)
    JOB(P0_I_IN, a.in[I_WIN] + 1024, INW, 1024, a.in[I_MIXN], WS_WIN, D, 0, 1024, 0, 0)
    JOB(P0_I_IN, a.in[I_WIN] + 2048, INW, 1024, a.in[I_MIXN], F8I ? WS_WIN8 : WS_WIN, D, 0, F8I ? 0 : 2048, 0, F8I)
    JOB(P0_I_IN, a.in[I_WIN] + 3072, INW, 1024, a.in[I_MIXN], F8I ? WS_WIN8 : WS_WIN, D, 0, F8I ? 1024 : 3072, 1, F8I)
    JOB(P0_I_IN, a.in[I_WIN] + 5120, INW, 1024, a.in[I_MIXN], F8I ? WS_WIN8 : WS_WIN, D, 0, F8I ? 1024 : 3072, 2, F8I)
    JOB(P0_I_IN, a.in[I_WIN] + 4096, INW, 1024, a.in[I_MIXN], F8I ? WS_WIN8 : WS_WIN, D, 0, F8I ? 3072 : 5120, 0, F8I)
    JOB(P0_I_OUT, a.in[I_WOUT], D, D, a.in[I_AON], WS_WOUT, D, 0, 0, 0, F8M)
    JOB(P0_I_OUT, a.in[I_WOUT] + (size_t)1024 * D, D, D, a.in[I_CON], WS_WOUT, D, 1024, 0, 0, F8M)
    JOB(P0_I_XQ, a.in[I_XQ], XW, XW, a.in[I_XN], WS_WQ, D, 0, 0, 0, F8Q)
    JOB(P0_I_XKV, a.in[I_XKV], 1024, 1024, nullptr, WS_WKV, D, 0, 0, 0, 0)
    JOB(P0_I_XO, a.in[I_XO], D, D, nullptr, WS_WO, XW, 0, 0, 0, F8O)
    JOB(P0_I_FF, a.in[I_F2G], FF, FF, a.in[I_F2N], WS_WGU2, D, 0, 0, 1, F8G)
    JOB(P0_I_FF, a.in[I_F2U], FF, FF, a.in[I_F2N], WS_WGU2, D, 0, 0, 2, F8G)
    JOB(P0_I_FD, a.in[I_F2D], D, D, nullptr, WS_WD2, FF, 0, 0, 0, F8D)
#undef JOB
    const int nblk = ncols / 32, kb = r / nblk, nb = r % nblk, k0 = 64 * kb, n0 = 32 * nb;
    P0Job J; J.src = src + n0; J.gain = gain; J.dst = dst; J.pitch = pitch; J.dstK = dstK; J.dkoff = dkoff; J.k0 = k0; J.f8 = f8;
    J.drow0 = rowoff + (mode ? (n0 >> 7) * 256 + (n0 & 127) + (mode == 2 ? 128 : 0) : n0);
    return J;
}
__device__ __forceinline__ void p0_prologue(Frame& F_, const Args& a) {
    Frame F = F_; asm volatile("" : "+v"(F.lane));
    LAS float* scr = (LAS float*)(F.lds + RING_OFF + F.wave * 16384);
    const int gw = F.vcu * NWAVES + F.wave, NGW = F.G * NWAVES;
    unsigned char* ws = a.ws;
    { float va[32], vb[32]; P0Job Ja, Jb; int it = gw;
      if (it < P0_NITEMS) { Ja = p0_job(a, it); p0_load(Ja, F.lane, va); }
      while (it < P0_NITEMS) {
          const int i2 = it + NGW; if (i2 < P0_NITEMS) { Jb = p0_job(a, i2); p0_load(Jb, F.lane, vb); }
          p0_store(Ja, F.lane, va, scr);
          if (i2 >= P0_NITEMS) break;
          const int i3 = i2 + NGW; if (i3 < P0_NITEMS) { Ja = p0_job(a, i3); p0_load(Ja, F.lane, va); }
          p0_store(Jb, F.lane, vb, scr);
          it = i3; } }
    { bf16* HB = (bf16*)(ws + WS_HB); pg8::u64_t* ss0 = (pg8::u64_t*)(ws + WS_CTL + CTL_SS);
      for (int m = gw; m < M; m += NGW) { const GAS f32x4* xr = (const GAS f32x4*)(a.in[I_X] + (size_t)m * D) + F.lane; GAS v2u* o8 = (GAS v2u*)(HB + (size_t)m * D) + F.lane; float s = 0.f;
#pragma unroll
          for (int j = 0; j < 8; ++j) { const f32x4 v = xr[64 * j]; s += (v.x * v.x + v.y * v.y) + (v.z * v.z + v.w * v.w); v2u w; w.x = pk2(v.x, v.y); w.y = pk2(v.z, v.w); o8[64 * j] = w; }
          s = wave_sum(s); if (F.lane == 0) ss0[m] = (pg8::u64_t)(s * 65536.0f + 0.5f); } }
    { bf16* MN = (bf16*)(ws + WS_MEMN); const float* gm = a.in[I_MEMNRM];
      for (int m = gw; m < BATCH * MEML; m += NGW) { const GAS f32x4* xr = (const GAS f32x4*)(a.in[I_MEM] + (size_t)m * D) + F.lane; GAS v2u* o8 = (GAS v2u*)(MN + (size_t)m * D) + F.lane; f32x4 v[8]; float s = 0.f;
#pragma unroll
          for (int j = 0; j < 8; ++j) { v[j] = xr[64 * j]; s += (v[j].x * v[j].x + v[j].y * v[j].y) + (v[j].z * v[j].z + v[j].w * v[j].w); }
          const float rs = rsqrtf(wave_sum(s) * (1.0f / D) + 1e-6f);
#pragma unroll
          for (int j = 0; j < 8; ++j) { const f32x4 g = *((const GAS f32x4*)gm + F.lane + 64 * j); v2u w; w.x = pk2(v[j].x * rs * g.x, v[j].y * rs * g.y); w.y = pk2(v[j].z * rs * g.z, v[j].w * rs * g.w); o8[64 * j] = w; } } }
}
__device__ __forceinline__ void p5_conv(Frame& F_, const Args& a) {
    Frame F = F_; asm volatile("" : "+v"(F.lane));
    const int gw = F.vcu * NWAVES + F.wave, NGW = F.G * NWAVES; unsigned char* ws = a.ws;
    const bf16* CU = (const bf16*)(ws + WS_CU); const bf16* BG = (const bf16*)(ws + WS_BG); bf16* MX = (bf16*)(ws + WS_MIXED); const float* cw = a.in[I_CONVW];
    for (int m = gw; m < M; m += NGW) { const int t = m & (SEQ - 1); float y[16]; float s = 0.f;
#pragma unroll
        for (int gsel = 0; gsel < 2; ++gsel) { const int ch = gsel * 512 + F.lane * 8;
            const v4u c0 = *(const GAS v4u*)(CU + (size_t)m * 1024 + ch); v4u c1 = (v4u){0u, 0u, 0u, 0u}, c2 = (v4u){0u, 0u, 0u, 0u};
            if (t >= 1) c1 = *(const GAS v4u*)(CU + (size_t)(m - 1) * 1024 + ch);
            if (t >= 2) c2 = *(const GAS v4u*)(CU + (size_t)(m - 2) * 1024 + ch);
            const v4u bg = *(const GAS v4u*)(BG + (size_t)m * 1024 + ch);
            const f32x4 w0a = *(const GAS f32x4*)(cw + ch), w0b = *(const GAS f32x4*)(cw + ch + 4), w1a = *(const GAS f32x4*)(cw + 1024 + ch), w1b = *(const GAS f32x4*)(cw + 1024 + ch + 4), w2a = *(const GAS f32x4*)(cw + 2048 + ch), w2b = *(const GAS f32x4*)(cw + 2048 + ch + 4);
#pragma unroll
            for (int e = 0; e < 4; ++e) { const unsigned x0 = c0[e], x1 = c1[e], x2 = c2[e], bw = bg[e];
                const float wl0 = e < 2 ? w0a[2 * e] : w0b[2 * e - 4], wh0 = e < 2 ? w0a[2 * e + 1] : w0b[2 * e - 3];
                const float wl1 = e < 2 ? w1a[2 * e] : w1b[2 * e - 4], wh1 = e < 2 ? w1a[2 * e + 1] : w1b[2 * e - 3];
                const float wl2 = e < 2 ? w2a[2 * e] : w2b[2 * e - 4], wh2 = e < 2 ? w2a[2 * e + 1] : w2b[2 * e - 3];
                const float lo = bflo(bw) * (wl0 * bflo(x2) + wl1 * bflo(x1) + wl2 * bflo(x0)), hi = bfhi(bw) * (wh0 * bfhi(x2) + wh1 * bfhi(x1) + wh2 * bfhi(x0));
                y[gsel * 8 + 2 * e] = lo; y[gsel * 8 + 2 * e + 1] = hi; s += lo * lo + hi * hi; } }
        const float rs = rsqrtf(wave_sum(s) * (1.0f / 1024.0f) + 1e-6f);
#pragma unroll
        for (int gsel = 0; gsel < 2; ++gsel) {
            if constexpr (((USE_FP8 >> 6) & 1) != 0) { const pg8::u32x2 o = pg8::pack8_f8((f32x4){y[gsel * 8 + 0], y[gsel * 8 + 1], y[gsel * 8 + 2], y[gsel * 8 + 3]} * rs, (f32x4){y[gsel * 8 + 4], y[gsel * 8 + 5], y[gsel * 8 + 6], y[gsel * 8 + 7]} * rs);
                *(GAS v2u*)((unsigned char*)MX + (size_t)m * 2048 + 1024 + gsel * 512 + F.lane * 8) = (v2u){o.x, o.y}; }
            else { v4u o; o.x = pk2(y[gsel * 8 + 0] * rs, y[gsel * 8 + 1] * rs); o.y = pk2(y[gsel * 8 + 2] * rs, y[gsel * 8 + 3] * rs); o.z = pk2(y[gsel * 8 + 4] * rs, y[gsel * 8 + 5] * rs); o.w = pk2(y[gsel * 8 + 6] * rs, y[gsel * 8 + 7] * rs);
                *(GAS v4u*)(MX + (size_t)m * 2048 + 1024 + gsel * 512 + F.lane * 8) = o; } } }
}
__device__ __forceinline__ void p12_final(Frame& F_, const Args& a) {
    Frame F = F_; asm volatile("" : "+v"(F.lane));
    const int gw = F.vcu * NWAVES + F.wave, NGW = F.G * NWAVES; const pg8::u64_t* ss4 = (const pg8::u64_t*)(a.ws + WS_CTL + CTL_SS) + 5 * M; const float* gf = a.in[I_FINAL]; const bf16* HB = (const bf16*)(a.ws + WS_HB);
    for (int m = gw; m < M; m += NGW) { GAS f32x4* xr = (GAS f32x4*)(a.out + (size_t)m * D); const GAS v4u* hr = (const GAS v4u*)(HB + (size_t)m * D) + F.lane; const float rs = rsqrtf(pg8::ss_val(ss4, m) * (1.0f / D) + 1e-6f);
#pragma unroll
        for (int j = 0; j < 4; ++j) { const v4u w = hr[64 * j]; const int c = (F.lane + 64 * j) * 8; const f32x4 g0 = *(const GAS f32x4*)(gf + c), g1 = *(const GAS f32x4*)(gf + c + 4);
            xr[(c >> 2)] = (f32x4){bflo(w.x), bfhi(w.x), bflo(w.y), bfhi(w.y)} * g0 * rs; xr[(c >> 2) + 1] = (f32x4){bflo(w.z), bfhi(w.z), bflo(w.w), bfhi(w.w)} * g1 * rs; } }
}
#ifndef DUP_MASK
#define DUP_MASK 0
#endif
#ifndef MOBA_SDEPTH
#define MOBA_SDEPTH 1
#endif
__global__ void __launch_bounds__(NWAVES * 64, 2) fwd_kernel(Args args) {
    extern __shared__ __attribute__((aligned(16))) unsigned char lds[];
    Frame F;
    F.lds = (LAS unsigned char*)lds;
    F.MISC = (volatile LAS unsigned*)(F.lds + MISC_OFF);
    F.tid = threadIdx.x; F.lane = F.tid & 63; F.wave = __builtin_amdgcn_readfirstlane(F.tid >> 6);
    F.G = gridDim.x; { const int bx = blockIdx.x; F.vcu = (F.G % 8 == 0) ? (bx % 8) * (F.G / 8) + bx / 8 : bx; }
    unsigned char* ws = args.ws;
    for (int u = F.tid; u < (LDS_BYTES - LDSCTL_OFF) / 4; u += NWAVES * 64) ((LAS unsigned*)(F.lds + LDSCTL_OFF))[u] = 0u;
    __syncthreads();
    const int lo = args.ph_lo, hi = args.ph_hi; const bool multi = (hi - lo) > 1;
    XcdBarrier bar; bar.bar = (unsigned*)(ws + WS_CTL + CTL_BAR + (size_t)lo * BAR_STRIDE); bar.x = 0; bar.st = nullptr;
    if (multi) bar = xcd_barrier_post((unsigned*)(ws + WS_CTL + CTL_BAR + (size_t)lo * BAR_STRIDE), F.MISC + 8);
#ifndef PH_ENABLE
#define PH_ENABLE 0x1fff
#endif
#define IN(k) ((((PH_ENABLE) >> (k)) & 1) && lo <= (k) && (k) < hi)
#define SEAM(k) do { if (IN(k) && IN((k) + 1)) xcd_barrier(bar); } while (0)
    pg8::u64_t* SS = (pg8::u64_t*)(ws + WS_CTL + CTL_SS);
    float* KMS = (float*)(ws + WS_CTL + CTL_KMS);
    bf16* HB = (bf16*)(ws + WS_HB); bf16* ACT = (bf16*)(ws + WS_ACT); bf16* MIXED = (bf16*)(ws + WS_MIXED);
    bf16* Qb = (bf16*)(ws + WS_Q); bf16* Kb = (bf16*)(ws + WS_K); bf16* Vb = (bf16*)(ws + WS_V); bf16* CUb = (bf16*)(ws + WS_CU); bf16* BGb = (bf16*)(ws + WS_BG);
    bf16* QX = (bf16*)(ws + WS_QX); bf16* OX = (bf16*)(ws + WS_OX); bf16* KVX = (bf16*)(ws + WS_KVX);
    const int bx = (int)blockIdx.x;

#ifndef F8_SP2
#define F8_SP2 PG8_SP2
#endif
#ifndef F8_ALIGN
#define F8_ALIGN PG8_ALIGN
#endif
#define GEMM_RUN(EPI, FP8FLAG, G_, S_, E_) pg8::gemm_phase<EPI, pg8::StaticOrder, (FP8FLAG) ? F8_ALIGN : PG8_ALIGN, (FP8FLAG) ? F8_SP2 : PG8_SP2, FP8FLAG>(F.lds + RING_OFF, G_, S_, E_)
#define DUPQ(k) (((DUP_MASK) >> (k)) & 1)
    pg8::u64_t* DUMMY = (pg8::u64_t*)(ws + WS_DUMMY);
    unsigned char* MIXED8 = ws + WS_MIXED; unsigned char* HB8 = ws + WS_HB8; unsigned char* ACT8 = ws + WS_ACT8; unsigned char* OX8 = ws + WS_OX8;
    constexpr bool F3 = ((USE_FP8 >> 3) & 1) != 0, F6 = ((USE_FP8 >> 6) & 1) != 0, F7 = ((USE_FP8 >> 7) & 1) != 0, F9 = ((USE_FP8 >> 9) & 1) != 0, F10 = ((USE_FP8 >> 10) & 1) != 0, F11 = ((USE_FP8 >> 11) & 1) != 0;
    static_assert(!F3 || F6, "the e4m3 copy of h1 lives in the upper half of the mixed buffer: phase 3 on e4m3 needs phase 6 on e4m3");
    constexpr float WSC = 1.0f / 64.0f;
    if (IN(0)) { p0_prologue(F, args); if (DUPQ(0)) p0_prologue(F, args); } SEAM(0);
    if (IN(1)) { pg8::Gemm g{HB, (const bf16*)(ws + WS_WGU1), M, 2 * FF, D}; pg8::StaticOrder S; S.init(M, 2 * FF, F.G, bx);
        typedef pg8::EpiSwiglu<false> EP; EP E{ACT, nullptr, FF, SS, 1.0f, 1.0f}; GEMM_RUN(EP, false, g, S, E); if (DUPQ(1)) GEMM_RUN(EP, false, g, S, E); } SEAM(1);
    if (IN(2)) { pg8::Gemm g{ACT, (const bf16*)(ws + WS_WD1), M, D, FF}; pg8::StaticOrder S; S.init(M, D, F.G, bx);
        typedef pg8::EpiResid<0, false, false> EP; EP E{args.in[I_X], nullptr, nullptr, HB, SS + M, 0.5f, nullptr, F3 ? ws + WS_H1F8 : nullptr, 1.0f}; GEMM_RUN(EP, false, g, S, E);
        if (DUPQ(2)) { EP E2{args.in[I_X], nullptr, nullptr, HB, DUMMY, 0.5f, nullptr, F3 ? ws + WS_H1F8 : nullptr, 1.0f}; GEMM_RUN(EP, false, g, S, E2); } } SEAM(2);
    if (IN(3)) for (int rep = 0; rep < (DUPQ(3) ? 2 : 1); ++rep) {
        float* kms = rep ? (float*)DUMMY : KMS;
        if constexpr (F3) {
            { pg8::Gemm g{HB, (const bf16*)(ws + WS_WIN), M, 2048, D}; pg8::StaticOrder S; S.init(M, 2048, F.G, bx);
              pg8::EpiWin E{Qb, Kb, Vb, CUb, BGb, kms, SS + M, 0, 1.0f}; GEMM_RUN(pg8::EpiWin, false, g, S, E); }
            { pg8::Gemm g{(const bf16*)(ws + WS_H1F8), (const bf16*)(ws + WS_WIN8), M, 4096, D}; pg8::StaticOrder S; S.init(M, 4096, F.G, bx);
              pg8::EpiWin E{Qb, Kb, Vb, CUb, BGb, kms, SS + M, 8, WSC}; GEMM_RUN(pg8::EpiWin, true, g, S, E); }
        } else { pg8::Gemm g{HB, (const bf16*)(ws + WS_WIN), M, INW, D}; pg8::StaticOrder S; S.init(M, INW, F.G, bx);
            pg8::EpiWin E{Qb, Kb, Vb, CUb, BGb, kms, SS + M, 0, 1.0f}; GEMM_RUN(pg8::EpiWin, false, g, S, E); } } SEAM(3);
    if (IN(4)) for (int rep = 0; rep < (DUPQ(4) ? 2 : 1); ++rep) {
        for (int u = F.vcu; u < BATCH * NH * 8; u += F.G) { const int b = u >> 6, h = (u >> 3) & 7, p = u & 7;
#pragma unroll 1
            for (int half = 0; half < 2; ++half) { const int qb = half ? 15 - p : p; const size_t r0 = (size_t)b * SEQ + (size_t)qb * 256;
                if constexpr (F6) att::attn_body<true, 1024, 1024, 2048, MOBA_SDEPTH, unsigned char, 32>(Qb + r0 * 1024 + h * 128, Kb + (size_t)b * SEQ * 1024 + h * 128, Vb + (size_t)b * SEQ * 1024 + h * 128, MIXED8 + r0 * 2048 + h * 128,
                                                       256 * (qb + 1), (att::lptr)(F.lds + RING_OFF), qb, KMS + ((size_t)b * 16 * 8 + h) * 128, 8 * 128, (rep ? DUMMY : SS + 2 * M) + r0);
                else att::attn_body<true, 1024, 1024, 2048, MOBA_SDEPTH, bf16, 1>(Qb + r0 * 1024 + h * 128, Kb + (size_t)b * SEQ * 1024 + h * 128, Vb + (size_t)b * SEQ * 1024 + h * 128, MIXED + r0 * 2048 + h * 128,
                                                       256 * (qb + 1), (att::lptr)(F.lds + RING_OFF), qb, KMS + ((size_t)b * 16 * 8 + h) * 128, 8 * 128, (rep ? DUMMY : SS + 2 * M) + r0); } } }
    if (IN(5)) { p5_conv(F, args); if (DUPQ(5)) p5_conv(F, args); } SEAM(5);
    if (IN(6)) { pg8::Gemm g{F6 ? (const bf16*)MIXED8 : MIXED, (const bf16*)(ws + WS_WOUT), M, D, D}; pg8::StaticOrder S; S.init(M, D, F.G, bx);
        typedef pg8::EpiResid<F6 ? 8 : 16, true, false> EP; EP E{nullptr, HB, nullptr, HB, SS + 3 * M, F6 ? WSC : 1.0f, SS + 2 * M, F7 ? HB8 : nullptr, F6 ? 1.0f / 32.0f : 1.0f}; GEMM_RUN(EP, F6, g, S, E);
        if (DUPQ(6)) { EP E2{nullptr, HB, nullptr, HB, DUMMY, 0.0f, SS + 2 * M, F7 ? HB8 : nullptr, F6 ? 1.0f / 32.0f : 1.0f}; GEMM_RUN(EP, F6, g, S, E2); } } SEAM(6);
    if (IN(7)) for (int rep = 0; rep < (DUPQ(7) ? 2 : 1); ++rep) {
        { pg8::Gemm g{F7 ? (const bf16*)HB8 : HB, (const bf16*)(ws + WS_WQ), M, XW, D}; pg8::StaticOrder S; S.init(M, XW, F.G, bx);
          pg8::EpiScaleBf16 E{QX, XW, SS + 3 * M, F7 ? WSC : 1.0f}; GEMM_RUN(pg8::EpiScaleBf16, F7, g, S, E); }
        { pg8::Gemm g{(const bf16*)(ws + WS_MEMN), (const bf16*)(ws + WS_WKV), BATCH * MEML, 1024, D}; pg8::StaticOrder S; S.init(BATCH * MEML, 1024, F.G, (bx + F.G - 128) % F.G);
          pg8::EpiScaleBf16 E{KVX, 1024, nullptr, 1.0f}; GEMM_RUN(pg8::EpiScaleBf16, false, g, S, E); } } SEAM(7);
    if (IN(8)) for (int rep = 0; rep < (DUPQ(8) ? 2 : 1); ++rep) {
        for (int u = F.vcu; u < BATCH * XH * 16; u += F.G) { const int b = u >> 6, h = (u >> 4) & 3, qb = u & 15; const size_t r0 = (size_t)b * SEQ + (size_t)qb * 256;
            if constexpr (F9) att::attn_body<false, 512, 1024, 512, 2, unsigned char, 16>(QX + r0 * 512 + h * 128, KVX + (size_t)b * MEML * 1024 + h * 128, KVX + (size_t)b * MEML * 1024 + 512 + h * 128, OX8 + r0 * 512 + h * 128,
                                                  MEML, (att::lptr)(F.lds + RING_OFF), 0, nullptr, 0, nullptr);
            else att::attn_body<false, 512, 1024, 512, 2, bf16, 1>(QX + r0 * 512 + h * 128, KVX + (size_t)b * MEML * 1024 + h * 128, KVX + (size_t)b * MEML * 1024 + 512 + h * 128, OX + r0 * 512 + h * 128,
                                                  MEML, (att::lptr)(F.lds + RING_OFF), 0, nullptr, 0, nullptr); } } SEAM(8);
    if (IN(9)) { pg8::Gemm g{F9 ? (const bf16*)OX8 : OX, (const bf16*)(ws + WS_WO), M, D, XW}; pg8::StaticOrder S; S.init(M, D, F.G, bx);
        typedef pg8::EpiResid<0, true, false> EP; EP E{nullptr, HB, nullptr, HB, SS + 4 * M, F9 ? WSC / 16.0f : 1.0f, nullptr, F10 ? HB8 : nullptr, 1.0f}; GEMM_RUN(EP, F9, g, S, E);
        if (DUPQ(9)) { EP E2{nullptr, HB, nullptr, HB, DUMMY, 0.0f, nullptr, F10 ? HB8 : nullptr, 1.0f}; GEMM_RUN(EP, F9, g, S, E2); } } SEAM(9);
    if (IN(10)) { pg8::Gemm g{F10 ? (const bf16*)HB8 : HB, (const bf16*)(ws + WS_WGU2), M, 2 * FF, D}; pg8::StaticOrder S; S.init(M, 2 * FF, F.G, bx);
        typedef pg8::EpiSwiglu<F11> EP; EP E{ACT, ACT8, FF, SS + 4 * M, F10 ? WSC : 1.0f, 4.0f}; GEMM_RUN(EP, F10, g, S, E); if (DUPQ(10)) GEMM_RUN(EP, F10, g, S, E); } SEAM(10);
    if (IN(11)) { pg8::Gemm g{F11 ? (const bf16*)ACT8 : ACT, (const bf16*)(ws + WS_WD2), M, D, FF}; pg8::StaticOrder S; S.init(M, D, F.G, bx);
        typedef pg8::EpiResid<0, true, false> EP; EP E{nullptr, HB, nullptr, HB, SS + 5 * M, F11 ? 0.5f * WSC / 4.0f : 0.5f, nullptr, nullptr, 1.0f}; GEMM_RUN(EP, F11, g, S, E);
        if (DUPQ(11)) { EP E2{nullptr, HB, nullptr, HB, DUMMY, 0.0f, nullptr, nullptr, 1.0f}; GEMM_RUN(EP, F11, g, S, E2); } } SEAM(11);
    if (IN(12)) { p12_final(F, args); }
#undef GEMM_RUN
#undef DUPQ
#undef IN
#undef SEAM
}

extern "C" void kernel_launch(void* const* d_in, const int* in_sizes, int n_in, void* d_out, int out_size, void* d_ws, size_t ws_size, hipStream_t stream) {
    static int grid = 0;
    if (grid == 0) {
        if (n_in != 22 || in_sizes[0] != M * D || out_size != M * D || ws_size < WS_END) { fprintf(stderr, "kernel_launch: shape mismatch (n_in %d, in0 %d, out %d, ws %zu; need ws >= %zu); nothing launched\n", n_in, n_in > 0 ? in_sizes[0] : -1, out_size, ws_size, (size_t)WS_END); grid = -1; return; }
        int dev = 0, cus = 0, per_cu = 0;
        if (hipGetDevice(&dev) != hipSuccess || hipDeviceGetAttribute(&cus, hipDeviceAttributeMultiprocessorCount, dev) != hipSuccess) { grid = -1; return; }
        if (hipFuncSetAttribute((const void*)fwd_kernel, hipFuncAttributeMaxDynamicSharedMemorySize, LDS_BYTES) != hipSuccess) { fprintf(stderr, "kernel_launch: hipFuncSetAttribute failed\n"); grid = -1; return; }
        if (hipOccupancyMaxActiveBlocksPerMultiprocessor(&per_cu, (const void*)fwd_kernel, NWAVES * 64, LDS_BYTES) != hipSuccess || per_cu < 1) { fprintf(stderr, "kernel_launch: occupancy query reports %d workgroups per CU\n", per_cu); }
        (void)hipGetLastError();
        grid = cus;
    }
    if (grid < 0) return;
    if (hipMemsetAsync((char*)d_ws + WS_CTL, 0, CTL_ZERO_BYTES, stream) != hipSuccess) { fprintf(stderr, "kernel_launch: hipMemsetAsync failed\n"); return; }
    Args a{};
    for (int i = 0; i < 22; ++i) a.in[i] = (const float*)d_in[i];
    a.out = (float*)d_out; a.ws = (unsigned char*)d_ws;
    unsigned char* ws = (unsigned char*)d_ws; pg8::u64_t* SS = (pg8::u64_t*)(ws + WS_CTL + CTL_SS); float* KMS = (float*)(ws + WS_CTL + CTL_KMS); float* out = (float*)d_out;
    bf16* HB = (bf16*)(ws + WS_HB); bf16* ACT = (bf16*)(ws + WS_ACT); bf16* MIXED = (bf16*)(ws + WS_MIXED);
    bf16* Qb = (bf16*)(ws + WS_Q); bf16* Kb = (bf16*)(ws + WS_K); bf16* Vb = (bf16*)(ws + WS_V); bf16* CUb = (bf16*)(ws + WS_CU); bf16* BGb = (bf16*)(ws + WS_BG);
    bf16* QX = (bf16*)(ws + WS_QX); bf16* OX = (bf16*)(ws + WS_OX); bf16* KVX = (bf16*)(ws + WS_KVX);
    (void)SS; (void)KMS; (void)out; (void)HB; (void)ACT; (void)MIXED; (void)Qb; (void)Kb; (void)Vb; (void)CUb; (void)BGb; (void)QX; (void)OX; (void)KVX;
#if ONE_LAUNCH
    a.ph_lo = 0; a.ph_hi = NPH;
    hipLaunchKernelGGL(fwd_kernel, dim3(grid), dim3(NWAVES * 64), LDS_BYTES, stream, a);
#else
    for (int ph = 0; ph < NPH; ++ph) {
        if ((FAST_MASK >> ph) & 1) { a.ph_lo = ph; a.ph_hi = ph + 1; hipLaunchKernelGGL(fwd_kernel, dim3(grid), dim3(NWAVES * 64), LDS_BYTES, stream, a); continue; }
        switch (ph) {
        case 1: hipLaunchKernelGGL((nv::gemm<nv::FSwiglu>), dim3(FF / 64, M / 64), dim3(256), 0, stream, HB, (const bf16*)(ws + WS_WGU1), D, nv::FSwiglu{ACT, SS}); break;
        case 2: hipLaunchKernelGGL((nv::gemm<nv::FResid<0, false, false>>), dim3(D / 64, M / 64), dim3(256), 0, stream, ACT, (const bf16*)(ws + WS_WD1), FF, nv::FResid<0, false, false>{a.in[I_X], nullptr, nullptr, HB, SS + M, 0.5f, nullptr}); break;
        case 3: hipLaunchKernelGGL((nv::gemm<nv::FWin>), dim3(5120 / 64, M / 64), dim3(256), 0, stream, HB, (const bf16*)(ws + WS_WIN), D, nv::FWin{Qb, Kb, Vb, CUb, BGb, SS + M});
                hipLaunchKernelGGL(nv::kmean, dim3(BATCH * 16 * 8 * 128 / 256), dim3(256), 0, stream, Kb, KMS); break;
        case 4: hipLaunchKernelGGL(nv::moba, dim3(M * NH / 4), dim3(256), 0, stream, Qb, Kb, Vb, KMS, MIXED, SS + 2 * M); break;
        case 6: hipLaunchKernelGGL((nv::gemm<nv::FResid<1024, true, false>>), dim3(D / 64, M / 64), dim3(256), 0, stream, MIXED, (const bf16*)(ws + WS_WOUT), D, nv::FResid<1024, true, false>{nullptr, HB, nullptr, HB, SS + 3 * M, 1.0f, SS + 2 * M}); break;
        case 7: hipLaunchKernelGGL((nv::gemm<nv::FScale>), dim3(XW / 64, M / 64), dim3(256), 0, stream, HB, (const bf16*)(ws + WS_WQ), D, nv::FScale{QX, XW, SS + 3 * M});
                hipLaunchKernelGGL((nv::gemm<nv::FScale>), dim3(1024 / 64, BATCH * MEML / 64), dim3(256), 0, stream, (const bf16*)(ws + WS_MEMN), (const bf16*)(ws + WS_WKV), D, nv::FScale{KVX, 1024, nullptr}); break;
        case 8: hipLaunchKernelGGL(nv::xattn, dim3(M * XH / 4), dim3(256), 0, stream, QX, KVX, OX); break;
        case 9: hipLaunchKernelGGL((nv::gemm<nv::FResid<0, true, false>>), dim3(D / 64, M / 64), dim3(256), 0, stream, OX, (const bf16*)(ws + WS_WO), XW, nv::FResid<0, true, false>{nullptr, HB, nullptr, HB, SS + 4 * M, 1.0f, nullptr}); break;
        case 10: hipLaunchKernelGGL((nv::gemm<nv::FSwiglu>), dim3(FF / 64, M / 64), dim3(256), 0, stream, HB, (const bf16*)(ws + WS_WGU2), D, nv::FSwiglu{ACT, SS + 4 * M}); break;
        case 11: hipLaunchKernelGGL((nv::gemm<nv::FResid<0, true, false>>), dim3(D / 64, M / 64), dim3(256), 0, stream, ACT, (const bf16*)(ws + WS_WD2), FF, nv::FResid<0, true, false>{nullptr, HB, nullptr, HB, SS + 5 * M, 0.5f, nullptr}); break;
        default: break;
        }
    }
#endif
    const hipError_t le = hipPeekAtLastError();
    if (le != hipSuccess) fprintf(stderr, "kernel_launch: launch failed: %s\n", hipGetErrorName(le));
}
```

```cpp
#define ONE_LAUNCH 1
#define FAST_MASK 0x1fff
#define USE_FP8 0xEC8
#include <hip/hip_runtime.h>
#include <cstdio>
#include <cstdint>
namespace pg8 {
#define PG8_LAS __attribute__((address_space(3)))
typedef unsigned short bf16_t;
typedef short bf16x8 __attribute__((ext_vector_type(8)));
typedef float f32x4 __attribute__((ext_vector_type(4)));
typedef unsigned u32x4 __attribute__((ext_vector_type(4)));
typedef int i32x4 __attribute__((ext_vector_type(4)));
typedef int i32x8 __attribute__((ext_vector_type(8)));
typedef unsigned u32x2 __attribute__((ext_vector_type(2)));
constexpr int BM = 256, BK = 64, HALF = 128, HTB = HALF * BK * 2  , STAGE_BYTES = 8 * HTB, NXCD = 8, WGM = 8;

__host__ __device__ __forceinline__ int lds_byte(int r, int c) { const int st = (r >> 4) * 2 + (c >> 5), rr = r & 15, cc = c & 31, ob = rr * 64 + cc * 2; return st * 1024 + (ob ^ (((ob >> 9) & 1) << 5)); }
__host__ __device__ __forceinline__ void stage_rc(int b, int& R, int& C) { const int st = b / 1024, sb = b % 1024, swz = sb ^ (((sb >> 9) & 1) << 5); R = (st >> 1) * 16 + swz / 64; C = (st & 1) * 32 + (swz % 64) / 2; }
__host__ __device__ __forceinline__ int perm32(int rho) { const int n = rho >> 4, i = rho & 15; return 8 * (i >> 2) + 4 * n + (i & 3); }

struct Unit { int pm, pn; };
struct Gemm { const bf16_t* A; const bf16_t* Bt; int M, N, K; };

struct StaticOrder {
    int nM, nN, nwg, G, c;
    __host__ __device__ void init(int M, int N, int G_, int c_) { nM = M / BM; nN = N / BM; nwg = nM * nN; G = G_; c = c_; }
    __host__ __device__ bool next(int i, Unit& u) const {
        const long L = (long)i * G + c; if (L >= nwg) return false;
        int wgid = (int)L; { const int q = nwg / NXCD, r = nwg % NXCD, xcd = wgid % NXCD, off = wgid / NXCD; wgid = (xcd < r ? xcd * (q + 1) : r * (q + 1) + (xcd - r) * q) + off; }
        const int nig = WGM * nN, gid = wgid / nig, fm = gid * WGM, gsz = (nM - fm) < WGM ? (nM - fm) : WGM;
        u.pm = fm + ((wgid % nig) % gsz); u.pn = (wgid % nig) / gsz; return true;
    }
    __device__ __forceinline__ void a_ready(const Unit&) const {}
    __device__ __forceinline__ void done(const Unit&) const {}
};

__device__ __forceinline__ unsigned cvt_pk_bf16(float lo, float hi) { unsigned r; asm volatile("v_cvt_pk_bf16_f32 %0, %1, %2" : "=v"(r) : "v"(lo), "v"(hi)); return r; }
__device__ __forceinline__ u32x4 pack8(const f32x4 v0, const f32x4 v1) { u32x4 w; w.x = cvt_pk_bf16(v0[0], v0[1]); w.y = cvt_pk_bf16(v0[2], v0[3]); w.z = cvt_pk_bf16(v1[0], v1[1]); w.w = cvt_pk_bf16(v1[2], v1[3]); return w; }
constexpr float RMS_EPS = 1e-6f;
typedef unsigned long long u64_t;
__device__ __forceinline__ float ss_val(const u64_t* ss, int row) { return (float)ss[row] * (1.0f / 65536.0f); }
__device__ __forceinline__ void ss_add(u64_t* ss, int row, float sq) { atomicAdd(ss + row, (u64_t)(unsigned)(sq * 65536.0f + 0.5f)); }
__device__ __forceinline__ float clamp_f8(float x) { return __builtin_amdgcn_fmed3f(x, -448.0f, 448.0f); }
__device__ __forceinline__ u32x2 pack8_f8(const f32x4 v0, const f32x4 v1) { int a = __builtin_amdgcn_cvt_pk_fp8_f32(clamp_f8(v0[0]), clamp_f8(v0[1]), 0, false); a = __builtin_amdgcn_cvt_pk_fp8_f32(clamp_f8(v0[2]), clamp_f8(v0[3]), a, true);
    int b = __builtin_amdgcn_cvt_pk_fp8_f32(clamp_f8(v1[0]), clamp_f8(v1[1]), 0, false); b = __builtin_amdgcn_cvt_pk_fp8_f32(clamp_f8(v1[2]), clamp_f8(v1[3]), b, true); u32x2 w; w.x = (unsigned)a; w.y = (unsigned)b; return w; }
__device__ __forceinline__ float silu_mul(float g, float u) { return g * u * __builtin_amdgcn_rcpf(1.0f + __builtin_amdgcn_exp2f(-1.4426950408889634f * g)); }

template <bool F8OUT> struct EpiSwiglu {
    static constexpr bool PERM = true, AFTER_DRAIN = false; static constexpr int MIDT = 0;
    bf16_t* O; unsigned char* O8; int ldo; const u64_t* ss; float asc, osc;
    __device__ __forceinline__ void mid(f32x4 (&)[2][2][4][2], const Unit&, int, int) const {}
    __device__ __forceinline__ void operator()(const f32x4 (&acc)[2][2][4][2], const Unit& u, int wr, int wc, int fr_, int fq_) const {
        int fr = fr_, fq = fq_; asm volatile("" : "+v"(fr), "+v"(fq));
        const int row0 = u.pm * BM + wr * 64 + fr, col0 = u.pn * HALF + wc * 32 + 8 * fq;
#pragma unroll
        for (int ai = 0; ai < 2; ++ai)
#pragma unroll
            for (int m = 0; m < 4; ++m) { const int row = row0 + ai * HALF + m * 16; const float rs = asc * rsqrtf(ss_val(ss, row) * (1.0f / 2048.0f) + RMS_EPS);
                f32x4 o0, o1;
#pragma unroll
                for (int j = 0; j < 4; ++j) { o0[j] = silu_mul(acc[ai][0][m][0][j] * rs, acc[ai][1][m][0][j] * rs); o1[j] = silu_mul(acc[ai][0][m][1][j] * rs, acc[ai][1][m][1][j] * rs); }
                if constexpr (F8OUT) *(u32x2*)(O8 + (size_t)row * ldo + col0) = pack8_f8(o0 * osc, o1 * osc);
                else *(u32x4*)(O + (size_t)row * ldo + col0) = pack8(o0, o1); }
    }
};
template <int MIDT_, bool RBF, bool OF32> struct EpiResid {
    static constexpr bool PERM = true, AFTER_DRAIN = false; static constexpr int MIDT = MIDT_;
    const float* R; const bf16_t* RB; float* H; bf16_t* HB; u64_t* ssn; float alpha; const u64_t* midss; unsigned char* HB8; float midmul;
    __device__ __forceinline__ void mid(f32x4 (&acc)[2][2][4][2], const Unit& u, int wr, int fr) const {
        const int row0 = u.pm * BM + wr * 64 + fr;
#pragma unroll
        for (int ai = 0; ai < 2; ++ai)
#pragma unroll
            for (int m = 0; m < 4; ++m) { const float s = midmul * rsqrtf(ss_val(midss, row0 + ai * HALF + m * 16) * (1.0f / 1024.0f) + RMS_EPS);
#pragma unroll
                for (int bj = 0; bj < 2; ++bj)
#pragma unroll
                    for (int n = 0; n < 2; ++n) acc[ai][bj][m][n] = acc[ai][bj][m][n] * s; }
    }
    __device__ __forceinline__ void operator()(const f32x4 (&acc)[2][2][4][2], const Unit& u, int wr, int wc, int fr_, int fq_) const {
        int fr = fr_, fq = fq_; asm volatile("" : "+v"(fr), "+v"(fq));
        const int row0 = u.pm * BM + wr * 64 + fr, col0 = u.pn * BM + wc * 32 + 8 * fq;
#pragma unroll
        for (int ai = 0; ai < 2; ++ai)
#pragma unroll
            for (int m = 0; m < 4; ++m) { const int row = row0 + ai * HALF + m * 16; const size_t off = (size_t)row * 2048 + col0; float sq = 0.f;
#pragma unroll
                for (int bj = 0; bj < 2; ++bj) { f32x4 r0, r1;
                    if constexpr (RBF) { const u32x4 w = *(const u32x4*)(RB + off + bj * HALF);
                        r0 = (f32x4){__uint_as_float(w.x << 16), __uint_as_float(w.x & 0xffff0000u), __uint_as_float(w.y << 16), __uint_as_float(w.y & 0xffff0000u)};
                        r1 = (f32x4){__uint_as_float(w.z << 16), __uint_as_float(w.z & 0xffff0000u), __uint_as_float(w.w << 16), __uint_as_float(w.w & 0xffff0000u)}; }
                    else { r0 = *(const f32x4*)(R + off + bj * HALF); r1 = *(const f32x4*)(R + off + bj * HALF + 4); }
                    const f32x4 h0 = r0 + acc[ai][bj][m][0] * alpha, h1 = r1 + acc[ai][bj][m][1] * alpha;
                    if constexpr (OF32) { *(f32x4*)(H + off + bj * HALF) = h0; *(f32x4*)(H + off + bj * HALF + 4) = h1; }
                    else { *(u32x4*)(HB + off + bj * HALF) = pack8(h0, h1); if (HB8) *(u32x2*)(HB8 + off + bj * HALF) = pack8_f8(h0, h1); }
                    sq += (h0[0] * h0[0] + h0[1] * h0[1]) + (h0[2] * h0[2] + h0[3] * h0[3]) + (h1[0] * h1[0] + h1[1] * h1[1]) + (h1[2] * h1[2] + h1[3] * h1[3]); }
                sq += __shfl_xor(sq, 16); sq += __shfl_xor(sq, 32);
                if (fq == 0) ss_add(ssn, row, sq);
                asm volatile("" ::: "memory"); }
    }
};
struct EpiWin {
    static constexpr bool PERM = true, AFTER_DRAIN = false; static constexpr int MIDT = 0;
    bf16_t *Q, *K, *V, *CU, *BG; float* kms; const u64_t* ss; int pn_off; float asc;
    __device__ __forceinline__ void mid(f32x4 (&)[2][2][4][2], const Unit&, int, int) const {}
    __device__ __forceinline__ void operator()(const f32x4 (&acc)[2][2][4][2], const Unit& u, int wr, int wc, int fr_, int fq_) const {
        int fr = fr_, fq = fq_; asm volatile("" : "+v"(fr), "+v"(fq));
        const int row0 = u.pm * BM + wr * 64 + fr, pn = u.pn + pn_off;
        if (pn >= 12 && pn < 20) {
            const int col0 = (pn - 12) * HALF + wc * 32 + 8 * fq;
#pragma unroll
            for (int ai = 0; ai < 2; ++ai)
#pragma unroll
                for (int m = 0; m < 4; ++m) { const int row = row0 + ai * HALF + m * 16; float rs = asc * rsqrtf(ss_val(ss, row) * (1.0f / 2048.0f) + RMS_EPS); rs = rs * rs;
                    const f32x4 o0 = acc[ai][0][m][0] * acc[ai][1][m][0] * rs, o1 = acc[ai][0][m][1] * acc[ai][1][m][1] * rs;
                    *(u32x4*)(CU + (size_t)row * 1024 + col0) = pack8(o0, o1); }
        } else {
            bf16_t* base = pn < 4 ? Q : pn < 8 ? K : pn < 12 ? V : BG; const int colt = (pn & 3) * BM, col0 = colt + wc * 32 + 8 * fq; const bool isk = (pn >= 4 && pn < 8);
            float rsv[2][4];
#pragma unroll
            for (int ai = 0; ai < 2; ++ai)
#pragma unroll
                for (int m = 0; m < 4; ++m) rsv[ai][m] = asc * rsqrtf(ss_val(ss, row0 + ai * HALF + m * 16) * (1.0f / 2048.0f) + RMS_EPS);
#pragma unroll
            for (int ai = 0; ai < 2; ++ai)
#pragma unroll
                for (int m = 0; m < 4; ++m) { const int row = row0 + ai * HALF + m * 16;
#pragma unroll
                    for (int bj = 0; bj < 2; ++bj) *(u32x4*)(base + (size_t)row * 1024 + col0 + bj * HALF) = pack8(acc[ai][bj][m][0] * rsv[ai][m], acc[ai][bj][m][1] * rsv[ai][m]); }
            if (isk) {
#pragma unroll
                for (int bj = 0; bj < 2; ++bj)
#pragma unroll
                    for (int n = 0; n < 2; ++n) { f32x4 c = (f32x4){0.f, 0.f, 0.f, 0.f};
#pragma unroll
                        for (int ai = 0; ai < 2; ++ai)
#pragma unroll
                            for (int m = 0; m < 4; ++m) { float r2 = rsv[ai][m]; asm volatile("" : "+v"(r2)); c += acc[ai][bj][m][n] * r2; }
#pragma unroll
                        for (int j = 0; j < 4; ++j) { float v = c[j]; v += __shfl_xor(v, 1); v += __shfl_xor(v, 2); v += __shfl_xor(v, 4); v += __shfl_xor(v, 8);
                            const int col = col0 + bj * HALF + 4 * n + j;
                            if (fr == 0) unsafeAtomicAdd(kms + ((size_t)u.pm * 8 + (col >> 7)) * 128 + (col & 127), v); }
                        asm volatile("" ::: "memory"); }
            }
        }
    }
};
struct EpiScaleBf16 {
    static constexpr bool PERM = true, AFTER_DRAIN = false; static constexpr int MIDT = 0;
    bf16_t* O; int ldo; const u64_t* ss; float asc;
    __device__ __forceinline__ void mid(f32x4 (&)[2][2][4][2], const Unit&, int, int) const {}
    __device__ __forceinline__ void operator()(const f32x4 (&acc)[2][2][4][2], const Unit& u, int wr, int wc, int fr_, int fq_) const {
        int fr = fr_, fq = fq_; asm volatile("" : "+v"(fr), "+v"(fq));
        const int row0 = u.pm * BM + wr * 64 + fr, col0 = u.pn * BM + wc * 32 + 8 * fq;
#pragma unroll
        for (int ai = 0; ai < 2; ++ai)
#pragma unroll
            for (int m = 0; m < 4; ++m) { const int row = row0 + ai * HALF + m * 16; const float rs = asc * (ss ? rsqrtf(ss_val(ss, row) * (1.0f / 2048.0f) + RMS_EPS) : 1.0f);
#pragma unroll
                for (int bj = 0; bj < 2; ++bj) *(u32x4*)(O + (size_t)row * ldo + col0 + bj * HALF) = pack8(acc[ai][bj][m][0] * rs, acc[ai][bj][m][1] * rs); }
    }
};

template <class Epi, class Sched, bool ALIGN_EPI = false, bool SP2 = false, bool FP8 = false>
__device__ __forceinline__ void gemm_phase(PG8_LAS unsigned char* lds, const Gemm g, const Sched& S, const Epi& E, const int wave_sgpr) {
    int tid_ = (int)__builtin_amdgcn_mbcnt_hi(~0u, __builtin_amdgcn_mbcnt_lo(~0u, 0u)) + 64 * wave_sgpr; asm volatile("" : "+v"(tid_));
    const int tid = tid_, wid = __builtin_amdgcn_readfirstlane(tid >> 6), lane = tid & 63, wr = wid >> 2, wc = wid & 3, fr = lane & 15, fq = lane >> 4;
    const int KB = FP8 ? g.K : g.K * 2, nt = KB / (BK * 2);
    unsigned voffA[2], voffB[2];
#pragma unroll
    for (int i = 0; i < 2; ++i) { int R, C; stage_rc(tid * 16 + i * 8192, R, C); const int Rb = Epi::PERM ? ((R & ~31) + perm32(R & 31)) : R;
        voffA[i] = (unsigned)(R * KB + C * 2); voffB[i] = (unsigned)(Rb * KB + C * 2); }
    const size_t kstep = (size_t)(BK * 2);
    const size_t hstep = (size_t)HALF * KB;
    const size_t tstep = 2 * hstep;
    const unsigned ldsw = (unsigned)wid * 1024u;
    const int aoff = lds_byte(wr * 64 + fr, fq * 8), boff = lds_byte(wc * 32 + fr, fq * 8);
#define PG8_SA(b, h) (((b) * 2 + (h)) * HTB)
#define PG8_SB(b, h) ((4 + (b) * 2 + (h)) * HTB)
#define PG8_STAGE(bufoff, gbase, voff) do { _Pragma("unroll") for (int _i = 0; _i < 2; ++_i) \
        __builtin_amdgcn_global_load_lds((const unsigned*)((const char*)(gbase) + (voff)[_i]), (PG8_LAS unsigned*)(lds + (bufoff) + ldsw + _i * 8192), 16, 0, 0); } while (0)
#define PG8_LDA(dst, b, h) do { _Pragma("unroll") for (int m = 0; m < 4; ++m) _Pragma("unroll") for (int k = 0; k < 2; ++k) dst[m][k] = *(const PG8_LAS bf16x8*)(lds + PG8_SA(b, h) + aoff + m * 2048 + k * 1024); } while (0)
#define PG8_LDB(dst, b, h) do { _Pragma("unroll") for (int n = 0; n < 2; ++n) _Pragma("unroll") for (int k = 0; k < 2; ++k) dst[n][k] = *(const PG8_LAS bf16x8*)(lds + PG8_SB(b, h) + boff + n * 2048 + k * 1024); } while (0)
#define PG8_CAT(x) __builtin_shufflevector(__builtin_bit_cast(i32x4, (x)[0]), __builtin_bit_cast(i32x4, (x)[1]), 0, 1, 2, 3, 4, 5, 6, 7)
#define PG8_MMA(ai, bj, At, Bt) do { __builtin_amdgcn_s_setprio(1); _Pragma("unroll") for (int m = 0; m < 4; ++m) _Pragma("unroll") for (int n = 0; n < 2; ++n) { \
        if constexpr (FP8) { const i32x8 b8_ = PG8_CAT(Bt[n]), a8_ = PG8_CAT(At[m]); asm volatile("v_mfma_f32_16x16x128_f8f6f4 %0, %1, %2, %0" : "+v"(acc[ai][bj][m][n]) : "v"(b8_), "v"(a8_)); }   \
        else { _Pragma("unroll") for (int k = 0; k < 2; ++k) acc[ai][bj][m][n] = __builtin_amdgcn_mfma_f32_16x16x32_bf16(Bt[n][k], At[m][k], acc[ai][bj][m][n], 0, 0, 0); } } __builtin_amdgcn_s_setprio(0); } while (0)
#define PG8_WAIT_V(n) asm volatile("s_waitcnt vmcnt(" #n ")" ::: "memory")
#define PG8_WAIT_L(n) asm volatile("s_waitcnt lgkmcnt(" #n ")" ::: "memory")
#define PG8_BAR __builtin_amdgcn_s_barrier()
#define PG8_SCHED __builtin_amdgcn_sched_barrier(0)
    Unit cur, nxt; int ui = 0;
    if (!S.next(0, cur)) return;
    f32x4 acc[2][2][4][2];
#pragma unroll
    for (int a = 0; a < 2; ++a)
#pragma unroll
        for (int b = 0; b < 2; ++b)
#pragma unroll
            for (int m = 0; m < 4; ++m)
#pragma unroll
                for (int n = 0; n < 2; ++n) acc[a][b][m][n] = (f32x4){0.f, 0.f, 0.f, 0.f};
    bf16x8 At[4][2], B0[2][2], B1[2][2];
    const char* cA = (const char*)g.A + (size_t)cur.pm * tstep; const char* cB = (const char*)g.Bt + (size_t)cur.pn * tstep;
    S.a_ready(cur);
    if constexpr (SP2) {
        PG8_STAGE(PG8_SB(0, 0), cB, voffB); PG8_STAGE(PG8_SB(0, 1), cB + hstep, voffB); PG8_STAGE(PG8_SA(0, 0), cA, voffA); PG8_STAGE(PG8_SA(0, 1), cA + hstep, voffA);
        if (wr == 1) PG8_BAR;
        PG8_WAIT_V(2); PG8_BAR;
        PG8_STAGE(PG8_SB(1, 0), cB + kstep, voffB); PG8_STAGE(PG8_SA(1, 0), cA + kstep, voffA); PG8_STAGE(PG8_SB(1, 1), cB + hstep + kstep, voffB);
        PG8_WAIT_V(6); PG8_BAR;
    } else {
        PG8_STAGE(PG8_SB(0, 0), cB, voffB); PG8_STAGE(PG8_SA(0, 0), cA, voffA); PG8_STAGE(PG8_SB(0, 1), cB + hstep, voffB); PG8_STAGE(PG8_SA(0, 1), cA + hstep, voffA);
        if (wr == 1) PG8_BAR;
        PG8_WAIT_V(4); PG8_BAR;
        PG8_STAGE(PG8_SB(1, 0), cB + kstep, voffB); PG8_STAGE(PG8_SA(1, 0), cA + kstep, voffA); PG8_STAGE(PG8_SB(1, 1), cB + hstep + kstep, voffB);
        PG8_WAIT_V(6); PG8_BAR;
    }
    for (;;) {
        const bool has_next = S.next(ui + 1, nxt);
        const char* nA = has_next ? (const char*)g.A + (size_t)nxt.pm * tstep : cA; const char* nB = has_next ? (const char*)g.Bt + (size_t)nxt.pn * tstep : cB;
        for (int t = 0; t < nt; t += 2) {
            if constexpr (Epi::MIDT > 0) { if (t == Epi::MIDT) {
                if constexpr (FP8) { asm volatile("s_nop 15\n\ts_nop 15" ::: "memory");
#pragma unroll
                    for (int a = 0; a < 2; ++a)
#pragma unroll
                        for (int b = 0; b < 2; ++b)
#pragma unroll
                            for (int m = 0; m < 4; ++m)
#pragma unroll
                                for (int n = 0; n < 2; ++n) asm volatile("" : "+v"(acc[a][b][m][n])); }
                E.mid(acc, cur, wr, fr); } }
            const bool last = (t == nt - 2);
            const char* a1 = cA + (size_t)(t + 1) * kstep;
            const char* a2 = last ? nA : cA + (size_t)(t + 2) * kstep; const char* b2 = last ? nB : cB + (size_t)(t + 2) * kstep;
            const char* a3 = a2 + kstep; const char* b3 = b2 + kstep;
            if (last && has_next) S.a_ready(nxt);
            if constexpr (SP2) {
            PG8_LDB(B0, 0, 0); PG8_LDB(B1, 0, 1); PG8_SCHED; PG8_LDA(At, 0, 0); PG8_STAGE(PG8_SA(1, 1), a1 + hstep, voffA);
            PG8_WAIT_V(8); PG8_WAIT_L(0); PG8_BAR; PG8_MMA(0, 0, At, B0); PG8_MMA(0, 1, At, B1); PG8_BAR; PG8_SCHED;
            PG8_LDA(At, 0, 1); PG8_STAGE(PG8_SB(0, 0), b2, voffB); PG8_STAGE(PG8_SB(0, 1), b2 + hstep, voffB); PG8_STAGE(PG8_SA(0, 0), a2, voffA);
            PG8_WAIT_V(8); PG8_WAIT_L(0); PG8_BAR; PG8_MMA(1, 0, At, B0); PG8_MMA(1, 1, At, B1); PG8_BAR; PG8_SCHED;
            PG8_LDB(B0, 1, 0); PG8_LDB(B1, 1, 1); PG8_SCHED; PG8_LDA(At, 1, 0); PG8_STAGE(PG8_SA(0, 1), a2 + hstep, voffA);
            PG8_WAIT_V(8); PG8_WAIT_L(0); PG8_BAR; PG8_MMA(0, 0, At, B0); PG8_MMA(0, 1, At, B1); PG8_BAR; PG8_SCHED;
            PG8_LDA(At, 1, 1); PG8_STAGE(PG8_SB(1, 0), b3, voffB); PG8_STAGE(PG8_SB(1, 1), b3 + hstep, voffB); PG8_STAGE(PG8_SA(1, 0), a3, voffA);
            PG8_WAIT_V(8); PG8_WAIT_L(0); PG8_BAR; PG8_MMA(1, 0, At, B0); PG8_MMA(1, 1, At, B1); PG8_BAR; PG8_SCHED;
            } else {
            PG8_LDB(B0, 0, 0); PG8_SCHED; PG8_LDA(At, 0, 0); PG8_STAGE(PG8_SA(1, 1), a1 + hstep, voffA);
            PG8_WAIT_L(8); PG8_BAR; PG8_WAIT_L(0); PG8_MMA(0, 0, At, B0); PG8_BAR; PG8_SCHED;
            PG8_LDB(B1, 0, 1); PG8_STAGE(PG8_SB(0, 0), b2, voffB);
            PG8_BAR; PG8_WAIT_L(0); PG8_MMA(0, 1, At, B1); PG8_BAR;
            PG8_LDA(At, 0, 1); PG8_STAGE(PG8_SA(0, 0), a2, voffA);
            PG8_BAR; PG8_WAIT_L(0); PG8_MMA(1, 0, At, B0); PG8_BAR; PG8_SCHED;
            PG8_STAGE(PG8_SB(0, 1), b2 + hstep, voffB);
            PG8_WAIT_V(6); PG8_BAR; PG8_MMA(1, 1, At, B1); PG8_BAR;
            PG8_LDB(B0, 1, 0); PG8_SCHED; PG8_LDA(At, 1, 0); PG8_STAGE(PG8_SA(0, 1), a2 + hstep, voffA);
            PG8_WAIT_L(8); PG8_BAR; PG8_WAIT_L(0); PG8_MMA(0, 0, At, B0); PG8_BAR; PG8_SCHED;
            PG8_LDB(B1, 1, 1); PG8_STAGE(PG8_SB(1, 0), b3, voffB);
            PG8_BAR; PG8_WAIT_L(0); PG8_MMA(0, 1, At, B1); PG8_BAR;
            PG8_LDA(At, 1, 1); PG8_STAGE(PG8_SA(1, 0), a3, voffA);
            PG8_BAR; PG8_WAIT_L(0); PG8_MMA(1, 0, At, B0); PG8_BAR; PG8_SCHED;
            PG8_STAGE(PG8_SB(1, 1), b3 + hstep, voffB);
            PG8_WAIT_V(6); PG8_BAR; PG8_MMA(1, 1, At, B1); PG8_BAR;
            }
        }
        if constexpr (FP8) {
            asm volatile("s_nop 15\n\ts_nop 15" ::: "memory");
#pragma unroll
            for (int a = 0; a < 2; ++a)
#pragma unroll
                for (int b = 0; b < 2; ++b)
#pragma unroll
                    for (int m = 0; m < 4; ++m)
#pragma unroll
                        for (int n = 0; n < 2; ++n) asm volatile("" : "+v"(acc[a][b][m][n]));
        }
        if constexpr (ALIGN_EPI) { if (wr == 0) PG8_BAR; }
        if constexpr (!Epi::AFTER_DRAIN) { E(acc, cur, wr, wc, fr, fq); S.done(cur); }
        if (!has_next) break;
#pragma unroll
        for (int a = 0; a < 2; ++a)
#pragma unroll
            for (int b = 0; b < 2; ++b)
#pragma unroll
                for (int m = 0; m < 4; ++m)
#pragma unroll
                    for (int n = 0; n < 2; ++n) acc[a][b][m][n] = (f32x4){0.f, 0.f, 0.f, 0.f};
        cur = nxt; cA = nA; cB = nB; ++ui;
        if constexpr (ALIGN_EPI) { if (wr == 1) PG8_BAR; }
    }
    PG8_WAIT_V(0);
    if constexpr (!ALIGN_EPI) { if (wr == 0) PG8_BAR; }
    PG8_BAR;
    if constexpr (Epi::AFTER_DRAIN) { E.fused(acc, cur, wr, wc, fr, fq, lds, wid, lane); S.done(cur); }
#undef PG8_SA
#undef PG8_SB
#undef PG8_STAGE
#undef PG8_LDA
#undef PG8_LDB
#undef PG8_MMA
#undef PG8_CAT
#undef PG8_WAIT_V
#undef PG8_WAIT_L
#undef PG8_BAR
#undef PG8_SCHED
}
}

#define PG8_SP2 true
#define PG8_ALIGN true
namespace att {
typedef unsigned short bf16;
using bf16x8 = __attribute__((ext_vector_type(8))) short;
using s16x4  = __attribute__((ext_vector_type(4))) short;
using f32x16 = __attribute__((ext_vector_type(16))) float;
using u32x4  = __attribute__((ext_vector_type(4))) unsigned;
#define ATT_LAS __attribute__((address_space(3)))
typedef ATT_LAS char* lptr;
constexpr int   D = 128, NW = 8, QBLK = 32, KVBLK = 64;
constexpr float SCALE = 0.088388347648318440f;
constexpr float THR = 8.f;
constexpr int SHM_V = KVBLK * D * 2, SHM_K = KVBLK * D * 2, SHM_ATTN = 2 * SHM_V + 2 * SHM_K + NW * 64 * 4;
#define KSWZ(row, colB) ((row) * 256 + ((colB) ^ (((row) & 7) << 4)))
#define SBAR() __builtin_amdgcn_sched_barrier(0)
__device__ __forceinline__ int crow(int r, int hi) { return (r & 3) + 8 * (r >> 2) + 4 * hi; }
__device__ __forceinline__ unsigned cvtpk(float lo, float hi) { unsigned r; asm volatile("v_cvt_pk_bf16_f32 %0, %1, %2" : "=v"(r) : "v"(lo), "v"(hi)); return r; }
__device__ __forceinline__ void partialSM(f32x16& p0, f32x16& p1, float& m_reg, float& mn, float& alpha, const bool dead = false) {
  constexpr float C = SCALE * 1.4426950408889634f;
  float pmax = p0[0];
#pragma unroll
  for (int r = 1; r < 16; ++r) pmax = fmaxf(pmax, p0[r]);
#pragma unroll
  for (int r = 0; r < 16; ++r) pmax = fmaxf(pmax, p1[r]);
  { auto rr = __builtin_amdgcn_permlane32_swap(__float_as_uint(pmax), __float_as_uint(pmax), false, false);
    pmax = fmaxf(__uint_as_float(rr[0]), __uint_as_float(rr[1])); }
  pmax = dead ? -__builtin_inff() : pmax;
  if (__builtin_expect(__all(pmax - m_reg <= THR / SCALE), 1)) { mn = m_reg; alpha = 1.f; }
  else { mn = fmaxf(m_reg, pmax); alpha = __builtin_amdgcn_exp2f((m_reg - mn) * C); m_reg = mn; }
  float mnC = dead ? -__builtin_inff() : -mn * C;
#pragma unroll
  for (int r = 0; r < 16; ++r) p0[r] = fmaf(p0[r], C, mnC);
#pragma unroll
  for (int r = 0; r < 16; ++r) p1[r] = fmaf(p1[r], C, mnC);
#pragma unroll
  for (int r = 0; r < 16; ++r) p0[r] = __builtin_amdgcn_exp2f(p0[r]);
}
__device__ __forceinline__ void finishSM(f32x16& p0, f32x16& p1, float alpha, float& l_reg, bf16x8& pa0, bf16x8& pa1, bf16x8& pa2, bf16x8& pa3) {
#pragma unroll
  for (int r = 0; r < 16; ++r) p1[r] = __builtin_amdgcn_exp2f(p1[r]);
  float ps = 0;
#pragma unroll
  for (int r = 0; r < 16; ++r) ps += p0[r];
#pragma unroll
  for (int r = 0; r < 16; ++r) ps += p1[r];
  { auto rr = __builtin_amdgcn_permlane32_swap(__float_as_uint(ps), __float_as_uint(ps), false, false);
    ps = __uint_as_float(rr[0]) + __uint_as_float(rr[1]); }
  l_reg = l_reg * alpha + ps;
#define PK4(P, BASE, OUT) do { unsigned a0 = cvtpk(P[BASE + 0], P[BASE + 1]), a1 = cvtpk(P[BASE + 2], P[BASE + 3]);   \
    unsigned b0 = cvtpk(P[BASE + 4], P[BASE + 5]), b1 = cvtpk(P[BASE + 6], P[BASE + 7]);                              \
    auto r0 = __builtin_amdgcn_permlane32_swap(a0, b0, false, false); auto r1 = __builtin_amdgcn_permlane32_swap(a1, b1, false, false); \
    u32x4 w = {r0[0], r1[0], r0[1], r1[1]}; OUT = *reinterpret_cast<bf16x8*>(&w); } while (0)
  PK4(p0, 0, pa0); PK4(p0, 8, pa1); PK4(p1, 0, pa2); PK4(p1, 8, pa3);
#undef PK4
}
__device__ __forceinline__ void qkt(f32x16& p0, f32x16& p1, lptr Ks, const bf16x8* qr, int r32, int hi) {
  p0 = f32x16{}; p1 = f32x16{};
#pragma unroll
  for (int d0 = 0; d0 < 8; ++d0) { int cb = (d0 * 16 + hi * 8) * 2;
    bf16x8 b0 = *reinterpret_cast<const ATT_LAS bf16x8*>(Ks + KSWZ(r32, cb));
    bf16x8 b1 = *reinterpret_cast<const ATT_LAS bf16x8*>(Ks + KSWZ(32 + r32, cb));
    p0 = __builtin_amdgcn_mfma_f32_32x32x16_bf16(b0, qr[d0], p0, 0, 0, 0);
    p1 = __builtin_amdgcn_mfma_f32_32x32x16_bf16(b1, qr[d0], p1, 0, 0, 0); }
}
__device__ __forceinline__ int v_st(int k, int c) { const int kk = (k & ~0xC) | ((k & 4) << 1) | ((k & 8) >> 1); return ((kk >> 3) * 4 + (c >> 5)) * 512 + ((kk & 7) * 32 + (c & 31)) * 2; }
__device__ __forceinline__ int v_rd_base(int lane) { return ((lane & 3) << 3) | (((lane >> 2) & 3) << 6) | (((lane >> 4) & 1) << 5) | (((lane >> 5) & 1) << 8); }
constexpr int v_rd_off(int d0, int ks, int half) { return d0 * 512 + ks * 4096 + half * 2048; }
template <int OFF> __device__ __forceinline__ s16x4 tr_read(int vb) {
  s16x4 r; asm volatile("ds_read_b64_tr_b16 %0, %1 offset:%2" : "=&v"(r) : "v"(vb), "i"(OFF) : "memory"); return r;
}
template <int D0> __device__ __forceinline__ void pv_one(f32x16& od, int vb, bf16x8 pa0, bf16x8 pa1, bf16x8 pa2, bf16x8 pa3) {
  const s16x4 l0 = tr_read<v_rd_off(D0, 0, 0)>(vb), h0 = tr_read<v_rd_off(D0, 0, 1)>(vb), l1 = tr_read<v_rd_off(D0, 1, 0)>(vb), h1 = tr_read<v_rd_off(D0, 1, 1)>(vb);
  const s16x4 l2 = tr_read<v_rd_off(D0, 2, 0)>(vb), h2 = tr_read<v_rd_off(D0, 2, 1)>(vb), l3 = tr_read<v_rd_off(D0, 3, 0)>(vb), h3 = tr_read<v_rd_off(D0, 3, 1)>(vb);
  asm volatile("s_waitcnt lgkmcnt(0)" ::: "memory"); SBAR();
#define PK(L, H) (bf16x8){L[0], L[1], L[2], L[3], H[0], H[1], H[2], H[3]}
  od = __builtin_amdgcn_mfma_f32_32x32x16_bf16(pa0, PK(l0, h0), od, 0, 0, 0);
  od = __builtin_amdgcn_mfma_f32_32x32x16_bf16(pa1, PK(l1, h1), od, 0, 0, 0);
  od = __builtin_amdgcn_mfma_f32_32x32x16_bf16(pa2, PK(l2, h2), od, 0, 0, 0);
  od = __builtin_amdgcn_mfma_f32_32x32x16_bf16(pa3, PK(l3, h3), od, 0, 0, 0);
#undef PK
}
__device__ __forceinline__ void pv_d0(f32x16* o, int vb, bf16x8 pa0, bf16x8 pa1, bf16x8 pa2, bf16x8 pa3) {
  pv_one<0>(o[0], vb, pa0, pa1, pa2, pa3); pv_one<1>(o[1], vb, pa0, pa1, pa2, pa3); pv_one<2>(o[2], vb, pa0, pa1, pa2, pa3); pv_one<3>(o[3], vb, pa0, pa1, pa2, pa3);
}
__device__ __forceinline__ bool moba_mask(f32x16& p0, f32x16& p1, int tile, int qb, unsigned sel, int qi, int w0, int hi) {
  const float NINF = -__builtin_inff();
  const int jb = tile >> 2;
  if (jb < qb) return ((sel >> jb) & 1u) == 0u;
  {
    const int k0 = (tile & 3) * 64;
    if (k0 + 63 > w0) {
      int lim = qi - k0 - 4 * hi; asm volatile("" : "+v"(lim));
#pragma unroll
      for (int r = 0; r < 16; ++r) { const int kc = (r & 3) + 8 * (r >> 2); p0[r] = (kc <= lim) ? p0[r] : NINF; p1[r] = (kc + 32 <= lim) ? p1[r] : NINF; }
    }
  }
  return false;
}

template <bool MOBA, int LDQ, int LDK, int LDO, int SDEPTH, typename TO, int OSC>
__device__ __forceinline__ void attn_body(const bf16* __restrict__ Qb, const bf16* __restrict__ Kh, const bf16* __restrict__ Vh, TO* __restrict__ Ob, int seq, lptr lds,
                                          int qb, const float* __restrict__ kms, int kms_stride, unsigned long long* __restrict__ ssq, const int wave_sgpr) {
  int tid_ = (int)__builtin_amdgcn_mbcnt_hi(~0u, __builtin_amdgcn_mbcnt_lo(~0u, 0u)) + 64 * wave_sgpr; asm volatile("" : "+v"(tid_));
  const int tid = tid_, wid = tid >> 6, lane = tid & 63, r32 = lane & 31, hi = lane >> 5;
  lptr V_lds = lds; lptr K_lds = lds + 2 * SHM_V;
  ATT_LAS float* ws = (ATT_LAS float*)(lds + 2 * SHM_V + 2 * SHM_K) + wid * 64; ATT_LAS float* li_l = ws; ATT_LAS float* al_l = ws + 32;
  float m_reg = -1e30f, l_reg = 0; f32x16 o[4] = {}; bf16x8 qr[8];
  unsigned qoff = (unsigned)((wid * QBLK + r32) * LDQ + hi * 8); asm volatile("" : "+v"(qoff));
  const bf16* Qw = Qb + qoff;
#pragma unroll
  for (int d0 = 0; d0 < 8; ++d0) qr[d0] = *reinterpret_cast<const bf16x8*>(Qw + d0 * 16);
  const int sr = tid >> 4, sc = (tid & 15) * 8, vst0 = v_st(sr, sc), vst1 = v_st(32 + sr, sc);
  const int vb0 = (int)(uintptr_t)V_lds + v_rd_base(lane);
  struct { bf16x8 vs0, vs1, ks0, ks1; } sr_[SDEPTH];
  const unsigned so0 = (unsigned)(sr * LDK + sc), so1 = (unsigned)((32 + sr) * LDK + sc);
#define SLOAD(i, k0) do { const bf16* Vt_ = Vh + (long)(k0) * LDK; const bf16* Kt_ = Kh + (long)(k0) * LDK; \
    sr_[i].vs0 = *reinterpret_cast<const bf16x8*>(Vt_ + so0); sr_[i].vs1 = *reinterpret_cast<const bf16x8*>(Vt_ + so1); \
    sr_[i].ks0 = *reinterpret_cast<const bf16x8*>(Kt_ + so0); sr_[i].ks1 = *reinterpret_cast<const bf16x8*>(Kt_ + so1); } while (0)
#define SWRITE(b, i) do { *(ATT_LAS bf16x8*)(V_lds + (b) * SHM_V + vst0) = sr_[i].vs0;          \
    *(ATT_LAS bf16x8*)(V_lds + (b) * SHM_V + vst1) = sr_[i].vs1; int kc = sc * 2;               \
    *(ATT_LAS bf16x8*)(K_lds + (b) * SHM_K + KSWZ(sr, kc)) = sr_[i].ks0;                       \
    *(ATT_LAS bf16x8*)(K_lds + (b) * SHM_K + KSWZ(32 + sr, kc)) = sr_[i].ks1; } while (0)
#define SWAIT() do { if constexpr (SDEPTH == 2) asm volatile("s_waitcnt vmcnt(4)" ::: "memory"); else asm volatile("s_waitcnt vmcnt(0)" ::: "memory"); } while (0)
#define RESC(a) do { if (__any((a) < 1.f)) { if (hi == 0) al_l[r32] = (a); asm volatile("s_waitcnt lgkmcnt(0)" ::: "memory"); \
    _Pragma("unroll") for (int d = 0; d < 4; ++d) _Pragma("unroll") for (int r = 0; r < 16; ++r) o[d][r] *= al_l[crow(r, hi)]; } } while (0)
  f32x16 pA0, pA1, pB0, pB1; float mnA, mnB, alA, alB; bf16x8 pa0, pa1, pa2, pa3; const int NT = seq / KVBLK;
  constexpr int SE = 0, SO = SDEPTH - 1;
  unsigned sel = 0u; const int qi = wid * QBLK + r32, w0 = wid * QBLK;
  SLOAD(SE, 0);
  if constexpr (MOBA) {
    { const int j = sr & 15; const float* src = kms + (size_t)j * kms_stride + sc; const float4 x0 = *reinterpret_cast<const float4*>(src), x1 = *reinterpret_cast<const float4*>(src + 4);
      const float xv[8] = {x0.x, x0.y, x0.z, x0.w, x1.x, x1.y, x1.z, x1.w}; unsigned w[4];
#pragma unroll
      for (int e = 0; e < 4; ++e) { const unsigned h2 = cvtpk(xv[2 * e], xv[2 * e + 1]); const float f0 = __uint_as_float(h2 << 16), f1 = __uint_as_float(h2 & 0xffff0000u);
        const unsigned l2 = cvtpk(xv[2 * e] - f0, xv[2 * e + 1] - f1); w[e] = (sr < 16) ? h2 : l2; }
      u32x4 wv = {w[0], w[1], w[2], w[3]}; *(ATT_LAS u32x4*)(K_lds + KSWZ(sr, sc * 2)) = wv; }
    __syncthreads();
    f32x16 g = f32x16{};
#pragma unroll
    for (int d0 = 0; d0 < 8; ++d0) { const int cb = (d0 * 16 + hi * 8) * 2; const bf16x8 b0 = *reinterpret_cast<const ATT_LAS bf16x8*>(K_lds + KSWZ(r32, cb));
      g = __builtin_amdgcn_mfma_f32_32x32x16_bf16(b0, qr[d0], g, 0, 0, 0); }
    float G[16];
#pragma unroll
    for (int r = 0; r < 8; ++r) { const float own = g[r] + g[r + 8]; const float oth = __shfl_xor(own, 32); const int lb = (r & 3) + 8 * (r >> 2);
      G[lb] = hi ? oth : own; G[lb + 4] = hi ? own : oth; }
    const float NINF = -__builtin_inff();
#pragma unroll
    for (int j = 0; j < 16; ++j) G[j] = (j < qb) ? G[j] : NINF;
#pragma unroll
    for (int it = 0; it < 3; ++it) { float mx = NINF; int mi = -1;
#pragma unroll
      for (int j = 0; j < 16; ++j) { const bool gt = G[j] > mx; mx = gt ? G[j] : mx; mi = gt ? j : mi; }
      if (mi >= 0) sel |= 1u << mi;
#pragma unroll
      for (int j = 0; j < 16; ++j) G[j] = (j == mi) ? NINF : G[j]; }
    __syncthreads();
  }
  asm volatile("s_waitcnt vmcnt(0)" ::: "memory"); SWRITE(0, SE); __syncthreads();
  qkt(pA0, pA1, K_lds, qr, r32, hi);
  { bool dead = false; if constexpr (MOBA) dead = moba_mask(pA0, pA1, 0, qb, sel, qi, w0, hi);
    partialSM(pA0, pA1, m_reg, mnA, alA, dead); }
  SLOAD(SO, KVBLK); if constexpr (SDEPTH == 2) { if (2 < NT) SLOAD(SE, 2 * KVBLK); }
  SWAIT(); SWRITE(1, SO); __syncthreads();
  for (int j = 1; j + 1 < NT; j += 2) {
    SBAR(); qkt(pB0, pB1, K_lds + SHM_K, qr, r32, hi);
    finishSM(pA0, pA1, alA, l_reg, pa0, pa1, pa2, pa3); SBAR();
    SLOAD(SO, (j + SDEPTH) * KVBLK); SBAR();
    pv_d0(o, vb0, pa0, pa1, pa2, pa3);
    { bool dead = false; if constexpr (MOBA) dead = moba_mask(pB0, pB1, j, qb, sel, qi, w0, hi);
      partialSM(pB0, pB1, m_reg, mnB, alB, dead); }
    __syncthreads(); SWAIT(); SWRITE(0, SE);
    RESC(alB); __syncthreads();
    SBAR(); qkt(pA0, pA1, K_lds, qr, r32, hi);
    finishSM(pB0, pB1, alB, l_reg, pa0, pa1, pa2, pa3); SBAR();
    if (SDEPTH == 1 || j + 3 < NT) SLOAD(SE, (j + 1 + SDEPTH) * KVBLK); SBAR();
    pv_d0(o, vb0 + SHM_V, pa0, pa1, pa2, pa3);
    { bool dead = false; if constexpr (MOBA) dead = moba_mask(pA0, pA1, j + 1, qb, sel, qi, w0, hi);
      partialSM(pA0, pA1, m_reg, mnA, alA, dead); }
    __syncthreads(); SWAIT(); SWRITE(1, SO);
    RESC(alA); __syncthreads();
  }
  SBAR(); qkt(pB0, pB1, K_lds + SHM_K, qr, r32, hi);
  finishSM(pA0, pA1, alA, l_reg, pa0, pa1, pa2, pa3); SBAR();
  pv_d0(o, vb0, pa0, pa1, pa2, pa3);
  { bool dead = false; if constexpr (MOBA) dead = moba_mask(pB0, pB1, NT - 1, qb, sel, qi, w0, hi);
    partialSM(pB0, pB1, m_reg, mnB, alB, dead); }
  __syncthreads(); RESC(alB);
  finishSM(pB0, pB1, alB, l_reg, pa0, pa1, pa2, pa3); SBAR();
  pv_d0(o, vb0 + SHM_V, pa0, pa1, pa2, pa3);
  if (hi == 0) li_l[r32] = l_reg; asm volatile("s_waitcnt lgkmcnt(0)" ::: "memory");
  float rli[16];
#pragma unroll
  for (int r = 0; r < 16; ++r) rli[r] = __builtin_amdgcn_rcpf(li_l[crow(r, hi)]);
  int ohi = hi * 4, ocol = r32; asm volatile("" : "+v"(ohi), "+v"(ocol));
  TO* Ow = Ob + (long)(wid * QBLK) * LDO;
#pragma unroll
  for (int r = 0; r < 16; ++r) { const int orow = (r & 3) + 8 * (r >> 2) + ohi; float sq = 0.f;
#pragma unroll
    for (int d0 = 0; d0 < 4; ++d0) { const float v = o[d0][r] * rli[r]; sq += v * v; if constexpr (sizeof(TO) == 2) Ow[(unsigned)(orow * LDO + d0 * 32 + ocol)] = (TO)(cvtpk(v, v) & 0xffffu);
      else Ow[(unsigned)(orow * LDO + d0 * 32 + ocol)] = (TO)(__builtin_amdgcn_cvt_pk_fp8_f32(__builtin_amdgcn_fmed3f(v * (float)OSC, -448.0f, 448.0f), 0.0f, 0, false) & 0xff); }
    if constexpr (MOBA) { sq += __shfl_xor(sq, 1); sq += __shfl_xor(sq, 2); sq += __shfl_xor(sq, 4); sq += __shfl_xor(sq, 8); sq += __shfl_xor(sq, 16);
      if (ocol == 0) pg8::ss_add(ssq, wid * QBLK + orow, sq); } }
  __syncthreads();
#undef SLOAD
#undef SWRITE
#undef SWAIT
#undef RESC
}
#undef KSWZ
#undef SBAR
}

constexpr int NWAVES = 8;
constexpr int BATCH = 4, SEQ = 4096, D = 2048, M = BATCH * SEQ, FF = 5632, AW = 1024, CW = 1024, INW = 6144, MEML = 256, XW = 512, NH = 8, XH = 4, NBLK = 16;
constexpr int NPH = 13;
#ifndef FAST_MASK
#define FAST_MASK 0x1fff
#endif
#ifndef ONE_LAUNCH
#define ONE_LAUNCH 1
#endif
constexpr size_t MiB = 1u << 20, KiB = 1u << 10;
constexpr size_t WS_CTL = 0, CTL_ZERO_BYTES = 1536 * KiB;
constexpr size_t CTL_BAR = 64 * KiB, BAR_STRIDE = 16 * KiB;
constexpr size_t CTL_SS = 320 * KiB;
constexpr size_t CTL_KMS = 1088 * KiB;
constexpr size_t WS_WGU1 = 2 * MiB, WS_WD1 = 46 * MiB, WS_WGU2 = 68 * MiB, WS_WD2 = 112 * MiB, WS_WIN = 134 * MiB, WS_WOUT = 158 * MiB, WS_WQ = 166 * MiB, WS_WKV = 168 * MiB, WS_WO = 172 * MiB;
constexpr size_t WS_MEMN = 174 * MiB, WS_KVX = 178 * MiB, WS_HB = 180 * MiB, WS_MIXED = 244 * MiB, WS_ACT = 308 * MiB;
constexpr size_t WS_Q = 308 * MiB, WS_K = 340 * MiB, WS_V = 372 * MiB, WS_CU = 404 * MiB, WS_BG = 436 * MiB;
constexpr size_t WS_QX = 308 * MiB, WS_OX = 324 * MiB;
constexpr size_t WS_HB8 = 340 * MiB, WS_ACT8 = 396 * MiB, WS_OX8 = 324 * MiB;
constexpr size_t WS_H1F8 = WS_MIXED + 32 * MiB, WS_WIN8 = WS_WIN + 8 * MiB;
constexpr size_t WS_DUMMY = 484 * MiB;
constexpr size_t WS_END = 486 * MiB;
static_assert(WS_ACT + (size_t)M * FF * 2 <= WS_END && WS_BG + (size_t)M * 1024 * 2 <= WS_END && CTL_KMS + BATCH * 16 * 8 * 128 * 4 <= CTL_ZERO_BYTES && CTL_SS + 6 * M * 8 <= CTL_KMS && CTL_ZERO_BYTES <= WS_WGU1, "d_ws map");
constexpr int RING_OFF = 0, RING_BYTES = 131072;
constexpr int LDSCTL_OFF = RING_BYTES, MISC_OFF = LDSCTL_OFF + 320;
constexpr int LDS_BYTES = 147456;
static_assert(MISC_OFF + 128 <= LDS_BYTES && att::SHM_ATTN <= RING_BYTES, "LDS map");

#define GAS __attribute__((address_space(1)))
#define LAS __attribute__((address_space(3)))
typedef unsigned short bf16;
typedef unsigned v4u __attribute__((ext_vector_type(4)));
typedef unsigned v2u __attribute__((ext_vector_type(2)));
typedef float f32x4 __attribute__((ext_vector_type(4)));
typedef short bf16x8 __attribute__((ext_vector_type(8)));
typedef GAS unsigned gu32;
#define RLX_AGENT __ATOMIC_RELAXED, __HIP_MEMORY_SCOPE_AGENT
#define LDS_WAIT() asm volatile("s_waitcnt lgkmcnt(0)" ::: "memory")
#define VM_WAIT() asm volatile("s_waitcnt vmcnt(0)" ::: "memory")
__device__ __forceinline__ unsigned pk2(float lo, float hi) { return pg8::cvt_pk_bf16(lo, hi); }
__device__ __forceinline__ float bflo(unsigned w) { return __uint_as_float(w << 16); }
__device__ __forceinline__ float bfhi(unsigned w) { return __uint_as_float(w & 0xffff0000u); }
__device__ __forceinline__ float wave_sum(float v) {
#pragma unroll
    for (int o = 1; o < 64; o <<= 1) v += __shfl_xor(v, o);
    return v;
}
#define XB_TMO      128
#define XB_XCNT(j)  (256  + 64 * (j))
#define XB_XSUB(j)  (1280 + 64 * (j))
#define XB_XGEN(j)  (2304 + 64 * (j))
#define XB_TOP      3328
#define XB_TOPGEN   3392
#define XCD_BAR_WORDS 3456
#define XB_SPIN_CAP (1u << 18)

__device__ __forceinline__ unsigned xb_ld(unsigned* p)              { return __hip_atomic_load(p, __ATOMIC_RELAXED, __HIP_MEMORY_SCOPE_AGENT); }
__device__ __forceinline__ unsigned xb_add(unsigned* p, unsigned v) { return __hip_atomic_fetch_add(p, v, __ATOMIC_RELAXED, __HIP_MEMORY_SCOPE_AGENT); }
__device__ __forceinline__ unsigned xb_xcc_id() { return (unsigned)__builtin_amdgcn_s_getreg((3 << 11) | 20) & 0xFu; }
#define XB_SPIN(cond, bar) do { unsigned _sp = 0; while (cond) { __builtin_amdgcn_s_sleep(1); \
    if ((++_sp & 255u) == 0u) { if (xb_ld(&(bar)[XB_TMO])) break; if (_sp > XB_SPIN_CAP) { atomicAdd(&(bar)[XB_TMO], 1u); break; } } } } while (0)

struct XcdBarrier {
    unsigned* bar; unsigned x;
    volatile LAS unsigned* st;
};

__device__ __forceinline__ XcdBarrier xcd_barrier_post(unsigned* bar, volatile LAS unsigned* st) {
    XcdBarrier b; b.bar = bar; b.x = xb_xcc_id(); b.st = st;
    if (threadIdx.x == 0) (void)xb_add(&bar[XB_XCNT(b.x)], 1u);
    return b;
}
__device__ __forceinline__ void xcd_barrier_complete(unsigned* bar, unsigned x, unsigned& nloc, unsigned& nx) {
    const unsigned G = gridDim.x * gridDim.y * gridDim.z;
    unsigned sum, cnt, mine, sp = 0u;
    for (;;) {
        sum = 0u; cnt = 0u; mine = 0u;
#pragma unroll
        for (unsigned j = 0; j < 16; ++j) { const unsigned c = xb_ld(&bar[XB_XCNT(j)]); sum += c; cnt += (c > 0u) ? 1u : 0u; mine = (j == x) ? c : mine; }
        if (sum == G) break;
        __builtin_amdgcn_s_sleep(1);
        if ((++sp & 255u) == 0u) { if (xb_ld(&bar[XB_TMO])) break; if (sp > XB_SPIN_CAP) { atomicAdd(&bar[XB_TMO], 1u); break; } }
    }
    nloc = mine > 0u ? mine : 1u; nx = cnt > 0u ? cnt : 1u;
}

__device__ __forceinline__ void xcd_barrier(const XcdBarrier& b) {
    asm volatile("s_waitcnt vmcnt(0)" ::: "memory");
    __syncthreads();
    if (threadIdx.x == 0) {
        unsigned* bar = b.bar;
        __builtin_amdgcn_s_waitcnt(0);
        unsigned nloc = b.st[0], nx = b.st[1];
        if (nloc == 0u) { xcd_barrier_complete(bar, b.x, nloc, nx); b.st[0] = nloc; b.st[1] = nx; }
        const unsigned old = xb_add(&bar[XB_XSUB(b.x)], 1u);
        const unsigned gen = old / nloc;
        if (old + 1u == (gen + 1u) * nloc) {
            __builtin_amdgcn_fence(__ATOMIC_RELEASE, "agent");
            asm volatile("s_waitcnt vmcnt(0)" ::: "memory");
            const unsigned og = xb_add(&bar[XB_TOP], 1u);
            const unsigned tg = og / nx;
            if (og + 1u == (tg + 1u) * nx) xb_add(&bar[XB_TOPGEN], 1u);
            else XB_SPIN(xb_ld(&bar[XB_TOPGEN]) == tg, bar);
            __builtin_amdgcn_fence(__ATOMIC_ACQUIRE, "agent");
            xb_add(&bar[XB_XGEN(b.x)], 1u);
            asm volatile("s_waitcnt vmcnt(0)" ::: "memory");
        } else {
            XB_SPIN(xb_ld(&bar[XB_XGEN(b.x)]) == gen, bar);
            __builtin_amdgcn_fence(__ATOMIC_ACQUIRE, "agent");
            asm volatile("s_waitcnt vmcnt(0)" ::: "memory");
        }
    }
    __syncthreads();
}

namespace nv {
typedef float f32x4 __attribute__((ext_vector_type(4)));
typedef short bf16x8 __attribute__((ext_vector_type(8)));
constexpr float EPS = 1e-6f;
template <class F> __global__ __launch_bounds__(256) void gemm(const bf16* __restrict__ A, const bf16* __restrict__ Bt, int K, F f) {
    const int wave = threadIdx.x >> 6, lane = threadIdx.x & 63;
    const int row0 = blockIdx.y * 64 + wave * 16, col0 = blockIdx.x * 64;
    f32x4 acc[4], acc2[4];
#pragma unroll
    for (int c = 0; c < 4; ++c) { acc[c] = (f32x4){0.f, 0.f, 0.f, 0.f}; acc2[c] = (f32x4){0.f, 0.f, 0.f, 0.f}; }
    const bf16* ap = A + (size_t)(row0 + (lane & 15)) * K + 8 * (lane >> 4);
    const bf16* bp[4]; const bf16* bp2[4];
#pragma unroll
    for (int c = 0; c < 4; ++c) { const int col = col0 + 16 * c + (lane & 15); bp[c] = Bt + (size_t)f.brow(col) * K + 8 * (lane >> 4); bp2[c] = Bt + (size_t)f.brow2(col) * K + 8 * (lane >> 4); }
    for (int k0 = 0; k0 < K; k0 += 32) {
        if (F::MIDK > 0 && k0 == F::MIDK) {
#pragma unroll
            for (int j = 0; j < 4; ++j) { const float s = f.midscale(row0 + (lane >> 4) * 4 + j);
#pragma unroll
                for (int c = 0; c < 4; ++c) acc[c][j] *= s; }
        }
        const bf16x8 a = *(const bf16x8*)(ap + k0);
#pragma unroll
        for (int c = 0; c < 4; ++c) { const bf16x8 b = *(const bf16x8*)(bp[c] + k0); acc[c] = __builtin_amdgcn_mfma_f32_16x16x32_bf16(a, b, acc[c], 0, 0, 0);
            if (F::DUAL) { const bf16x8 b2 = *(const bf16x8*)(bp2[c] + k0); acc2[c] = __builtin_amdgcn_mfma_f32_16x16x32_bf16(a, b2, acc2[c], 0, 0, 0); } }
    }
#pragma unroll
    for (int j = 0; j < 4; ++j) { const int row = row0 + (lane >> 4) * 4 + j; float sq = 0.f;
#pragma unroll
        for (int c = 0; c < 4; ++c) { const float h = f.store(row, col0 + 16 * c + (lane & 15), acc[c][j], acc2[c][j]); sq += h * h; }
        if (F::ROWSS) { sq += __shfl_xor(sq, 1); sq += __shfl_xor(sq, 2); sq += __shfl_xor(sq, 4); sq += __shfl_xor(sq, 8); if ((lane & 15) == 0) f.addss(row, sq); } }
}
__device__ __forceinline__ bf16 tobf(float v) { return (bf16)(pg8::cvt_pk_bf16(v, v) & 0xffffu); }
struct FSwiglu { static constexpr bool DUAL = true, ROWSS = false; static constexpr int MIDK = 0; bf16* O; const pg8::u64_t* ss;
    __device__ int brow(int col) const { return (col >> 7) * 256 + (col & 127); } __device__ int brow2(int col) const { return brow(col) + 128; } __device__ float midscale(int) const { return 1.f; } __device__ void addss(int, float) const {}
    __device__ float store(int row, int col, float a, float a2) const { const float rs = rsqrtf(pg8::ss_val(ss, row) * (1.0f / 2048.0f) + EPS), g = a * rs, u = a2 * rs; O[(size_t)row * FF + col] = tobf(g / (1.0f + __expf(-g)) * u); return 0.f; } };
template <int MIDK_, bool RBF, bool OF32> struct FResid { static constexpr bool DUAL = false, ROWSS = true; static constexpr int MIDK = MIDK_; const float* R; const bf16* RB; float* H; bf16* HB; pg8::u64_t* ssn; float alpha; const pg8::u64_t* midss;
    __device__ int brow(int col) const { return col; } __device__ int brow2(int col) const { return col; } __device__ float midscale(int row) const { return rsqrtf(pg8::ss_val(midss, row) * (1.0f / 1024.0f) + EPS); }
    __device__ void addss(int row, float s) const { pg8::ss_add(ssn, row, s); }
    __device__ float store(int row, int col, float a, float) const { const size_t o = (size_t)row * 2048 + col; const float r = RBF ? __uint_as_float((unsigned)RB[o] << 16) : R[o]; const float h = r + alpha * a; if (OF32) H[o] = h; else HB[o] = tobf(h); return h; } };
struct FWin { static constexpr bool DUAL = true, ROWSS = false; static constexpr int MIDK = 0; bf16 *Q, *K, *V, *CU, *BG; const pg8::u64_t* ss;
    __device__ int brow(int col) const { if (col < 3072) return col; if (col < 4096) { const int j = col - 3072; return 3072 + (j >> 7) * 256 + (j & 127); } return 5120 + (col - 4096); }
    __device__ int brow2(int col) const { return (col >= 3072 && col < 4096) ? brow(col) + 128 : brow(col); } __device__ float midscale(int) const { return 1.f; } __device__ void addss(int, float) const {}
    __device__ float store(int row, int col, float a, float a2) const { const float rs = rsqrtf(pg8::ss_val(ss, row) * (1.0f / 2048.0f) + EPS); const size_t o = (size_t)row * 1024 + (col & 1023);
        if (col < 1024) Q[o] = tobf(a * rs); else if (col < 2048) K[o] = tobf(a * rs); else if (col < 3072) V[o] = tobf(a * rs); else if (col < 4096) CU[o] = tobf((a * rs) * (a2 * rs)); else BG[o] = tobf(a * rs); return 0.f; } };
struct FScale { static constexpr bool DUAL = false, ROWSS = false; static constexpr int MIDK = 0; bf16* O; int ldo; const pg8::u64_t* ss;
    __device__ int brow(int col) const { return col; } __device__ int brow2(int col) const { return col; } __device__ float midscale(int) const { return 1.f; } __device__ void addss(int, float) const {}
    __device__ float store(int row, int col, float a, float) const { const float rs = ss ? rsqrtf(pg8::ss_val(ss, row) * (1.0f / 2048.0f) + EPS) : 1.0f; O[(size_t)row * ldo + col] = tobf(a * rs); return 0.f; } };
__global__ __launch_bounds__(256) void kmean(const bf16* __restrict__ K, float* __restrict__ kms) {
    const int i = blockIdx.x * 256 + threadIdx.x; const int d = i & 127, h = (i >> 7) & 7, bb = i >> 10;
    float s = 0.f; for (int r = 0; r < 256; ++r) s += __uint_as_float((unsigned)K[((size_t)bb * 256 + r) * 1024 + h * 128 + d] << 16);
    kms[i] = s;
}
__global__ __launch_bounds__(256) void moba(const bf16* __restrict__ Q, const bf16* __restrict__ K, const bf16* __restrict__ V, const float* __restrict__ kms, bf16* __restrict__ AO, pg8::u64_t* __restrict__ ssA) {
    const int wave = threadIdx.x >> 6, lane = threadIdx.x & 63; const int idx = blockIdx.x * 4 + wave; const int h = idx & 7, row = idx >> 3, b = row >> 12, t = row & 4095, qb = t >> 8;
    const unsigned qw = *(const unsigned*)(Q + (size_t)row * 1024 + h * 128 + 2 * lane); const float q0 = bflo(qw), q1 = bfhi(qw);
    unsigned sel = 0u;
    { float g[16];
#pragma unroll
      for (int j = 0; j < 16; ++j) { const float* km = kms + ((size_t)(b * 16 + j) * 8 + h) * 128 + 2 * lane; const float p = wave_sum(q0 * km[0] + q1 * km[1]); g[j] = (j < qb) ? p : -__builtin_inff(); }
#pragma unroll
      for (int it = 0; it < 3; ++it) { float mx = -__builtin_inff(); int mi = -1;
#pragma unroll
        for (int j = 0; j < 16; ++j) { const bool gt = g[j] > mx; mx = gt ? g[j] : mx; mi = gt ? j : mi; }
        if (mi >= 0) sel |= 1u << mi;
#pragma unroll
        for (int j = 0; j < 16; ++j) g[j] = (j == mi) ? -__builtin_inff() : g[j]; } }
    sel |= 1u << qb;
    float m = -1e30f, l = 0.f, o0 = 0.f, o1 = 0.f;
    for (int jb = 0; jb <= qb; ++jb) { if (!((sel >> jb) & 1u)) continue;
        const int nk = (jb < qb) ? 256 : (t & 255) + 1;
        for (int kk = 0; kk < nk; ++kk) { const size_t ko = ((size_t)b * 4096 + jb * 256 + kk) * 1024 + h * 128 + 2 * lane;
            const unsigned kw = *(const unsigned*)(K + ko), vw = *(const unsigned*)(V + ko);
            const float s = wave_sum(q0 * bflo(kw) + q1 * bfhi(kw)) * 0.088388347648318440f;
            const float mn = fmaxf(m, s), a = __expf(m - mn), p = __expf(s - mn);
            l = l * a + p; o0 = o0 * a + p * bflo(vw); o1 = o1 * a + p * bfhi(vw); m = mn; } }
    const float il = 1.0f / l; o0 *= il; o1 *= il;
    *(unsigned*)(AO + (size_t)row * 2048 + h * 128 + 2 * lane) = pk2(o0, o1);
    const float sq = wave_sum(o0 * o0 + o1 * o1); if (lane == 0) pg8::ss_add(ssA, row, sq);
}
__global__ __launch_bounds__(256) void xattn(const bf16* __restrict__ QX, const bf16* __restrict__ KVX, bf16* __restrict__ OX) {
    const int wave = threadIdx.x >> 6, lane = threadIdx.x & 63; const int idx = blockIdx.x * 4 + wave; const int h = idx & 3, row = idx >> 2, b = row >> 12;
    const unsigned qw = *(const unsigned*)(QX + (size_t)row * 512 + h * 128 + 2 * lane); const float q0 = bflo(qw), q1 = bfhi(qw);
    float m = -1e30f, l = 0.f, o0 = 0.f, o1 = 0.f;
    for (int kk = 0; kk < 256; ++kk) { const size_t ko = ((size_t)b * 256 + kk) * 1024 + h * 128 + 2 * lane;
        const unsigned kw = *(const unsigned*)(KVX + ko), vw = *(const unsigned*)(KVX + ko + 512);
        const float s = wave_sum(q0 * bflo(kw) + q1 * bfhi(kw)) * 0.088388347648318440f;
        const float mn = fmaxf(m, s), a = __expf(m - mn), p = __expf(s - mn);
        l = l * a + p; o0 = o0 * a + p * bflo(vw); o1 = o1 * a + p * bfhi(vw); m = mn; }
    const float il = 1.0f / l;
    *(unsigned*)(OX + (size_t)row * 512 + h * 128 + 2 * lane) = pk2(o0 * il, o1 * il);
}
}


#ifndef USE_FP8
#define USE_FP8 0xE80
#endif
struct Frame {
    LAS unsigned char* lds;
    volatile LAS unsigned* MISC;
    int tid, lane, wave;
    int vcu, G;
};
struct Args { const float* in[22]; float* out; unsigned char* ws; int ph_lo, ph_hi; };
enum { I_X = 0, I_MEM, I_F1N, I_F1G, I_F1U, I_F1D, I_MIXN, I_WIN, I_CONVW, I_AON, I_CON, I_WOUT, I_XN, I_MEMNRM, I_XQ, I_XKV, I_XO, I_F2N, I_F2G, I_F2U, I_F2D, I_FINAL };

struct P0Job { const float* src; const float* gain; bf16* dst; int pitch, dstK, dkoff, drow0, k0, f8; };
__device__ __forceinline__ void p0_load(const P0Job& J, int lane, float (&v)[32]) {
    const float* wp = J.src + (size_t)(J.k0 + (lane >> 5)) * J.pitch + (lane & 31);
#pragma unroll
    for (int i = 0; i < 32; ++i) v[i] = wp[(size_t)(2 * i) * J.pitch];
}
__device__ __forceinline__ void p0_store(const P0Job& J, int lane, const float (&v)[32], LAS float* scr) {
    const int c = lane & 7;
    f32x4 g0 = (f32x4){1.f, 1.f, 1.f, 1.f}, g1 = g0;
    if (J.gain) { g0 = *(const GAS f32x4*)(J.gain + J.k0 + 8 * c); g1 = *(const GAS f32x4*)(J.gain + J.k0 + 8 * c + 4); }
#pragma unroll
    for (int i = 0; i < 32; ++i) scr[(2 * i + (lane >> 5)) * 33 + (lane & 31)] = v[i];
    LDS_WAIT(); asm volatile("" ::: "memory");
#pragma unroll
    for (int j = 0; j < 4; ++j) { const int n = (lane >> 3) + 8 * j; const LAS float* s = scr + (8 * c) * 33 + n;
        const f32x4 x0 = (f32x4){s[0 * 33], s[1 * 33], s[2 * 33], s[3 * 33]} * g0, x1 = (f32x4){s[4 * 33], s[5 * 33], s[6 * 33], s[7 * 33]} * g1;
        if (J.f8) { const pg8::u32x2 o = pg8::pack8_f8(x0 * 64.0f, x1 * 64.0f); *(GAS v2u*)((unsigned char*)J.dst + (size_t)(J.drow0 + n) * J.dstK + J.dkoff + J.k0 + 8 * c) = (v2u){o.x, o.y}; }
        else { v4u o; o.x = pk2(x0[0], x0[1]); o.y = pk2(x0[2], x0[3]); o.z = pk2(x1[0], x1[1]); o.w = pk2(x1[2], x1[3]); *(GAS v4u*)(J.dst + (size_t)(J.drow0 + n) * J.dstK + J.dkoff + J.k0 + 8 * c) = o; } }
    LDS_WAIT(); asm volatile("" ::: "memory");
}
constexpr int P0_I_FF = (D / 64) * (FF / 32), P0_I_FD = (FF / 64) * (D / 32), P0_I_IN = (D / 64) * (1024 / 32), P0_I_OUT = (1024 / 64) * (D / 32), P0_I_XQ = (D / 64) * (XW / 32), P0_I_XKV = (D / 64) * (1024 / 32), P0_I_XO = (XW / 64) * (D / 32);
constexpr int P0_NITEMS = 4 * P0_I_FF + 2 * P0_I_FD + 6 * P0_I_IN + 2 * P0_I_OUT + P0_I_XQ + P0_I_XKV + P0_I_XO;
__device__ __forceinline__ P0Job p0_job(const Args& a, int it) {
    unsigned char* ws = a.ws;
    int r = it; const float* src = nullptr; const float* gain = nullptr; bf16* dst = nullptr; int pitch = 0, ncols = 32, dstK = 0, dkoff = 0, rowoff = 0, mode = 0, f8 = 0; bool hit = false;
    constexpr int F8I = (USE_FP8 >> 3) & 1, F8M = (USE_FP8 >> 6) & 1, F8Q = (USE_FP8 >> 7) & 1, F8O = (USE_FP8 >> 9) & 1, F8G = (USE_FP8 >> 10) & 1, F8D = (USE_FP8 >> 11) & 1;
#define JOB(cnt, SRC, PITCH, NCOLS, GAIN, DST, DSTK, DKOFF, ROWOFF, MODE, F8J) if (!hit) { if (r < (cnt)) { hit = true; f8 = (F8J); src = (SRC); pitch = (PITCH); ncols = (NCOLS); gain = (GAIN); dst = (bf16*)(ws + (DST)); dstK = (DSTK); dkoff = (DKOFF); rowoff = (ROWOFF); mode = (MODE); } else r -= (cnt); }
    JOB(P0_I_FF, a.in[I_F1G], FF, FF, a.in[I_F1N], WS_WGU1, D, 0, 0, 1, 0)
    JOB(P0_I_FF, a.in[I_F1U], FF, FF, a.in[I_F1N], WS_WGU1, D, 0, 0, 2, 0)
    JOB(P0_I_FD, a.in[I_F1D], D, D, nullptr, WS_WD1, FF, 0, 0, 0, 0)
    JOB(P0_I_IN, a.in[I_WIN] + 0, INW, 1024, a.in[I_MIXN], WS_WIN, D, 0, 0, 0, 0)
    JOB(P0_I_IN, a.in[I_WIN] + 1024, INW, 1024, a.in[I_MIXN], WS_WIN, D, 0, 1024, 0, 0)
    JOB(P0_I_IN, a.in[I_WIN] + 2048, INW, 1024, a.in[I_MIXN], F8I ? WS_WIN8 : WS_WIN, D, 0, F8I ? 0 : 2048, 0, F8I)
    JOB(P0_I_IN, a.in[I_WIN] + 3072, INW, 1024, a.in[I_MIXN], F8I ? WS_WIN8 : WS_WIN, D, 0, F8I ? 1024 : 3072, 1, F8I)
    JOB(P0_I_IN, a.in[I_WIN] + 5120, INW, 1024, a.in[I_MIXN], F8I ? WS_WIN8 : WS_WIN, D, 0, F8I ? 1024 : 3072, 2, F8I)
    JOB(P0_I_IN, a.in[I_WIN] + 4096, INW, 1024, a.in[I_MIXN], F8I ? WS_WIN8 : WS_WIN, D, 0, F8I ? 3072 : 5120, 0, F8I)
    JOB(P0_I_OUT, a.in[I_WOUT], D, D, a.in[I_AON], WS_WOUT, D, 0, 0, 0, F8M)
    JOB(P0_I_OUT, a.in[I_WOUT] + (size_t)1024 * D, D, D, a.in[I_CON], WS_WOUT, D, 1024, 0, 0, F8M)
    JOB(P0_I_XQ, a.in[I_XQ], XW, XW, a.in[I_XN], WS_WQ, D, 0, 0, 0, F8Q)
    JOB(P0_I_XKV, a.in[I_XKV], 1024, 1024, nullptr, WS_WKV, D, 0, 0, 0, 0)
    JOB(P0_I_XO, a.in[I_XO], D, D, nullptr, WS_WO, XW, 0, 0, 0, F8O)
    JOB(P0_I_FF, a.in[I_F2G], FF, FF, a.in[I_F2N], WS_WGU2, D, 0, 0, 1, F8G)
    JOB(P0_I_FF, a.in[I_F2U], FF, FF, a.in[I_F2N], WS_WGU2, D, 0, 0, 2, F8G)
    JOB(P0_I_FD, a.in[I_F2D], D, D, nullptr, WS_WD2, FF, 0, 0, 0, F8D)
#undef JOB
    const int nblk = ncols / 32, kb = r / nblk, nb = r % nblk, k0 = 64 * kb, n0 = 32 * nb;
    P0Job J; J.src = src + n0; J.gain = gain; J.dst = dst; J.pitch = pitch; J.dstK = dstK; J.dkoff = dkoff; J.k0 = k0; J.f8 = f8;
    J.drow0 = rowoff + (mode ? (n0 >> 7) * 256 + (n0 & 127) + (mode == 2 ? 128 : 0) : n0);
    return J;
}
__device__ __forceinline__ void p0_prologue(Frame& F_, const Args& a) {
    Frame F = F_; { int t_ = (int)__builtin_amdgcn_mbcnt_hi(~0u, __builtin_amdgcn_mbcnt_lo(~0u, 0u)); asm volatile("" : "+v"(t_)); F.lane = t_; F.tid = t_ + 64 * F.wave; }
    LAS float* scr = (LAS float*)(F.lds + RING_OFF + F.wave * 16384);
    const int gw = F.vcu * NWAVES + F.wave, NGW = F.G * NWAVES;
    unsigned char* ws = a.ws;
    { float va[32], vb[32]; P0Job Ja, Jb; int it = gw;
      if (it < P0_NITEMS) { Ja = p0_job(a, it); p0_load(Ja, F.lane, va); }
      while (it < P0_NITEMS) {
          const int i2 = it + NGW; if (i2 < P0_NITEMS) { Jb = p0_job(a, i2); p0_load(Jb, F.lane, vb); }
          p0_store(Ja, F.lane, va, scr);
          if (i2 >= P0_NITEMS) break;
          const int i3 = i2 + NGW; if (i3 < P0_NITEMS) { Ja = p0_job(a, i3); p0_load(Ja, F.lane, va); }
          p0_store(Jb, F.lane, vb, scr);
          it = i3; } }
    { bf16* HB = (bf16*)(ws + WS_HB); pg8::u64_t* ss0 = (pg8::u64_t*)(ws + WS_CTL + CTL_SS);
      for (int m = gw; m < M; m += NGW) { const GAS f32x4* xr = (const GAS f32x4*)(a.in[I_X] + (size_t)m * D) + F.lane; GAS v2u* o8 = (GAS v2u*)(HB + (size_t)m * D) + F.lane; float s = 0.f;
#pragma unroll
          for (int j = 0; j < 8; ++j) { const f32x4 v = xr[64 * j]; s += (v.x * v.x + v.y * v.y) + (v.z * v.z + v.w * v.w); v2u w; w.x = pk2(v.x, v.y); w.y = pk2(v.z, v.w); o8[64 * j] = w; }
          s = wave_sum(s); if (F.lane == 0) ss0[m] = (pg8::u64_t)(s * 65536.0f + 0.5f); } }
    { bf16* MN = (bf16*)(ws + WS_MEMN); const float* gm = a.in[I_MEMNRM];
      for (int m = gw; m < BATCH * MEML; m += NGW) { const GAS f32x4* xr = (const GAS f32x4*)(a.in[I_MEM] + (size_t)m * D) + F.lane; GAS v2u* o8 = (GAS v2u*)(MN + (size_t)m * D) + F.lane; f32x4 v[8]; float s = 0.f;
#pragma unroll
          for (int j = 0; j < 8; ++j) { v[j] = xr[64 * j]; s += (v[j].x * v[j].x + v[j].y * v[j].y) + (v[j].z * v[j].z + v[j].w * v[j].w); }
          const float rs = rsqrtf(wave_sum(s) * (1.0f / D) + 1e-6f);
#pragma unroll
          for (int j = 0; j < 8; ++j) { const f32x4 g = *((const GAS f32x4*)gm + F.lane + 64 * j); v2u w; w.x = pk2(v[j].x * rs * g.x, v[j].y * rs * g.y); w.y = pk2(v[j].z * rs * g.z, v[j].w * rs * g.w); o8[64 * j] = w; } } }
}
__device__ __forceinline__ void p5_conv(Frame& F_, const Args& a) {
    Frame F = F_; { int t_ = (int)__builtin_amdgcn_mbcnt_hi(~0u, __builtin_amdgcn_mbcnt_lo(~0u, 0u)); asm volatile("" : "+v"(t_)); F.lane = t_; F.tid = t_ + 64 * F.wave; }
    const int gw = F.vcu * NWAVES + F.wave, NGW = F.G * NWAVES; unsigned char* ws = a.ws;
    const bf16* CU = (const bf16*)(ws + WS_CU); const bf16* BG = (const bf16*)(ws + WS_BG); bf16* MX = (bf16*)(ws + WS_MIXED); const float* cw = a.in[I_CONVW];
    for (int m = gw; m < M; m += NGW) { const int t = m & (SEQ - 1); float y[16]; float s = 0.f;
#pragma unroll
        for (int gsel = 0; gsel < 2; ++gsel) { const int ch = gsel * 512 + F.lane * 8;
            const v4u c0 = *(const GAS v4u*)(CU + (size_t)m * 1024 + ch); v4u c1 = (v4u){0u, 0u, 0u, 0u}, c2 = (v4u){0u, 0u, 0u, 0u};
            if (t >= 1) c1 = *(const GAS v4u*)(CU + (size_t)(m - 1) * 1024 + ch);
            if (t >= 2) c2 = *(const GAS v4u*)(CU + (size_t)(m - 2) * 1024 + ch);
            const v4u bg = *(const GAS v4u*)(BG + (size_t)m * 1024 + ch);
            const f32x4 w0a = *(const GAS f32x4*)(cw + ch), w0b = *(const GAS f32x4*)(cw + ch + 4), w1a = *(const GAS f32x4*)(cw + 1024 + ch), w1b = *(const GAS f32x4*)(cw + 1024 + ch + 4), w2a = *(const GAS f32x4*)(cw + 2048 + ch), w2b = *(const GAS f32x4*)(cw + 2048 + ch + 4);
#pragma unroll
            for (int e = 0; e < 4; ++e) { const unsigned x0 = c0[e], x1 = c1[e], x2 = c2[e], bw = bg[e];
                const float wl0 = e < 2 ? w0a[2 * e] : w0b[2 * e - 4], wh0 = e < 2 ? w0a[2 * e + 1] : w0b[2 * e - 3];
                const float wl1 = e < 2 ? w1a[2 * e] : w1b[2 * e - 4], wh1 = e < 2 ? w1a[2 * e + 1] : w1b[2 * e - 3];
                const float wl2 = e < 2 ? w2a[2 * e] : w2b[2 * e - 4], wh2 = e < 2 ? w2a[2 * e + 1] : w2b[2 * e - 3];
                const float lo = bflo(bw) * (wl0 * bflo(x2) + wl1 * bflo(x1) + wl2 * bflo(x0)), hi = bfhi(bw) * (wh0 * bfhi(x2) + wh1 * bfhi(x1) + wh2 * bfhi(x0));
                y[gsel * 8 + 2 * e] = lo; y[gsel * 8 + 2 * e + 1] = hi; s += lo * lo + hi * hi; } }
        const float rs = rsqrtf(wave_sum(s) * (1.0f / 1024.0f) + 1e-6f);
#pragma unroll
        for (int gsel = 0; gsel < 2; ++gsel) {
            if constexpr (((USE_FP8 >> 6) & 1) != 0) { const pg8::u32x2 o = pg8::pack8_f8((f32x4){y[gsel * 8 + 0], y[gsel * 8 + 1], y[gsel * 8 + 2], y[gsel * 8 + 3]} * rs, (f32x4){y[gsel * 8 + 4], y[gsel * 8 + 5], y[gsel * 8 + 6], y[gsel * 8 + 7]} * rs);
                *(GAS v2u*)((unsigned char*)MX + (size_t)m * 2048 + 1024 + gsel * 512 + F.lane * 8) = (v2u){o.x, o.y}; }
            else { v4u o; o.x = pk2(y[gsel * 8 + 0] * rs, y[gsel * 8 + 1] * rs); o.y = pk2(y[gsel * 8 + 2] * rs, y[gsel * 8 + 3] * rs); o.z = pk2(y[gsel * 8 + 4] * rs, y[gsel * 8 + 5] * rs); o.w = pk2(y[gsel * 8 + 6] * rs, y[gsel * 8 + 7] * rs);
                *(GAS v4u*)(MX + (size_t)m * 2048 + 1024 + gsel * 512 + F.lane * 8) = o; } } }
}
__device__ __forceinline__ void p12_final(Frame& F_, const Args& a) {
    Frame F = F_; { int t_ = (int)__builtin_amdgcn_mbcnt_hi(~0u, __builtin_amdgcn_mbcnt_lo(~0u, 0u)); asm volatile("" : "+v"(t_)); F.lane = t_; F.tid = t_ + 64 * F.wave; }
    const int gw = F.vcu * NWAVES + F.wave, NGW = F.G * NWAVES; const pg8::u64_t* ss4 = (const pg8::u64_t*)(a.ws + WS_CTL + CTL_SS) + 5 * M; const float* gf = a.in[I_FINAL]; const bf16* HB = (const bf16*)(a.ws + WS_HB);
    for (int m = gw; m < M; m += NGW) { GAS f32x4* xr = (GAS f32x4*)(a.out + (size_t)m * D); const GAS v4u* hr = (const GAS v4u*)(HB + (size_t)m * D) + F.lane; const float rs = rsqrtf(pg8::ss_val(ss4, m) * (1.0f / D) + 1e-6f);
#pragma unroll
        for (int j = 0; j < 4; ++j) { const v4u w = hr[64 * j]; const int c = (F.lane + 64 * j) * 8; const f32x4 g0 = *(const GAS f32x4*)(gf + c), g1 = *(const GAS f32x4*)(gf + c + 4);
            xr[(c >> 2)] = (f32x4){bflo(w.x), bfhi(w.x), bflo(w.y), bfhi(w.y)} * g0 * rs; xr[(c >> 2) + 1] = (f32x4){bflo(w.z), bfhi(w.z), bflo(w.w), bfhi(w.w)} * g1 * rs; } }
}
#ifndef DUP_MASK
#define DUP_MASK 0
#endif
#ifndef MOBA_SDEPTH
#define MOBA_SDEPTH 1
#endif
__global__ void __launch_bounds__(NWAVES * 64, 2) fwd_kernel(Args args) {
    extern __shared__ __attribute__((aligned(16))) unsigned char lds[];
    Frame F;
    F.lds = (LAS unsigned char*)lds;
    F.MISC = (volatile LAS unsigned*)(F.lds + MISC_OFF);
    F.tid = threadIdx.x; F.lane = F.tid & 63; F.wave = __builtin_amdgcn_readfirstlane(F.tid >> 6);
    F.G = gridDim.x; { const int bx = blockIdx.x; F.vcu = (F.G % 8 == 0) ? (bx % 8) * (F.G / 8) + bx / 8 : bx; }
    unsigned char* ws = args.ws;
    for (int u = F.tid; u < (LDS_BYTES - LDSCTL_OFF) / 4; u += NWAVES * 64) ((LAS unsigned*)(F.lds + LDSCTL_OFF))[u] = 0u;
    __syncthreads();
    const int lo = args.ph_lo, hi = args.ph_hi; const bool multi = (hi - lo) > 1;
    XcdBarrier bar; bar.bar = (unsigned*)(ws + WS_CTL + CTL_BAR + (size_t)lo * BAR_STRIDE); bar.x = 0; bar.st = nullptr;
    if (multi) bar = xcd_barrier_post((unsigned*)(ws + WS_CTL + CTL_BAR + (size_t)lo * BAR_STRIDE), F.MISC + 8);
#ifndef PH_ENABLE
#define PH_ENABLE 0x1fff
#endif
#define IN(k) ((((PH_ENABLE) >> (k)) & 1) && lo <= (k) && (k) < hi)
#define SEAM(k) do { if (IN(k) && IN((k) + 1)) xcd_barrier(bar); } while (0)
    pg8::u64_t* SS = (pg8::u64_t*)(ws + WS_CTL + CTL_SS);
    float* KMS = (float*)(ws + WS_CTL + CTL_KMS);
    bf16* HB = (bf16*)(ws + WS_HB); bf16* ACT = (bf16*)(ws + WS_ACT); bf16* MIXED = (bf16*)(ws + WS_MIXED);
    bf16* Qb = (bf16*)(ws + WS_Q); bf16* Kb = (bf16*)(ws + WS_K); bf16* Vb = (bf16*)(ws + WS_V); bf16* CUb = (bf16*)(ws + WS_CU); bf16* BGb = (bf16*)(ws + WS_BG);
    bf16* QX = (bf16*)(ws + WS_QX); bf16* OX = (bf16*)(ws + WS_OX); bf16* KVX = (bf16*)(ws + WS_KVX);
    const int bx = (int)blockIdx.x;

#ifndef F8_SP2
#define F8_SP2 PG8_SP2
#endif
#ifndef F8_ALIGN
#define F8_ALIGN PG8_ALIGN
#endif
#define GEMM_RUN(EPI, FP8FLAG, G_, S_, E_) pg8::gemm_phase<EPI, pg8::StaticOrder, (FP8FLAG) ? F8_ALIGN : PG8_ALIGN, (FP8FLAG) ? F8_SP2 : PG8_SP2, FP8FLAG>(F.lds + RING_OFF, G_, S_, E_, F.wave)
#define DUPQ(k) (((DUP_MASK) >> (k)) & 1)
    pg8::u64_t* DUMMY = (pg8::u64_t*)(ws + WS_DUMMY);
    unsigned char* MIXED8 = ws + WS_MIXED; unsigned char* HB8 = ws + WS_HB8; unsigned char* ACT8 = ws + WS_ACT8; unsigned char* OX8 = ws + WS_OX8;
    constexpr bool F3 = ((USE_FP8 >> 3) & 1) != 0, F6 = ((USE_FP8 >> 6) & 1) != 0, F7 = ((USE_FP8 >> 7) & 1) != 0, F9 = ((USE_FP8 >> 9) & 1) != 0, F10 = ((USE_FP8 >> 10) & 1) != 0, F11 = ((USE_FP8 >> 11) & 1) != 0;
    static_assert(!F3 || F6, "the e4m3 copy of h1 lives in the upper half of the mixed buffer: phase 3 on e4m3 needs phase 6 on e4m3");
    constexpr float WSC = 1.0f / 64.0f;
    if (IN(0)) { p0_prologue(F, args); if (DUPQ(0)) p0_prologue(F, args); } SEAM(0);
    if (IN(1)) { pg8::Gemm g{HB, (const bf16*)(ws + WS_WGU1), M, 2 * FF, D}; pg8::StaticOrder S; S.init(M, 2 * FF, F.G, bx);
        typedef pg8::EpiSwiglu<false> EP; EP E{ACT, nullptr, FF, SS, 1.0f, 1.0f}; GEMM_RUN(EP, false, g, S, E); if (DUPQ(1)) GEMM_RUN(EP, false, g, S, E); } SEAM(1);
    if (IN(2)) { pg8::Gemm g{ACT, (const bf16*)(ws + WS_WD1), M, D, FF}; pg8::StaticOrder S; S.init(M, D, F.G, bx);
        typedef pg8::EpiResid<0, false, false> EP; EP E{args.in[I_X], nullptr, nullptr, HB, SS + M, 0.5f, nullptr, F3 ? ws + WS_H1F8 : nullptr, 1.0f}; GEMM_RUN(EP, false, g, S, E);
        if (DUPQ(2)) { EP E2{args.in[I_X], nullptr, nullptr, HB, DUMMY, 0.5f, nullptr, F3 ? ws + WS_H1F8 : nullptr, 1.0f}; GEMM_RUN(EP, false, g, S, E2); } } SEAM(2);
    if (IN(3)) for (int rep = 0; rep < (DUPQ(3) ? 2 : 1); ++rep) {
        float* kms = rep ? (float*)DUMMY : KMS;
        if constexpr (F3) {
            { pg8::Gemm g{HB, (const bf16*)(ws + WS_WIN), M, 2048, D}; pg8::StaticOrder S; S.init(M, 2048, F.G, bx);
              pg8::EpiWin E{Qb, Kb, Vb, CUb, BGb, kms, SS + M, 0, 1.0f}; GEMM_RUN(pg8::EpiWin, false, g, S, E); }
            { pg8::Gemm g{(const bf16*)(ws + WS_H1F8), (const bf16*)(ws + WS_WIN8), M, 4096, D}; pg8::StaticOrder S; S.init(M, 4096, F.G, bx);
              pg8::EpiWin E{Qb, Kb, Vb, CUb, BGb, kms, SS + M, 8, WSC}; GEMM_RUN(pg8::EpiWin, true, g, S, E); }
        } else { pg8::Gemm g{HB, (const bf16*)(ws + WS_WIN), M, INW, D}; pg8::StaticOrder S; S.init(M, INW, F.G, bx);
            pg8::EpiWin E{Qb, Kb, Vb, CUb, BGb, kms, SS + M, 0, 1.0f}; GEMM_RUN(pg8::EpiWin, false, g, S, E); } } SEAM(3);
    if (IN(4)) for (int rep = 0; rep < (DUPQ(4) ? 2 : 1); ++rep) {
        for (int u = F.vcu; u < BATCH * NH * 8; u += F.G) { const int b = u >> 6, h = (u >> 3) & 7, p = u & 7;
#pragma unroll 1
            for (int half = 0; half < 2; ++half) { const int qb = half ? 15 - p : p; const size_t r0 = (size_t)b * SEQ + (size_t)qb * 256;
                if constexpr (F6) att::attn_body<true, 1024, 1024, 2048, MOBA_SDEPTH, unsigned char, 32>(Qb + r0 * 1024 + h * 128, Kb + (size_t)b * SEQ * 1024 + h * 128, Vb + (size_t)b * SEQ * 1024 + h * 128, MIXED8 + r0 * 2048 + h * 128,
                                                       256 * (qb + 1), (att::lptr)(F.lds + RING_OFF), qb, KMS + ((size_t)b * 16 * 8 + h) * 128, 8 * 128, (rep ? DUMMY : SS + 2 * M) + r0, F.wave);
                else att::attn_body<true, 1024, 1024, 2048, MOBA_SDEPTH, bf16, 1>(Qb + r0 * 1024 + h * 128, Kb + (size_t)b * SEQ * 1024 + h * 128, Vb + (size_t)b * SEQ * 1024 + h * 128, MIXED + r0 * 2048 + h * 128,
                                                       256 * (qb + 1), (att::lptr)(F.lds + RING_OFF), qb, KMS + ((size_t)b * 16 * 8 + h) * 128, 8 * 128, (rep ? DUMMY : SS + 2 * M) + r0, F.wave); } } }
    if (IN(5)) { p5_conv(F, args); if (DUPQ(5)) p5_conv(F, args); } SEAM(5);
    if (IN(6)) { pg8::Gemm g{F6 ? (const bf16*)MIXED8 : MIXED, (const bf16*)(ws + WS_WOUT), M, D, D}; pg8::StaticOrder S; S.init(M, D, F.G, bx);
        typedef pg8::EpiResid<F6 ? 8 : 16, true, false> EP; EP E{nullptr, HB, nullptr, HB, SS + 3 * M, F6 ? WSC : 1.0f, SS + 2 * M, F7 ? HB8 : nullptr, F6 ? 1.0f / 32.0f : 1.0f}; GEMM_RUN(EP, F6, g, S, E);
        if (DUPQ(6)) { EP E2{nullptr, HB, nullptr, HB, DUMMY, 0.0f, SS + 2 * M, F7 ? HB8 : nullptr, F6 ? 1.0f / 32.0f : 1.0f}; GEMM_RUN(EP, F6, g, S, E2); } } SEAM(6);
    if (IN(7)) for (int rep = 0; rep < (DUPQ(7) ? 2 : 1); ++rep) {
        { pg8::Gemm g{F7 ? (const bf16*)HB8 : HB, (const bf16*)(ws + WS_WQ), M, XW, D}; pg8::StaticOrder S; S.init(M, XW, F.G, bx);
          pg8::EpiScaleBf16 E{QX, XW, SS + 3 * M, F7 ? WSC : 1.0f}; GEMM_RUN(pg8::EpiScaleBf16, F7, g, S, E); }
        { pg8::Gemm g{(const bf16*)(ws + WS_MEMN), (const bf16*)(ws + WS_WKV), BATCH * MEML, 1024, D}; pg8::StaticOrder S; S.init(BATCH * MEML, 1024, F.G, (bx + F.G - 128) % F.G);
          pg8::EpiScaleBf16 E{KVX, 1024, nullptr, 1.0f}; GEMM_RUN(pg8::EpiScaleBf16, false, g, S, E); } } SEAM(7);
    if (IN(8)) for (int rep = 0; rep < (DUPQ(8) ? 2 : 1); ++rep) {
        for (int u = F.vcu; u < BATCH * XH * 16; u += F.G) { const int b = u >> 6, h = (u >> 4) & 3, qb = u & 15; const size_t r0 = (size_t)b * SEQ + (size_t)qb * 256;
            if constexpr (F9) att::attn_body<false, 512, 1024, 512, 2, unsigned char, 16>(QX + r0 * 512 + h * 128, KVX + (size_t)b * MEML * 1024 + h * 128, KVX + (size_t)b * MEML * 1024 + 512 + h * 128, OX8 + r0 * 512 + h * 128,
                                                  MEML, (att::lptr)(F.lds + RING_OFF), 0, nullptr, 0, nullptr, F.wave);
            else att::attn_body<false, 512, 1024, 512, 2, bf16, 1>(QX + r0 * 512 + h * 128, KVX + (size_t)b * MEML * 1024 + h * 128, KVX + (size_t)b * MEML * 1024 + 512 + h * 128, OX + r0 * 512 + h * 128,
                                                  MEML, (att::lptr)(F.lds + RING_OFF), 0, nullptr, 0, nullptr, F.wave); } } SEAM(8);
    if (IN(9)) { pg8::Gemm g{F9 ? (const bf16*)OX8 : OX, (const bf16*)(ws + WS_WO), M, D, XW}; pg8::StaticOrder S; S.init(M, D, F.G, bx);
        typedef pg8::EpiResid<0, true, false> EP; EP E{nullptr, HB, nullptr, HB, SS + 4 * M, F9 ? WSC / 16.0f : 1.0f, nullptr, F10 ? HB8 : nullptr, 1.0f}; GEMM_RUN(EP, F9, g, S, E);
        if (DUPQ(9)) { EP E2{nullptr, HB, nullptr, HB, DUMMY, 0.0f, nullptr, F10 ? HB8 : nullptr, 1.0f}; GEMM_RUN(EP, F9, g, S, E2); } } SEAM(9);
    if (IN(10)) { pg8::Gemm g{F10 ? (const bf16*)HB8 : HB, (const bf16*)(ws + WS_WGU2), M, 2 * FF, D}; pg8::StaticOrder S; S.init(M, 2 * FF, F.G, bx);
        typedef pg8::EpiSwiglu<F11> EP; EP E{ACT, ACT8, FF, SS + 4 * M, F10 ? WSC : 1.0f, 4.0f}; GEMM_RUN(EP, F10, g, S, E); if (DUPQ(10)) GEMM_RUN(EP, F10, g, S, E); } SEAM(10);
    if (IN(11)) { pg8::Gemm g{F11 ? (const bf16*)ACT8 : ACT, (const bf16*)(ws + WS_WD2), M, D, FF}; pg8::StaticOrder S; S.init(M, D, F.G, bx);
        typedef pg8::EpiResid<0, true, false> EP; EP E{nullptr, HB, nullptr, HB, SS + 5 * M, F11 ? 0.5f * WSC / 4.0f : 0.5f, nullptr, nullptr, 1.0f}; GEMM_RUN(EP, F11, g, S, E);
        if (DUPQ(11)) { EP E2{nullptr, HB, nullptr, HB, DUMMY, 0.0f, nullptr, nullptr, 1.0f}; GEMM_RUN(EP, F11, g, S, E2); } } SEAM(11);
    if (IN(12)) { p12_final(F, args); }
#undef GEMM_RUN
#undef DUPQ
#undef IN
#undef SEAM
}

extern "C" void kernel_launch(void* const* d_in, const int* in_sizes, int n_in, void* d_out, int out_size, void* d_ws, size_t ws_size, hipStream_t stream) {
    static int grid = 0;
    if (grid == 0) {
        if (n_in != 22 || in_sizes[0] != M * D || out_size != M * D || ws_size < WS_END) { fprintf(stderr, "kernel_launch: shape mismatch (n_in %d, in0 %d, out %d, ws %zu; need ws >= %zu); nothing launched\n", n_in, n_in > 0 ? in_sizes[0] : -1, out_size, ws_size, (size_t)WS_END); grid = -1; return; }
        int dev = 0, cus = 0, per_cu = 0;
        if (hipGetDevice(&dev) != hipSuccess || hipDeviceGetAttribute(&cus, hipDeviceAttributeMultiprocessorCount, dev) != hipSuccess) { grid = -1; return; }
        if (hipFuncSetAttribute((const void*)fwd_kernel, hipFuncAttributeMaxDynamicSharedMemorySize, LDS_BYTES) != hipSuccess) { fprintf(stderr, "kernel_launch: hipFuncSetAttribute failed\n"); grid = -1; return; }
        if (hipOccupancyMaxActiveBlocksPerMultiprocessor(&per_cu, (const void*)fwd_kernel, NWAVES * 64, LDS_BYTES) != hipSuccess || per_cu < 1) { fprintf(stderr, "kernel_launch: occupancy query reports %d workgroups per CU\n", per_cu); }
        (void)hipGetLastError();
        grid = cus;
    }
    if (grid < 0) return;
    if (hipMemsetAsync((char*)d_ws + WS_CTL, 0, CTL_ZERO_BYTES, stream) != hipSuccess) { fprintf(stderr, "kernel_launch: hipMemsetAsync failed\n"); return; }
    Args a{};
    for (int i = 0; i < 22; ++i) a.in[i] = (const float*)d_in[i];
    a.out = (float*)d_out; a.ws = (unsigned char*)d_ws;
    unsigned char* ws = (unsigned char*)d_ws; pg8::u64_t* SS = (pg8::u64_t*)(ws + WS_CTL + CTL_SS); float* KMS = (float*)(ws + WS_CTL + CTL_KMS); float* out = (float*)d_out;
    bf16* HB = (bf16*)(ws + WS_HB); bf16* ACT = (bf16*)(ws + WS_ACT); bf16* MIXED = (bf16*)(ws + WS_MIXED);
    bf16* Qb = (bf16*)(ws + WS_Q); bf16* Kb = (bf16*)(ws + WS_K); bf16* Vb = (bf16*)(ws + WS_V); bf16* CUb = (bf16*)(ws + WS_CU); bf16* BGb = (bf16*)(ws + WS_BG);
    bf16* QX = (bf16*)(ws + WS_QX); bf16* OX = (bf16*)(ws + WS_OX); bf16* KVX = (bf16*)(ws + WS_KVX);
    (void)SS; (void)KMS; (void)out; (void)HB; (void)ACT; (void)MIXED; (void)Qb; (void)Kb; (void)Vb; (void)CUb; (void)BGb; (void)QX; (void)OX; (void)KVX;
#if ONE_LAUNCH
    a.ph_lo = 0; a.ph_hi = NPH;
    hipLaunchKernelGGL(fwd_kernel, dim3(grid), dim3(NWAVES * 64), LDS_BYTES, stream, a);
#else
    for (int ph = 0; ph < NPH; ++ph) {
        if ((FAST_MASK >> ph) & 1) { a.ph_lo = ph; a.ph_hi = ph + 1; hipLaunchKernelGGL(fwd_kernel, dim3(grid), dim3(NWAVES * 64), LDS_BYTES, stream, a); continue; }
        switch (ph) {
        case 1: hipLaunchKernelGGL((nv::gemm<nv::FSwiglu>), dim3(FF / 64, M / 64), dim3(256), 0, stream, HB, (const bf16*)(ws + WS_WGU1), D, nv::FSwiglu{ACT, SS}); break;
        case 2: hipLaunchKernelGGL((nv::gemm<nv::FResid<0, false, false>>), dim3(D / 64, M / 64), dim3(256), 0, stream, ACT, (const bf16*)(ws + WS_WD1), FF, nv::FResid<0, false, false>{a.in[I_X], nullptr, nullptr, HB, SS + M, 0.5f, nullptr}); break;
        case 3: hipLaunchKernelGGL((nv::gemm<nv::FWin>), dim3(5120 / 64, M / 64), dim3(256), 0, stream, HB, (const bf16*)(ws + WS_WIN), D, nv::FWin{Qb, Kb, Vb, CUb, BGb, SS + M});
                hipLaunchKernelGGL(nv::kmean, dim3(BATCH * 16 * 8 * 128 / 256), dim3(256), 0, stream, Kb, KMS); break;
        case 4: hipLaunchKernelGGL(nv::moba, dim3(M * NH / 4), dim3(256), 0, stream, Qb, Kb, Vb, KMS, MIXED, SS + 2 * M); break;
        case 6: hipLaunchKernelGGL((nv::gemm<nv::FResid<1024, true, false>>), dim3(D / 64, M / 64), dim3(256), 0, stream, MIXED, (const bf16*)(ws + WS_WOUT), D, nv::FResid<1024, true, false>{nullptr, HB, nullptr, HB, SS + 3 * M, 1.0f, SS + 2 * M}); break;
        case 7: hipLaunchKernelGGL((nv::gemm<nv::FScale>), dim3(XW / 64, M / 64), dim3(256), 0, stream, HB, (const bf16*)(ws + WS_WQ), D, nv::FScale{QX, XW, SS + 3 * M});
                hipLaunchKernelGGL((nv::gemm<nv::FScale>), dim3(1024 / 64, BATCH * MEML / 64), dim3(256), 0, stream, (const bf16*)(ws + WS_MEMN), (const bf16*)(ws + WS_WKV), D, nv::FScale{KVX, 1024, nullptr}); break;
        case 8: hipLaunchKernelGGL(nv::xattn, dim3(M * XH / 4), dim3(256), 0, stream, QX, KVX, OX); break;
        case 9: hipLaunchKernelGGL((nv::gemm<nv::FResid<0, true, false>>), dim3(D / 64, M / 64), dim3(256), 0, stream, OX, (const bf16*)(ws + WS_WO), XW, nv::FResid<0, true, false>{nullptr, HB, nullptr, HB, SS + 4 * M, 1.0f, nullptr}); break;
        case 10: hipLaunchKernelGGL((nv::gemm<nv::FSwiglu>), dim3(FF / 64, M / 64), dim3(256), 0, stream, HB, (const bf16*)(ws + WS_WGU2), D, nv::FSwiglu{ACT, SS + 4 * M}); break;
        case 11: hipLaunchKernelGGL((nv::gemm<nv::FResid<0, true, false>>), dim3(D / 64, M / 64), dim3(256), 0, stream, ACT, (const bf16*)(ws + WS_WD2), FF, nv::FResid<0, true, false>{nullptr, HB, nullptr, HB, SS + 5 * M, 0.5f, nullptr}); break;
        default: break;
        }
    }
#endif
    const hipError_t le = hipPeekAtLastError();
    if (le != hipSuccess) fprintf(stderr, "kernel_launch: launch failed: %s\n", hipGetErrorName(le));
}
```

```cpp
#define ONE_LAUNCH 1
#define FAST_MASK 0x1fff
#define USE_FP8 0xEC8
#define MOBA_SDEPTH 2
#include <hip/hip_runtime.h>
#include <cstdio>
#include <cstdint>
namespace pg8 {
#define PG8_LAS __attribute__((address_space(3)))
typedef unsigned short bf16_t;
typedef short bf16x8 __attribute__((ext_vector_type(8)));
typedef float f32x4 __attribute__((ext_vector_type(4)));
typedef unsigned u32x4 __attribute__((ext_vector_type(4)));
typedef int i32x4 __attribute__((ext_vector_type(4)));
typedef int i32x8 __attribute__((ext_vector_type(8)));
typedef unsigned u32x2 __attribute__((ext_vector_type(2)));
constexpr int BM = 256, BK = 64, HALF = 128, HTB = HALF * BK * 2  , STAGE_BYTES = 8 * HTB, NXCD = 8, WGM = 8;

__host__ __device__ __forceinline__ int lds_byte(int r, int c) { const int st = (r >> 4) * 2 + (c >> 5), rr = r & 15, cc = c & 31, ob = rr * 64 + cc * 2; return st * 1024 + (ob ^ (((ob >> 9) & 1) << 5)); }
__host__ __device__ __forceinline__ void stage_rc(int b, int& R, int& C) { const int st = b / 1024, sb = b % 1024, swz = sb ^ (((sb >> 9) & 1) << 5); R = (st >> 1) * 16 + swz / 64; C = (st & 1) * 32 + (swz % 64) / 2; }
__host__ __device__ __forceinline__ int perm32(int rho) { const int n = rho >> 4, i = rho & 15; return 8 * (i >> 2) + 4 * n + (i & 3); }

struct Unit { int pm, pn; };
struct Gemm { const bf16_t* A; const bf16_t* Bt; int M, N, K; };

struct StaticOrder {
    int nM, nN, nwg, G, c;
    __host__ __device__ void init(int M, int N, int G_, int c_) { nM = M / BM; nN = N / BM; nwg = nM * nN; G = G_; c = c_; }
    __host__ __device__ bool next(int i, Unit& u) const {
        const long L = (long)i * G + c; if (L >= nwg) return false;
        int wgid = (int)L; { const int q = nwg / NXCD, r = nwg % NXCD, xcd = wgid % NXCD, off = wgid / NXCD; wgid = (xcd < r ? xcd * (q + 1) : r * (q + 1) + (xcd - r) * q) + off; }
        const int nig = WGM * nN, gid = wgid / nig, fm = gid * WGM, gsz = (nM - fm) < WGM ? (nM - fm) : WGM;
        u.pm = fm + ((wgid % nig) % gsz); u.pn = (wgid % nig) / gsz; return true;
    }
    __device__ __forceinline__ void a_ready(const Unit&) const {}
    __device__ __forceinline__ void done(const Unit&) const {}
};

__device__ __forceinline__ unsigned cvt_pk_bf16(float lo, float hi) { unsigned r; asm volatile("v_cvt_pk_bf16_f32 %0, %1, %2" : "=v"(r) : "v"(lo), "v"(hi)); return r; }
__device__ __forceinline__ u32x4 pack8(const f32x4 v0, const f32x4 v1) { u32x4 w; w.x = cvt_pk_bf16(v0[0], v0[1]); w.y = cvt_pk_bf16(v0[2], v0[3]); w.z = cvt_pk_bf16(v1[0], v1[1]); w.w = cvt_pk_bf16(v1[2], v1[3]); return w; }
constexpr float RMS_EPS = 1e-6f;
typedef unsigned long long u64_t;
__device__ __forceinline__ float ss_val(const u64_t* ss, int row) { return (float)ss[row] * (1.0f / 65536.0f); }
__device__ __forceinline__ void ss_add(u64_t* ss, int row, float sq) { atomicAdd(ss + row, (u64_t)(unsigned)(sq * 65536.0f + 0.5f)); }
__device__ __forceinline__ float clamp_f8(float x) { return __builtin_amdgcn_fmed3f(x, -448.0f, 448.0f); }
__device__ __forceinline__ u32x2 pack8_f8(const f32x4 v0, const f32x4 v1) { int a = __builtin_amdgcn_cvt_pk_fp8_f32(clamp_f8(v0[0]), clamp_f8(v0[1]), 0, false); a = __builtin_amdgcn_cvt_pk_fp8_f32(clamp_f8(v0[2]), clamp_f8(v0[3]), a, true);
    int b = __builtin_amdgcn_cvt_pk_fp8_f32(clamp_f8(v1[0]), clamp_f8(v1[1]), 0, false); b = __builtin_amdgcn_cvt_pk_fp8_f32(clamp_f8(v1[2]), clamp_f8(v1[3]), b, true); u32x2 w; w.x = (unsigned)a; w.y = (unsigned)b; return w; }
__device__ __forceinline__ float silu_mul(float g, float u) { return g * u * __builtin_amdgcn_rcpf(1.0f + __builtin_amdgcn_exp2f(-1.4426950408889634f * g)); }

template <bool F8OUT> struct EpiSwiglu {
    static constexpr bool PERM = true, AFTER_DRAIN = false; static constexpr int MIDT = 0;
    bf16_t* O; unsigned char* O8; int ldo; const u64_t* ss; float asc, osc;
    __device__ __forceinline__ void mid(f32x4 (&)[2][2][4][2], const Unit&, int, int) const {}
    __device__ __forceinline__ void operator()(const f32x4 (&acc)[2][2][4][2], const Unit& u, int wr, int wc, int fr_, int fq_) const {
        int fr = fr_, fq = fq_; asm volatile("" : "+v"(fr), "+v"(fq));
        const int row0 = u.pm * BM + wr * 64 + fr, col0 = u.pn * HALF + wc * 32 + 8 * fq;
#pragma unroll
        for (int ai = 0; ai < 2; ++ai)
#pragma unroll
            for (int m = 0; m < 4; ++m) { const int row = row0 + ai * HALF + m * 16; const float rs = asc * rsqrtf(ss_val(ss, row) * (1.0f / 2048.0f) + RMS_EPS);
                f32x4 o0, o1;
#pragma unroll
                for (int j = 0; j < 4; ++j) { o0[j] = silu_mul(acc[ai][0][m][0][j] * rs, acc[ai][1][m][0][j] * rs); o1[j] = silu_mul(acc[ai][0][m][1][j] * rs, acc[ai][1][m][1][j] * rs); }
                if constexpr (F8OUT) *(u32x2*)(O8 + (size_t)row * ldo + col0) = pack8_f8(o0 * osc, o1 * osc);
                else *(u32x4*)(O + (size_t)row * ldo + col0) = pack8(o0, o1); }
    }
};
template <int MIDT_, bool RBF, bool OF32> struct EpiResid {
    static constexpr bool PERM = true, AFTER_DRAIN = false; static constexpr int MIDT = MIDT_;
    const float* R; const bf16_t* RB; float* H; bf16_t* HB; u64_t* ssn; float alpha; const u64_t* midss; unsigned char* HB8; float midmul;
    __device__ __forceinline__ void mid(f32x4 (&acc)[2][2][4][2], const Unit& u, int wr, int fr) const {
        const int row0 = u.pm * BM + wr * 64 + fr;
#pragma unroll
        for (int ai = 0; ai < 2; ++ai)
#pragma unroll
            for (int m = 0; m < 4; ++m) { const float s = midmul * rsqrtf(ss_val(midss, row0 + ai * HALF + m * 16) * (1.0f / 1024.0f) + RMS_EPS);
#pragma unroll
                for (int bj = 0; bj < 2; ++bj)
#pragma unroll
                    for (int n = 0; n < 2; ++n) acc[ai][bj][m][n] = acc[ai][bj][m][n] * s; }
    }
    __device__ __forceinline__ void operator()(const f32x4 (&acc)[2][2][4][2], const Unit& u, int wr, int wc, int fr_, int fq_) const {
        int fr = fr_, fq = fq_; asm volatile("" : "+v"(fr), "+v"(fq));
        const int row0 = u.pm * BM + wr * 64 + fr, col0 = u.pn * BM + wc * 32 + 8 * fq;
#pragma unroll
        for (int ai = 0; ai < 2; ++ai)
#pragma unroll
            for (int m = 0; m < 4; ++m) { const int row = row0 + ai * HALF + m * 16; const size_t off = (size_t)row * 2048 + col0; float sq = 0.f;
#pragma unroll
                for (int bj = 0; bj < 2; ++bj) { f32x4 r0, r1;
                    if constexpr (RBF) { const u32x4 w = *(const u32x4*)(RB + off + bj * HALF);
                        r0 = (f32x4){__uint_as_float(w.x << 16), __uint_as_float(w.x & 0xffff0000u), __uint_as_float(w.y << 16), __uint_as_float(w.y & 0xffff0000u)};
                        r1 = (f32x4){__uint_as_float(w.z << 16), __uint_as_float(w.z & 0xffff0000u), __uint_as_float(w.w << 16), __uint_as_float(w.w & 0xffff0000u)}; }
                    else { r0 = *(const f32x4*)(R + off + bj * HALF); r1 = *(const f32x4*)(R + off + bj * HALF + 4); }
                    const f32x4 h0 = r0 + acc[ai][bj][m][0] * alpha, h1 = r1 + acc[ai][bj][m][1] * alpha;
                    if constexpr (OF32) { *(f32x4*)(H + off + bj * HALF) = h0; *(f32x4*)(H + off + bj * HALF + 4) = h1; }
                    else { *(u32x4*)(HB + off + bj * HALF) = pack8(h0, h1); if (HB8) *(u32x2*)(HB8 + off + bj * HALF) = pack8_f8(h0, h1); }
                    sq += (h0[0] * h0[0] + h0[1] * h0[1]) + (h0[2] * h0[2] + h0[3] * h0[3]) + (h1[0] * h1[0] + h1[1] * h1[1]) + (h1[2] * h1[2] + h1[3] * h1[3]); }
                sq += __shfl_xor(sq, 16); sq += __shfl_xor(sq, 32);
                if (fq == 0) ss_add(ssn, row, sq);
                asm volatile("" ::: "memory"); }
    }
};
struct EpiWin {
    static constexpr bool PERM = true, AFTER_DRAIN = false; static constexpr int MIDT = 0;
    bf16_t *Q, *K, *V, *CU, *BG; float* kms; const u64_t* ss; int pn_off; float asc;
    __device__ __forceinline__ void mid(f32x4 (&)[2][2][4][2], const Unit&, int, int) const {}
    __device__ __forceinline__ void operator()(const f32x4 (&acc)[2][2][4][2], const Unit& u, int wr, int wc, int fr_, int fq_) const {
        int fr = fr_, fq = fq_; asm volatile("" : "+v"(fr), "+v"(fq));
        const int row0 = u.pm * BM + wr * 64 + fr, pn = u.pn + pn_off;
        if (pn >= 12 && pn < 20) {
            const int col0 = (pn - 12) * HALF + wc * 32 + 8 * fq;
#pragma unroll
            for (int ai = 0; ai < 2; ++ai)
#pragma unroll
                for (int m = 0; m < 4; ++m) { const int row = row0 + ai * HALF + m * 16; float rs = asc * rsqrtf(ss_val(ss, row) * (1.0f / 2048.0f) + RMS_EPS); rs = rs * rs;
                    const f32x4 o0 = acc[ai][0][m][0] * acc[ai][1][m][0] * rs, o1 = acc[ai][0][m][1] * acc[ai][1][m][1] * rs;
                    *(u32x4*)(CU + (size_t)row * 1024 + col0) = pack8(o0, o1); }
        } else {
            bf16_t* base = pn < 4 ? Q : pn < 8 ? K : pn < 12 ? V : BG; const int colt = (pn & 3) * BM, col0 = colt + wc * 32 + 8 * fq; const bool isk = (pn >= 4 && pn < 8);
            float rsv[2][4];
#pragma unroll
            for (int ai = 0; ai < 2; ++ai)
#pragma unroll
                for (int m = 0; m < 4; ++m) rsv[ai][m] = asc * rsqrtf(ss_val(ss, row0 + ai * HALF + m * 16) * (1.0f / 2048.0f) + RMS_EPS);
#pragma unroll
            for (int ai = 0; ai < 2; ++ai)
#pragma unroll
                for (int m = 0; m < 4; ++m) { const int row = row0 + ai * HALF + m * 16;
#pragma unroll
                    for (int bj = 0; bj < 2; ++bj) *(u32x4*)(base + (size_t)row * 1024 + col0 + bj * HALF) = pack8(acc[ai][bj][m][0] * rsv[ai][m], acc[ai][bj][m][1] * rsv[ai][m]); }
            if (isk) {
#pragma unroll
                for (int bj = 0; bj < 2; ++bj)
#pragma unroll
                    for (int n = 0; n < 2; ++n) { f32x4 c = (f32x4){0.f, 0.f, 0.f, 0.f};
#pragma unroll
                        for (int ai = 0; ai < 2; ++ai)
#pragma unroll
                            for (int m = 0; m < 4; ++m) { float r2 = rsv[ai][m]; asm volatile("" : "+v"(r2)); c += acc[ai][bj][m][n] * r2; }
#pragma unroll
                        for (int j = 0; j < 4; ++j) { float v = c[j]; v += __shfl_xor(v, 1); v += __shfl_xor(v, 2); v += __shfl_xor(v, 4); v += __shfl_xor(v, 8);
                            const int col = col0 + bj * HALF + 4 * n + j;
                            if (fr == 0) unsafeAtomicAdd(kms + ((size_t)u.pm * 8 + (col >> 7)) * 128 + (col & 127), v); }
                        asm volatile("" ::: "memory"); }
            }
        }
    }
};
struct EpiScaleBf16 {
    static constexpr bool PERM = true, AFTER_DRAIN = false; static constexpr int MIDT = 0;
    bf16_t* O; int ldo; const u64_t* ss; float asc;
    __device__ __forceinline__ void mid(f32x4 (&)[2][2][4][2], const Unit&, int, int) const {}
    __device__ __forceinline__ void operator()(const f32x4 (&acc)[2][2][4][2], const Unit& u, int wr, int wc, int fr_, int fq_) const {
        int fr = fr_, fq = fq_; asm volatile("" : "+v"(fr), "+v"(fq));
        const int row0 = u.pm * BM + wr * 64 + fr, col0 = u.pn * BM + wc * 32 + 8 * fq;
#pragma unroll
        for (int ai = 0; ai < 2; ++ai)
#pragma unroll
            for (int m = 0; m < 4; ++m) { const int row = row0 + ai * HALF + m * 16; const float rs = asc * (ss ? rsqrtf(ss_val(ss, row) * (1.0f / 2048.0f) + RMS_EPS) : 1.0f);
#pragma unroll
                for (int bj = 0; bj < 2; ++bj) *(u32x4*)(O + (size_t)row * ldo + col0 + bj * HALF) = pack8(acc[ai][bj][m][0] * rs, acc[ai][bj][m][1] * rs); }
    }
};

template <class Epi, class Sched, bool ALIGN_EPI = false, bool SP2 = false, bool FP8 = false>
__device__ __forceinline__ void gemm_phase(PG8_LAS unsigned char* lds, const Gemm g, const Sched& S, const Epi& E, const int wave_sgpr) {
    int tid_ = (int)__builtin_amdgcn_mbcnt_hi(~0u, __builtin_amdgcn_mbcnt_lo(~0u, 0u)) + 64 * wave_sgpr; asm volatile("" : "+v"(tid_));
    const int tid = tid_, wid = __builtin_amdgcn_readfirstlane(tid >> 6), lane = tid & 63, wr = wid >> 2, wc = wid & 3, fr = lane & 15, fq = lane >> 4;
    const int KB = FP8 ? g.K : g.K * 2, nt = KB / (BK * 2);
    unsigned voffA[2], voffB[2];
#pragma unroll
    for (int i = 0; i < 2; ++i) { int R, C; stage_rc(tid * 16 + i * 8192, R, C); const int Rb = Epi::PERM ? ((R & ~31) + perm32(R & 31)) : R;
        voffA[i] = (unsigned)(R * KB + C * 2); voffB[i] = (unsigned)(Rb * KB + C * 2); }
    const size_t kstep = (size_t)(BK * 2);
    const size_t hstep = (size_t)HALF * KB;
    const size_t tstep = 2 * hstep;
    const unsigned ldsw = (unsigned)wid * 1024u;
    const int aoff = lds_byte(wr * 64 + fr, fq * 8), boff = lds_byte(wc * 32 + fr, fq * 8);
#define PG8_SA(b, h) (((b) * 2 + (h)) * HTB)
#define PG8_SB(b, h) ((4 + (b) * 2 + (h)) * HTB)
#define PG8_STAGE(bufoff, gbase, voff) do { _Pragma("unroll") for (int _i = 0; _i < 2; ++_i) \
        __builtin_amdgcn_global_load_lds((const unsigned*)((const char*)(gbase) + (voff)[_i]), (PG8_LAS unsigned*)(lds + (bufoff) + ldsw + _i * 8192), 16, 0, 0); } while (0)
#define PG8_LDA(dst, b, h) do { _Pragma("unroll") for (int m = 0; m < 4; ++m) _Pragma("unroll") for (int k = 0; k < 2; ++k) dst[m][k] = *(const PG8_LAS bf16x8*)(lds + PG8_SA(b, h) + aoff + m * 2048 + k * 1024); } while (0)
#define PG8_LDB(dst, b, h) do { _Pragma("unroll") for (int n = 0; n < 2; ++n) _Pragma("unroll") for (int k = 0; k < 2; ++k) dst[n][k] = *(const PG8_LAS bf16x8*)(lds + PG8_SB(b, h) + boff + n * 2048 + k * 1024); } while (0)
#define PG8_CAT(x) __builtin_shufflevector(__builtin_bit_cast(i32x4, (x)[0]), __builtin_bit_cast(i32x4, (x)[1]), 0, 1, 2, 3, 4, 5, 6, 7)
#define PG8_MMA(ai, bj, At, Bt) do { __builtin_amdgcn_s_setprio(1); _Pragma("unroll") for (int m = 0; m < 4; ++m) _Pragma("unroll") for (int n = 0; n < 2; ++n) { \
        if constexpr (FP8) { const i32x8 b8_ = PG8_CAT(Bt[n]), a8_ = PG8_CAT(At[m]); asm volatile("v_mfma_f32_16x16x128_f8f6f4 %0, %1, %2, %0" : "+v"(acc[ai][bj][m][n]) : "v"(b8_), "v"(a8_)); }   \
        else { _Pragma("unroll") for (int k = 0; k < 2; ++k) acc[ai][bj][m][n] = __builtin_amdgcn_mfma_f32_16x16x32_bf16(Bt[n][k], At[m][k], acc[ai][bj][m][n], 0, 0, 0); } } __builtin_amdgcn_s_setprio(0); } while (0)
#define PG8_WAIT_V(n) asm volatile("s_waitcnt vmcnt(" #n ")" ::: "memory")
#define PG8_WAIT_L(n) asm volatile("s_waitcnt lgkmcnt(" #n ")" ::: "memory")
#define PG8_BAR __builtin_amdgcn_s_barrier()
#define PG8_SCHED __builtin_amdgcn_sched_barrier(0)
    Unit cur, nxt; int ui = 0;
    if (!S.next(0, cur)) return;
    f32x4 acc[2][2][4][2];
#pragma unroll
    for (int a = 0; a < 2; ++a)
#pragma unroll
        for (int b = 0; b < 2; ++b)
#pragma unroll
            for (int m = 0; m < 4; ++m)
#pragma unroll
                for (int n = 0; n < 2; ++n) acc[a][b][m][n] = (f32x4){0.f, 0.f, 0.f, 0.f};
    bf16x8 At[4][2], B0[2][2], B1[2][2];
    const char* cA = (const char*)g.A + (size_t)cur.pm * tstep; const char* cB = (const char*)g.Bt + (size_t)cur.pn * tstep;
    S.a_ready(cur);
    if constexpr (SP2) {
        PG8_STAGE(PG8_SB(0, 0), cB, voffB); PG8_STAGE(PG8_SB(0, 1), cB + hstep, voffB); PG8_STAGE(PG8_SA(0, 0), cA, voffA); PG8_STAGE(PG8_SA(0, 1), cA + hstep, voffA);
        if (wr == 1) PG8_BAR;
        PG8_WAIT_V(2); PG8_BAR;
        PG8_STAGE(PG8_SB(1, 0), cB + kstep, voffB); PG8_STAGE(PG8_SA(1, 0), cA + kstep, voffA); PG8_STAGE(PG8_SB(1, 1), cB + hstep + kstep, voffB);
        PG8_WAIT_V(6); PG8_BAR;
    } else {
        PG8_STAGE(PG8_SB(0, 0), cB, voffB); PG8_STAGE(PG8_SA(0, 0), cA, voffA); PG8_STAGE(PG8_SB(0, 1), cB + hstep, voffB); PG8_STAGE(PG8_SA(0, 1), cA + hstep, voffA);
        if (wr == 1) PG8_BAR;
        PG8_WAIT_V(4); PG8_BAR;
        PG8_STAGE(PG8_SB(1, 0), cB + kstep, voffB); PG8_STAGE(PG8_SA(1, 0), cA + kstep, voffA); PG8_STAGE(PG8_SB(1, 1), cB + hstep + kstep, voffB);
        PG8_WAIT_V(6); PG8_BAR;
    }
    for (;;) {
        const bool has_next = S.next(ui + 1, nxt);
        const char* nA = has_next ? (const char*)g.A + (size_t)nxt.pm * tstep : cA; const char* nB = has_next ? (const char*)g.Bt + (size_t)nxt.pn * tstep : cB;
        for (int t = 0; t < nt; t += 2) {
            if constexpr (Epi::MIDT > 0) { if (t == Epi::MIDT) {
                if constexpr (FP8) { asm volatile("s_nop 15\n\ts_nop 15" ::: "memory");
#pragma unroll
                    for (int a = 0; a < 2; ++a)
#pragma unroll
                        for (int b = 0; b < 2; ++b)
#pragma unroll
                            for (int m = 0; m < 4; ++m)
#pragma unroll
                                for (int n = 0; n < 2; ++n) asm volatile("" : "+v"(acc[a][b][m][n])); }
                E.mid(acc, cur, wr, fr); } }
            const bool last = (t == nt - 2);
            const char* a1 = cA + (size_t)(t + 1) * kstep;
            const char* a2 = last ? nA : cA + (size_t)(t + 2) * kstep; const char* b2 = last ? nB : cB + (size_t)(t + 2) * kstep;
            const char* a3 = a2 + kstep; const char* b3 = b2 + kstep;
            if (last && has_next) S.a_ready(nxt);
            if constexpr (SP2) {
            PG8_LDB(B0, 0, 0); PG8_LDB(B1, 0, 1); PG8_SCHED; PG8_LDA(At, 0, 0); PG8_STAGE(PG8_SA(1, 1), a1 + hstep, voffA);
            PG8_WAIT_V(8); PG8_WAIT_L(0); PG8_BAR; PG8_MMA(0, 0, At, B0); PG8_MMA(0, 1, At, B1); PG8_BAR; PG8_SCHED;
            PG8_LDA(At, 0, 1); PG8_STAGE(PG8_SB(0, 0), b2, voffB); PG8_STAGE(PG8_SB(0, 1), b2 + hstep, voffB); PG8_STAGE(PG8_SA(0, 0), a2, voffA);
            PG8_WAIT_V(8); PG8_WAIT_L(0); PG8_BAR; PG8_MMA(1, 0, At, B0); PG8_MMA(1, 1, At, B1); PG8_BAR; PG8_SCHED;
            PG8_LDB(B0, 1, 0); PG8_LDB(B1, 1, 1); PG8_SCHED; PG8_LDA(At, 1, 0); PG8_STAGE(PG8_SA(0, 1), a2 + hstep, voffA);
            PG8_WAIT_V(8); PG8_WAIT_L(0); PG8_BAR; PG8_MMA(0, 0, At, B0); PG8_MMA(0, 1, At, B1); PG8_BAR; PG8_SCHED;
            PG8_LDA(At, 1, 1); PG8_STAGE(PG8_SB(1, 0), b3, voffB); PG8_STAGE(PG8_SB(1, 1), b3 + hstep, voffB); PG8_STAGE(PG8_SA(1, 0), a3, voffA);
            PG8_WAIT_V(8); PG8_WAIT_L(0); PG8_BAR; PG8_MMA(1, 0, At, B0); PG8_MMA(1, 1, At, B1); PG8_BAR; PG8_SCHED;
            } else {
            PG8_LDB(B0, 0, 0); PG8_SCHED; PG8_LDA(At, 0, 0); PG8_STAGE(PG8_SA(1, 1), a1 + hstep, voffA);
            PG8_WAIT_L(8); PG8_BAR; PG8_WAIT_L(0); PG8_MMA(0, 0, At, B0); PG8_BAR; PG8_SCHED;
            PG8_LDB(B1, 0, 1); PG8_STAGE(PG8_SB(0, 0), b2, voffB);
            PG8_BAR; PG8_WAIT_L(0); PG8_MMA(0, 1, At, B1); PG8_BAR;
            PG8_LDA(At, 0, 1); PG8_STAGE(PG8_SA(0, 0), a2, voffA);
            PG8_BAR; PG8_WAIT_L(0); PG8_MMA(1, 0, At, B0); PG8_BAR; PG8_SCHED;
            PG8_STAGE(PG8_SB(0, 1), b2 + hstep, voffB);
            PG8_WAIT_V(6); PG8_BAR; PG8_MMA(1, 1, At, B1); PG8_BAR;
            PG8_LDB(B0, 1, 0); PG8_SCHED; PG8_LDA(At, 1, 0); PG8_STAGE(PG8_SA(0, 1), a2 + hstep, voffA);
            PG8_WAIT_L(8); PG8_BAR; PG8_WAIT_L(0); PG8_MMA(0, 0, At, B0); PG8_BAR; PG8_SCHED;
            PG8_LDB(B1, 1, 1); PG8_STAGE(PG8_SB(1, 0), b3, voffB);
            PG8_BAR; PG8_WAIT_L(0); PG8_MMA(0, 1, At, B1); PG8_BAR;
            PG8_LDA(At, 1, 1); PG8_STAGE(PG8_SA(1, 0), a3, voffA);
            PG8_BAR; PG8_WAIT_L(0); PG8_MMA(1, 0, At, B0); PG8_BAR; PG8_SCHED;
            PG8_STAGE(PG8_SB(1, 1), b3 + hstep, voffB);
            PG8_WAIT_V(6); PG8_BAR; PG8_MMA(1, 1, At, B1); PG8_BAR;
            }
        }
        if constexpr (FP8) {
            asm volatile("s_nop 15\n\ts_nop 15" ::: "memory");
#pragma unroll
            for (int a = 0; a < 2; ++a)
#pragma unroll
                for (int b = 0; b < 2; ++b)
#pragma unroll
                    for (int m = 0; m < 4; ++m)
#pragma unroll
                        for (int n = 0; n < 2; ++n) asm volatile("" : "+v"(acc[a][b][m][n]));
        }
        if constexpr (ALIGN_EPI) { if (wr == 0) PG8_BAR; }
        if constexpr (!Epi::AFTER_DRAIN) { E(acc, cur, wr, wc, fr, fq); S.done(cur); }
        if (!has_next) break;
#pragma unroll
        for (int a = 0; a < 2; ++a)
#pragma unroll
            for (int b = 0; b < 2; ++b)
#pragma unroll
                for (int m = 0; m < 4; ++m)
#pragma unroll
                    for (int n = 0; n < 2; ++n) acc[a][b][m][n] = (f32x4){0.f, 0.f, 0.f, 0.f};
        cur = nxt; cA = nA; cB = nB; ++ui;
        if constexpr (ALIGN_EPI) { if (wr == 1) PG8_BAR; }
    }
    PG8_WAIT_V(0);
    if constexpr (!ALIGN_EPI) { if (wr == 0) PG8_BAR; }
    PG8_BAR;
    if constexpr (Epi::AFTER_DRAIN) { E.fused(acc, cur, wr, wc, fr, fq, lds, wid, lane); S.done(cur); }
#undef PG8_SA
#undef PG8_SB
#undef PG8_STAGE
#undef PG8_LDA
#undef PG8_LDB
#undef PG8_MMA
#undef PG8_CAT
#undef PG8_WAIT_V
#undef PG8_WAIT_L
#undef PG8_BAR
#undef PG8_SCHED
}
}

#define PG8_SP2 true
#define PG8_ALIGN true
namespace att {
typedef unsigned short bf16;
using bf16x8 = __attribute__((ext_vector_type(8))) short;
using s16x4  = __attribute__((ext_vector_type(4))) short;
using f32x16 = __attribute__((ext_vector_type(16))) float;
using u32x4  = __attribute__((ext_vector_type(4))) unsigned;
#define ATT_LAS __attribute__((address_space(3)))
typedef ATT_LAS char* lptr;
constexpr int   D = 128, NW = 8, QBLK = 32, KVBLK = 64;
constexpr float SCALE = 0.088388347648318440f;
constexpr float THR = 8.f;
constexpr int SHM_V = KVBLK * D * 2, SHM_K = KVBLK * D * 2, SHM_ATTN = 2 * SHM_V + 2 * SHM_K + NW * 64 * 4;
#define KSWZ(row, colB) ((row) * 256 + ((colB) ^ (((row) & 7) << 4)))
#define SBAR() __builtin_amdgcn_sched_barrier(0)
__device__ __forceinline__ int crow(int r, int hi) { return (r & 3) + 8 * (r >> 2) + 4 * hi; }
__device__ __forceinline__ unsigned cvtpk(float lo, float hi) { unsigned r; asm volatile("v_cvt_pk_bf16_f32 %0, %1, %2" : "=v"(r) : "v"(lo), "v"(hi)); return r; }
__device__ __forceinline__ void partialSM(f32x16& p0, f32x16& p1, float& m_reg, float& mn, float& alpha, const bool dead = false) {
  constexpr float C = SCALE * 1.4426950408889634f;
  float pmax = p0[0];
#pragma unroll
  for (int r = 1; r < 16; ++r) pmax = fmaxf(pmax, p0[r]);
#pragma unroll
  for (int r = 0; r < 16; ++r) pmax = fmaxf(pmax, p1[r]);
  { auto rr = __builtin_amdgcn_permlane32_swap(__float_as_uint(pmax), __float_as_uint(pmax), false, false);
    pmax = fmaxf(__uint_as_float(rr[0]), __uint_as_float(rr[1])); }
  pmax = dead ? -__builtin_inff() : pmax;
  if (__builtin_expect(__all(pmax - m_reg <= THR / SCALE), 1)) { mn = m_reg; alpha = 1.f; }
  else { mn = fmaxf(m_reg, pmax); alpha = __builtin_amdgcn_exp2f((m_reg - mn) * C); m_reg = mn; }
  float mnC = dead ? -__builtin_inff() : -mn * C;
#pragma unroll
  for (int r = 0; r < 16; ++r) p0[r] = fmaf(p0[r], C, mnC);
#pragma unroll
  for (int r = 0; r < 16; ++r) p1[r] = fmaf(p1[r], C, mnC);
#pragma unroll
  for (int r = 0; r < 16; ++r) p0[r] = __builtin_amdgcn_exp2f(p0[r]);
}
__device__ __forceinline__ void finishSM(f32x16& p0, f32x16& p1, float alpha, float& l_reg, bf16x8& pa0, bf16x8& pa1, bf16x8& pa2, bf16x8& pa3) {
#pragma unroll
  for (int r = 0; r < 16; ++r) p1[r] = __builtin_amdgcn_exp2f(p1[r]);
  float ps = 0;
#pragma unroll
  for (int r = 0; r < 16; ++r) ps += p0[r];
#pragma unroll
  for (int r = 0; r < 16; ++r) ps += p1[r];
  { auto rr = __builtin_amdgcn_permlane32_swap(__float_as_uint(ps), __float_as_uint(ps), false, false);
    ps = __uint_as_float(rr[0]) + __uint_as_float(rr[1]); }
  l_reg = l_reg * alpha + ps;
#define PK4(P, BASE, OUT) do { unsigned a0 = cvtpk(P[BASE + 0], P[BASE + 1]), a1 = cvtpk(P[BASE + 2], P[BASE + 3]);   \
    unsigned b0 = cvtpk(P[BASE + 4], P[BASE + 5]), b1 = cvtpk(P[BASE + 6], P[BASE + 7]);                              \
    auto r0 = __builtin_amdgcn_permlane32_swap(a0, b0, false, false); auto r1 = __builtin_amdgcn_permlane32_swap(a1, b1, false, false); \
    u32x4 w = {r0[0], r1[0], r0[1], r1[1]}; OUT = *reinterpret_cast<bf16x8*>(&w); } while (0)
  PK4(p0, 0, pa0); PK4(p0, 8, pa1); PK4(p1, 0, pa2); PK4(p1, 8, pa3);
#undef PK4
}
__device__ __forceinline__ void qkt(f32x16& p0, f32x16& p1, lptr Ks, const bf16x8* qr, int r32, int hi) {
  p0 = f32x16{}; p1 = f32x16{};
#pragma unroll
  for (int d0 = 0; d0 < 8; ++d0) { int cb = (d0 * 16 + hi * 8) * 2;
    bf16x8 b0 = *reinterpret_cast<const ATT_LAS bf16x8*>(Ks + KSWZ(r32, cb));
    bf16x8 b1 = *reinterpret_cast<const ATT_LAS bf16x8*>(Ks + KSWZ(32 + r32, cb));
    p0 = __builtin_amdgcn_mfma_f32_32x32x16_bf16(b0, qr[d0], p0, 0, 0, 0);
    p1 = __builtin_amdgcn_mfma_f32_32x32x16_bf16(b1, qr[d0], p1, 0, 0, 0); }
}
__device__ __forceinline__ int v_st(int k, int c) { const int kk = (k & ~0xC) | ((k & 4) << 1) | ((k & 8) >> 1); return ((kk >> 3) * 4 + (c >> 5)) * 512 + ((kk & 7) * 32 + (c & 31)) * 2; }
__device__ __forceinline__ int v_rd_base(int lane) { return ((lane & 3) << 3) | (((lane >> 2) & 3) << 6) | (((lane >> 4) & 1) << 5) | (((lane >> 5) & 1) << 8); }
constexpr int v_rd_off(int d0, int ks, int half) { return d0 * 512 + ks * 4096 + half * 2048; }
template <int OFF> __device__ __forceinline__ s16x4 tr_read(int vb) {
  s16x4 r; asm volatile("ds_read_b64_tr_b16 %0, %1 offset:%2" : "=&v"(r) : "v"(vb), "i"(OFF) : "memory"); return r;
}
template <int D0> __device__ __forceinline__ void pv_one(f32x16& od, int vb, bf16x8 pa0, bf16x8 pa1, bf16x8 pa2, bf16x8 pa3) {
  const s16x4 l0 = tr_read<v_rd_off(D0, 0, 0)>(vb), h0 = tr_read<v_rd_off(D0, 0, 1)>(vb), l1 = tr_read<v_rd_off(D0, 1, 0)>(vb), h1 = tr_read<v_rd_off(D0, 1, 1)>(vb);
  const s16x4 l2 = tr_read<v_rd_off(D0, 2, 0)>(vb), h2 = tr_read<v_rd_off(D0, 2, 1)>(vb), l3 = tr_read<v_rd_off(D0, 3, 0)>(vb), h3 = tr_read<v_rd_off(D0, 3, 1)>(vb);
  asm volatile("s_waitcnt lgkmcnt(0)" ::: "memory"); SBAR();
#define PK(L, H) (bf16x8){L[0], L[1], L[2], L[3], H[0], H[1], H[2], H[3]}
  od = __builtin_amdgcn_mfma_f32_32x32x16_bf16(pa0, PK(l0, h0), od, 0, 0, 0);
  od = __builtin_amdgcn_mfma_f32_32x32x16_bf16(pa1, PK(l1, h1), od, 0, 0, 0);
  od = __builtin_amdgcn_mfma_f32_32x32x16_bf16(pa2, PK(l2, h2), od, 0, 0, 0);
  od = __builtin_amdgcn_mfma_f32_32x32x16_bf16(pa3, PK(l3, h3), od, 0, 0, 0);
#undef PK
}
__device__ __forceinline__ void pv_d0(f32x16* o, int vb, bf16x8 pa0, bf16x8 pa1, bf16x8 pa2, bf16x8 pa3) {
  pv_one<0>(o[0], vb, pa0, pa1, pa2, pa3); pv_one<1>(o[1], vb, pa0, pa1, pa2, pa3); pv_one<2>(o[2], vb, pa0, pa1, pa2, pa3); pv_one<3>(o[3], vb, pa0, pa1, pa2, pa3);
}
__device__ __forceinline__ bool moba_mask(f32x16& p0, f32x16& p1, int tile, int qb, unsigned sel, int qi, int w0, int hi) {
  const float NINF = -__builtin_inff();
  const int jb = tile >> 2;
  if (jb < qb) return ((sel >> jb) & 1u) == 0u;
  {
    const int k0 = (tile & 3) * 64;
    if (k0 + 63 > w0) {
      int lim = qi - k0 - 4 * hi; asm volatile("" : "+v"(lim));
#pragma unroll
      for (int r = 0; r < 16; ++r) { const int kc = (r & 3) + 8 * (r >> 2); p0[r] = (kc <= lim) ? p0[r] : NINF; p1[r] = (kc + 32 <= lim) ? p1[r] : NINF; }
    }
  }
  return false;
}

template <bool MOBA, int LDQ, int LDK, int LDO, int SDEPTH, typename TO, int OSC>
__device__ __forceinline__ void attn_body(const bf16* __restrict__ Qb, const bf16* __restrict__ Kh, const bf16* __restrict__ Vh, TO* __restrict__ Ob, int seq, lptr lds,
                                          int qb, const float* __restrict__ kms, int kms_stride, unsigned long long* __restrict__ ssq, const int wave_sgpr) {
  int tid_ = (int)__builtin_amdgcn_mbcnt_hi(~0u, __builtin_amdgcn_mbcnt_lo(~0u, 0u)) + 64 * wave_sgpr; asm volatile("" : "+v"(tid_));
  const int tid = tid_, wid = tid >> 6, lane = tid & 63, r32 = lane & 31, hi = lane >> 5;
  lptr V_lds = lds; lptr K_lds = lds + 2 * SHM_V;
  ATT_LAS float* ws = (ATT_LAS float*)(lds + 2 * SHM_V + 2 * SHM_K) + wid * 64; ATT_LAS float* li_l = ws; ATT_LAS float* al_l = ws + 32;
  float m_reg = -1e30f, l_reg = 0; f32x16 o[4] = {}; bf16x8 qr[8];
  unsigned qoff = (unsigned)((wid * QBLK + r32) * LDQ + hi * 8); asm volatile("" : "+v"(qoff));
  const bf16* Qw = Qb + qoff;
#pragma unroll
  for (int d0 = 0; d0 < 8; ++d0) qr[d0] = *reinterpret_cast<const bf16x8*>(Qw + d0 * 16);
  const int sr = tid >> 4, sc = (tid & 15) * 8, vst0 = v_st(sr, sc), vst1 = v_st(32 + sr, sc);
  const int vb0 = (int)(uintptr_t)V_lds + v_rd_base(lane);
  struct { bf16x8 vs0, vs1, ks0, ks1; } sr_[SDEPTH];
  const unsigned so0 = (unsigned)(sr * LDK + sc), so1 = (unsigned)((32 + sr) * LDK + sc);
#define SLOAD(i, k0) do { const bf16* Vt_ = Vh + (long)(k0) * LDK; const bf16* Kt_ = Kh + (long)(k0) * LDK; \
    sr_[i].vs0 = *reinterpret_cast<const bf16x8*>(Vt_ + so0); sr_[i].vs1 = *reinterpret_cast<const bf16x8*>(Vt_ + so1); \
    sr_[i].ks0 = *reinterpret_cast<const bf16x8*>(Kt_ + so0); sr_[i].ks1 = *reinterpret_cast<const bf16x8*>(Kt_ + so1); } while (0)
#define SWRITE(b, i) do { *(ATT_LAS bf16x8*)(V_lds + (b) * SHM_V + vst0) = sr_[i].vs0;          \
    *(ATT_LAS bf16x8*)(V_lds + (b) * SHM_V + vst1) = sr_[i].vs1; int kc = sc * 2;               \
    *(ATT_LAS bf16x8*)(K_lds + (b) * SHM_K + KSWZ(sr, kc)) = sr_[i].ks0;                       \
    *(ATT_LAS bf16x8*)(K_lds + (b) * SHM_K + KSWZ(32 + sr, kc)) = sr_[i].ks1; } while (0)
#define SWAIT() do { if constexpr (SDEPTH == 2) asm volatile("s_waitcnt vmcnt(4)" ::: "memory"); else asm volatile("s_waitcnt vmcnt(0)" ::: "memory"); } while (0)
#define RESC(a) do { if (__any((a) < 1.f)) { if (hi == 0) al_l[r32] = (a); asm volatile("s_waitcnt lgkmcnt(0)" ::: "memory"); \
    _Pragma("unroll") for (int d = 0; d < 4; ++d) _Pragma("unroll") for (int r = 0; r < 16; ++r) o[d][r] *= al_l[crow(r, hi)]; } } while (0)
  f32x16 pA0, pA1, pB0, pB1; float mnA, mnB, alA, alB; bf16x8 pa0, pa1, pa2, pa3; const int NT = seq / KVBLK;
  constexpr int SE = 0, SO = SDEPTH - 1;
  unsigned sel = 0u; const int qi = wid * QBLK + r32, w0 = wid * QBLK;
  SLOAD(SE, 0);
  if constexpr (MOBA) {
    { const int j = sr & 15; const float* src = kms + (size_t)j * kms_stride + sc; const float4 x0 = *reinterpret_cast<const float4*>(src), x1 = *reinterpret_cast<const float4*>(src + 4);
      const float xv[8] = {x0.x, x0.y, x0.z, x0.w, x1.x, x1.y, x1.z, x1.w}; unsigned w[4];
#pragma unroll
      for (int e = 0; e < 4; ++e) { const unsigned h2 = cvtpk(xv[2 * e], xv[2 * e + 1]); const float f0 = __uint_as_float(h2 << 16), f1 = __uint_as_float(h2 & 0xffff0000u);
        const unsigned l2 = cvtpk(xv[2 * e] - f0, xv[2 * e + 1] - f1); w[e] = (sr < 16) ? h2 : l2; }
      u32x4 wv = {w[0], w[1], w[2], w[3]}; *(ATT_LAS u32x4*)(K_lds + KSWZ(sr, sc * 2)) = wv; }
    __syncthreads();
    f32x16 g = f32x16{};
#pragma unroll
    for (int d0 = 0; d0 < 8; ++d0) { const int cb = (d0 * 16 + hi * 8) * 2; const bf16x8 b0 = *reinterpret_cast<const ATT_LAS bf16x8*>(K_lds + KSWZ(r32, cb));
      g = __builtin_amdgcn_mfma_f32_32x32x16_bf16(b0, qr[d0], g, 0, 0, 0); }
    float G[16];
#pragma unroll
    for (int r = 0; r < 8; ++r) { const float own = g[r] + g[r + 8]; const float oth = __shfl_xor(own, 32); const int lb = (r & 3) + 8 * (r >> 2);
      G[lb] = hi ? oth : own; G[lb + 4] = hi ? own : oth; }
    const float NINF = -__builtin_inff();
#pragma unroll
    for (int j = 0; j < 16; ++j) G[j] = (j < qb) ? G[j] : NINF;
#pragma unroll
    for (int it = 0; it < 3; ++it) { float mx = NINF; int mi = -1;
#pragma unroll
      for (int j = 0; j < 16; ++j) { const bool gt = G[j] > mx; mx = gt ? G[j] : mx; mi = gt ? j : mi; }
      if (mi >= 0) sel |= 1u << mi;
#pragma unroll
      for (int j = 0; j < 16; ++j) G[j] = (j == mi) ? NINF : G[j]; }
    __syncthreads();
  }
  asm volatile("s_waitcnt vmcnt(0)" ::: "memory"); SWRITE(0, SE); __syncthreads();
  qkt(pA0, pA1, K_lds, qr, r32, hi);
  { bool dead = false; if constexpr (MOBA) dead = moba_mask(pA0, pA1, 0, qb, sel, qi, w0, hi);
    partialSM(pA0, pA1, m_reg, mnA, alA, dead); }
  SLOAD(SO, KVBLK); if constexpr (SDEPTH == 2) { if (2 < NT) SLOAD(SE, 2 * KVBLK); }
  SWAIT(); SWRITE(1, SO); __syncthreads();
  for (int j = 1; j + 1 < NT; j += 2) {
    SBAR(); qkt(pB0, pB1, K_lds + SHM_K, qr, r32, hi);
    finishSM(pA0, pA1, alA, l_reg, pa0, pa1, pa2, pa3); SBAR();
    SLOAD(SO, (j + SDEPTH) * KVBLK); SBAR();
    pv_d0(o, vb0, pa0, pa1, pa2, pa3);
    { bool dead = false; if constexpr (MOBA) dead = moba_mask(pB0, pB1, j, qb, sel, qi, w0, hi);
      partialSM(pB0, pB1, m_reg, mnB, alB, dead); }
    __syncthreads(); SWAIT(); SWRITE(0, SE);
    RESC(alB); __syncthreads();
    SBAR(); qkt(pA0, pA1, K_lds, qr, r32, hi);
    finishSM(pB0, pB1, alB, l_reg, pa0, pa1, pa2, pa3); SBAR();
    if (SDEPTH == 1 || j + 3 < NT) SLOAD(SE, (j + 1 + SDEPTH) * KVBLK); SBAR();
    pv_d0(o, vb0 + SHM_V, pa0, pa1, pa2, pa3);
    { bool dead = false; if constexpr (MOBA) dead = moba_mask(pA0, pA1, j + 1, qb, sel, qi, w0, hi);
      partialSM(pA0, pA1, m_reg, mnA, alA, dead); }
    __syncthreads(); SWAIT(); SWRITE(1, SO);
    RESC(alA); __syncthreads();
  }
  SBAR(); qkt(pB0, pB1, K_lds + SHM_K, qr, r32, hi);
  finishSM(pA0, pA1, alA, l_reg, pa0, pa1, pa2, pa3); SBAR();
  pv_d0(o, vb0, pa0, pa1, pa2, pa3);
  { bool dead = false; if constexpr (MOBA) dead = moba_mask(pB0, pB1, NT - 1, qb, sel, qi, w0, hi);
    partialSM(pB0, pB1, m_reg, mnB, alB, dead); }
  __syncthreads(); RESC(alB);
  finishSM(pB0, pB1, alB, l_reg, pa0, pa1, pa2, pa3); SBAR();
  pv_d0(o, vb0 + SHM_V, pa0, pa1, pa2, pa3);
  if (hi == 0) li_l[r32] = l_reg; asm volatile("s_waitcnt lgkmcnt(0)" ::: "memory");
  float rli[16];
#pragma unroll
  for (int r = 0; r < 16; ++r) rli[r] = __builtin_amdgcn_rcpf(li_l[crow(r, hi)]);
  int ohi = hi * 4, ocol = r32; asm volatile("" : "+v"(ohi), "+v"(ocol));
  TO* Ow = Ob + (long)(wid * QBLK) * LDO;
#pragma unroll
  for (int r = 0; r < 16; ++r) { const int orow = (r & 3) + 8 * (r >> 2) + ohi; float sq = 0.f;
#pragma unroll
    for (int d0 = 0; d0 < 4; ++d0) { const float v = o[d0][r] * rli[r]; sq += v * v; if constexpr (sizeof(TO) == 2) Ow[(unsigned)(orow * LDO + d0 * 32 + ocol)] = (TO)(cvtpk(v, v) & 0xffffu);
      else Ow[(unsigned)(orow * LDO + d0 * 32 + ocol)] = (TO)(__builtin_amdgcn_cvt_pk_fp8_f32(__builtin_amdgcn_fmed3f(v * (float)OSC, -448.0f, 448.0f), 0.0f, 0, false) & 0xff); }
    if constexpr (MOBA) { sq += __shfl_xor(sq, 1); sq += __shfl_xor(sq, 2); sq += __shfl_xor(sq, 4); sq += __shfl_xor(sq, 8); sq += __shfl_xor(sq, 16);
      if (ocol == 0) pg8::ss_add(ssq, wid * QBLK + orow, sq); } }
  __syncthreads();
#undef SLOAD
#undef SWRITE
#undef SWAIT
#undef RESC
}
#undef KSWZ
#undef SBAR
}

constexpr int NWAVES = 8;
constexpr int BATCH = 4, SEQ = 4096, D = 2048, M = BATCH * SEQ, FF = 5632, AW = 1024, CW = 1024, INW = 6144, MEML = 256, XW = 512, NH = 8, XH = 4, NBLK = 16;
constexpr int NPH = 13;
#ifndef FAST_MASK
#define FAST_MASK 0x1fff
#endif
#ifndef ONE_LAUNCH
#define ONE_LAUNCH 1
#endif
constexpr size_t MiB = 1u << 20, KiB = 1u << 10;
constexpr size_t WS_CTL = 0, CTL_ZERO_BYTES = 1536 * KiB;
constexpr size_t CTL_BAR = 64 * KiB, BAR_STRIDE = 16 * KiB;
constexpr size_t CTL_SS = 320 * KiB;
constexpr size_t CTL_KMS = 1088 * KiB;
constexpr size_t WS_WGU1 = 2 * MiB, WS_WD1 = 46 * MiB, WS_WGU2 = 68 * MiB, WS_WD2 = 112 * MiB, WS_WIN = 134 * MiB, WS_WOUT = 158 * MiB, WS_WQ = 166 * MiB, WS_WKV = 168 * MiB, WS_WO = 172 * MiB;
constexpr size_t WS_MEMN = 174 * MiB, WS_KVX = 178 * MiB, WS_HB = 180 * MiB, WS_MIXED = 244 * MiB, WS_ACT = 308 * MiB;
constexpr size_t WS_Q = 308 * MiB, WS_K = 340 * MiB, WS_V = 372 * MiB, WS_CU = 404 * MiB, WS_BG = 436 * MiB;
constexpr size_t WS_QX = 308 * MiB, WS_OX = 324 * MiB;
constexpr size_t WS_HB8 = 340 * MiB, WS_ACT8 = 396 * MiB, WS_OX8 = 324 * MiB;
constexpr size_t WS_H1F8 = WS_MIXED + 32 * MiB, WS_WIN8 = WS_WIN + 8 * MiB;
constexpr size_t WS_DUMMY = 484 * MiB;
constexpr size_t WS_END = 486 * MiB;
static_assert(WS_ACT + (size_t)M * FF * 2 <= WS_END && WS_BG + (size_t)M * 1024 * 2 <= WS_END && CTL_KMS + BATCH * 16 * 8 * 128 * 4 <= CTL_ZERO_BYTES && CTL_SS + 6 * M * 8 <= CTL_KMS && CTL_ZERO_BYTES <= WS_WGU1, "d_ws map");
constexpr int RING_OFF = 0, RING_BYTES = 131072;
constexpr int LDSCTL_OFF = RING_BYTES, MISC_OFF = LDSCTL_OFF + 320;
constexpr int LDS_BYTES = 147456;
static_assert(MISC_OFF + 128 <= LDS_BYTES && att::SHM_ATTN <= RING_BYTES, "LDS map");

#define GAS __attribute__((address_space(1)))
#define LAS __attribute__((address_space(3)))
typedef unsigned short bf16;
typedef unsigned v4u __attribute__((ext_vector_type(4)));
typedef unsigned v2u __attribute__((ext_vector_type(2)));
typedef float f32x4 __attribute__((ext_vector_type(4)));
typedef short bf16x8 __attribute__((ext_vector_type(8)));
typedef GAS unsigned gu32;
#define RLX_AGENT __ATOMIC_RELAXED, __HIP_MEMORY_SCOPE_AGENT
#define LDS_WAIT() asm volatile("s_waitcnt lgkmcnt(0)" ::: "memory")
#define VM_WAIT() asm volatile("s_waitcnt vmcnt(0)" ::: "memory")
__device__ __forceinline__ unsigned pk2(float lo, float hi) { return pg8::cvt_pk_bf16(lo, hi); }
__device__ __forceinline__ float bflo(unsigned w) { return __uint_as_float(w << 16); }
__device__ __forceinline__ float bfhi(unsigned w) { return __uint_as_float(w & 0xffff0000u); }
__device__ __forceinline__ float wave_sum(float v) {
#pragma unroll
    for (int o = 1; o < 64; o <<= 1) v += __shfl_xor(v, o);
    return v;
}
#define XB_TMO      128
#define XB_XCNT(j)  (256  + 64 * (j))
#define XB_XSUB(j)  (1280 + 64 * (j))
#define XB_XGEN(j)  (2304 + 64 * (j))
#define XB_TOP      3328
#define XB_TOPGEN   3392
#define XCD_BAR_WORDS 3456
#define XB_SPIN_CAP (1u << 18)

__device__ __forceinline__ unsigned xb_ld(unsigned* p)              { return __hip_atomic_load(p, __ATOMIC_RELAXED, __HIP_MEMORY_SCOPE_AGENT); }
__device__ __forceinline__ unsigned xb_add(unsigned* p, unsigned v) { return __hip_atomic_fetch_add(p, v, __ATOMIC_RELAXED, __HIP_MEMORY_SCOPE_AGENT); }
__device__ __forceinline__ unsigned xb_xcc_id() { return (unsigned)__builtin_amdgcn_s_getreg((3 << 11) | 20) & 0xFu; }
#define XB_SPIN(cond, bar) do { unsigned _sp = 0; while (cond) { __builtin_amdgcn_s_sleep(1); \
    if ((++_sp & 255u) == 0u) { if (xb_ld(&(bar)[XB_TMO])) break; if (_sp > XB_SPIN_CAP) { atomicAdd(&(bar)[XB_TMO], 1u); break; } } } } while (0)

struct XcdBarrier {
    unsigned* bar; unsigned x;
    int wave;
    volatile LAS unsigned* st;
};

__device__ __forceinline__ bool xb_thread0(int wave) { return wave == 0 && __builtin_amdgcn_mbcnt_hi(~0u, __builtin_amdgcn_mbcnt_lo(~0u, 0u)) == 0u; }
__device__ __forceinline__ XcdBarrier xcd_barrier_post(unsigned* bar, volatile LAS unsigned* st, int wave) {
    XcdBarrier b; b.bar = bar; b.x = xb_xcc_id(); b.st = st; b.wave = wave;
    if (xb_thread0(wave)) (void)xb_add(&bar[XB_XCNT(b.x)], 1u);
    return b;
}
__device__ __forceinline__ void xcd_barrier_complete(unsigned* bar, unsigned x, unsigned& nloc, unsigned& nx) {
    const unsigned G = gridDim.x * gridDim.y * gridDim.z;
    unsigned sum, cnt, mine, sp = 0u;
    for (;;) {
        sum = 0u; cnt = 0u; mine = 0u;
#pragma unroll
        for (unsigned j = 0; j < 16; ++j) { const unsigned c = xb_ld(&bar[XB_XCNT(j)]); sum += c; cnt += (c > 0u) ? 1u : 0u; mine = (j == x) ? c : mine; }
        if (sum == G) break;
        __builtin_amdgcn_s_sleep(1);
        if ((++sp & 255u) == 0u) { if (xb_ld(&bar[XB_TMO])) break; if (sp > XB_SPIN_CAP) { atomicAdd(&bar[XB_TMO], 1u); break; } }
    }
    nloc = mine > 0u ? mine : 1u; nx = cnt > 0u ? cnt : 1u;
}

__device__ __forceinline__ void xcd_barrier(const XcdBarrier& b) {
    asm volatile("s_waitcnt vmcnt(0)" ::: "memory");
    __syncthreads();
    if (xb_thread0(b.wave)) {
        unsigned* bar = b.bar;
        __builtin_amdgcn_s_waitcnt(0);
        unsigned nloc = b.st[0], nx = b.st[1];
        if (nloc == 0u) { xcd_barrier_complete(bar, b.x, nloc, nx); b.st[0] = nloc; b.st[1] = nx; }
        const unsigned old = xb_add(&bar[XB_XSUB(b.x)], 1u);
        const unsigned gen = old / nloc;
        if (old + 1u == (gen + 1u) * nloc) {
            __builtin_amdgcn_fence(__ATOMIC_RELEASE, "agent");
            asm volatile("s_waitcnt vmcnt(0)" ::: "memory");
            const unsigned og = xb_add(&bar[XB_TOP], 1u);
            const unsigned tg = og / nx;
            if (og + 1u == (tg + 1u) * nx) xb_add(&bar[XB_TOPGEN], 1u);
            else XB_SPIN(xb_ld(&bar[XB_TOPGEN]) == tg, bar);
            __builtin_amdgcn_fence(__ATOMIC_ACQUIRE, "agent");
            xb_add(&bar[XB_XGEN(b.x)], 1u);
            asm volatile("s_waitcnt vmcnt(0)" ::: "memory");
        } else {
            XB_SPIN(xb_ld(&bar[XB_XGEN(b.x)]) == gen, bar);
            __builtin_amdgcn_fence(__ATOMIC_ACQUIRE, "agent");
            asm volatile("s_waitcnt vmcnt(0)" ::: "memory");
        }
    }
    __syncthreads();
}

namespace nv {
typedef float f32x4 __attribute__((ext_vector_type(4)));
typedef short bf16x8 __attribute__((ext_vector_type(8)));
constexpr float EPS = 1e-6f;
template <class F> __global__ __launch_bounds__(256) void gemm(const bf16* __restrict__ A, const bf16* __restrict__ Bt, int K, F f) {
    const int wave = threadIdx.x >> 6, lane = threadIdx.x & 63;
    const int row0 = blockIdx.y * 64 + wave * 16, col0 = blockIdx.x * 64;
    f32x4 acc[4], acc2[4];
#pragma unroll
    for (int c = 0; c < 4; ++c) { acc[c] = (f32x4){0.f, 0.f, 0.f, 0.f}; acc2[c] = (f32x4){0.f, 0.f, 0.f, 0.f}; }
    const bf16* ap = A + (size_t)(row0 + (lane & 15)) * K + 8 * (lane >> 4);
    const bf16* bp[4]; const bf16* bp2[4];
#pragma unroll
    for (int c = 0; c < 4; ++c) { const int col = col0 + 16 * c + (lane & 15); bp[c] = Bt + (size_t)f.brow(col) * K + 8 * (lane >> 4); bp2[c] = Bt + (size_t)f.brow2(col) * K + 8 * (lane >> 4); }
    for (int k0 = 0; k0 < K; k0 += 32) {
        if (F::MIDK > 0 && k0 == F::MIDK) {
#pragma unroll
            for (int j = 0; j < 4; ++j) { const float s = f.midscale(row0 + (lane >> 4) * 4 + j);
#pragma unroll
                for (int c = 0; c < 4; ++c) acc[c][j] *= s; }
        }
        const bf16x8 a = *(const bf16x8*)(ap + k0);
#pragma unroll
        for (int c = 0; c < 4; ++c) { const bf16x8 b = *(const bf16x8*)(bp[c] + k0); acc[c] = __builtin_amdgcn_mfma_f32_16x16x32_bf16(a, b, acc[c], 0, 0, 0);
            if (F::DUAL) { const bf16x8 b2 = *(const bf16x8*)(bp2[c] + k0); acc2[c] = __builtin_amdgcn_mfma_f32_16x16x32_bf16(a, b2, acc2[c], 0, 0, 0); } }
    }
#pragma unroll
    for (int j = 0; j < 4; ++j) { const int row = row0 + (lane >> 4) * 4 + j; float sq = 0.f;
#pragma unroll
        for (int c = 0; c < 4; ++c) { const float h = f.store(row, col0 + 16 * c + (lane & 15), acc[c][j], acc2[c][j]); sq += h * h; }
        if (F::ROWSS) { sq += __shfl_xor(sq, 1); sq += __shfl_xor(sq, 2); sq += __shfl_xor(sq, 4); sq += __shfl_xor(sq, 8); if ((lane & 15) == 0) f.addss(row, sq); } }
}
__device__ __forceinline__ bf16 tobf(float v) { return (bf16)(pg8::cvt_pk_bf16(v, v) & 0xffffu); }
struct FSwiglu { static constexpr bool DUAL = true, ROWSS = false; static constexpr int MIDK = 0; bf16* O; const pg8::u64_t* ss;
    __device__ int brow(int col) const { return (col >> 7) * 256 + (col & 127); } __device__ int brow2(int col) const { return brow(col) + 128; } __device__ float midscale(int) const { return 1.f; } __device__ void addss(int, float) const {}
    __device__ float store(int row, int col, float a, float a2) const { const float rs = rsqrtf(pg8::ss_val(ss, row) * (1.0f / 2048.0f) + EPS), g = a * rs, u = a2 * rs; O[(size_t)row * FF + col] = tobf(g / (1.0f + __expf(-g)) * u); return 0.f; } };
template <int MIDK_, bool RBF, bool OF32> struct FResid { static constexpr bool DUAL = false, ROWSS = true; static constexpr int MIDK = MIDK_; const float* R; const bf16* RB; float* H; bf16* HB; pg8::u64_t* ssn; float alpha; const pg8::u64_t* midss;
    __device__ int brow(int col) const { return col; } __device__ int brow2(int col) const { return col; } __device__ float midscale(int row) const { return rsqrtf(pg8::ss_val(midss, row) * (1.0f / 1024.0f) + EPS); }
    __device__ void addss(int row, float s) const { pg8::ss_add(ssn, row, s); }
    __device__ float store(int row, int col, float a, float) const { const size_t o = (size_t)row * 2048 + col; const float r = RBF ? __uint_as_float((unsigned)RB[o] << 16) : R[o]; const float h = r + alpha * a; if (OF32) H[o] = h; else HB[o] = tobf(h); return h; } };
struct FWin { static constexpr bool DUAL = true, ROWSS = false; static constexpr int MIDK = 0; bf16 *Q, *K, *V, *CU, *BG; const pg8::u64_t* ss;
    __device__ int brow(int col) const { if (col < 3072) return col; if (col < 4096) { const int j = col - 3072; return 3072 + (j >> 7) * 256 + (j & 127); } return 5120 + (col - 4096); }
    __device__ int brow2(int col) const { return (col >= 3072 && col < 4096) ? brow(col) + 128 : brow(col); } __device__ float midscale(int) const { return 1.f; } __device__ void addss(int, float) const {}
    __device__ float store(int row, int col, float a, float a2) const { const float rs = rsqrtf(pg8::ss_val(ss, row) * (1.0f / 2048.0f) + EPS); const size_t o = (size_t)row * 1024 + (col & 1023);
        if (col < 1024) Q[o] = tobf(a * rs); else if (col < 2048) K[o] = tobf(a * rs); else if (col < 3072) V[o] = tobf(a * rs); else if (col < 4096) CU[o] = tobf((a * rs) * (a2 * rs)); else BG[o] = tobf(a * rs); return 0.f; } };
struct FScale { static constexpr bool DUAL = false, ROWSS = false; static constexpr int MIDK = 0; bf16* O; int ldo; const pg8::u64_t* ss;
    __device__ int brow(int col) const { return col; } __device__ int brow2(int col) const { return col; } __device__ float midscale(int) const { return 1.f; } __device__ void addss(int, float) const {}
    __device__ float store(int row, int col, float a, float) const { const float rs = ss ? rsqrtf(pg8::ss_val(ss, row) * (1.0f / 2048.0f) + EPS) : 1.0f; O[(size_t)row * ldo + col] = tobf(a * rs); return 0.f; } };
__global__ __launch_bounds__(256) void kmean(const bf16* __restrict__ K, float* __restrict__ kms) {
    const int i = blockIdx.x * 256 + threadIdx.x; const int d = i & 127, h = (i >> 7) & 7, bb = i >> 10;
    float s = 0.f; for (int r = 0; r < 256; ++r) s += __uint_as_float((unsigned)K[((size_t)bb * 256 + r) * 1024 + h * 128 + d] << 16);
    kms[i] = s;
}
__global__ __launch_bounds__(256) void moba(const bf16* __restrict__ Q, const bf16* __restrict__ K, const bf16* __restrict__ V, const float* __restrict__ kms, bf16* __restrict__ AO, pg8::u64_t* __restrict__ ssA) {
    const int wave = threadIdx.x >> 6, lane = threadIdx.x & 63; const int idx = blockIdx.x * 4 + wave; const int h = idx & 7, row = idx >> 3, b = row >> 12, t = row & 4095, qb = t >> 8;
    const unsigned qw = *(const unsigned*)(Q + (size_t)row * 1024 + h * 128 + 2 * lane); const float q0 = bflo(qw), q1 = bfhi(qw);
    unsigned sel = 0u;
    { float g[16];
#pragma unroll
      for (int j = 0; j < 16; ++j) { const float* km = kms + ((size_t)(b * 16 + j) * 8 + h) * 128 + 2 * lane; const float p = wave_sum(q0 * km[0] + q1 * km[1]); g[j] = (j < qb) ? p : -__builtin_inff(); }
#pragma unroll
      for (int it = 0; it < 3; ++it) { float mx = -__builtin_inff(); int mi = -1;
#pragma unroll
        for (int j = 0; j < 16; ++j) { const bool gt = g[j] > mx; mx = gt ? g[j] : mx; mi = gt ? j : mi; }
        if (mi >= 0) sel |= 1u << mi;
#pragma unroll
        for (int j = 0; j < 16; ++j) g[j] = (j == mi) ? -__builtin_inff() : g[j]; } }
    sel |= 1u << qb;
    float m = -1e30f, l = 0.f, o0 = 0.f, o1 = 0.f;
    for (int jb = 0; jb <= qb; ++jb) { if (!((sel >> jb) & 1u)) continue;
        const int nk = (jb < qb) ? 256 : (t & 255) + 1;
        for (int kk = 0; kk < nk; ++kk) { const size_t ko = ((size_t)b * 4096 + jb * 256 + kk) * 1024 + h * 128 + 2 * lane;
            const unsigned kw = *(const unsigned*)(K + ko), vw = *(const unsigned*)(V + ko);
            const float s = wave_sum(q0 * bflo(kw) + q1 * bfhi(kw)) * 0.088388347648318440f;
            const float mn = fmaxf(m, s), a = __expf(m - mn), p = __expf(s - mn);
            l = l * a + p; o0 = o0 * a + p * bflo(vw); o1 = o1 * a + p * bfhi(vw); m = mn; } }
    const float il = 1.0f / l; o0 *= il; o1 *= il;
    *(unsigned*)(AO + (size_t)row * 2048 + h * 128 + 2 * lane) = pk2(o0, o1);
    const float sq = wave_sum(o0 * o0 + o1 * o1); if (lane == 0) pg8::ss_add(ssA, row, sq);
}
__global__ __launch_bounds__(256) void xattn(const bf16* __restrict__ QX, const bf16* __restrict__ KVX, bf16* __restrict__ OX) {
    const int wave = threadIdx.x >> 6, lane = threadIdx.x & 63; const int idx = blockIdx.x * 4 + wave; const int h = idx & 3, row = idx >> 2, b = row >> 12;
    const unsigned qw = *(const unsigned*)(QX + (size_t)row * 512 + h * 128 + 2 * lane); const float q0 = bflo(qw), q1 = bfhi(qw);
    float m = -1e30f, l = 0.f, o0 = 0.f, o1 = 0.f;
    for (int kk = 0; kk < 256; ++kk) { const size_t ko = ((size_t)b * 256 + kk) * 1024 + h * 128 + 2 * lane;
        const unsigned kw = *(const unsigned*)(KVX + ko), vw = *(const unsigned*)(KVX + ko + 512);
        const float s = wave_sum(q0 * bflo(kw) + q1 * bfhi(kw)) * 0.088388347648318440f;
        const float mn = fmaxf(m, s), a = __expf(m - mn), p = __expf(s - mn);
        l = l * a + p; o0 = o0 * a + p * bflo(vw); o1 = o1 * a + p * bfhi(vw); m = mn; }
    const float il = 1.0f / l;
    *(unsigned*)(OX + (size_t)row * 512 + h * 128 + 2 * lane) = pk2(o0 * il, o1 * il);
}
}


#ifndef USE_FP8
#define USE_FP8 0xE80
#endif
struct Frame {
    LAS unsigned char* lds;
    volatile LAS unsigned* MISC;
    int tid, lane, wave;
    int vcu, G;
};
struct Args { const float* in[22]; float* out; unsigned char* ws; int ph_lo, ph_hi; };
enum { I_X = 0, I_MEM, I_F1N, I_F1G, I_F1U, I_F1D, I_MIXN, I_WIN, I_CONVW, I_AON, I_CON, I_WOUT, I_XN, I_MEMNRM, I_XQ, I_XKV, I_XO, I_F2N, I_F2G, I_F2U, I_F2D, I_FINAL };

struct P0Job { const float* src; const float* gain; bf16* dst; int pitch, dstK, dkoff, drow0, k0, f8; };
__device__ __forceinline__ void p0_load(const P0Job& J, int lane, float (&v)[32]) {
    const float* wp = J.src + (size_t)(J.k0 + (lane >> 5)) * J.pitch + (lane & 31);
#pragma unroll
    for (int i = 0; i < 32; ++i) v[i] = wp[(size_t)(2 * i) * J.pitch];
}
__device__ __forceinline__ void p0_store(const P0Job& J, int lane, const float (&v)[32], LAS float* scr) {
    const int c = lane & 7;
    f32x4 g0 = (f32x4){1.f, 1.f, 1.f, 1.f}, g1 = g0;
    if (J.gain) { g0 = *(const GAS f32x4*)(J.gain + J.k0 + 8 * c); g1 = *(const GAS f32x4*)(J.gain + J.k0 + 8 * c + 4); }
#pragma unroll
    for (int i = 0; i < 32; ++i) scr[(2 * i + (lane >> 5)) * 33 + (lane & 31)] = v[i];
    LDS_WAIT(); asm volatile("" ::: "memory");
#pragma unroll
    for (int j = 0; j < 4; ++j) { const int n = (lane >> 3) + 8 * j; const LAS float* s = scr + (8 * c) * 33 + n;
        const f32x4 x0 = (f32x4){s[0 * 33], s[1 * 33], s[2 * 33], s[3 * 33]} * g0, x1 = (f32x4){s[4 * 33], s[5 * 33], s[6 * 33], s[7 * 33]} * g1;
        if (J.f8) { const pg8::u32x2 o = pg8::pack8_f8(x0 * 64.0f, x1 * 64.0f); *(GAS v2u*)((unsigned char*)J.dst + (size_t)(J.drow0 + n) * J.dstK + J.dkoff + J.k0 + 8 * c) = (v2u){o.x, o.y}; }
        else { v4u o; o.x = pk2(x0[0], x0[1]); o.y = pk2(x0[2], x0[3]); o.z = pk2(x1[0], x1[1]); o.w = pk2(x1[2], x1[3]); *(GAS v4u*)(J.dst + (size_t)(J.drow0 + n) * J.dstK + J.dkoff + J.k0 + 8 * c) = o; } }
    LDS_WAIT(); asm volatile("" ::: "memory");
}
constexpr int P0_I_FF = (D / 64) * (FF / 32), P0_I_FD = (FF / 64) * (D / 32), P0_I_IN = (D / 64) * (1024 / 32), P0_I_OUT = (1024 / 64) * (D / 32), P0_I_XQ = (D / 64) * (XW / 32), P0_I_XKV = (D / 64) * (1024 / 32), P0_I_XO = (XW / 64) * (D / 32);
constexpr int P0_NITEMS = 4 * P0_I_FF + 2 * P0_I_FD + 6 * P0_I_IN + 2 * P0_I_OUT + P0_I_XQ + P0_I_XKV + P0_I_XO;
__device__ __forceinline__ P0Job p0_job(const Args& a, int it) {
    unsigned char* ws = a.ws;
    int r = it; const float* src = nullptr; const float* gain = nullptr; bf16* dst = nullptr; int pitch = 0, ncols = 32, dstK = 0, dkoff = 0, rowoff = 0, mode = 0, f8 = 0; bool hit = false;
    constexpr int F8I = (USE_FP8 >> 3) & 1, F8M = (USE_FP8 >> 6) & 1, F8Q = (USE_FP8 >> 7) & 1, F8O = (USE_FP8 >> 9) & 1, F8G = (USE_FP8 >> 10) & 1, F8D = (USE_FP8 >> 11) & 1;
#define JOB(cnt, SRC, PITCH, NCOLS, GAIN, DST, DSTK, DKOFF, ROWOFF, MODE, F8J) if (!hit) { if (r < (cnt)) { hit = true; f8 = (F8J); src = (SRC); pitch = (PITCH); ncols = (NCOLS); gain = (GAIN); dst = (bf16*)(ws + (DST)); dstK = (DSTK); dkoff = (DKOFF); rowoff = (ROWOFF); mode = (MODE); } else r -= (cnt); }
    JOB(P0_I_FF, a.in[I_F1G], FF, FF, a.in[I_F1N], WS_WGU1, D, 0, 0, 1, 0)
    JOB(P0_I_FF, a.in[I_F1U], FF, FF, a.in[I_F1N], WS_WGU1, D, 0, 0, 2, 0)
    JOB(P0_I_FD, a.in[I_F1D], D, D, nullptr, WS_WD1, FF, 0, 0, 0, 0)
    JOB(P0_I_IN, a.in[I_WIN] + 0, INW, 1024, a.in[I_MIXN], WS_WIN, D, 0, 0, 0, 0)
    JOB(P0_I_IN, a.in[I_WIN] + 1024, INW, 1024, a.in[I_MIXN], WS_WIN, D, 0, 1024, 0, 0)
    JOB(P0_I_IN, a.in[I_WIN] + 2048, INW, 1024, a.in[I_MIXN], F8I ? WS_WIN8 : WS_WIN, D, 0, F8I ? 0 : 2048, 0, F8I)
    JOB(P0_I_IN, a.in[I_WIN] + 3072, INW, 1024, a.in[I_MIXN], F8I ? WS_WIN8 : WS_WIN, D, 0, F8I ? 1024 : 3072, 1, F8I)
    JOB(P0_I_IN, a.in[I_WIN] + 5120, INW, 1024, a.in[I_MIXN], F8I ? WS_WIN8 : WS_WIN, D, 0, F8I ? 1024 : 3072, 2, F8I)
    JOB(P0_I_IN, a.in[I_WIN] + 4096, INW, 1024, a.in[I_MIXN], F8I ? WS_WIN8 : WS_WIN, D, 0, F8I ? 3072 : 5120, 0, F8I)
    JOB(P0_I_OUT, a.in[I_WOUT], D, D, a.in[I_AON], WS_WOUT, D, 0, 0, 0, F8M)
    JOB(P0_I_OUT, a.in[I_WOUT] + (size_t)1024 * D, D, D, a.in[I_CON], WS_WOUT, D, 1024, 0, 0, F8M)
    JOB(P0_I_XQ, a.in[I_XQ], XW, XW, a.in[I_XN], WS_WQ, D, 0, 0, 0, F8Q)
    JOB(P0_I_XKV, a.in[I_XKV], 1024, 1024, nullptr, WS_WKV, D, 0, 0, 0, 0)
    JOB(P0_I_XO, a.in[I_XO], D, D, nullptr, WS_WO, XW, 0, 0, 0, F8O)
    JOB(P0_I_FF, a.in[I_F2G], FF, FF, a.in[I_F2N], WS_WGU2, D, 0, 0, 1, F8G)
    JOB(P0_I_FF, a.in[I_F2U], FF, FF, a.in[I_F2N], WS_WGU2, D, 0, 0, 2, F8G)
    JOB(P0_I_FD, a.in[I_F2D], D, D, nullptr, WS_WD2, FF, 0, 0, 0, F8D)
#undef JOB
    const int nblk = ncols / 32, kb = r / nblk, nb = r % nblk, k0 = 64 * kb, n0 = 32 * nb;
    P0Job J; J.src = src + n0; J.gain = gain; J.dst = dst; J.pitch = pitch; J.dstK = dstK; J.dkoff = dkoff; J.k0 = k0; J.f8 = f8;
    J.drow0 = rowoff + (mode ? (n0 >> 7) * 256 + (n0 & 127) + (mode == 2 ? 128 : 0) : n0);
    return J;
}
__device__ __forceinline__ void p0_prologue(Frame& F_, const Args& a) {
    Frame F = F_; { int t_ = (int)__builtin_amdgcn_mbcnt_hi(~0u, __builtin_amdgcn_mbcnt_lo(~0u, 0u)); asm volatile("" : "+v"(t_)); F.lane = t_; F.tid = t_ + 64 * F.wave; }
    LAS float* scr = (LAS float*)(F.lds + RING_OFF + F.wave * 16384);
    const int gw = F.vcu * NWAVES + F.wave, NGW = F.G * NWAVES;
    unsigned char* ws = a.ws;
    { float va[32], vb[32]; P0Job Ja, Jb; int it = gw;
      if (it < P0_NITEMS) { Ja = p0_job(a, it); p0_load(Ja, F.lane, va); }
      while (it < P0_NITEMS) {
          const int i2 = it + NGW; if (i2 < P0_NITEMS) { Jb = p0_job(a, i2); p0_load(Jb, F.lane, vb); }
          p0_store(Ja, F.lane, va, scr);
          if (i2 >= P0_NITEMS) break;
          const int i3 = i2 + NGW; if (i3 < P0_NITEMS) { Ja = p0_job(a, i3); p0_load(Ja, F.lane, va); }
          p0_store(Jb, F.lane, vb, scr);
          it = i3; } }
    { bf16* HB = (bf16*)(ws + WS_HB); pg8::u64_t* ss0 = (pg8::u64_t*)(ws + WS_CTL + CTL_SS);
      for (int m = gw; m < M; m += NGW) { const GAS f32x4* xr = (const GAS f32x4*)(a.in[I_X] + (size_t)m * D) + F.lane; GAS v2u* o8 = (GAS v2u*)(HB + (size_t)m * D) + F.lane; float s = 0.f;
#pragma unroll
          for (int j = 0; j < 8; ++j) { const f32x4 v = xr[64 * j]; s += (v.x * v.x + v.y * v.y) + (v.z * v.z + v.w * v.w); v2u w; w.x = pk2(v.x, v.y); w.y = pk2(v.z, v.w); o8[64 * j] = w; }
          s = wave_sum(s); if (F.lane == 0) ss0[m] = (pg8::u64_t)(s * 65536.0f + 0.5f); } }
    { bf16* MN = (bf16*)(ws + WS_MEMN); const float* gm = a.in[I_MEMNRM];
      for (int m = gw; m < BATCH * MEML; m += NGW) { const GAS f32x4* xr = (const GAS f32x4*)(a.in[I_MEM] + (size_t)m * D) + F.lane; GAS v2u* o8 = (GAS v2u*)(MN + (size_t)m * D) + F.lane; f32x4 v[8]; float s = 0.f;
#pragma unroll
          for (int j = 0; j < 8; ++j) { v[j] = xr[64 * j]; s += (v[j].x * v[j].x + v[j].y * v[j].y) + (v[j].z * v[j].z + v[j].w * v[j].w); }
          const float rs = rsqrtf(wave_sum(s) * (1.0f / D) + 1e-6f);
#pragma unroll
          for (int j = 0; j < 8; ++j) { const f32x4 g = *((const GAS f32x4*)gm + F.lane + 64 * j); v2u w; w.x = pk2(v[j].x * rs * g.x, v[j].y * rs * g.y); w.y = pk2(v[j].z * rs * g.z, v[j].w * rs * g.w); o8[64 * j] = w; } } }
}
__device__ __forceinline__ void p5_conv(Frame& F_, const Args& a) {
    Frame F = F_; { int t_ = (int)__builtin_amdgcn_mbcnt_hi(~0u, __builtin_amdgcn_mbcnt_lo(~0u, 0u)); asm volatile("" : "+v"(t_)); F.lane = t_; F.tid = t_ + 64 * F.wave; }
    const int gw = F.vcu * NWAVES + F.wave, NGW = F.G * NWAVES; unsigned char* ws = a.ws;
    const bf16* CU = (const bf16*)(ws + WS_CU); const bf16* BG = (const bf16*)(ws + WS_BG); bf16* MX = (bf16*)(ws + WS_MIXED); const float* cw = a.in[I_CONVW];
    for (int m = gw; m < M; m += NGW) { const int t = m & (SEQ - 1); float y[16]; float s = 0.f;
#pragma unroll
        for (int gsel = 0; gsel < 2; ++gsel) { const int ch = gsel * 512 + F.lane * 8;
            const v4u c0 = *(const GAS v4u*)(CU + (size_t)m * 1024 + ch); v4u c1 = (v4u){0u, 0u, 0u, 0u}, c2 = (v4u){0u, 0u, 0u, 0u};
            if (t >= 1) c1 = *(const GAS v4u*)(CU + (size_t)(m - 1) * 1024 + ch);
            if (t >= 2) c2 = *(const GAS v4u*)(CU + (size_t)(m - 2) * 1024 + ch);
            const v4u bg = *(const GAS v4u*)(BG + (size_t)m * 1024 + ch);
            const f32x4 w0a = *(const GAS f32x4*)(cw + ch), w0b = *(const GAS f32x4*)(cw + ch + 4), w1a = *(const GAS f32x4*)(cw + 1024 + ch), w1b = *(const GAS f32x4*)(cw + 1024 + ch + 4), w2a = *(const GAS f32x4*)(cw + 2048 + ch), w2b = *(const GAS f32x4*)(cw + 2048 + ch + 4);
#pragma unroll
            for (int e = 0; e < 4; ++e) { const unsigned x0 = c0[e], x1 = c1[e], x2 = c2[e], bw = bg[e];
                const float wl0 = e < 2 ? w0a[2 * e] : w0b[2 * e - 4], wh0 = e < 2 ? w0a[2 * e + 1] : w0b[2 * e - 3];
                const float wl1 = e < 2 ? w1a[2 * e] : w1b[2 * e - 4], wh1 = e < 2 ? w1a[2 * e + 1] : w1b[2 * e - 3];
                const float wl2 = e < 2 ? w2a[2 * e] : w2b[2 * e - 4], wh2 = e < 2 ? w2a[2 * e + 1] : w2b[2 * e - 3];
                const float lo = bflo(bw) * (wl0 * bflo(x2) + wl1 * bflo(x1) + wl2 * bflo(x0)), hi = bfhi(bw) * (wh0 * bfhi(x2) + wh1 * bfhi(x1) + wh2 * bfhi(x0));
                y[gsel * 8 + 2 * e] = lo; y[gsel * 8 + 2 * e + 1] = hi; s += lo * lo + hi * hi; } }
        const float rs = rsqrtf(wave_sum(s) * (1.0f / 1024.0f) + 1e-6f);
#pragma unroll
        for (int gsel = 0; gsel < 2; ++gsel) {
            if constexpr (((USE_FP8 >> 6) & 1) != 0) { const pg8::u32x2 o = pg8::pack8_f8((f32x4){y[gsel * 8 + 0], y[gsel * 8 + 1], y[gsel * 8 + 2], y[gsel * 8 + 3]} * rs, (f32x4){y[gsel * 8 + 4], y[gsel * 8 + 5], y[gsel * 8 + 6], y[gsel * 8 + 7]} * rs);
                *(GAS v2u*)((unsigned char*)MX + (size_t)m * 2048 + 1024 + gsel * 512 + F.lane * 8) = (v2u){o.x, o.y}; }
            else { v4u o; o.x = pk2(y[gsel * 8 + 0] * rs, y[gsel * 8 + 1] * rs); o.y = pk2(y[gsel * 8 + 2] * rs, y[gsel * 8 + 3] * rs); o.z = pk2(y[gsel * 8 + 4] * rs, y[gsel * 8 + 5] * rs); o.w = pk2(y[gsel * 8 + 6] * rs, y[gsel * 8 + 7] * rs);
                *(GAS v4u*)(MX + (size_t)m * 2048 + 1024 + gsel * 512 + F.lane * 8) = o; } } }
}
__device__ __forceinline__ void p12_final(Frame& F_, const Args& a) {
    Frame F = F_; { int t_ = (int)__builtin_amdgcn_mbcnt_hi(~0u, __builtin_amdgcn_mbcnt_lo(~0u, 0u)); asm volatile("" : "+v"(t_)); F.lane = t_; F.tid = t_ + 64 * F.wave; }
    const int gw = F.vcu * NWAVES + F.wave, NGW = F.G * NWAVES; const pg8::u64_t* ss4 = (const pg8::u64_t*)(a.ws + WS_CTL + CTL_SS) + 5 * M; const float* gf = a.in[I_FINAL]; const bf16* HB = (const bf16*)(a.ws + WS_HB);
    for (int m = gw; m < M; m += NGW) { GAS f32x4* xr = (GAS f32x4*)(a.out + (size_t)m * D); const GAS v4u* hr = (const GAS v4u*)(HB + (size_t)m * D) + F.lane; const float rs = rsqrtf(pg8::ss_val(ss4, m) * (1.0f / D) + 1e-6f);
#pragma unroll
        for (int j = 0; j < 4; ++j) { const v4u w = hr[64 * j]; const int c = (F.lane + 64 * j) * 8; const f32x4 g0 = *(const GAS f32x4*)(gf + c), g1 = *(const GAS f32x4*)(gf + c + 4);
            xr[(c >> 2)] = (f32x4){bflo(w.x), bfhi(w.x), bflo(w.y), bfhi(w.y)} * g0 * rs; xr[(c >> 2) + 1] = (f32x4){bflo(w.z), bfhi(w.z), bflo(w.w), bfhi(w.w)} * g1 * rs; } }
}
#ifndef DUP_MASK
#define DUP_MASK 0
#endif
#ifndef MOBA_SDEPTH
#define MOBA_SDEPTH 1
#endif
__global__ void __launch_bounds__(NWAVES * 64, 2) fwd_kernel(Args args) {
    extern __shared__ __attribute__((aligned(16))) unsigned char lds[];
    Frame F;
    F.lds = (LAS unsigned char*)lds;
    F.MISC = (volatile LAS unsigned*)(F.lds + MISC_OFF);
    F.tid = threadIdx.x; F.lane = F.tid & 63; F.wave = __builtin_amdgcn_readfirstlane(F.tid >> 6);
    F.G = gridDim.x; { const int bx = blockIdx.x; F.vcu = (F.G % 8 == 0) ? (bx % 8) * (F.G / 8) + bx / 8 : bx; }
    unsigned char* ws = args.ws;
    for (int u = F.tid; u < (LDS_BYTES - LDSCTL_OFF) / 4; u += NWAVES * 64) ((LAS unsigned*)(F.lds + LDSCTL_OFF))[u] = 0u;
    __syncthreads();
    const int lo = args.ph_lo, hi = args.ph_hi; const bool multi = (hi - lo) > 1;
    XcdBarrier bar; bar.bar = (unsigned*)(ws + WS_CTL + CTL_BAR + (size_t)lo * BAR_STRIDE); bar.x = 0; bar.st = nullptr; bar.wave = F.wave;
    if (multi) bar = xcd_barrier_post((unsigned*)(ws + WS_CTL + CTL_BAR + (size_t)lo * BAR_STRIDE), F.MISC + 8, F.wave);
#ifndef PH_ENABLE
#define PH_ENABLE 0x1fff
#endif
#define IN(k) ((((PH_ENABLE) >> (k)) & 1) && lo <= (k) && (k) < hi)
#define SEAM(k) do { if (IN(k) && IN((k) + 1)) xcd_barrier(bar); } while (0)
    pg8::u64_t* SS = (pg8::u64_t*)(ws + WS_CTL + CTL_SS);
    float* KMS = (float*)(ws + WS_CTL + CTL_KMS);
    bf16* HB = (bf16*)(ws + WS_HB); bf16* ACT = (bf16*)(ws + WS_ACT); bf16* MIXED = (bf16*)(ws + WS_MIXED);
    bf16* Qb = (bf16*)(ws + WS_Q); bf16* Kb = (bf16*)(ws + WS_K); bf16* Vb = (bf16*)(ws + WS_V); bf16* CUb = (bf16*)(ws + WS_CU); bf16* BGb = (bf16*)(ws + WS_BG);
    bf16* QX = (bf16*)(ws + WS_QX); bf16* OX = (bf16*)(ws + WS_OX); bf16* KVX = (bf16*)(ws + WS_KVX);
    const int bx = (int)blockIdx.x;

#ifndef F8_SP2
#define F8_SP2 PG8_SP2
#endif
#ifndef F8_ALIGN
#define F8_ALIGN PG8_ALIGN
#endif
#define GEMM_RUN(EPI, FP8FLAG, G_, S_, E_) pg8::gemm_phase<EPI, pg8::StaticOrder, (FP8FLAG) ? F8_ALIGN : PG8_ALIGN, (FP8FLAG) ? F8_SP2 : PG8_SP2, FP8FLAG>(F.lds + RING_OFF, G_, S_, E_, F.wave)
#define DUPQ(k) (((DUP_MASK) >> (k)) & 1)
    pg8::u64_t* DUMMY = (pg8::u64_t*)(ws + WS_DUMMY);
    unsigned char* MIXED8 = ws + WS_MIXED; unsigned char* HB8 = ws + WS_HB8; unsigned char* ACT8 = ws + WS_ACT8; unsigned char* OX8 = ws + WS_OX8;
    constexpr bool F3 = ((USE_FP8 >> 3) & 1) != 0, F6 = ((USE_FP8 >> 6) & 1) != 0, F7 = ((USE_FP8 >> 7) & 1) != 0, F9 = ((USE_FP8 >> 9) & 1) != 0, F10 = ((USE_FP8 >> 10) & 1) != 0, F11 = ((USE_FP8 >> 11) & 1) != 0;
    static_assert(!F3 || F6, "the e4m3 copy of h1 lives in the upper half of the mixed buffer: phase 3 on e4m3 needs phase 6 on e4m3");
    constexpr float WSC = 1.0f / 64.0f;
    if (IN(0)) { p0_prologue(F, args); if (DUPQ(0)) p0_prologue(F, args); } SEAM(0);
    if (IN(1)) { pg8::Gemm g{HB, (const bf16*)(ws + WS_WGU1), M, 2 * FF, D}; pg8::StaticOrder S; S.init(M, 2 * FF, F.G, bx);
        typedef pg8::EpiSwiglu<false> EP; EP E{ACT, nullptr, FF, SS, 1.0f, 1.0f}; GEMM_RUN(EP, false, g, S, E); if (DUPQ(1)) GEMM_RUN(EP, false, g, S, E); } SEAM(1);
    if (IN(2)) { pg8::Gemm g{ACT, (const bf16*)(ws + WS_WD1), M, D, FF}; pg8::StaticOrder S; S.init(M, D, F.G, bx);
        typedef pg8::EpiResid<0, false, false> EP; EP E{args.in[I_X], nullptr, nullptr, HB, SS + M, 0.5f, nullptr, F3 ? ws + WS_H1F8 : nullptr, 1.0f}; GEMM_RUN(EP, false, g, S, E);
        if (DUPQ(2)) { EP E2{args.in[I_X], nullptr, nullptr, HB, DUMMY, 0.5f, nullptr, F3 ? ws + WS_H1F8 : nullptr, 1.0f}; GEMM_RUN(EP, false, g, S, E2); } } SEAM(2);
    if (IN(3)) for (int rep = 0; rep < (DUPQ(3) ? 2 : 1); ++rep) {
        float* kms = rep ? (float*)DUMMY : KMS;
        if constexpr (F3) {
            { pg8::Gemm g{HB, (const bf16*)(ws + WS_WIN), M, 2048, D}; pg8::StaticOrder S; S.init(M, 2048, F.G, bx);
              pg8::EpiWin E{Qb, Kb, Vb, CUb, BGb, kms, SS + M, 0, 1.0f}; GEMM_RUN(pg8::EpiWin, false, g, S, E); }
            { pg8::Gemm g{(const bf16*)(ws + WS_H1F8), (const bf16*)(ws + WS_WIN8), M, 4096, D}; pg8::StaticOrder S; S.init(M, 4096, F.G, bx);
              pg8::EpiWin E{Qb, Kb, Vb, CUb, BGb, kms, SS + M, 8, WSC}; GEMM_RUN(pg8::EpiWin, true, g, S, E); }
        } else { pg8::Gemm g{HB, (const bf16*)(ws + WS_WIN), M, INW, D}; pg8::StaticOrder S; S.init(M, INW, F.G, bx);
            pg8::EpiWin E{Qb, Kb, Vb, CUb, BGb, kms, SS + M, 0, 1.0f}; GEMM_RUN(pg8::EpiWin, false, g, S, E); } } SEAM(3);
    if (IN(4)) for (int rep = 0; rep < (DUPQ(4) ? 2 : 1); ++rep) {
        for (int u = F.vcu; u < BATCH * NH * 8; u += F.G) { const int b = u >> 6, h = (u >> 3) & 7, p = u & 7;
#pragma unroll 1
            for (int half = 0; half < 2; ++half) { const int qb = half ? 15 - p : p; const size_t r0 = (size_t)b * SEQ + (size_t)qb * 256;
                if constexpr (F6) att::attn_body<true, 1024, 1024, 2048, MOBA_SDEPTH, unsigned char, 32>(Qb + r0 * 1024 + h * 128, Kb + (size_t)b * SEQ * 1024 + h * 128, Vb + (size_t)b * SEQ * 1024 + h * 128, MIXED8 + r0 * 2048 + h * 128,
                                                       256 * (qb + 1), (att::lptr)(F.lds + RING_OFF), qb, KMS + ((size_t)b * 16 * 8 + h) * 128, 8 * 128, (rep ? DUMMY : SS + 2 * M) + r0, F.wave);
                else att::attn_body<true, 1024, 1024, 2048, MOBA_SDEPTH, bf16, 1>(Qb + r0 * 1024 + h * 128, Kb + (size_t)b * SEQ * 1024 + h * 128, Vb + (size_t)b * SEQ * 1024 + h * 128, MIXED + r0 * 2048 + h * 128,
                                                       256 * (qb + 1), (att::lptr)(F.lds + RING_OFF), qb, KMS + ((size_t)b * 16 * 8 + h) * 128, 8 * 128, (rep ? DUMMY : SS + 2 * M) + r0, F.wave); } } }
    if (IN(5)) { p5_conv(F, args); if (DUPQ(5)) p5_conv(F, args); } SEAM(5);
    if (IN(6)) { pg8::Gemm g{F6 ? (const bf16*)MIXED8 : MIXED, (const bf16*)(ws + WS_WOUT), M, D, D}; pg8::StaticOrder S; S.init(M, D, F.G, bx);
        typedef pg8::EpiResid<F6 ? 8 : 16, true, false> EP; EP E{nullptr, HB, nullptr, HB, SS + 3 * M, F6 ? WSC : 1.0f, SS + 2 * M, F7 ? HB8 : nullptr, F6 ? 1.0f / 32.0f : 1.0f}; GEMM_RUN(EP, F6, g, S, E);
        if (DUPQ(6)) { EP E2{nullptr, HB, nullptr, HB, DUMMY, 0.0f, SS + 2 * M, F7 ? HB8 : nullptr, F6 ? 1.0f / 32.0f : 1.0f}; GEMM_RUN(EP, F6, g, S, E2); } } SEAM(6);
    if (IN(7)) for (int rep = 0; rep < (DUPQ(7) ? 2 : 1); ++rep) {
        { pg8::Gemm g{F7 ? (const bf16*)HB8 : HB, (const bf16*)(ws + WS_WQ), M, XW, D}; pg8::StaticOrder S; S.init(M, XW, F.G, bx);
          pg8::EpiScaleBf16 E{QX, XW, SS + 3 * M, F7 ? WSC : 1.0f}; GEMM_RUN(pg8::EpiScaleBf16, F7, g, S, E); }
        { pg8::Gemm g{(const bf16*)(ws + WS_MEMN), (const bf16*)(ws + WS_WKV), BATCH * MEML, 1024, D}; pg8::StaticOrder S; S.init(BATCH * MEML, 1024, F.G, (bx + F.G - 128) % F.G);
          pg8::EpiScaleBf16 E{KVX, 1024, nullptr, 1.0f}; GEMM_RUN(pg8::EpiScaleBf16, false, g, S, E); } } SEAM(7);
    if (IN(8)) for (int rep = 0; rep < (DUPQ(8) ? 2 : 1); ++rep) {
        for (int u = F.vcu; u < BATCH * XH * 16; u += F.G) { const int b = u >> 6, h = (u >> 4) & 3, qb = u & 15; const size_t r0 = (size_t)b * SEQ + (size_t)qb * 256;
            if constexpr (F9) att::attn_body<false, 512, 1024, 512, 2, unsigned char, 16>(QX + r0 * 512 + h * 128, KVX + (size_t)b * MEML * 1024 + h * 128, KVX + (size_t)b * MEML * 1024 + 512 + h * 128, OX8 + r0 * 512 + h * 128,
                                                  MEML, (att::lptr)(F.lds + RING_OFF), 0, nullptr, 0, nullptr, F.wave);
            else att::attn_body<false, 512, 1024, 512, 2, bf16, 1>(QX + r0 * 512 + h * 128, KVX + (size_t)b * MEML * 1024 + h * 128, KVX + (size_t)b * MEML * 1024 + 512 + h * 128, OX + r0 * 512 + h * 128,
                                                  MEML, (att::lptr)(F.lds + RING_OFF), 0, nullptr, 0, nullptr, F.wave); } } SEAM(8);
    if (IN(9)) { pg8::Gemm g{F9 ? (const bf16*)OX8 : OX, (const bf16*)(ws + WS_WO), M, D, XW}; pg8::StaticOrder S; S.init(M, D, F.G, bx);
        typedef pg8::EpiResid<0, true, false> EP; EP E{nullptr, HB, nullptr, HB, SS + 4 * M, F9 ? WSC / 16.0f : 1.0f, nullptr, F10 ? HB8 : nullptr, 1.0f}; GEMM_RUN(EP, F9, g, S, E);
        if (DUPQ(9)) { EP E2{nullptr, HB, nullptr, HB, DUMMY, 0.0f, nullptr, F10 ? HB8 : nullptr, 1.0f}; GEMM_RUN(EP, F9, g, S, E2); } } SEAM(9);
    if (IN(10)) { pg8::Gemm g{F10 ? (const bf16*)HB8 : HB, (const bf16*)(ws + WS_WGU2), M, 2 * FF, D}; pg8::StaticOrder S; S.init(M, 2 * FF, F.G, bx);
        typedef pg8::EpiSwiglu<F11> EP; EP E{ACT, ACT8, FF, SS + 4 * M, F10 ? WSC : 1.0f, 4.0f}; GEMM_RUN(EP, F10, g, S, E); if (DUPQ(10)) GEMM_RUN(EP, F10, g, S, E); } SEAM(10);
    if (IN(11)) { pg8::Gemm g{F11 ? (const bf16*)ACT8 : ACT, (const bf16*)(ws + WS_WD2), M, D, FF}; pg8::StaticOrder S; S.init(M, D, F.G, bx);
        typedef pg8::EpiResid<0, true, false> EP; EP E{nullptr, HB, nullptr, HB, SS + 5 * M, F11 ? 0.5f * WSC / 4.0f : 0.5f, nullptr, nullptr, 1.0f}; GEMM_RUN(EP, F11, g, S, E);
        if (DUPQ(11)) { EP E2{nullptr, HB, nullptr, HB, DUMMY, 0.0f, nullptr, nullptr, 1.0f}; GEMM_RUN(EP, F11, g, S, E2); } } SEAM(11);
    if (IN(12)) { p12_final(F, args); }
#undef GEMM_RUN
#undef DUPQ
#undef IN
#undef SEAM
}

extern "C" void kernel_launch(void* const* d_in, const int* in_sizes, int n_in, void* d_out, int out_size, void* d_ws, size_t ws_size, hipStream_t stream) {
    static int grid = 0;
    if (grid == 0) {
        if (n_in != 22 || in_sizes[0] != M * D || out_size != M * D || ws_size < WS_END) { fprintf(stderr, "kernel_launch: shape mismatch (n_in %d, in0 %d, out %d, ws %zu; need ws >= %zu); nothing launched\n", n_in, n_in > 0 ? in_sizes[0] : -1, out_size, ws_size, (size_t)WS_END); grid = -1; return; }
        int dev = 0, cus = 0, per_cu = 0;
        if (hipGetDevice(&dev) != hipSuccess || hipDeviceGetAttribute(&cus, hipDeviceAttributeMultiprocessorCount, dev) != hipSuccess) { grid = -1; return; }
        if (hipFuncSetAttribute((const void*)fwd_kernel, hipFuncAttributeMaxDynamicSharedMemorySize, LDS_BYTES) != hipSuccess) { fprintf(stderr, "kernel_launch: hipFuncSetAttribute failed\n"); grid = -1; return; }
        if (hipOccupancyMaxActiveBlocksPerMultiprocessor(&per_cu, (const void*)fwd_kernel, NWAVES * 64, LDS_BYTES) != hipSuccess || per_cu < 1) { fprintf(stderr, "kernel_launch: occupancy query reports %d workgroups per CU\n", per_cu); }
        (void)hipGetLastError();
        grid = cus;
    }
    if (grid < 0) return;
    if (hipMemsetAsync((char*)d_ws + WS_CTL, 0, CTL_ZERO_BYTES, stream) != hipSuccess) { fprintf(stderr, "kernel_launch: hipMemsetAsync failed\n"); return; }
    Args a{};
    for (int i = 0; i < 22; ++i) a.in[i] = (const float*)d_in[i];
    a.out = (float*)d_out; a.ws = (unsigned char*)d_ws;
    unsigned char* ws = (unsigned char*)d_ws; pg8::u64_t* SS = (pg8::u64_t*)(ws + WS_CTL + CTL_SS); float* KMS = (float*)(ws + WS_CTL + CTL_KMS); float* out = (float*)d_out;
    bf16* HB = (bf16*)(ws + WS_HB); bf16* ACT = (bf16*)(ws + WS_ACT); bf16* MIXED = (bf16*)(ws + WS_MIXED);
    bf16* Qb = (bf16*)(ws + WS_Q); bf16* Kb = (bf16*)(ws + WS_K); bf16* Vb = (bf16*)(ws + WS_V); bf16* CUb = (bf16*)(ws + WS_CU); bf16* BGb = (bf16*)(ws + WS_BG);
    bf16* QX = (bf16*)(ws + WS_QX); bf16* OX = (bf16*)(ws + WS_OX); bf16* KVX = (bf16*)(ws + WS_KVX);
    (void)SS; (void)KMS; (void)out; (void)HB; (void)ACT; (void)MIXED; (void)Qb; (void)Kb; (void)Vb; (void)CUb; (void)BGb; (void)QX; (void)OX; (void)KVX;
#if ONE_LAUNCH
    a.ph_lo = 0; a.ph_hi = NPH;
    hipLaunchKernelGGL(fwd_kernel, dim3(grid), dim3(NWAVES * 64), LDS_BYTES, stream, a);
#else
    for (int ph = 0; ph < NPH; ++ph) {
        if ((FAST_MASK >> ph) & 1) { a.ph_lo = ph; a.ph_hi = ph + 1; hipLaunchKernelGGL(fwd_kernel, dim3(grid), dim3(NWAVES * 64), LDS_BYTES, stream, a); continue; }
        switch (ph) {
        case 1: hipLaunchKernelGGL((nv::gemm<nv::FSwiglu>), dim3(FF / 64, M / 64), dim3(256), 0, stream, HB, (const bf16*)(ws + WS_WGU1), D, nv::FSwiglu{ACT, SS}); break;
        case 2: hipLaunchKernelGGL((nv::gemm<nv::FResid<0, false, false>>), dim3(D / 64, M / 64), dim3(256), 0, stream, ACT, (const bf16*)(ws + WS_WD1), FF, nv::FResid<0, false, false>{a.in[I_X], nullptr, nullptr, HB, SS + M, 0.5f, nullptr}); break;
        case 3: hipLaunchKernelGGL((nv::gemm<nv::FWin>), dim3(5120 / 64, M / 64), dim3(256), 0, stream, HB, (const bf16*)(ws + WS_WIN), D, nv::FWin{Qb, Kb, Vb, CUb, BGb, SS + M});
                hipLaunchKernelGGL(nv::kmean, dim3(BATCH * 16 * 8 * 128 / 256), dim3(256), 0, stream, Kb, KMS); break;
        case 4: hipLaunchKernelGGL(nv::moba, dim3(M * NH / 4), dim3(256), 0, stream, Qb, Kb, Vb, KMS, MIXED, SS + 2 * M); break;
        case 6: hipLaunchKernelGGL((nv::gemm<nv::FResid<1024, true, false>>), dim3(D / 64, M / 64), dim3(256), 0, stream, MIXED, (const bf16*)(ws + WS_WOUT), D, nv::FResid<1024, true, false>{nullptr, HB, nullptr, HB, SS + 3 * M, 1.0f, SS + 2 * M}); break;
        case 7: hipLaunchKernelGGL((nv::gemm<nv::FScale>), dim3(XW / 64, M / 64), dim3(256), 0, stream, HB, (const bf16*)(ws + WS_WQ), D, nv::FScale{QX, XW, SS + 3 * M});
                hipLaunchKernelGGL((nv::gemm<nv::FScale>), dim3(1024 / 64, BATCH * MEML / 64), dim3(256), 0, stream, (const bf16*)(ws + WS_MEMN), (const bf16*)(ws + WS_WKV), D, nv::FScale{KVX, 1024, nullptr}); break;
        case 8: hipLaunchKernelGGL(nv::xattn, dim3(M * XH / 4), dim3(256), 0, stream, QX, KVX, OX); break;
        case 9: hipLaunchKernelGGL((nv::gemm<nv::FResid<0, true, false>>), dim3(D / 64, M / 64), dim3(256), 0, stream, OX, (const bf16*)(ws + WS_WO), XW, nv::FResid<0, true, false>{nullptr, HB, nullptr, HB, SS + 4 * M, 1.0f, nullptr}); break;
        case 10: hipLaunchKernelGGL((nv::gemm<nv::FSwiglu>), dim3(FF / 64, M / 64), dim3(256), 0, stream, HB, (const bf16*)(ws + WS_WGU2), D, nv::FSwiglu{ACT, SS + 4 * M}); break;
        case 11: hipLaunchKernelGGL((nv::gemm<nv::FResid<0, true, false>>), dim3(D / 64, M / 64), dim3(256), 0, stream, ACT, (const bf16*)(ws + WS_WD2), FF, nv::FResid<0, true, false>{nullptr, HB, nullptr, HB, SS + 5 * M, 0.5f, nullptr}); break;
        default: break;
        }
    }
#endif
    const hipError_t le = hipPeekAtLastError();
    if (le != hipSuccess) fprintf(stderr, "kernel_launch: launch failed: %s\n", hipGetErrorName(le));
}
```
